# Optimizing an MI355X kernel written in HIP

```python
import math
import jax
import jax.numpy as jnp
from jax import lax
import numpy as np

D_MODEL = 2048
BATCH = 4
SEQ = 2048
DEPTH = 2

HEAD_DIM = 128
N_HEADS = D_MODEL // 256
BRANCH_WIDTH = N_HEADS * HEAD_DIM
N_BRANCHES = 3
MLSTM_CHUNK = 64
CONV_WIDTH = 4
IDX_HEADS = 16
IDX_DIM = 64
TOPK_MAX = 256
N_BUCKETS = 32
MAX_DISTANCE = 128
Q_BLOCK = 128
N_GROUPS = 4
EXPERTS_PER_GROUP = 8
N_EXPERTS = N_GROUPS * EXPERTS_PER_GROUP
TOP_K_INNER = 2
D_EXPERT = D_MODEL // 4
EPS = 1e-6
N_IN = (4 * BRANCH_WIDTH + 2 * N_HEADS
        + 3 * BRANCH_WIDTH + IDX_HEADS * IDX_DIM + IDX_DIM + IDX_HEADS
        + 3 * BRANCH_WIDTH + N_BRANCHES * D_MODEL)

kernel_name = "hybrid_mlstm_dsa_stickbreak_hmoe"


def _in_sizes():
    bw = BRANCH_WIDTH
    return (bw, bw, bw, bw, N_HEADS, N_HEADS,
            bw, bw, bw, IDX_HEADS * IDX_DIM, IDX_DIM, IDX_HEADS,
            bw, bw, bw,
            N_BRANCHES * D_MODEL)


def rms_norm(x, g):
    xf = x.astype(jnp.float32)
    return xf * lax.rsqrt(jnp.mean(xf * xf, axis=-1, keepdims=True) + EPS) * g.astype(jnp.float32)


def causal_dwconv(x, w):
    c = x.shape[-1]
    return lax.conv_general_dilated(x, w[:, None, :].astype(x.dtype), window_strides=(1,),
                                    padding=[(CONV_WIDTH - 1, 0)],
                                    dimension_numbers=('NWC', 'WIO', 'NWC'),
                                    feature_group_count=c)


def t5_bucket(rel):
    n = jnp.maximum(rel, 0)
    max_exact = N_BUCKETS // 2
    nf = jnp.maximum(n, 1).astype(jnp.float32)
    large = max_exact + (jnp.log(nf / max_exact) / math.log(MAX_DISTANCE / max_exact)
                         * (N_BUCKETS - max_exact)).astype(jnp.int32)
    large = jnp.minimum(large, N_BUCKETS - 1)
    return jnp.where(n < max_exact, n, large)


def mlstm(q, k, v, i_pre, f_pre):
    B, S, H, d = q.shape
    L = MLSTM_CHUNK
    nc = S // L
    f32 = jnp.float32

    def chunks(t):
        t = t.astype(f32).reshape((B, nc, L, H) + t.shape[3:])
        return jnp.moveaxis(jnp.moveaxis(t, 1, 0), 3, 2)

    qc = chunks(q) * d ** -0.5
    kc, vc = chunks(k), chunks(v)
    ic = chunks(i_pre)
    lfc = jax.nn.log_sigmoid(chunks(f_pre))
    causal = jnp.tril(jnp.ones((L, L), dtype=bool))

    def step(carry, inp):
        C, n, m = carry
        qt, kt, vt, it, lft = inp
        b = jnp.cumsum(lft, axis=-1)
        dlog = jnp.where(causal, b[..., :, None] - b[..., None, :] + it[..., None, :], -jnp.inf)
        inter = b + m[..., None]
        m_t = jnp.maximum(inter, jnp.max(dlog, axis=-1))
        w_intra = jnp.exp(dlog - m_t[..., None])
        w_inter = jnp.exp(inter - m_t)
        s = jnp.einsum('bhtk,bhsk->bhts', qt, kt) * w_intra
        num = (w_inter[..., None] * jnp.einsum('bhvk,bhtk->bhtv', C, qt)
               + jnp.einsum('bhts,bhsv->bhtv', s, vt))
        den = w_inter * jnp.einsum('bhk,bhtk->bht', n, qt) + jnp.sum(s, axis=-1)
        h = num / jnp.maximum(jnp.abs(den), jnp.exp(-m_t))[..., None]
        b_end = b[..., -1]
        wlog = b_end[..., None] - b + it
        m_new = jnp.maximum(b_end + m, jnp.max(wlog, axis=-1))
        decay = jnp.exp(b_end + m - m_new)
        ws = jnp.exp(wlog - m_new[..., None])
        C_new = decay[..., None, None] * C + jnp.einsum('bhsv,bhsk->bhvk', vt * ws[..., None], kt)
        n_new = decay[..., None] * n + jnp.einsum('bhs,bhsk->bhk', ws, kt)
        return (C_new, n_new, m_new), h

    init = (jnp.zeros((B, H, d, d), f32), jnp.zeros((B, H, d), f32), jnp.zeros((B, H), f32))
    _, h = lax.scan(step, init, (qc, kc, vc, ic, lfc))
    return jnp.moveaxis(h, 0, 1).swapaxes(2, 3).reshape(B, S, H, d)


def dsa_attention(q, k, v, q_idx, k_idx, w_idx, rel_bias):
    B, S, H, d = q.shape
    topk = min(TOPK_MAX, S // 4)
    key_pos = jnp.arange(S)

    def block(start):
        qb = lax.dynamic_slice_in_dim(q, start, Q_BLOCK, axis=1)
        qib = lax.dynamic_slice_in_dim(q_idx, start, Q_BLOCK, axis=1)
        wib = lax.dynamic_slice_in_dim(w_idx, start, Q_BLOCK, axis=1)
        q_pos = start + jnp.arange(Q_BLOCK)
        r = jax.nn.relu(jnp.einsum('bthe,bse->bths', qib, k_idx) * IDX_DIM ** -0.5)
        score = jnp.einsum('bth,bths->bts', wib * IDX_HEADS ** -0.5, r).astype(jnp.float32)
        score = jnp.where(key_pos[None, :] <= q_pos[:, None], score, -jnp.inf)
        _, sel = lax.top_k(score, topk)
        valid = sel <= q_pos[None, :, None]
        k_sel = jax.vmap(lambda kk, ii: kk[ii])(k, sel)
        v_sel = jax.vmap(lambda vv, ii: vv[ii])(v, sel)
        logits = jnp.einsum('bthd,btkhd->bhtk', qb, k_sel).astype(jnp.float32) * d ** -0.5
        bias = rel_bias[t5_bucket(q_pos[None, :, None] - sel)]
        logits = logits + jnp.moveaxis(bias, 3, 1).astype(jnp.float32)
        logits = jnp.where(valid[:, None], logits, -jnp.inf)
        p = jax.nn.softmax(logits, axis=-1)
        return jnp.einsum('bhtk,btkhd->bthd', p, v_sel)

    out = lax.map(block, jnp.arange(S // Q_BLOCK) * Q_BLOCK)
    return jnp.moveaxis(out, 0, 1).reshape(B, S, H, d)


def stick_breaking(q, k, v):
    B, S, H, d = q.shape
    key_pos = jnp.arange(S)

    def block(start):
        qb = lax.dynamic_slice_in_dim(q, start, Q_BLOCK, axis=1)
        q_pos = start + jnp.arange(Q_BLOCK)
        z = jnp.einsum('bthd,bshd->bhts', qb, k).astype(jnp.float32) * d ** -0.5
        strict = key_pos[None, :] < q_pos[:, None]
        log_not = jnp.where(strict, jax.nn.log_sigmoid(-z), 0.0)
        suffix = lax.cumsum(log_not, axis=3, reverse=True) - log_not
        a = jnp.where(strict, jnp.exp(jax.nn.log_sigmoid(z) + suffix), 0.0)
        return jnp.einsum('bhts,bshd->bthd', a, v)

    out = lax.map(block, jnp.arange(S // Q_BLOCK) * Q_BLOCK)
    return jnp.moveaxis(out, 0, 1).reshape(B, S, H, d)


def token_mixer(xn, w_in, conv_w, b_i, b_f, mlstm_norm_g, q_norm_g, k_norm_g, w_branch, w_out, rel_bias):
    B, S, D = xn.shape
    proj = xn @ w_in
    offs = np.cumsum(_in_sizes())[:-1].tolist()
    (mq, mk, mv, mo, mi, mf, dq, dk, dv, iq, ik, iw, sq, sk, sv, gpre) = jnp.split(proj, offs, axis=-1)

    def heads(t):
        return t.reshape(B, S, N_HEADS, HEAD_DIM)

    qk = jax.nn.silu(causal_dwconv(jnp.concatenate([mq, mk], axis=-1), conv_w))
    mq, mk = jnp.split(qk, 2, axis=-1)
    h_m = mlstm(heads(mq), heads(mk), heads(mv), mi + b_i, mf + b_f)
    h_m = rms_norm(h_m, mlstm_norm_g.reshape(N_HEADS, HEAD_DIM)) * jax.nn.sigmoid(heads(mo))
    h_d = dsa_attention(rms_norm(heads(dq), q_norm_g), rms_norm(heads(dk), k_norm_g), heads(dv),
                        iq.reshape(B, S, IDX_HEADS, IDX_DIM), ik, iw, rel_bias)
    h_s = stick_breaking(heads(sq), heads(sk), heads(sv))

    branches = jnp.stack([h_m.reshape(B, S, BRANCH_WIDTH),
                          h_d.reshape(B, S, BRANCH_WIDTH).astype(jnp.float32),
                          h_s.reshape(B, S, BRANCH_WIDTH).astype(jnp.float32)], axis=0)
    up = jnp.einsum('nbsc,ncd->nbsd', branches, w_branch)
    gates = jax.nn.sigmoid(gpre.reshape(B, S, N_BRANCHES, D))
    merged = jnp.einsum('bsnd,nbsd->bsd', gates, up)
    return merged @ w_out


def hier_moe(xn, w_rg, b_rg, w_re, b_re, w_gate, w_up, w_down):
    B, S, D = xn.shape
    n_tok = B * S
    xf = xn.reshape(n_tok, D)
    tok = jnp.arange(n_tok)
    g_logits = (xf @ w_rg).astype(jnp.float32)
    g_sel = jnp.argmax(g_logits + b_rg, axis=-1)
    p_group = jax.nn.softmax(g_logits, axis=-1)[tok, g_sel][:, None]
    e_logits = (xf @ w_re).astype(jnp.float32).reshape(n_tok, N_GROUPS, EXPERTS_PER_GROUP)
    e_in = e_logits[tok, g_sel]
    _, top_e = lax.top_k(e_in + b_re[g_sel], TOP_K_INNER)
    w_top = jnp.take_along_axis(jax.nn.softmax(e_in, axis=-1), top_e, axis=-1)
    w_top = p_group * w_top / jnp.sum(w_top, axis=-1, keepdims=True)
    expert_id = g_sel[:, None] * EXPERTS_PER_GROUP + top_e
    comb = jnp.sum(jax.nn.one_hot(expert_id, N_EXPERTS, dtype=jnp.float32) * w_top[..., None], axis=1)
    h = jax.nn.silu(jnp.einsum('nd,edf->nef', xf, w_gate)) * jnp.einsum('nd,edf->nef', xf, w_up)
    y = jnp.einsum('nef,efd->nd', h * comb[..., None], w_down)
    return y.reshape(B, S, D)


def setup_inputs(seed: int = 0) -> dict:
    key = jax.random.key(seed)
    ks = jax.random.split(key, 20)
    f32 = jnp.float32
    bw = BRANCH_WIDTH

    def nrm(k, shape, scale):
        return jax.random.normal(k, shape, f32) * scale

    return {
        "x": nrm(ks[0], (BATCH, SEQ, D_MODEL), 1.0),
        "norm1_g": 1.0 + nrm(ks[1], (DEPTH, D_MODEL), 0.02),
        "w_in": nrm(ks[2], (DEPTH, D_MODEL, N_IN), D_MODEL ** -0.5),
        "conv_w": nrm(ks[3], (DEPTH, CONV_WIDTH, 2 * bw), CONV_WIDTH ** -0.5),
        "b_i": nrm(ks[4], (DEPTH, N_HEADS), 0.1),
        "b_f": jnp.linspace(3.0, 6.0, N_HEADS, dtype=f32)[None, :] + nrm(ks[5], (DEPTH, N_HEADS), 0.1),
        "mlstm_norm_g": 1.0 + nrm(ks[6], (DEPTH, bw), 0.02),
        "q_norm_g": 1.0 + nrm(ks[7], (DEPTH, HEAD_DIM), 0.02),
        "k_norm_g": 1.0 + nrm(ks[8], (DEPTH, HEAD_DIM), 0.02),
        "w_branch": nrm(ks[9], (DEPTH, N_BRANCHES, bw, D_MODEL), bw ** -0.5),
        "w_out": nrm(ks[10], (DEPTH, D_MODEL, D_MODEL), D_MODEL ** -0.5),
        "norm2_g": 1.0 + nrm(ks[11], (DEPTH, D_MODEL), 0.02),
        "w_router_g": nrm(ks[12], (DEPTH, D_MODEL, N_GROUPS), D_MODEL ** -0.5),
        "b_router_g": nrm(ks[13], (DEPTH, N_GROUPS), 0.01),
        "w_router_e": nrm(ks[14], (DEPTH, D_MODEL, N_EXPERTS), D_MODEL ** -0.5),
        "b_router_e": nrm(ks[15], (DEPTH, N_GROUPS, EXPERTS_PER_GROUP), 0.01),
        "w_gate": nrm(ks[16], (DEPTH, N_EXPERTS, D_MODEL, D_EXPERT), D_MODEL ** -0.5),
        "w_up": nrm(ks[17], (DEPTH, N_EXPERTS, D_MODEL, D_EXPERT), D_MODEL ** -0.5),
        "w_down": nrm(ks[18], (DEPTH, N_EXPERTS, D_EXPERT, D_MODEL), D_EXPERT ** -0.5),
        "rel_bias": nrm(ks[19], (N_BUCKETS, N_HEADS), 0.5),
    }


def reference(x, norm1_g, w_in, conv_w, b_i, b_f, mlstm_norm_g, q_norm_g, k_norm_g, w_branch, w_out,
              norm2_g, w_router_g, b_router_g, w_router_e, b_router_e, w_gate, w_up, w_down, rel_bias):
    for l in range(DEPTH):
        xn = rms_norm(x, norm1_g[l])
        mix = token_mixer(xn, w_in[l], conv_w[l], b_i[l], b_f[l], mlstm_norm_g[l], q_norm_g[l],
                          k_norm_g[l], w_branch[l], w_out[l], rel_bias)
        x = x + mix.astype(x.dtype)
        xn = rms_norm(x, norm2_g[l])
        ffn = hier_moe(xn, w_router_g[l], b_router_g[l], w_router_e[l], b_router_e[l],
                       w_gate[l], w_up[l], w_down[l])
        x = x + ffn.astype(x.dtype)
    return x
```

```cpp
#include <hip/hip_runtime.h>
#include <cstdio>
#include <cstdint>

constexpr int BATCH = 4, SEQ = 2048, DM = 2048, NTOK = BATCH * SEQ, NH = 8, HD = 128, BW = 1024, DEPTH = 2;
constexpr int NIN = 17504, PW = 17664;
constexpr int IDXH = 16, IDXD = 64, TOPK = 256, NEXP = 32, NGRP = 4, EPG = 8, DEXP = 512, MCH = 64, NCH = SEQ / MCH;
constexpr float EPS = 1e-6f;
constexpr int C_MQ = 0, C_MK = 1024, C_MV = 2048, C_MO = 3072, C_DQ = 4096, C_DK = 5120, C_DV = 6144, C_IQ = 7168, C_SQ = 8192, C_SK = 9216, C_SV = 10240,
              C_G = 11264, C_MI = 17408, C_MF = 17416, C_IK = 17424, C_IW = 17488;
__host__ __device__ __forceinline__ int src_col(int c) {
    if (c < 4096) return c;
    if (c < 8192) return c + 16;
    if (c < 17408) return c + 96;
    if (c < 17424) return 4096 + (c - 17408);
    if (c < 17488) return 8208 + (c - 17424);
    if (c < 17504) return 8272 + (c - 17488);
    return -1;
}

constexpr size_t MiB = 1u << 20;
constexpr size_t WS_CTL = 0, CTL_ZERO_BYTES = 1 * MiB;
constexpr size_t WS_WIN = 1 * MiB;
constexpr size_t WS_WBR = WS_WIN + 69 * MiB;
constexpr size_t WS_WOUT = WS_WBR + 12 * MiB;
constexpr size_t WS_WGU = WS_WOUT + 8 * MiB;
constexpr size_t WS_WDN = WS_WGU + 128 * MiB;
constexpr size_t WS_XN = WS_WDN + 64 * MiB;
constexpr size_t WS_XA = WS_XN + 32 * MiB;
constexpr size_t WS_X1 = WS_XA + 64 * MiB;
constexpr size_t WS_PROJ = WS_X1 + 64 * MiB;
constexpr size_t WS_BR = WS_PROJ + 276 * MiB;
constexpr size_t WS_MRG = WS_BR + 48 * MiB;
constexpr size_t WS_MASK = WS_MRG + 32 * MiB;
constexpr size_t WS_MDEL = WS_MASK + 2 * MiB;
constexpr size_t WS_MDN = WS_MDEL + 64 * MiB;
constexpr size_t WS_MST = WS_MDN + 1 * MiB;
constexpr size_t WS_MSN = WS_MST + 32 * MiB;
constexpr size_t WS_HB = WS_MSN + 1 * MiB;
constexpr size_t WS_YB = WS_HB + 16 * MiB;
constexpr size_t WS_LIST = WS_YB + 64 * MiB;
constexpr size_t WS_TMP = WS_LIST + 2 * MiB;
constexpr size_t WS_END = WS_TMP + 96 * MiB;
static_assert(WS_END <= 1100 * MiB, "workspace map");

constexpr int CW_BAR = 4096;
constexpr int CW_ECNT = 16384;

#define GAS __attribute__((address_space(1)))
#define LAS __attribute__((address_space(3)))
typedef unsigned short bf16;
typedef unsigned v4u __attribute__((ext_vector_type(4)));
typedef unsigned v2u __attribute__((ext_vector_type(2)));
typedef float f32x4 __attribute__((ext_vector_type(4)));
typedef float f32x2 __attribute__((ext_vector_type(2)));
typedef float f32x16 __attribute__((ext_vector_type(16)));
typedef short bf16x8 __attribute__((ext_vector_type(8)));
typedef short s16x4 __attribute__((ext_vector_type(4)));
#define RLX_AGENT __ATOMIC_RELAXED, __HIP_MEMORY_SCOPE_AGENT
#define LDS_WAIT() asm volatile("s_waitcnt lgkmcnt(0)" ::: "memory")
#define VM_WAIT() asm volatile("s_waitcnt vmcnt(0)" ::: "memory")
constexpr int NWAVES = 8, NTHR = 512;
constexpr int RING_BYTES = 131072, LDSCTL_OFF = RING_BYTES, LDS_BYTES = 147456;

__device__ __forceinline__ unsigned f2bf(float f) { unsigned u = __builtin_bit_cast(unsigned, f); return (u + 0x7fffu + ((u >> 16) & 1u)) >> 16; }
__device__ __forceinline__ unsigned pk2(float lo, float hi) { return f2bf(lo) | (f2bf(hi) << 16); }
__device__ __forceinline__ float bf2f(unsigned short b) { return __builtin_bit_cast(float, ((unsigned)b) << 16); }
__device__ __forceinline__ float bflo(unsigned w) { return __builtin_bit_cast(float, w << 16); }
__device__ __forceinline__ float bfhi(unsigned w) { return __builtin_bit_cast(float, w & 0xffff0000u); }
__device__ __forceinline__ unsigned cvt_pk_bf16(float lo, float hi) { unsigned r; asm volatile("v_cvt_pk_bf16_f32 %0, %1, %2" : "=v"(r) : "v"(lo), "v"(hi)); return r; }
__device__ __forceinline__ float wave_sum(float v) {
#pragma unroll
    for (int o = 1; o < 64; o <<= 1) v += __shfl_xor(v, o);
    return v;
}
__device__ __forceinline__ float wave_max(float v) {
#pragma unroll
    for (int o = 1; o < 64; o <<= 1) v = fmaxf(v, __shfl_xor(v, o));
    return v;
}
__device__ __forceinline__ float sigmoidf_(float x) { return 1.0f / (1.0f + __expf(-x)); }
__device__ __forceinline__ float siluf_(float x) { return x / (1.0f + __expf(-x)); }
__device__ __forceinline__ float logsigmoidf_(float x) { return fminf(x, 0.f) - log1pf(__expf(-fabsf(x))); }
__device__ __forceinline__ int t5_bucket(int n) {
    if (n < 16) return n;
    return 16 + (n >= 19) + (n >= 21) + (n >= 24) + (n >= 27) + (n >= 31) + (n >= 35) + (n >= 40) + (n >= 46) + (n >= 52) + (n >= 59) + (n >= 67) + (n >= 77) + (n >= 87) + (n >= 99) + (n >= 113);
}
namespace pg8 {
constexpr int BM = 256, BK = 64, HALF = 128, HTB = HALF * BK * 2, STAGE_BYTES = 8 * HTB, NXCD = 8, WGM = 8;
__host__ __device__ __forceinline__ int lds_byte(int r, int c) { const int st = (r >> 4) * 2 + (c >> 5), rr = r & 15, cc = c & 31, ob = rr * 64 + cc * 2; return st * 1024 + (ob ^ (((ob >> 9) & 1) << 5)); }
__host__ __device__ __forceinline__ void stage_rc(int b, int& R, int& C) { const int st = b / 1024, sb = b % 1024, swz = sb ^ (((sb >> 9) & 1) << 5); R = (st >> 1) * 16 + swz / 64; C = (st & 1) * 32 + (swz % 64) / 2; }
__host__ __device__ __forceinline__ int perm32(int rho) { const int n = rho >> 4, i = rho & 15; return 8 * (i >> 2) + 4 * n + (i & 3); }

struct Unit { int pm, pn, e, rows; };

struct TileOrder {
    int nM, nN, nwg, G, c;
    __device__ void init(int nM_, int nN_, int G_, int c_) { nM = nM_; nN = nN_; nwg = nM * nN; G = G_; c = c_; }
    __device__ bool tile(int i, int& pm, int& pn) const {
        const long L = (long)i * G + c; if (L >= nwg) return false;
        int wgid = (int)L; { const int q = nwg / NXCD, r = nwg % NXCD, xcd = wgid % NXCD, off = wgid / NXCD; wgid = (xcd < r ? xcd * (q + 1) : r * (q + 1) + (xcd - r) * q) + off; }
        const int nig = WGM * nN, gid = wgid / nig, fm = gid * WGM, gsz = (nM - fm) < WGM ? (nM - fm) : WGM;
        pm = fm + ((wgid % nig) % gsz); pn = (wgid % nig) / gsz; return true;
    }
};

template <class Sched, class Epi, int K, int LDA, int LDB, bool ALIGN_EPI>
__device__ __forceinline__ void gemm_phase(LAS unsigned char* lds, const Sched& S, const Epi& E) {
    int tid_ = threadIdx.x; asm volatile("" : "+v"(tid_));
    const int tid = tid_, wid = __builtin_amdgcn_readfirstlane(tid >> 6), lane = tid & 63, wr = wid >> 2, wc = wid & 3, fr = lane & 15, fq = lane >> 4;
    constexpr int nt = K / BK;
    static_assert(K % 128 == 0 && K >= 256, "K");
    int Rr[2], Cc[2];
    unsigned voffB[2];
#pragma unroll
    for (int i = 0; i < 2; ++i) { int R, C; stage_rc(tid * 16 + i * 8192, R, C); Rr[i] = R; Cc[i] = C; const int Rb = Epi::PERM ? ((R & ~31) + perm32(R & 31)) : R;
        voffB[i] = (unsigned)(Rb * LDB + C) * 2u; }
    constexpr size_t kstep = (size_t)(BK * 2);
    constexpr size_t hstepB = (size_t)HALF * LDB * 2;
    constexpr size_t hstepA = Sched::GATHER ? 0 : (size_t)HALF * LDA * 2;
    const unsigned ldsw = (unsigned)wid * 1024u;
    const int aoff = lds_byte(wr * 64 + fr, fq * 8), boff = lds_byte(wc * 32 + fr, fq * 8);
#define PG8_SA(b, h) (((b) * 2 + (h)) * HTB)
#define PG8_SB(b, h) ((4 + (b) * 2 + (h)) * HTB)
#define PG8_STAGE(bufoff, gbase, voff) do { _Pragma("unroll") for (int _i = 0; _i < 2; ++_i) \
        __builtin_amdgcn_global_load_lds((const unsigned*)((const char*)(gbase) + (voff)[_i]), (LAS unsigned*)(lds + (bufoff) + ldsw + _i * 8192), 16, 0, 0); } while (0)
#define PG8_LDA(dst, b, h) do { _Pragma("unroll") for (int m = 0; m < 4; ++m) _Pragma("unroll") for (int k = 0; k < 2; ++k) dst[m][k] = *(const LAS bf16x8*)(lds + PG8_SA(b, h) + aoff + m * 2048 + k * 1024); } while (0)
#define PG8_LDB(dst, b, h) do { _Pragma("unroll") for (int n = 0; n < 2; ++n) _Pragma("unroll") for (int k = 0; k < 2; ++k) dst[n][k] = *(const LAS bf16x8*)(lds + PG8_SB(b, h) + boff + n * 2048 + k * 1024); } while (0)
#define PG8_MMA(ai, bj, At, Bt) do { __builtin_amdgcn_s_setprio(1); _Pragma("unroll") for (int m = 0; m < 4; ++m) _Pragma("unroll") for (int n = 0; n < 2; ++n) _Pragma("unroll") for (int k = 0; k < 2; ++k) \
        acc[ai][bj][m][n] = __builtin_amdgcn_mfma_f32_16x16x32_bf16(Bt[n][k], At[m][k], acc[ai][bj][m][n], 0, 0, 0); __builtin_amdgcn_s_setprio(0); } while (0)
#define VA1 (Sched::GATHER ? vA1 : vA0)
#define W0 (Sched::GATHER ? w0 : vA0)
#define W1 (Sched::GATHER ? w1 : vA0)
#define PG8_WAIT_V(n) asm volatile("s_waitcnt vmcnt(" #n ")" ::: "memory")
#define PG8_WAIT_L(n) asm volatile("s_waitcnt lgkmcnt(" #n ")" ::: "memory")
#define PG8_BAR __builtin_amdgcn_s_barrier()
#define PG8_SCHED __builtin_amdgcn_sched_barrier(0)
    Unit cur, nxt; int ui = 0;
    if (!S.next(0, cur)) return;
    f32x4 acc[2][2][4][2];
#pragma unroll
    for (int a = 0; a < 2; ++a)
#pragma unroll
        for (int b = 0; b < 2; ++b)
#pragma unroll
            for (int m = 0; m < 4; ++m)
#pragma unroll
                for (int n = 0; n < 2; ++n) acc[a][b][m][n] = (f32x4){0.f, 0.f, 0.f, 0.f};
    bf16x8 At[4][2], B0[2][2], B1[2][2];
    unsigned vA0[2], vA1[2], nA0[2], nA1[2];
    S.a_off(cur, Rr, Cc, vA0, vA1);
    if constexpr (Sched::GATHER) {
#pragma unroll
        for (int i = 0; i < 2; ++i) { nA0[i] = vA0[i]; nA1[i] = vA1[i]; } }
    const char* cA = S.a_base(cur); const char* cB = S.b_base(cur);
    PG8_STAGE(PG8_SB(0, 0), cB, voffB); PG8_STAGE(PG8_SB(0, 1), cB + hstepB, voffB); PG8_STAGE(PG8_SA(0, 0), cA, vA0); PG8_STAGE(PG8_SA(0, 1), cA + hstepA, VA1);
    if (wr == 1) PG8_BAR;
    PG8_WAIT_V(2); PG8_BAR;
    PG8_STAGE(PG8_SB(1, 0), cB + kstep, voffB); PG8_STAGE(PG8_SA(1, 0), cA + kstep, vA0); PG8_STAGE(PG8_SB(1, 1), cB + hstepB + kstep, voffB);
    PG8_WAIT_V(6); PG8_BAR;
    for (;;) {
        const bool has_next = S.next(ui + 1, nxt);
        const char* nA = has_next ? S.a_base(nxt) : cA; const char* nB = has_next ? S.b_base(nxt) : cB;
        if constexpr (Sched::GATHER) { if (has_next) S.a_off(nxt, Rr, Cc, nA0, nA1); }
        for (int t = 0; t < nt; t += 2) {
            const bool last = (t == nt - 2);
            const char* a1 = cA + (size_t)(t + 1) * kstep;
            const char* a2 = last ? nA : cA + (size_t)(t + 2) * kstep; const char* b2 = last ? nB : cB + (size_t)(t + 2) * kstep;
            const char* a3 = a2 + kstep; const char* b3 = b2 + kstep;
            unsigned w0[2], w1[2];
            if constexpr (Sched::GATHER) {
#pragma unroll
                for (int i = 0; i < 2; ++i) { w0[i] = last ? nA0[i] : vA0[i]; w1[i] = last ? nA1[i] : vA1[i]; } }
            PG8_LDB(B0, 0, 0); PG8_LDB(B1, 0, 1); PG8_SCHED; PG8_LDA(At, 0, 0); PG8_STAGE(PG8_SA(1, 1), a1 + hstepA, VA1);
            PG8_WAIT_V(8); PG8_WAIT_L(0); PG8_BAR; PG8_MMA(0, 0, At, B0); PG8_MMA(0, 1, At, B1); PG8_BAR; PG8_SCHED;
            PG8_LDA(At, 0, 1); PG8_STAGE(PG8_SB(0, 0), b2, voffB); PG8_STAGE(PG8_SB(0, 1), b2 + hstepB, voffB); PG8_STAGE(PG8_SA(0, 0), a2, W0);
            PG8_WAIT_V(8); PG8_WAIT_L(0); PG8_BAR; PG8_MMA(1, 0, At, B0); PG8_MMA(1, 1, At, B1); PG8_BAR; PG8_SCHED;
            PG8_LDB(B0, 1, 0); PG8_LDB(B1, 1, 1); PG8_SCHED; PG8_LDA(At, 1, 0); PG8_STAGE(PG8_SA(0, 1), a2 + hstepA, W1);
            PG8_WAIT_V(8); PG8_WAIT_L(0); PG8_BAR; PG8_MMA(0, 0, At, B0); PG8_MMA(0, 1, At, B1); PG8_BAR; PG8_SCHED;
            PG8_LDA(At, 1, 1); PG8_STAGE(PG8_SB(1, 0), b3, voffB); PG8_STAGE(PG8_SB(1, 1), b3 + hstepB, voffB); PG8_STAGE(PG8_SA(1, 0), a3, W0);
            PG8_WAIT_V(8); PG8_WAIT_L(0); PG8_BAR; PG8_MMA(1, 0, At, B0); PG8_MMA(1, 1, At, B1); PG8_BAR; PG8_SCHED;
        }
        if constexpr (ALIGN_EPI) { if (wr == 0) PG8_BAR; }
        E(acc, cur, wr, wc, fr, fq);
        if (!has_next) break;
#pragma unroll
        for (int a = 0; a < 2; ++a)
#pragma unroll
            for (int b = 0; b < 2; ++b)
#pragma unroll
                for (int m = 0; m < 4; ++m)
#pragma unroll
                    for (int n = 0; n < 2; ++n) acc[a][b][m][n] = (f32x4){0.f, 0.f, 0.f, 0.f};
        cur = nxt; cA = nA; cB = nB; ++ui;
        if constexpr (Sched::GATHER) {
#pragma unroll
            for (int i = 0; i < 2; ++i) { vA0[i] = nA0[i]; vA1[i] = nA1[i]; } }
        if constexpr (ALIGN_EPI) { if (wr == 1) PG8_BAR; }
    }
    PG8_WAIT_V(0);
    if constexpr (!ALIGN_EPI) { if (wr == 0) PG8_BAR; }
    PG8_BAR;
#undef PG8_SA
#undef VA1
#undef W0
#undef W1
#undef PG8_SB
#undef PG8_STAGE
#undef PG8_LDA
#undef PG8_LDB
#undef PG8_MMA
#undef PG8_WAIT_V
#undef PG8_WAIT_L
#undef PG8_BAR
#undef PG8_SCHED
}
}
#define XB_TMO      128
#define XB_XCNT(j)  (256  + 64 * (j))
#define XB_XSUB(j)  (1280 + 64 * (j))
#define XB_XGEN(j)  (2304 + 64 * (j))
#define XB_TOP      3328
#define XB_TOPGEN   3392
#define XCD_BAR_WORDS 3456
#define XB_SPIN_CAP (1u << 18)
__device__ __forceinline__ unsigned xb_ld(unsigned* p)              { return __hip_atomic_load(p, __ATOMIC_RELAXED, __HIP_MEMORY_SCOPE_AGENT); }
__device__ __forceinline__ unsigned xb_add(unsigned* p, unsigned v) { return __hip_atomic_fetch_add(p, v, __ATOMIC_RELAXED, __HIP_MEMORY_SCOPE_AGENT); }
__device__ __forceinline__ unsigned xb_xcc_id() { return (unsigned)__builtin_amdgcn_s_getreg((3 << 11) | 20) & 0xFu; }
#define XB_SPIN(cond, bar) do { unsigned _sp = 0; while (cond) { __builtin_amdgcn_s_sleep(1); \
    if ((++_sp & 255u) == 0u) { if (xb_ld(&(bar)[XB_TMO])) break; if (_sp > XB_SPIN_CAP) { atomicAdd(&(bar)[XB_TMO], 1u); break; } } } } while (0)
struct XcdBarrier { unsigned* bar; unsigned x; volatile LAS unsigned* st; };
__device__ __forceinline__ XcdBarrier xcd_barrier_post(unsigned* bar, volatile LAS unsigned* st) {
    XcdBarrier b; b.bar = bar; b.x = xb_xcc_id(); b.st = st;
    if (threadIdx.x == 0) (void)xb_add(&bar[XB_XCNT(b.x)], 1u);
    return b;
}
__device__ __forceinline__ void xcd_barrier_complete(unsigned* bar, unsigned x, unsigned& nloc, unsigned& nx) {
    const unsigned G = gridDim.x * gridDim.y * gridDim.z;
    unsigned sum, cnt, mine, sp = 0u;
    for (;;) {
        sum = 0u; cnt = 0u; mine = 0u;
#pragma unroll
        for (unsigned j = 0; j < 16; ++j) { const unsigned c = xb_ld(&bar[XB_XCNT(j)]); sum += c; cnt += (c > 0u) ? 1u : 0u; mine = (j == x) ? c : mine; }
        if (sum == G) break;
        __builtin_amdgcn_s_sleep(1);
        if ((++sp & 255u) == 0u) { if (xb_ld(&bar[XB_TMO])) break; if (sp > XB_SPIN_CAP) { atomicAdd(&bar[XB_TMO], 1u); break; } }
    }
    nloc = mine > 0u ? mine : 1u; nx = cnt > 0u ? cnt : 1u;
}
__device__ __forceinline__ void xcd_barrier(const XcdBarrier& b) {
    asm volatile("s_waitcnt vmcnt(0)" ::: "memory");
    __syncthreads();
    if (threadIdx.x == 0) {
        unsigned* bar = b.bar;
        __builtin_amdgcn_s_waitcnt(0);
        unsigned nloc = b.st[0], nx = b.st[1];
        if (nloc == 0u) { xcd_barrier_complete(bar, b.x, nloc, nx); b.st[0] = nloc; b.st[1] = nx; }
        const unsigned old = xb_add(&bar[XB_XSUB(b.x)], 1u);
        const unsigned gen = old / nloc;
        if (old + 1u == (gen + 1u) * nloc) {
            __builtin_amdgcn_fence(__ATOMIC_RELEASE, "agent");
            asm volatile("s_waitcnt vmcnt(0)" ::: "memory");
            const unsigned og = xb_add(&bar[XB_TOP], 1u);
            const unsigned tg = og / nx;
            if (og + 1u == (tg + 1u) * nx) xb_add(&bar[XB_TOPGEN], 1u);
            else XB_SPIN(xb_ld(&bar[XB_TOPGEN]) == tg, bar);
            __builtin_amdgcn_fence(__ATOMIC_ACQUIRE, "agent");
            xb_add(&bar[XB_XGEN(b.x)], 1u);
            asm volatile("s_waitcnt vmcnt(0)" ::: "memory");
        } else {
            XB_SPIN(xb_ld(&bar[XB_XGEN(b.x)]) == gen, bar);
            __builtin_amdgcn_fence(__ATOMIC_ACQUIRE, "agent");
            asm volatile("s_waitcnt vmcnt(0)" ::: "memory");
        }
    }
    __syncthreads();
}

struct Args { const float* in[20]; float* out; unsigned char* ws; int ph_lo, ph_hi, use_bar, pad; };
struct Frame {
    LAS unsigned char* lds;
    unsigned* ctl;
    int tid, lane, wave, vcu, G;
    unsigned char* ws;
    const float* in[20];
};
#define GW_ID(F) ((F).vcu * NWAVES + (F).wave)
#define GW_N(F) ((F).G * NWAVES)

__device__ __forceinline__ void cvt_item(const float* W, int ldw, int k0, int srcc, bf16* WT, size_t out_row0, int ldo, LAS float* scr, int lane) {
#pragma unroll 8
    for (int i = 0; i < 32; ++i) { const int kk = 2 * i + (lane >> 5); scr[kk * 33 + (lane & 31)] = srcc >= 0 ? W[(size_t)(k0 + kk) * ldw + srcc] : 0.f; }
    LDS_WAIT(); asm volatile("" ::: "memory");
    const int c = lane & 7;
#pragma unroll
    for (int j = 0; j < 4; ++j) { const int n = (lane >> 3) + 8 * j; const LAS float* s = scr + (8 * c) * 33 + n;
        v4u o; o.x = pk2(s[0 * 33], s[1 * 33]); o.y = pk2(s[2 * 33], s[3 * 33]); o.z = pk2(s[4 * 33], s[5 * 33]); o.w = pk2(s[6 * 33], s[7 * 33]);
        *(v4u*)(WT + (out_row0 + n) * (size_t)ldo + k0 + 8 * c) = o; }
    LDS_WAIT(); asm volatile("" ::: "memory");
}
__device__ __forceinline__ void ph_convw(const Frame& F, int l) {
    LAS float* scr = (LAS float*)(F.lds + F.wave * 16384);
    const int gw = GW_ID(F), NGW = GW_N(F), lane = F.lane, ln = lane & 31;
    constexpr int I_IN = (PW / 32) * 32, I_BR = 3 * 64 * 16, I_OUT = 64 * 32, I_G = 32 * 16 * 32, I_D = 32 * 64 * 8;
    constexpr int NITEMS = I_IN + I_BR + I_OUT + 2 * I_G + I_D;
    for (int it = gw; it < NITEMS; it += NGW) {
        int r = it;
        if (r < I_IN) { const int kb = r / (PW / 32), nb = r % (PW / 32);
            cvt_item(F.in[2] + (size_t)l * DM * NIN, NIN, 64 * kb, src_col(32 * nb + ln), (bf16*)(F.ws + WS_WIN), (size_t)32 * nb, DM, scr, lane); continue; }
        r -= I_IN;
        if (r < I_BR) { const int n = r / (64 * 16), q = r % (64 * 16), kb = q / 64, nb = q % 64;
            cvt_item(F.in[9] + ((size_t)l * 3 + n) * BW * DM, DM, 64 * kb, 32 * nb + ln, (bf16*)(F.ws + WS_WBR) + (size_t)n * DM * BW, (size_t)32 * nb, BW, scr, lane); continue; }
        r -= I_BR;
        if (r < I_OUT) { const int kb = r / 64, nb = r % 64;
            cvt_item(F.in[10] + (size_t)l * DM * DM, DM, 64 * kb, 32 * nb + ln, (bf16*)(F.ws + WS_WOUT), (size_t)32 * nb, DM, scr, lane); continue; }
        r -= I_OUT;
        if (r < 2 * I_G) { const int up = r >= I_G; if (up) r -= I_G; const int e = r / (16 * 32), q = r % (16 * 32), kb = q / 16, nb = q % 16, f0 = 32 * nb;
            cvt_item(F.in[up ? 17 : 16] + ((size_t)l * NEXP + e) * DM * DEXP, DEXP, 64 * kb, f0 + ln, (bf16*)(F.ws + WS_WGU) + (size_t)e * 1024 * DM,
                     (size_t)((f0 >> 7) * 256 + (up ? 128 : 0) + (f0 & 127)), DM, scr, lane); continue; }
        r -= 2 * I_G;
        { const int e = r / (64 * 8), q = r % (64 * 8), kb = q / 64, nb = q % 64;
            cvt_item(F.in[18] + ((size_t)l * NEXP + e) * DEXP * DM, DM, 64 * kb, 32 * nb + ln, (bf16*)(F.ws + WS_WDN) + (size_t)e * DM * DEXP, (size_t)32 * nb, DEXP, scr, lane); }
    }
}

__device__ __forceinline__ int* tokinfo_ptr(const Frame& F) { return (int*)(F.ws + WS_LIST + MiB); }

__device__ __forceinline__ void ph_norm1(const Frame& F, int l) {
    const int gw = GW_ID(F), NGW = GW_N(F), lane = F.lane;
    const float* g = F.in[1] + (size_t)l * DM;
    bf16* XN = (bf16*)(F.ws + WS_XN);
    for (int m = gw; m < NTOK; m += NGW) {
        f32x4 v[8]; float s = 0.f;
        if (l == 0) {
            const f32x4* xr = (const f32x4*)(F.in[0] + (size_t)m * DM) + lane;
#pragma unroll
            for (int j = 0; j < 8; ++j) v[j] = xr[64 * j];
        } else {
            const f32x4* xr = (const f32x4*)((const float*)(F.ws + WS_X1) + (size_t)m * DM) + lane;
            const v2u* y0 = (const v2u*)((const bf16*)(F.ws + WS_YB) + (size_t)(2 * m) * DM) + lane;
            const v2u* y1 = (const v2u*)((const bf16*)(F.ws + WS_YB) + (size_t)(2 * m + 1) * DM) + lane;
            f32x4* xo = (f32x4*)((float*)(F.ws + WS_XA) + (size_t)m * DM) + lane;
#pragma unroll
            for (int j = 0; j < 8; ++j) { f32x4 x = xr[64 * j]; const v2u a = y0[64 * j], b = y1[64 * j];
                x.x = (x.x + bflo(a.x)) + bflo(b.x); x.y = (x.y + bfhi(a.x)) + bfhi(b.x); x.z = (x.z + bflo(a.y)) + bflo(b.y); x.w = (x.w + bfhi(a.y)) + bfhi(b.y);
                v[j] = x; xo[64 * j] = x; }
        }
#pragma unroll
        for (int j = 0; j < 8; ++j) s += (v[j].x * v[j].x + v[j].y * v[j].y) + (v[j].z * v[j].z + v[j].w * v[j].w);
        const float rstd = 1.0f / sqrtf(wave_sum(s) * (1.f / DM) + EPS);
        v2u* o8 = (v2u*)(XN + (size_t)m * DM) + lane;
        const f32x4* gr = (const f32x4*)g + lane;
#pragma unroll
        for (int j = 0; j < 8; ++j) { const f32x4 gg = gr[64 * j]; v2u o; o.x = pk2(v[j].x * rstd * gg.x, v[j].y * rstd * gg.y); o.y = pk2(v[j].z * rstd * gg.z, v[j].w * rstd * gg.w); o8[64 * j] = o; }
    }
}

__device__ __forceinline__ void ph_final(const Frame& F, float* out) {
    const int gw = GW_ID(F), NGW = GW_N(F), lane = F.lane;
    for (int m = gw; m < NTOK; m += NGW) {
        const f32x4* xr = (const f32x4*)((const float*)(F.ws + WS_X1) + (size_t)m * DM) + lane;
        const v2u* y0 = (const v2u*)((const bf16*)(F.ws + WS_YB) + (size_t)(2 * m) * DM) + lane;
        const v2u* y1 = (const v2u*)((const bf16*)(F.ws + WS_YB) + (size_t)(2 * m + 1) * DM) + lane;
        f32x4* xo = (f32x4*)(out + (size_t)m * DM) + lane;
#pragma unroll
        for (int j = 0; j < 8; ++j) { f32x4 x = xr[64 * j]; const v2u a = y0[64 * j], b = y1[64 * j];
            x.x = (x.x + bflo(a.x)) + bflo(b.x); x.y = (x.y + bfhi(a.x)) + bfhi(b.x); x.z = (x.z + bflo(a.y)) + bflo(b.y); x.w = (x.w + bfhi(a.y)) + bfhi(b.y);
            xo[64 * j] = x; }
    }
}

__device__ __forceinline__ void ph_norm2(const Frame& F, int l) {
    const int gw = GW_ID(F), NGW = GW_N(F), lane = F.lane;
    const float* g = F.in[11] + (size_t)l * DM;
    const float* wrg = F.in[12] + (size_t)l * DM * NGRP; const float* brg = F.in[13] + l * NGRP;
    const float* wre = F.in[14] + (size_t)l * DM * NEXP; const float* bre = F.in[15] + l * NEXP;
    bf16* XN = (bf16*)(F.ws + WS_XN);
    int* list = (int*)(F.ws + WS_LIST); int* tinfo = tokinfo_ptr(F);
    unsigned* ecnt = F.ctl + CW_ECNT + l * NEXP * 64;
    for (int m = gw; m < NTOK; m += NGW) {
        f32x4 v[8]; float s = 0.f;
        const f32x4* xr = (const f32x4*)((const float*)(F.ws + WS_X1) + (size_t)m * DM) + lane;
#pragma unroll
        for (int j = 0; j < 8; ++j) { v[j] = xr[64 * j]; s += (v[j].x * v[j].x + v[j].y * v[j].y) + (v[j].z * v[j].z + v[j].w * v[j].w); }
        const float rstd = 1.0f / sqrtf(wave_sum(s) * (1.f / DM) + EPS);
        v2u* o8 = (v2u*)(XN + (size_t)m * DM) + lane;
        const f32x4* gr = (const f32x4*)g + lane;
#pragma unroll
        for (int j = 0; j < 8; ++j) { const f32x4 gg = gr[64 * j]; v2u o; o.x = pk2(v[j].x * rstd * gg.x, v[j].y * rstd * gg.y); o.y = pk2(v[j].z * rstd * gg.z, v[j].w * rstd * gg.w); o8[64 * j] = o; }
        float lg[36];
#pragma unroll
        for (int q = 0; q < 36; ++q) lg[q] = 0.f;
#pragma unroll 1
        for (int j = 0; j < 8; ++j) { const f32x4 gg = gr[64 * j], xx = xr[64 * j]; f32x4 x; x.x = xx.x * rstd * gg.x; x.y = xx.y * rstd * gg.y; x.z = xx.z * rstd * gg.z; x.w = xx.w * rstd * gg.w;
            const int k0 = 4 * lane + 256 * j;
#pragma unroll
            for (int c = 0; c < 4; ++c) { const float xv = x[c];
                const f32x4 wg = *(const f32x4*)(wrg + (size_t)(k0 + c) * NGRP);
                lg[0] += xv * wg.x; lg[1] += xv * wg.y; lg[2] += xv * wg.z; lg[3] += xv * wg.w;
                const f32x4* we = (const f32x4*)(wre + (size_t)(k0 + c) * NEXP);
#pragma unroll
                for (int q = 0; q < 8; ++q) { const f32x4 w = we[q]; lg[4 + 4 * q] += xv * w.x; lg[5 + 4 * q] += xv * w.y; lg[6 + 4 * q] += xv * w.z; lg[7 + 4 * q] += xv * w.w; } } }
#pragma unroll
        for (int q = 0; q < 36; ++q) lg[q] = wave_sum(lg[q]);
        LAS float* lgL = (LAS float*)(F.lds + F.wave * 256);
        if (lane == 0) {
#pragma unroll
            for (int q = 0; q < 36; ++q) lgL[q] = lg[q];
            int gs = 0; float best = lg[0] + brg[0];
#pragma unroll
            for (int q = 1; q < 4; ++q) { const float t = lg[q] + brg[q]; if (t > best) { best = t; gs = q; } }
            float gm = fmaxf(fmaxf(lg[0], lg[1]), fmaxf(lg[2], lg[3])), gsum = 0.f, gsel = 0.f;
#pragma unroll
            for (int q = 0; q < 4; ++q) { const float e = __expf(lg[q] - gm); gsum += e; gsel = (q == gs) ? e : gsel; }
            const float pg = gsel / gsum;
            LDS_WAIT(); asm volatile("" ::: "memory");
            float ein[8];
#pragma unroll
            for (int q = 0; q < 8; ++q) ein[q] = lgL[4 + gs * 8 + q];
            int e0 = 0, e1 = -1; float b0 = -3.0e38f, b1 = -3.0e38f;
#pragma unroll
            for (int q = 0; q < 8; ++q) { const float t = ein[q] + bre[gs * 8 + q];
                if (t > b0) { b1 = b0; e1 = e0; b0 = t; e0 = q; } else if (t > b1) { b1 = t; e1 = q; } }
            float em = ein[0];
#pragma unroll
            for (int q = 1; q < 8; ++q) em = fmaxf(em, ein[q]);
            float p0 = 0.f, p1 = 0.f;
#pragma unroll
            for (int q = 0; q < 8; ++q) { const float e = __expf(ein[q] - em); p0 = (q == e0) ? e : p0; p1 = (q == e1) ? e : p1; }
            const float w0 = pg * p0 / (p0 + p1), w1 = pg * p1 / (p0 + p1);
            const int x0 = gs * 8 + e0, x1 = gs * 8 + e1;
            const int pos0 = (int)atomicAdd(ecnt + x0 * 64, 1u), pos1 = (int)atomicAdd(ecnt + x1 * 64, 1u);
            list[x0 * NTOK + pos0] = 2 * m; list[x1 * NTOK + pos1] = 2 * m + 1;
            tinfo[m * 8 + 0] = x0; tinfo[m * 8 + 1] = pos0; tinfo[m * 8 + 2] = __float_as_int(w0); tinfo[m * 8 + 3] = 0;
            tinfo[m * 8 + 4] = x1; tinfo[m * 8 + 5] = pos1; tinfo[m * 8 + 6] = __float_as_int(w1); tinfo[m * 8 + 7] = 0;
        }
    }
}

__device__ __forceinline__ void nv_conv(const Frame& F, int l) {
    const bf16* P = (const bf16*)(F.ws + WS_PROJ); float* QK = (float*)(F.ws + WS_TMP);
    const float* cw = F.in[3] + (size_t)l * 4 * 2048;
    const size_t total = (size_t)NTOK * 2048, stride = (size_t)F.G * NTHR;
    for (size_t i = (size_t)F.vcu * NTHR + F.tid; i < total; i += stride) {
        const int row = (int)(i >> 11), c = (int)(i & 2047), t = row & (SEQ - 1);
        float a = 0.f;
#pragma unroll
        for (int j = 0; j < 4; ++j) { const int tt = t - 3 + j; if (tt >= 0) a += cw[j * 2048 + c] * bf2f(P[(size_t)(row - 3 + j) * PW + c]); }
        QK[i] = siluf_(a);
    }
}
__device__ __forceinline__ void nv_mlstm(const Frame& F, int l) {
    const bf16* P = (const bf16*)(F.ws + WS_PROJ); const float* QK = (const float*)(F.ws + WS_TMP); float* HR = (float*)(F.ws + WS_TMP + 64 * MiB);
    const int tid = F.tid, v = tid >> 2, kq = tid & 3;
    for (int bh = F.vcu; bh < BATCH * NH; bh += F.G) {
        const int b = bh >> 3, h = bh & 7;
        const float bi = F.in[4][l * NH + h], bfv = F.in[5][l * NH + h];
        float C[32], nn[32], m = 0.f;
#pragma unroll
        for (int j = 0; j < 32; ++j) { C[j] = 0.f; nn[j] = 0.f; }
        for (int t = 0; t < SEQ; ++t) {
            const size_t row = (size_t)b * SEQ + t;
            const float it = bf2f(P[row * PW + C_MI + h]) + bi, ft = bf2f(P[row * PW + C_MF + h]) + bfv;
            const float lf = logsigmoidf_(ft);
            const float mn = fmaxf(lf + m, it), ip = __expf(it - mn), fp = __expf(lf + m - mn); m = mn;
            const float vv = bf2f(P[row * PW + C_MV + h * HD + v]);
            const f32x4* qp = (const f32x4*)(QK + row * 2048 + h * HD + kq * 32);
            const f32x4* kp = (const f32x4*)(QK + row * 2048 + 1024 + h * HD + kq * 32);
            float num = 0.f, den = 0.f;
#pragma unroll
            for (int j4 = 0; j4 < 8; ++j4) { const f32x4 q = qp[j4], k = kp[j4];
#pragma unroll
                for (int c = 0; c < 4; ++c) { const int j = 4 * j4 + c; const float qq = q[c] * 0.08838834764831845f;
                    C[j] = fp * C[j] + ip * vv * k[c]; nn[j] = fp * nn[j] + ip * k[c]; num += C[j] * qq; den += nn[j] * qq; } }
            num += __shfl_xor(num, 1); num += __shfl_xor(num, 2); den += __shfl_xor(den, 1); den += __shfl_xor(den, 2);
            if (kq == 0) HR[row * 1024 + h * HD + v] = num / fmaxf(fabsf(den), __expf(-m));
        }
    }
}
__device__ __forceinline__ void nv_mnorm(const Frame& F, int l) {
    const bf16* P = (const bf16*)(F.ws + WS_PROJ); const float* HR = (const float*)(F.ws + WS_TMP + 64 * MiB); bf16* BR = (bf16*)(F.ws + WS_BR);
    const float* g = F.in[6] + (size_t)l * BW;
    const int gw = GW_ID(F), NGW = GW_N(F), lane = F.lane;
    for (int it = gw; it < NTOK * NH; it += NGW) {
        const size_t row = it >> 3; const int h = it & 7, c = h * HD + 2 * lane;
        const float a = HR[row * 1024 + c], b = HR[row * 1024 + c + 1];
        const float r = 1.0f / sqrtf(wave_sum(a * a + b * b) * (1.f / HD) + EPS);
        const float o0 = a * r * g[c] * sigmoidf_(bf2f(P[row * PW + C_MO + c])), o1 = b * r * g[c + 1] * sigmoidf_(bf2f(P[row * PW + C_MO + c + 1]));
        *(unsigned*)(BR + row * 3072 + c) = pk2(o0, o1);
    }
}
__device__ __forceinline__ unsigned fkey(float f) { const unsigned u = __float_as_uint(f); return (u & 0x80000000u) ? ~u : (u | 0x80000000u); }
__device__ __forceinline__ void select_row(const unsigned (&key)[32], int nvalid, unsigned long long* mrow, int lane) {
    if (nvalid <= TOPK) {
#pragma unroll
        for (int j = 0; j < 32; ++j) { const unsigned long long b = __ballot(lane + 64 * j < nvalid); if (lane == 0) mrow[j] = b; }
        return;
    }
    unsigned T = 0u;
    for (int bit = 31; bit >= 0; --bit) {
        const unsigned cand = T | (1u << bit); int c = 0;
#pragma unroll
        for (int j = 0; j < 32; ++j) c += (key[j] >= cand) ? 1 : 0;
#pragma unroll
        for (int o = 1; o < 64; o <<= 1) c += __shfl_xor(c, o);
        if (c >= TOPK) T = cand;
    }
    int cgt = 0;
#pragma unroll
    for (int j = 0; j < 32; ++j) cgt += (key[j] > T) ? 1 : 0;
#pragma unroll
    for (int o = 1; o < 64; o <<= 1) cgt += __shfl_xor(cgt, o);
    const int need = TOPK - cgt; int run = 0;
    const unsigned long long below = (lane == 0) ? 0ull : (~0ull >> (64 - lane));
#pragma unroll
    for (int j = 0; j < 32; ++j) {
        const bool eq = key[j] == T; const unsigned long long be = __ballot(eq);
        const int rank = run + __popcll(be & below);
        const bool sel = (key[j] > T) || (eq && rank < need);
        run += __popcll(be);
        const unsigned long long b = __ballot(sel); if (lane == 0) mrow[j] = b;
    }
}
__device__ __forceinline__ void nv_index(const Frame& F) {
    const bf16* P = (const bf16*)(F.ws + WS_PROJ); unsigned long long* MK = (unsigned long long*)(F.ws + WS_MASK);
    LAS float* iqL = (LAS float*)(F.lds + F.wave * 12288); LAS float* scL = iqL + 1024;
    const int gw = GW_ID(F), NGW = GW_N(F), lane = F.lane;
    for (int row = gw; row < NTOK; row += NGW) {
        const int t = row & (SEQ - 1), r0 = row - t;
        for (int i = lane; i < 1024; i += 64) iqL[i] = bf2f(P[(size_t)row * PW + C_IQ + i]);
        float w[16];
#pragma unroll
        for (int hh = 0; hh < 16; ++hh) w[hh] = bf2f(P[(size_t)row * PW + C_IW + hh]) * 0.25f;
        LDS_WAIT(); asm volatile("" ::: "memory");
        for (int s = lane; s <= t; s += 64) {
            float d[16];
#pragma unroll
            for (int hh = 0; hh < 16; ++hh) d[hh] = 0.f;
            const v4u* kp = (const v4u*)(P + (size_t)(r0 + s) * PW + C_IK);
#pragma unroll 1
            for (int hf = 0; hf < 2; ++hf) {
                float kr[32];
#pragma unroll
                for (int q = 0; q < 4; ++q) { const v4u x = kp[4 * hf + q]; kr[8 * q] = bflo(x.x); kr[8 * q + 1] = bfhi(x.x); kr[8 * q + 2] = bflo(x.y); kr[8 * q + 3] = bfhi(x.y); kr[8 * q + 4] = bflo(x.z); kr[8 * q + 5] = bfhi(x.z); kr[8 * q + 6] = bflo(x.w); kr[8 * q + 7] = bfhi(x.w); }
#pragma unroll
                for (int hh = 0; hh < 16; ++hh) {
#pragma unroll
                    for (int e = 0; e < 32; ++e) d[hh] += iqL[hh * 64 + hf * 32 + e] * kr[e]; }
            }
            float sc = 0.f;
#pragma unroll
            for (int hh = 0; hh < 16; ++hh) sc += w[hh] * fmaxf(d[hh] * 0.125f, 0.f);
            scL[s] = sc;
        }
        LDS_WAIT(); asm volatile("" ::: "memory");
        unsigned key[32];
#pragma unroll
        for (int j = 0; j < 32; ++j) { const int s = lane + 64 * j; key[j] = (s <= t) ? fkey(scL[s]) : 0u; }
        select_row(key, t + 1, MK + (size_t)row * 32, lane);
        LDS_WAIT(); asm volatile("" ::: "memory");
    }
}
__device__ __forceinline__ void nv_dsa(const Frame& F, int l) {
    const bf16* P = (const bf16*)(F.ws + WS_PROJ); const unsigned long long* MK = (const unsigned long long*)(F.ws + WS_MASK); bf16* BR = (bf16*)(F.ws + WS_BR);
    const float* qg = F.in[7] + l * HD; const float* kg = F.in[8] + l * HD; const float* rb = F.in[19];
    LAS float* lgL = (LAS float*)(F.lds + F.wave * 2048); LAS int* ixL = (LAS int*)(lgL + 256);
    const int gw = GW_ID(F), NGW = GW_N(F), lane = F.lane;
    for (int it = gw; it < NTOK * NH; it += NGW) {
        const int row = it >> 3, h = it & 7, t = row & (SEQ - 1), r0 = row - t, c = h * HD + 2 * lane;
        float q0 = bf2f(P[(size_t)row * PW + C_DQ + c]), q1 = bf2f(P[(size_t)row * PW + C_DQ + c + 1]);
        const float qr = 1.0f / sqrtf(wave_sum(q0 * q0 + q1 * q1) * (1.f / HD) + EPS);
        q0 *= qr * qg[2 * lane]; q1 *= qr * qg[2 * lane + 1];
        const float kg0 = kg[2 * lane], kg1 = kg[2 * lane + 1];
        int cnt = 0; float mx = -3.0e38f;
        for (int wi = 0; wi <= (t >> 6); ++wi) {
            unsigned long long w = MK[(size_t)row * 32 + wi];
            while (w) { const int s = wi * 64 + __builtin_ctzll(w); w &= w - 1;
                const unsigned kk = *(const unsigned*)(P + (size_t)(r0 + s) * PW + C_DK + c);
                const float k0 = bflo(kk), k1 = bfhi(kk);
                const float ss = wave_sum(k0 * k0 + k1 * k1), dd = wave_sum(q0 * k0 * kg0 + q1 * k1 * kg1);
                const float kr = 1.0f / sqrtf(ss * (1.f / HD) + EPS);
                const float lgt = dd * kr * 0.08838834764831845f + rb[t5_bucket(t - s) * NH + h];
                if (lane == 0) { lgL[cnt] = lgt; ixL[cnt] = s; }
                mx = fmaxf(mx, lgt); ++cnt; }
        }
        LDS_WAIT(); asm volatile("" ::: "memory");
        float o0 = 0.f, o1 = 0.f, den = 0.f;
        for (int j = 0; j < cnt; ++j) { const float p = __expf(lgL[j] - mx); const int s = ixL[j];
            const unsigned vv = *(const unsigned*)(P + (size_t)(r0 + s) * PW + C_DV + c);
            o0 += p * bflo(vv); o1 += p * bfhi(vv); den += p; }
        *(unsigned*)(BR + (size_t)row * 3072 + 1024 + c) = pk2(o0 / den, o1 / den);
        LDS_WAIT(); asm volatile("" ::: "memory");
    }
}
__device__ __forceinline__ void nv_sb(const Frame& F) {
    const bf16* P = (const bf16*)(F.ws + WS_PROJ); bf16* BR = (bf16*)(F.ws + WS_BR);
    const int gw = GW_ID(F), NGW = GW_N(F), lane = F.lane;
    for (int it = gw; it < NTOK * NH; it += NGW) {
        const int row = it >> 3, h = it & 7, t = row & (SEQ - 1), r0 = row - t, c = h * HD + 2 * lane;
        const unsigned qq = *(const unsigned*)(P + (size_t)row * PW + C_SQ + c);
        const float q0 = bflo(qq) * 0.08838834764831845f, q1 = bfhi(qq) * 0.08838834764831845f;
        float o0 = 0.f, o1 = 0.f, lp = 0.f;
        for (int s = t - 1; s >= 0; --s) {
            const unsigned kk = *(const unsigned*)(P + (size_t)(r0 + s) * PW + C_SK + c);
            const float z = wave_sum(q0 * bflo(kk) + q1 * bfhi(kk));
            const float a = __expf(logsigmoidf_(z) + lp);
            const unsigned vv = *(const unsigned*)(P + (size_t)(r0 + s) * PW + C_SV + c);
            o0 += a * bflo(vv); o1 += a * bfhi(vv);
            lp += logsigmoidf_(-z);
            if (lp < -80.f) break;
        }
        *(unsigned*)(BR + (size_t)row * 3072 + 2048 + c) = pk2(o0, o1);
    }
}
__device__ __forceinline__ void nv_moe(const Frame& F) {
    const bf16* XN = (const bf16*)(F.ws + WS_XN); bf16* YB = (bf16*)(F.ws + WS_YB); const int* tinfo = tokinfo_ptr(F);
    LAS float* xL = (LAS float*)F.lds; LAS float* hL = xL + 2048;
    const int tid = F.tid;
    for (int slot = F.vcu; slot < 2 * NTOK; slot += F.G) {
        const int m = slot >> 1, k = slot & 1; const int e = tinfo[m * 8 + 4 * k]; const float w = __int_as_float(tinfo[m * 8 + 4 * k + 2]);
        __syncthreads();
        for (int i = tid; i < 2048; i += NTHR) xL[i] = bf2f(XN[(size_t)m * DM + i]);
        __syncthreads();
        { const int f = tid; const bf16* wg = (const bf16*)(F.ws + WS_WGU) + ((size_t)e * 1024 + (f >> 7) * 256 + (f & 127)) * DM; const bf16* wu = wg + (size_t)128 * DM;
          float g = 0.f, u = 0.f;
          for (int k8 = 0; k8 < 256; ++k8) { const v4u a = ((const v4u*)wg)[k8], b = ((const v4u*)wu)[k8]; const LAS float* x = xL + 8 * k8;
              g += x[0] * bflo(a.x) + x[1] * bfhi(a.x) + x[2] * bflo(a.y) + x[3] * bfhi(a.y) + x[4] * bflo(a.z) + x[5] * bfhi(a.z) + x[6] * bflo(a.w) + x[7] * bfhi(a.w);
              u += x[0] * bflo(b.x) + x[1] * bfhi(b.x) + x[2] * bflo(b.y) + x[3] * bfhi(b.y) + x[4] * bflo(b.z) + x[5] * bfhi(b.z) + x[6] * bflo(b.w) + x[7] * bfhi(b.w); }
          hL[f] = bf2f((unsigned short)f2bf(siluf_(g) * u)); }
        __syncthreads();
        { float y[4];
#pragma unroll
          for (int c = 0; c < 4; ++c) { const int d = 4 * tid + c; const bf16* wd = (const bf16*)(F.ws + WS_WDN) + ((size_t)e * DM + d) * DEXP; float a = 0.f;
              for (int k8 = 0; k8 < 64; ++k8) { const v4u x = ((const v4u*)wd)[k8]; const LAS float* hh = hL + 8 * k8;
                  a += hh[0] * bflo(x.x) + hh[1] * bfhi(x.x) + hh[2] * bflo(x.y) + hh[3] * bfhi(x.y) + hh[4] * bflo(x.z) + hh[5] * bfhi(x.z) + hh[6] * bflo(x.w) + hh[7] * bfhi(x.w); }
              y[c] = a * w; }
          v2u o; o.x = pk2(y[0], y[1]); o.y = pk2(y[2], y[3]); *(v2u*)(YB + (size_t)slot * DM + 4 * tid) = o; }
    }
}
template <int LDA, int LDB> struct SchedDense {
    static constexpr bool GATHER = false;
    pg8::TileOrder T; const char* A; const char* B;
    __device__ __forceinline__ bool next(int i, pg8::Unit& u) const { u.e = 0; u.rows = 256; return T.tile(i, u.pm, u.pn); }
    __device__ __forceinline__ const char* a_base(const pg8::Unit& u) const { return A + (size_t)u.pm * 256 * LDA * 2; }
    __device__ __forceinline__ const char* b_base(const pg8::Unit& u) const { return B + (size_t)u.pn * 256 * LDB * 2; }
    __device__ __forceinline__ void a_off(const pg8::Unit&, const int (&R)[2], const int (&C)[2], unsigned (&v0)[2], unsigned (&v1)[2]) const {
#pragma unroll
        for (int i = 0; i < 2; ++i) { v0[i] = (unsigned)(R[i] * LDA + C[i]) * 2u; v1[i] = v0[i] + 128u * LDA * 2u; } }
};
struct EpiProj {
    static constexpr bool PERM = true;
    bf16* O;
    __device__ __forceinline__ void operator()(const f32x4 (&acc)[2][2][4][2], const pg8::Unit& u, int wr, int wc, int fr, int fq) const {
        const int row0 = u.pm * 256 + wr * 64 + fr, col0 = u.pn * 256 + wc * 32 + 8 * fq;
#pragma unroll
        for (int ai = 0; ai < 2; ++ai)
#pragma unroll
            for (int m = 0; m < 4; ++m) { bf16* rowp = O + (size_t)(row0 + ai * 128 + m * 16) * PW + col0;
#pragma unroll
                for (int bj = 0; bj < 2; ++bj) { const f32x4 v0 = acc[ai][bj][m][0], v1 = acc[ai][bj][m][1];
                    v4u w; w.x = cvt_pk_bf16(v0[0], v0[1]); w.y = cvt_pk_bf16(v0[2], v0[3]); w.z = cvt_pk_bf16(v1[0], v1[1]); w.w = cvt_pk_bf16(v1[2], v1[3]);
                    *(v4u*)(rowp + bj * 128) = w; } }
    }
};
struct SchedBranch {
    static constexpr bool GATHER = false;
    pg8::TileOrder T; const char* A; const char* B;
    __device__ __forceinline__ bool next(int i, pg8::Unit& u) const { u.e = i % 3; u.rows = 256; return T.tile(i / 3, u.pm, u.pn); }
    __device__ __forceinline__ const char* a_base(const pg8::Unit& u) const { return A + ((size_t)u.pm * 256 * 3072 + (size_t)u.e * 1024) * 2; }
    __device__ __forceinline__ const char* b_base(const pg8::Unit& u) const { return B + ((size_t)u.e * 2048 + (size_t)u.pn * 256) * 1024 * 2; }
    __device__ __forceinline__ void a_off(const pg8::Unit&, const int (&R)[2], const int (&C)[2], unsigned (&v0)[2], unsigned (&v1)[2]) const {
#pragma unroll
        for (int i = 0; i < 2; ++i) { v0[i] = (unsigned)(R[i] * 3072 + C[i]) * 2u; v1[i] = v0[i] + 128u * 3072u * 2u; } }
};
struct EpiBranch {
    static constexpr bool PERM = true;
    const bf16* P; float* scr; bf16* O;
    __device__ __forceinline__ void operator()(const f32x4 (&acc)[2][2][4][2], const pg8::Unit& u, int wr, int wc, int fr, int fq) const {
        const int row0 = u.pm * 256 + wr * 64 + fr, col0 = u.pn * 256 + wc * 32 + 8 * fq;
#pragma unroll
        for (int ai = 0; ai < 2; ++ai)
#pragma unroll
            for (int m = 0; m < 4; ++m) { const size_t row = (size_t)(row0 + ai * 128 + m * 16);
#pragma unroll
                for (int bj = 0; bj < 2; ++bj) { const int col = col0 + bj * 128;
                    const v4u gw = *(const v4u*)(P + row * PW + C_G + u.e * 2048 + col);
                    f32x4 v0 = acc[ai][bj][m][0], v1 = acc[ai][bj][m][1];
                    v0[0] *= sigmoidf_(bflo(gw.x)); v0[1] *= sigmoidf_(bfhi(gw.x)); v0[2] *= sigmoidf_(bflo(gw.y)); v0[3] *= sigmoidf_(bfhi(gw.y));
                    v1[0] *= sigmoidf_(bflo(gw.z)); v1[1] *= sigmoidf_(bfhi(gw.z)); v1[2] *= sigmoidf_(bflo(gw.w)); v1[3] *= sigmoidf_(bfhi(gw.w));
                    float* sp = scr + row * DM + col;
                    if (u.e > 0) { v0 += *(const f32x4*)sp; v1 += *(const f32x4*)(sp + 4); }
                    if (u.e < 2) { *(f32x4*)sp = v0; *(f32x4*)(sp + 4) = v1; }
                    else { v4u w; w.x = cvt_pk_bf16(v0[0], v0[1]); w.y = cvt_pk_bf16(v0[2], v0[3]); w.z = cvt_pk_bf16(v1[0], v1[1]); w.w = cvt_pk_bf16(v1[2], v1[3]);
                        *(v4u*)(O + row * DM + col) = w; } } }
    }
};
struct EpiOut {
    static constexpr bool PERM = false;
    const float* base; float* out;
    __device__ __forceinline__ void operator()(const f32x4 (&acc)[2][2][4][2], const pg8::Unit& u, int wr, int wc, int fr, int fq) const {
        const int row0 = u.pm * 256 + wr * 64 + fr, col0 = u.pn * 256 + wc * 32 + 4 * fq;
#pragma unroll
        for (int ai = 0; ai < 2; ++ai)
#pragma unroll
            for (int m = 0; m < 4; ++m) { const size_t off = (size_t)(row0 + ai * 128 + m * 16) * DM + col0;
#pragma unroll
                for (int bj = 0; bj < 2; ++bj)
#pragma unroll
                    for (int n = 0; n < 2; ++n) { const f32x4 bs = *(const f32x4*)(base + off + bj * 128 + n * 16); *(f32x4*)(out + off + bj * 128 + n * 16) = bs + acc[ai][bj][m][n]; } }
    }
};

#ifndef OFFMASK
#define OFFMASK 0
#endif
constexpr int PH_CONVW = 0, PH_NORM1 = 1, PH_INPROJ = 2, PH_NVCONV = 3, PH_NVMLSTM = 4, PH_NVMNORM = 5, PH_NVIDX = 6, PH_NVDSA = 7, PH_NVSB = 8,
              PH_BRANCH = 9, PH_OUT = 10, PH_NORM2 = 11, PH_MOE = 12, NPH_L = 13, PH_FINAL = DEPTH * NPH_L, NPH = PH_FINAL + 1;

__global__ void __launch_bounds__(NTHR, 2) fwd_kernel(Args args) {
    extern __shared__ __attribute__((aligned(16))) unsigned char lds_raw[];
    Frame F;
    F.lds = (LAS unsigned char*)lds_raw;
    F.tid = threadIdx.x; F.lane = F.tid & 63; F.wave = __builtin_amdgcn_readfirstlane(F.tid >> 6);
    F.G = gridDim.x; { const int bx = blockIdx.x; F.vcu = (F.G % 8 == 0) ? (bx % 8) * (F.G / 8) + bx / 8 : bx; }
    F.ws = args.ws; F.ctl = (unsigned*)(args.ws + WS_CTL);
#pragma unroll
    for (int i = 0; i < 20; ++i) F.in[i] = args.in[i];
    volatile LAS unsigned* MISC = (volatile LAS unsigned*)(F.lds + LDSCTL_OFF);
    for (int u = F.tid; u < (LDS_BYTES - LDSCTL_OFF) / 4; u += NTHR) ((LAS unsigned*)(F.lds + LDSCTL_OFF))[u] = 0u;
    __syncthreads();
    XcdBarrier bar; bar.bar = F.ctl + CW_BAR; bar.x = 0; bar.st = nullptr;
    if (args.use_bar) bar = xcd_barrier_post(F.ctl + CW_BAR, MISC + 8);
    const int lo = args.ph_lo, hi = args.ph_hi;
#define IN(k) (lo <= (k) && (k) < hi)
#define FRESH() do { int t_ = threadIdx.x; asm volatile("" : "+v"(t_)); F.tid = t_; F.lane = t_ & 63; F.wave = __builtin_amdgcn_readfirstlane(t_ >> 6); } while (0)
#define SEAM(k) do { if (args.use_bar && IN((k) + 1)) xcd_barrier(bar); } while (0)
    for (int l = 0; l < DEPTH; ++l) {
        const int p0 = l * NPH_L;
        if (IN(p0 + PH_CONVW)) { FRESH(); if (!(OFFMASK & (1<<0))) ph_convw(F, l); SEAM(p0 + PH_CONVW); }
        if (IN(p0 + PH_NORM1)) { FRESH(); if (!(OFFMASK & (1<<1))) ph_norm1(F, l); SEAM(p0 + PH_NORM1); }
        if (IN(p0 + PH_INPROJ)) {
            SchedDense<DM, DM> S; S.T.init(NTOK / 256, PW / 256, F.G, (int)blockIdx.x); S.A = (const char*)(F.ws + WS_XN); S.B = (const char*)(F.ws + WS_WIN);
            EpiProj E{(bf16*)(F.ws + WS_PROJ)};
            if (!(OFFMASK & (1<<10))) pg8::gemm_phase<SchedDense<DM, DM>, EpiProj, DM, DM, DM, true>(F.lds, S, E);
            SEAM(p0 + PH_INPROJ);
        }
        if (IN(p0 + PH_NVCONV)) { FRESH(); if (!(OFFMASK & (1<<2))) nv_conv(F, l); SEAM(p0 + PH_NVCONV); }
        if (IN(p0 + PH_NVMLSTM)) { FRESH(); if (!(OFFMASK & (1<<3))) nv_mlstm(F, l); SEAM(p0 + PH_NVMLSTM); }
        if (IN(p0 + PH_NVMNORM)) { FRESH(); if (!(OFFMASK & (1<<4))) nv_mnorm(F, l); SEAM(p0 + PH_NVMNORM); }
        if (IN(p0 + PH_NVIDX)) { FRESH(); if (!(OFFMASK & (1<<5))) nv_index(F); SEAM(p0 + PH_NVIDX); }
        if (IN(p0 + PH_NVDSA)) { FRESH(); if (!(OFFMASK & (1<<6))) nv_dsa(F, l); SEAM(p0 + PH_NVDSA); }
        if (IN(p0 + PH_NVSB)) { FRESH(); if (!(OFFMASK & (1<<7))) nv_sb(F); SEAM(p0 + PH_NVSB); }
        if (IN(p0 + PH_BRANCH)) {
            SchedBranch S; S.T.init(NTOK / 256, DM / 256, F.G, (int)blockIdx.x); S.A = (const char*)(F.ws + WS_BR); S.B = (const char*)(F.ws + WS_WBR);
            EpiBranch E{(const bf16*)(F.ws + WS_PROJ), (float*)(F.ws + WS_X1), (bf16*)(F.ws + WS_MRG)};
            if (!(OFFMASK & (1<<11))) pg8::gemm_phase<SchedBranch, EpiBranch, BW, 3072, BW, true>(F.lds, S, E);
            SEAM(p0 + PH_BRANCH);
        }
        if (IN(p0 + PH_OUT)) {
            SchedDense<DM, DM> S; S.T.init(NTOK / 256, DM / 256, F.G, (int)blockIdx.x); S.A = (const char*)(F.ws + WS_MRG); S.B = (const char*)(F.ws + WS_WOUT);
            EpiOut E{l == 0 ? F.in[0] : (const float*)(F.ws + WS_XA), (float*)(F.ws + WS_X1)};
            if (!(OFFMASK & (1<<12))) pg8::gemm_phase<SchedDense<DM, DM>, EpiOut, DM, DM, DM, true>(F.lds, S, E);
            SEAM(p0 + PH_OUT);
        }
        if (IN(p0 + PH_NORM2)) { FRESH(); if (!(OFFMASK & (1<<8))) ph_norm2(F, l); SEAM(p0 + PH_NORM2); }
        if (IN(p0 + PH_MOE)) { FRESH(); if (!(OFFMASK & (1<<9))) nv_moe(F); SEAM(p0 + PH_MOE); }
    }
    if (IN(PH_FINAL)) { FRESH(); } if (IN(PH_FINAL)) ph_final(F, args.out);
#undef IN
#undef SEAM
}

#ifndef MK_ONE_LAUNCH
#define MK_ONE_LAUNCH 0
#endif
extern "C" void kernel_launch(void* const* d_in, const int* in_sizes, int n_in, void* d_out, int out_size, void* d_ws, size_t ws_size, hipStream_t stream) {
    static int grid = 0;
    if (grid == 0) {
        if (n_in != 20 || in_sizes[0] != NTOK * DM || out_size != NTOK * DM || ws_size < WS_END) { fprintf(stderr, "kernel_launch: shape mismatch (n_in %d, ws %zu < %zu?)\n", n_in, ws_size, (size_t)WS_END); grid = -1; return; }
        int dev = 0, cus = 0, per_cu = 0;
        if (hipGetDevice(&dev) != hipSuccess || hipDeviceGetAttribute(&cus, hipDeviceAttributeMultiprocessorCount, dev) != hipSuccess) { grid = -1; return; }
        if (hipFuncSetAttribute((const void*)fwd_kernel, hipFuncAttributeMaxDynamicSharedMemorySize, LDS_BYTES) != hipSuccess) { fprintf(stderr, "kernel_launch: hipFuncSetAttribute failed\n"); grid = -1; return; }
        if (hipOccupancyMaxActiveBlocksPerMultiprocessor(&per_cu, (const void*)fwd_kernel, NTHR, LDS_BYTES) != hipSuccess || per_cu < 1) fprintf(stderr, "kernel_launch: occupancy query says %d\n", per_cu);
        (void)hipGetLastError();
        grid = cus;
    }
    if (grid < 0) return;
    if (hipMemsetAsync((char*)d_ws + WS_CTL, 0, CTL_ZERO_BYTES, stream) != hipSuccess) return;
    Args a{};
    for (int i = 0; i < 20; ++i) a.in[i] = (const float*)d_in[i];
    a.out = (float*)d_out; a.ws = (unsigned char*)d_ws;
#if MK_ONE_LAUNCH
    a.ph_lo = 0; a.ph_hi = NPH; a.use_bar = 1; a.pad = 0;
    hipLaunchKernelGGL(fwd_kernel, dim3(grid), dim3(NTHR), LDS_BYTES, stream, a);
#else
    for (int ph = 0; ph < NPH; ++ph) { a.ph_lo = ph; a.ph_hi = ph + 1; a.use_bar = 0; a.pad = 0;
        hipLaunchKernelGGL(fwd_kernel, dim3(grid), dim3(NTHR), LDS_BYTES, stream, a); }
#endif
    const hipError_t le = hipPeekAtLastError();
    if (le != hipSuccess) fprintf(stderr, "kernel_launch: launch failed: %s\n", hipGetErrorName(le));
}
```

```cpp
#include <hip/hip_runtime.h>
#include <cstdio>
#include <cstdint>

constexpr int BATCH = 4, SEQ = 2048, DM = 2048, NTOK = BATCH * SEQ, NH = 8, HD = 128, BW = 1024, DEPTH = 2;
constexpr int NIN = 17504, PW = 17664;
constexpr int IDXH = 16, IDXD = 64, TOPK = 256, NEXP = 32, NGRP = 4, EPG = 8, DEXP = 512, MCH = 64, NCH = SEQ / MCH;
constexpr float EPS = 1e-6f;
constexpr int C_MQ = 0, C_MK = 1024, C_MV = 2048, C_MO = 3072, C_DQ = 4096, C_DK = 5120, C_DV = 6144, C_IQ = 7168, C_SQ = 8192, C_SK = 9216, C_SV = 10240,
              C_G = 11264, C_MI = 17408, C_MF = 17416, C_IK = 17424, C_IW = 17488;
__host__ __device__ __forceinline__ int src_col(int c) {
    if (c < 4096) return c;
    if (c < 8192) return c + 16;
    if (c < 17408) return c + 96;
    if (c < 17424) return 4096 + (c - 17408);
    if (c < 17488) return 8208 + (c - 17424);
    if (c < 17504) return 8272 + (c - 17488);
    return -1;
}

constexpr size_t MiB = 1u << 20;
constexpr size_t WS_CTL = 0, CTL_ZERO_BYTES = 1 * MiB;
constexpr size_t WS_WIN = 1 * MiB;
constexpr size_t WS_WBR = WS_WIN + 69 * MiB;
constexpr size_t WS_WOUT = WS_WBR + 12 * MiB;
constexpr size_t WS_WGU = WS_WOUT + 8 * MiB;
constexpr size_t WS_WDN = WS_WGU + 128 * MiB;
constexpr size_t WS_XN = WS_WDN + 64 * MiB;
constexpr size_t WS_XA = WS_XN + 32 * MiB;
constexpr size_t WS_X1 = WS_XA + 64 * MiB;
constexpr size_t WS_PROJ = WS_X1 + 64 * MiB;
constexpr size_t WS_BR = WS_PROJ + 276 * MiB;
constexpr size_t WS_MRG = WS_BR + 48 * MiB;
constexpr size_t WS_MASK = WS_MRG + 32 * MiB;
constexpr size_t WS_MDEL = WS_MASK + 2 * MiB;
constexpr size_t WS_MDN = WS_MDEL + 64 * MiB;
constexpr size_t WS_MST = WS_MDN + 1 * MiB;
constexpr size_t WS_MSN = WS_MST + 32 * MiB;
constexpr size_t WS_HB = WS_MSN + 1 * MiB;
constexpr size_t WS_YB = WS_HB + 16 * MiB;
constexpr size_t WS_LIST = WS_YB + 64 * MiB;
constexpr size_t WS_TMP = WS_LIST + 2 * MiB;
constexpr size_t WS_END = WS_TMP + 96 * MiB;
static_assert(WS_END <= 1100 * MiB, "workspace map");

constexpr int CW_BAR = 4096;
constexpr int CW_ECNT = 16384;

#define GAS __attribute__((address_space(1)))
#define LAS __attribute__((address_space(3)))
typedef unsigned short bf16;
typedef unsigned v4u __attribute__((ext_vector_type(4)));
typedef unsigned v2u __attribute__((ext_vector_type(2)));
typedef float f32x4 __attribute__((ext_vector_type(4)));
typedef float f32x2 __attribute__((ext_vector_type(2)));
typedef float f32x16 __attribute__((ext_vector_type(16)));
typedef short bf16x8 __attribute__((ext_vector_type(8)));
typedef short s16x4 __attribute__((ext_vector_type(4)));
#define RLX_AGENT __ATOMIC_RELAXED, __HIP_MEMORY_SCOPE_AGENT
#define LDS_WAIT() asm volatile("s_waitcnt lgkmcnt(0)" ::: "memory")
#define VM_WAIT() asm volatile("s_waitcnt vmcnt(0)" ::: "memory")
constexpr int NWAVES = 8, NTHR = 512;
constexpr int RING_BYTES = 131072, LDSCTL_OFF = RING_BYTES, LDS_BYTES = 147456;

__device__ __forceinline__ unsigned f2bf(float f) { unsigned u = __builtin_bit_cast(unsigned, f); return (u + 0x7fffu + ((u >> 16) & 1u)) >> 16; }
__device__ __forceinline__ unsigned pk2(float lo, float hi) { return f2bf(lo) | (f2bf(hi) << 16); }
__device__ __forceinline__ float bf2f(unsigned short b) { return __builtin_bit_cast(float, ((unsigned)b) << 16); }
__device__ __forceinline__ float bflo(unsigned w) { return __builtin_bit_cast(float, w << 16); }
__device__ __forceinline__ float bfhi(unsigned w) { return __builtin_bit_cast(float, w & 0xffff0000u); }
__device__ __forceinline__ unsigned cvt_pk_bf16(float lo, float hi) { unsigned r; asm volatile("v_cvt_pk_bf16_f32 %0, %1, %2" : "=v"(r) : "v"(lo), "v"(hi)); return r; }
__device__ __forceinline__ float wave_sum(float v) {
#pragma unroll
    for (int o = 1; o < 64; o <<= 1) v += __shfl_xor(v, o);
    return v;
}
__device__ __forceinline__ float wave_max(float v) {
#pragma unroll
    for (int o = 1; o < 64; o <<= 1) v = fmaxf(v, __shfl_xor(v, o));
    return v;
}
__device__ __forceinline__ float sigmoidf_(float x) { return 1.0f / (1.0f + __expf(-x)); }
__device__ __forceinline__ float siluf_(float x) { return x / (1.0f + __expf(-x)); }
__device__ __forceinline__ float logsigmoidf_(float x) { return fminf(x, 0.f) - log1pf(__expf(-fabsf(x))); }
__device__ __forceinline__ int t5_bucket(int n) {
    if (n < 16) return n;
    return 16 + (n >= 19) + (n >= 21) + (n >= 24) + (n >= 27) + (n >= 31) + (n >= 35) + (n >= 40) + (n >= 46) + (n >= 52) + (n >= 59) + (n >= 67) + (n >= 77) + (n >= 87) + (n >= 99) + (n >= 113);
}
namespace pg8 {
constexpr int BM = 256, BK = 64, HALF = 128, HTB = HALF * BK * 2, STAGE_BYTES = 8 * HTB, NXCD = 8, WGM = 8;
__host__ __device__ __forceinline__ int lds_byte(int r, int c) { const int st = (r >> 4) * 2 + (c >> 5), rr = r & 15, cc = c & 31, ob = rr * 64 + cc * 2; return st * 1024 + (ob ^ (((ob >> 9) & 1) << 5)); }
__host__ __device__ __forceinline__ void stage_rc(int b, int& R, int& C) { const int st = b / 1024, sb = b % 1024, swz = sb ^ (((sb >> 9) & 1) << 5); R = (st >> 1) * 16 + swz / 64; C = (st & 1) * 32 + (swz % 64) / 2; }
__host__ __device__ __forceinline__ int perm32(int rho) { const int n = rho >> 4, i = rho & 15; return 8 * (i >> 2) + 4 * n + (i & 3); }

struct Unit { int pm, pn, e, rows; };

struct TileOrder {
    int nM, nN, nwg, G, c;
    __device__ void init(int nM_, int nN_, int G_, int c_) { nM = nM_; nN = nN_; nwg = nM * nN; G = G_; c = c_; }
    __device__ bool tile(int i, int& pm, int& pn) const {
        const long L = (long)i * G + c; if (L >= nwg) return false;
        int wgid = (int)L; { const int q = nwg / NXCD, r = nwg % NXCD, xcd = wgid % NXCD, off = wgid / NXCD; wgid = (xcd < r ? xcd * (q + 1) : r * (q + 1) + (xcd - r) * q) + off; }
        const int nig = WGM * nN, gid = wgid / nig, fm = gid * WGM, gsz = (nM - fm) < WGM ? (nM - fm) : WGM;
        pm = fm + ((wgid % nig) % gsz); pn = (wgid % nig) / gsz; return true;
    }
};

template <class Sched, class Epi, int K, int LDA, int LDB, bool ALIGN_EPI>
__device__ __forceinline__ void gemm_phase(LAS unsigned char* lds, const Sched& S, const Epi& E) {
    int tid_ = threadIdx.x; asm volatile("" : "+v"(tid_));
    const int tid = tid_, wid = __builtin_amdgcn_readfirstlane(tid >> 6), lane = tid & 63, wr = wid >> 2, wc = wid & 3, fr = lane & 15, fq = lane >> 4;
    constexpr int nt = K / BK;
    static_assert(K % 128 == 0 && K >= 256, "K");
    int Rr[2], Cc[2];
    unsigned voffB[2];
#pragma unroll
    for (int i = 0; i < 2; ++i) { int R, C; stage_rc(tid * 16 + i * 8192, R, C); Rr[i] = R; Cc[i] = C; const int Rb = Epi::PERM ? ((R & ~31) + perm32(R & 31)) : R;
        voffB[i] = (unsigned)(Rb * LDB + C) * 2u; }
    constexpr size_t kstep = (size_t)(BK * 2);
    constexpr size_t hstepB = (size_t)HALF * LDB * 2;
    constexpr size_t hstepA = Sched::GATHER ? 0 : (size_t)HALF * LDA * 2;
    const unsigned ldsw = (unsigned)wid * 1024u;
    const int aoff = lds_byte(wr * 64 + fr, fq * 8), boff = lds_byte(wc * 32 + fr, fq * 8);
#define PG8_SA(b, h) (((b) * 2 + (h)) * HTB)
#define PG8_SB(b, h) ((4 + (b) * 2 + (h)) * HTB)
#define PG8_STAGE(bufoff, gbase, voff) do { _Pragma("unroll") for (int _i = 0; _i < 2; ++_i) \
        __builtin_amdgcn_global_load_lds((const unsigned*)((const char*)(gbase) + (voff)[_i]), (LAS unsigned*)(lds + (bufoff) + ldsw + _i * 8192), 16, 0, 0); } while (0)
#define PG8_LDA(dst, b, h) do { _Pragma("unroll") for (int m = 0; m < 4; ++m) _Pragma("unroll") for (int k = 0; k < 2; ++k) dst[m][k] = *(const LAS bf16x8*)(lds + PG8_SA(b, h) + aoff + m * 2048 + k * 1024); } while (0)
#define PG8_LDB(dst, b, h) do { _Pragma("unroll") for (int n = 0; n < 2; ++n) _Pragma("unroll") for (int k = 0; k < 2; ++k) dst[n][k] = *(const LAS bf16x8*)(lds + PG8_SB(b, h) + boff + n * 2048 + k * 1024); } while (0)
#define PG8_MMA(ai, bj, At, Bt) do { __builtin_amdgcn_s_setprio(1); _Pragma("unroll") for (int m = 0; m < 4; ++m) _Pragma("unroll") for (int n = 0; n < 2; ++n) _Pragma("unroll") for (int k = 0; k < 2; ++k) \
        acc[ai][bj][m][n] = __builtin_amdgcn_mfma_f32_16x16x32_bf16(Bt[n][k], At[m][k], acc[ai][bj][m][n], 0, 0, 0); __builtin_amdgcn_s_setprio(0); } while (0)
#define VA1 (Sched::GATHER ? vA1 : vA0)
#define W0 (Sched::GATHER ? w0 : vA0)
#define W1 (Sched::GATHER ? w1 : vA0)
#define PG8_WAIT_V(n) asm volatile("s_waitcnt vmcnt(" #n ")" ::: "memory")
#define PG8_WAIT_L(n) asm volatile("s_waitcnt lgkmcnt(" #n ")" ::: "memory")
#define PG8_BAR __builtin_amdgcn_s_barrier()
#define PG8_SCHED __builtin_amdgcn_sched_barrier(0)
    Unit cur, nxt; int ui = 0;
    if (!S.next(0, cur)) return;
    f32x4 acc[2][2][4][2];
#pragma unroll
    for (int a = 0; a < 2; ++a)
#pragma unroll
        for (int b = 0; b < 2; ++b)
#pragma unroll
            for (int m = 0; m < 4; ++m)
#pragma unroll
                for (int n = 0; n < 2; ++n) acc[a][b][m][n] = (f32x4){0.f, 0.f, 0.f, 0.f};
    bf16x8 At[4][2], B0[2][2], B1[2][2];
    unsigned vA0[2], vA1[2], nA0[2], nA1[2];
    S.a_off(cur, Rr, Cc, vA0, vA1);
    if constexpr (Sched::GATHER) {
#pragma unroll
        for (int i = 0; i < 2; ++i) { nA0[i] = vA0[i]; nA1[i] = vA1[i]; } }
    const char* cA = S.a_base(cur); const char* cB = S.b_base(cur);
    PG8_STAGE(PG8_SB(0, 0), cB, voffB); PG8_STAGE(PG8_SB(0, 1), cB + hstepB, voffB); PG8_STAGE(PG8_SA(0, 0), cA, vA0); PG8_STAGE(PG8_SA(0, 1), cA + hstepA, VA1);
    if (wr == 1) PG8_BAR;
    PG8_WAIT_V(2); PG8_BAR;
    PG8_STAGE(PG8_SB(1, 0), cB + kstep, voffB); PG8_STAGE(PG8_SA(1, 0), cA + kstep, vA0); PG8_STAGE(PG8_SB(1, 1), cB + hstepB + kstep, voffB);
    PG8_WAIT_V(6); PG8_BAR;
    for (;;) {
        const bool has_next = S.next(ui + 1, nxt);
        const char* nA = has_next ? S.a_base(nxt) : cA; const char* nB = has_next ? S.b_base(nxt) : cB;
        if constexpr (Sched::GATHER) { if (has_next) S.a_off(nxt, Rr, Cc, nA0, nA1); }
        for (int t = 0; t < nt; t += 2) {
            const bool last = (t == nt - 2);
            const char* a1 = cA + (size_t)(t + 1) * kstep;
            const char* a2 = last ? nA : cA + (size_t)(t + 2) * kstep; const char* b2 = last ? nB : cB + (size_t)(t + 2) * kstep;
            const char* a3 = a2 + kstep; const char* b3 = b2 + kstep;
            unsigned w0[2], w1[2];
            if constexpr (Sched::GATHER) {
#pragma unroll
                for (int i = 0; i < 2; ++i) { w0[i] = last ? nA0[i] : vA0[i]; w1[i] = last ? nA1[i] : vA1[i]; } }
            PG8_LDB(B0, 0, 0); PG8_LDB(B1, 0, 1); PG8_SCHED; PG8_LDA(At, 0, 0); PG8_STAGE(PG8_SA(1, 1), a1 + hstepA, VA1);
            PG8_WAIT_V(8); PG8_WAIT_L(0); PG8_BAR; PG8_MMA(0, 0, At, B0); PG8_MMA(0, 1, At, B1); PG8_BAR; PG8_SCHED;
            PG8_LDA(At, 0, 1); PG8_STAGE(PG8_SB(0, 0), b2, voffB); PG8_STAGE(PG8_SB(0, 1), b2 + hstepB, voffB); PG8_STAGE(PG8_SA(0, 0), a2, W0);
            PG8_WAIT_V(8); PG8_WAIT_L(0); PG8_BAR; PG8_MMA(1, 0, At, B0); PG8_MMA(1, 1, At, B1); PG8_BAR; PG8_SCHED;
            PG8_LDB(B0, 1, 0); PG8_LDB(B1, 1, 1); PG8_SCHED; PG8_LDA(At, 1, 0); PG8_STAGE(PG8_SA(0, 1), a2 + hstepA, W1);
            PG8_WAIT_V(8); PG8_WAIT_L(0); PG8_BAR; PG8_MMA(0, 0, At, B0); PG8_MMA(0, 1, At, B1); PG8_BAR; PG8_SCHED;
            PG8_LDA(At, 1, 1); PG8_STAGE(PG8_SB(1, 0), b3, voffB); PG8_STAGE(PG8_SB(1, 1), b3 + hstepB, voffB); PG8_STAGE(PG8_SA(1, 0), a3, W0);
            PG8_WAIT_V(8); PG8_WAIT_L(0); PG8_BAR; PG8_MMA(1, 0, At, B0); PG8_MMA(1, 1, At, B1); PG8_BAR; PG8_SCHED;
        }
        if constexpr (ALIGN_EPI) { if (wr == 0) PG8_BAR; }
        E(acc, cur, wr, wc, fr, fq);
        if (!has_next) break;
#pragma unroll
        for (int a = 0; a < 2; ++a)
#pragma unroll
            for (int b = 0; b < 2; ++b)
#pragma unroll
                for (int m = 0; m < 4; ++m)
#pragma unroll
                    for (int n = 0; n < 2; ++n) acc[a][b][m][n] = (f32x4){0.f, 0.f, 0.f, 0.f};
        cur = nxt; cA = nA; cB = nB; ++ui;
        if constexpr (Sched::GATHER) {
#pragma unroll
            for (int i = 0; i < 2; ++i) { vA0[i] = nA0[i]; vA1[i] = nA1[i]; } }
        if constexpr (ALIGN_EPI) { if (wr == 1) PG8_BAR; }
    }
    PG8_WAIT_V(0);
    if constexpr (!ALIGN_EPI) { if (wr == 0) PG8_BAR; }
    PG8_BAR;
#undef PG8_SA
#undef VA1
#undef W0
#undef W1
#undef PG8_SB
#undef PG8_STAGE
#undef PG8_LDA
#undef PG8_LDB
#undef PG8_MMA
#undef PG8_WAIT_V
#undef PG8_WAIT_L
#undef PG8_BAR
#undef PG8_SCHED
}
}
#define XB_TMO      128
#define XB_XCNT(j)  (256  + 64 * (j))
#define XB_XSUB(j)  (1280 + 64 * (j))
#define XB_XGEN(j)  (2304 + 64 * (j))
#define XB_TOP      3328
#define XB_TOPGEN   3392
#define XCD_BAR_WORDS 3456
#define XB_SPIN_CAP (1u << 18)
__device__ __forceinline__ unsigned xb_ld(unsigned* p)              { return __hip_atomic_load(p, __ATOMIC_RELAXED, __HIP_MEMORY_SCOPE_AGENT); }
__device__ __forceinline__ unsigned xb_add(unsigned* p, unsigned v) { return __hip_atomic_fetch_add(p, v, __ATOMIC_RELAXED, __HIP_MEMORY_SCOPE_AGENT); }
__device__ __forceinline__ unsigned xb_xcc_id() { return (unsigned)__builtin_amdgcn_s_getreg((3 << 11) | 20) & 0xFu; }
#define XB_SPIN(cond, bar) do { unsigned _sp = 0; while (cond) { __builtin_amdgcn_s_sleep(1); \
    if ((++_sp & 255u) == 0u) { if (xb_ld(&(bar)[XB_TMO])) break; if (_sp > XB_SPIN_CAP) { atomicAdd(&(bar)[XB_TMO], 1u); break; } } } } while (0)
struct XcdBarrier { unsigned* bar; unsigned x; volatile LAS unsigned* st; };
__device__ __forceinline__ XcdBarrier xcd_barrier_post(unsigned* bar, volatile LAS unsigned* st) {
    XcdBarrier b; b.bar = bar; b.x = xb_xcc_id(); b.st = st;
    if (threadIdx.x == 0) (void)xb_add(&bar[XB_XCNT(b.x)], 1u);
    return b;
}
__device__ __forceinline__ void xcd_barrier_complete(unsigned* bar, unsigned x, unsigned& nloc, unsigned& nx) {
    const unsigned G = gridDim.x * gridDim.y * gridDim.z;
    unsigned sum, cnt, mine, sp = 0u;
    for (;;) {
        sum = 0u; cnt = 0u; mine = 0u;
#pragma unroll
        for (unsigned j = 0; j < 16; ++j) { const unsigned c = xb_ld(&bar[XB_XCNT(j)]); sum += c; cnt += (c > 0u) ? 1u : 0u; mine = (j == x) ? c : mine; }
        if (sum == G) break;
        __builtin_amdgcn_s_sleep(1);
        if ((++sp & 255u) == 0u) { if (xb_ld(&bar[XB_TMO])) break; if (sp > XB_SPIN_CAP) { atomicAdd(&bar[XB_TMO], 1u); break; } }
    }
    nloc = mine > 0u ? mine : 1u; nx = cnt > 0u ? cnt : 1u;
}
__device__ __forceinline__ void xcd_barrier(const XcdBarrier& b) {
    asm volatile("s_waitcnt vmcnt(0)" ::: "memory");
    __syncthreads();
    if (threadIdx.x == 0) {
        unsigned* bar = b.bar;
        __builtin_amdgcn_s_waitcnt(0);
        unsigned nloc = b.st[0], nx = b.st[1];
        if (nloc == 0u) { xcd_barrier_complete(bar, b.x, nloc, nx); b.st[0] = nloc; b.st[1] = nx; }
        const unsigned old = xb_add(&bar[XB_XSUB(b.x)], 1u);
        const unsigned gen = old / nloc;
        if (old + 1u == (gen + 1u) * nloc) {
            __builtin_amdgcn_fence(__ATOMIC_RELEASE, "agent");
            asm volatile("s_waitcnt vmcnt(0)" ::: "memory");
            const unsigned og = xb_add(&bar[XB_TOP], 1u);
            const unsigned tg = og / nx;
            if (og + 1u == (tg + 1u) * nx) xb_add(&bar[XB_TOPGEN], 1u);
            else XB_SPIN(xb_ld(&bar[XB_TOPGEN]) == tg, bar);
            __builtin_amdgcn_fence(__ATOMIC_ACQUIRE, "agent");
            xb_add(&bar[XB_XGEN(b.x)], 1u);
            asm volatile("s_waitcnt vmcnt(0)" ::: "memory");
        } else {
            XB_SPIN(xb_ld(&bar[XB_XGEN(b.x)]) == gen, bar);
            __builtin_amdgcn_fence(__ATOMIC_ACQUIRE, "agent");
            asm volatile("s_waitcnt vmcnt(0)" ::: "memory");
        }
    }
    __syncthreads();
}

struct Args { const float* in[20]; float* out; unsigned char* ws; int ph_lo, ph_hi, use_bar, pad; };
struct Frame {
    LAS unsigned char* lds;
    unsigned* ctl;
    int tid, lane, wave, vcu, G;
    unsigned char* ws;
    const float* in[20];
};
#define GW_ID(F) ((F).vcu * NWAVES + (F).wave)
#define GW_N(F) ((F).G * NWAVES)

__device__ __forceinline__ void cvt_item(const float* W, int ldw, int k0, int srcc, bf16* WT, size_t out_row0, int ldo, LAS float* scr, int lane) {
#pragma unroll 8
    for (int i = 0; i < 32; ++i) { const int kk = 2 * i + (lane >> 5); scr[kk * 33 + (lane & 31)] = srcc >= 0 ? W[(size_t)(k0 + kk) * ldw + srcc] : 0.f; }
    LDS_WAIT(); asm volatile("" ::: "memory");
    const int c = lane & 7;
#pragma unroll
    for (int j = 0; j < 4; ++j) { const int n = (lane >> 3) + 8 * j; const LAS float* s = scr + (8 * c) * 33 + n;
        v4u o; o.x = pk2(s[0 * 33], s[1 * 33]); o.y = pk2(s[2 * 33], s[3 * 33]); o.z = pk2(s[4 * 33], s[5 * 33]); o.w = pk2(s[6 * 33], s[7 * 33]);
        *(v4u*)(WT + (out_row0 + n) * (size_t)ldo + k0 + 8 * c) = o; }
    LDS_WAIT(); asm volatile("" ::: "memory");
}
__device__ __forceinline__ void ph_convw(const Frame& F, int l) {
    LAS float* scr = (LAS float*)(F.lds + F.wave * 16384);
    const int gw = GW_ID(F), NGW = GW_N(F), lane = F.lane, ln = lane & 31;
    constexpr int I_IN = (PW / 32) * 32, I_BR = 3 * 64 * 16, I_OUT = 64 * 32, I_G = 32 * 16 * 32, I_D = 32 * 64 * 8;
    constexpr int NITEMS = I_IN + I_BR + I_OUT + 2 * I_G + I_D;
    for (int it = gw; it < NITEMS; it += NGW) {
        int r = it;
        if (r < I_IN) { const int kb = r / (PW / 32), nb = r % (PW / 32);
            cvt_item(F.in[2] + (size_t)l * DM * NIN, NIN, 64 * kb, src_col(32 * nb + ln), (bf16*)(F.ws + WS_WIN), (size_t)32 * nb, DM, scr, lane); continue; }
        r -= I_IN;
        if (r < I_BR) { const int n = r / (64 * 16), q = r % (64 * 16), kb = q / 64, nb = q % 64;
            cvt_item(F.in[9] + ((size_t)l * 3 + n) * BW * DM, DM, 64 * kb, 32 * nb + ln, (bf16*)(F.ws + WS_WBR) + (size_t)n * DM * BW, (size_t)32 * nb, BW, scr, lane); continue; }
        r -= I_BR;
        if (r < I_OUT) { const int kb = r / 64, nb = r % 64;
            cvt_item(F.in[10] + (size_t)l * DM * DM, DM, 64 * kb, 32 * nb + ln, (bf16*)(F.ws + WS_WOUT), (size_t)32 * nb, DM, scr, lane); continue; }
        r -= I_OUT;
        if (r < 2 * I_G) { const int up = r >= I_G; if (up) r -= I_G; const int e = r / (16 * 32), q = r % (16 * 32), kb = q / 16, nb = q % 16, f0 = 32 * nb;
            cvt_item(F.in[up ? 17 : 16] + ((size_t)l * NEXP + e) * DM * DEXP, DEXP, 64 * kb, f0 + ln, (bf16*)(F.ws + WS_WGU) + (size_t)e * 1024 * DM,
                     (size_t)((f0 >> 7) * 256 + (up ? 128 : 0) + (f0 & 127)), DM, scr, lane); continue; }
        r -= 2 * I_G;
        { const int e = r / (64 * 8), q = r % (64 * 8), kb = q / 64, nb = q % 64;
            cvt_item(F.in[18] + ((size_t)l * NEXP + e) * DEXP * DM, DM, 64 * kb, 32 * nb + ln, (bf16*)(F.ws + WS_WDN) + (size_t)e * DM * DEXP, (size_t)32 * nb, DEXP, scr, lane); }
    }
}

__device__ __forceinline__ int* tokinfo_ptr(const Frame& F) { return (int*)(F.ws + WS_LIST + MiB); }

__device__ __forceinline__ void ph_norm1(const Frame& F, int l) {
    const int gw = GW_ID(F), NGW = GW_N(F), lane = F.lane;
    const float* g = F.in[1] + (size_t)l * DM;
    bf16* XN = (bf16*)(F.ws + WS_XN);
    for (int m = gw; m < NTOK; m += NGW) {
        f32x4 v[8]; float s = 0.f;
        if (l == 0) {
            const f32x4* xr = (const f32x4*)(F.in[0] + (size_t)m * DM) + lane;
#pragma unroll
            for (int j = 0; j < 8; ++j) v[j] = xr[64 * j];
        } else {
            const f32x4* xr = (const f32x4*)((const float*)(F.ws + WS_X1) + (size_t)m * DM) + lane;
            const v2u* y0 = (const v2u*)((const bf16*)(F.ws + WS_YB) + (size_t)(2 * m) * DM) + lane;
            const v2u* y1 = (const v2u*)((const bf16*)(F.ws + WS_YB) + (size_t)(2 * m + 1) * DM) + lane;
            f32x4* xo = (f32x4*)((float*)(F.ws + WS_XA) + (size_t)m * DM) + lane;
#pragma unroll
            for (int j = 0; j < 8; ++j) { f32x4 x = xr[64 * j]; const v2u a = y0[64 * j], b = y1[64 * j];
                x.x = (x.x + bflo(a.x)) + bflo(b.x); x.y = (x.y + bfhi(a.x)) + bfhi(b.x); x.z = (x.z + bflo(a.y)) + bflo(b.y); x.w = (x.w + bfhi(a.y)) + bfhi(b.y);
                v[j] = x; xo[64 * j] = x; }
        }
#pragma unroll
        for (int j = 0; j < 8; ++j) s += (v[j].x * v[j].x + v[j].y * v[j].y) + (v[j].z * v[j].z + v[j].w * v[j].w);
        const float rstd = 1.0f / sqrtf(wave_sum(s) * (1.f / DM) + EPS);
        v2u* o8 = (v2u*)(XN + (size_t)m * DM) + lane;
        const f32x4* gr = (const f32x4*)g + lane;
#pragma unroll
        for (int j = 0; j < 8; ++j) { const f32x4 gg = gr[64 * j]; v2u o; o.x = pk2(v[j].x * rstd * gg.x, v[j].y * rstd * gg.y); o.y = pk2(v[j].z * rstd * gg.z, v[j].w * rstd * gg.w); o8[64 * j] = o; }
    }
}

__device__ __forceinline__ void ph_final(const Frame& F, float* out) {
    const int gw = GW_ID(F), NGW = GW_N(F), lane = F.lane;
    for (int m = gw; m < NTOK; m += NGW) {
        const f32x4* xr = (const f32x4*)((const float*)(F.ws + WS_X1) + (size_t)m * DM) + lane;
        const v2u* y0 = (const v2u*)((const bf16*)(F.ws + WS_YB) + (size_t)(2 * m) * DM) + lane;
        const v2u* y1 = (const v2u*)((const bf16*)(F.ws + WS_YB) + (size_t)(2 * m + 1) * DM) + lane;
        f32x4* xo = (f32x4*)(out + (size_t)m * DM) + lane;
#pragma unroll
        for (int j = 0; j < 8; ++j) { f32x4 x = xr[64 * j]; const v2u a = y0[64 * j], b = y1[64 * j];
            x.x = (x.x + bflo(a.x)) + bflo(b.x); x.y = (x.y + bfhi(a.x)) + bfhi(b.x); x.z = (x.z + bflo(a.y)) + bflo(b.y); x.w = (x.w + bfhi(a.y)) + bfhi(b.y);
            xo[64 * j] = x; }
    }
}

__device__ __forceinline__ void ph_norm2(const Frame& F, int l) {
    const int gw = GW_ID(F), NGW = GW_N(F), lane = F.lane;
    const float* g = F.in[11] + (size_t)l * DM;
    const float* wrg = F.in[12] + (size_t)l * DM * NGRP; const float* brg = F.in[13] + l * NGRP;
    const float* wre = F.in[14] + (size_t)l * DM * NEXP; const float* bre = F.in[15] + l * NEXP;
    bf16* XN = (bf16*)(F.ws + WS_XN);
    int* list = (int*)(F.ws + WS_LIST); int* tinfo = tokinfo_ptr(F);
    unsigned* ecnt = F.ctl + CW_ECNT + l * NEXP * 64;
    for (int m = gw; m < NTOK; m += NGW) {
        f32x4 v[8]; float s = 0.f;
        const f32x4* xr = (const f32x4*)((const float*)(F.ws + WS_X1) + (size_t)m * DM) + lane;
#pragma unroll
        for (int j = 0; j < 8; ++j) { v[j] = xr[64 * j]; s += (v[j].x * v[j].x + v[j].y * v[j].y) + (v[j].z * v[j].z + v[j].w * v[j].w); }
        const float rstd = 1.0f / sqrtf(wave_sum(s) * (1.f / DM) + EPS);
        v2u* o8 = (v2u*)(XN + (size_t)m * DM) + lane;
        const f32x4* gr = (const f32x4*)g + lane;
#pragma unroll
        for (int j = 0; j < 8; ++j) { const f32x4 gg = gr[64 * j]; v2u o; o.x = pk2(v[j].x * rstd * gg.x, v[j].y * rstd * gg.y); o.y = pk2(v[j].z * rstd * gg.z, v[j].w * rstd * gg.w); o8[64 * j] = o; }
        float lg[36];
#pragma unroll
        for (int q = 0; q < 36; ++q) lg[q] = 0.f;
#pragma unroll 1
        for (int j = 0; j < 8; ++j) { const f32x4 gg = gr[64 * j], xx = xr[64 * j]; f32x4 x; x.x = xx.x * rstd * gg.x; x.y = xx.y * rstd * gg.y; x.z = xx.z * rstd * gg.z; x.w = xx.w * rstd * gg.w;
            const int k0 = 4 * lane + 256 * j;
#pragma unroll
            for (int c = 0; c < 4; ++c) { const float xv = x[c];
                const f32x4 wg = *(const f32x4*)(wrg + (size_t)(k0 + c) * NGRP);
                lg[0] += xv * wg.x; lg[1] += xv * wg.y; lg[2] += xv * wg.z; lg[3] += xv * wg.w;
                const f32x4* we = (const f32x4*)(wre + (size_t)(k0 + c) * NEXP);
#pragma unroll
                for (int q = 0; q < 8; ++q) { const f32x4 w = we[q]; lg[4 + 4 * q] += xv * w.x; lg[5 + 4 * q] += xv * w.y; lg[6 + 4 * q] += xv * w.z; lg[7 + 4 * q] += xv * w.w; } } }
#pragma unroll
        for (int q = 0; q < 36; ++q) lg[q] = wave_sum(lg[q]);
        LAS float* lgL = (LAS float*)(F.lds + F.wave * 256);
        if (lane == 0) {
#pragma unroll
            for (int q = 0; q < 36; ++q) lgL[q] = lg[q];
            int gs = 0; float best = lg[0] + brg[0];
#pragma unroll
            for (int q = 1; q < 4; ++q) { const float t = lg[q] + brg[q]; if (t > best) { best = t; gs = q; } }
            float gm = fmaxf(fmaxf(lg[0], lg[1]), fmaxf(lg[2], lg[3])), gsum = 0.f, gsel = 0.f;
#pragma unroll
            for (int q = 0; q < 4; ++q) { const float e = __expf(lg[q] - gm); gsum += e; gsel = (q == gs) ? e : gsel; }
            const float pg = gsel / gsum;
            LDS_WAIT(); asm volatile("" ::: "memory");
            float ein[8];
#pragma unroll
            for (int q = 0; q < 8; ++q) ein[q] = lgL[4 + gs * 8 + q];
            int e0 = 0, e1 = -1; float b0 = -3.0e38f, b1 = -3.0e38f;
#pragma unroll
            for (int q = 0; q < 8; ++q) { const float t = ein[q] + bre[gs * 8 + q];
                if (t > b0) { b1 = b0; e1 = e0; b0 = t; e0 = q; } else if (t > b1) { b1 = t; e1 = q; } }
            float em = ein[0];
#pragma unroll
            for (int q = 1; q < 8; ++q) em = fmaxf(em, ein[q]);
            float p0 = 0.f, p1 = 0.f;
#pragma unroll
            for (int q = 0; q < 8; ++q) { const float e = __expf(ein[q] - em); p0 = (q == e0) ? e : p0; p1 = (q == e1) ? e : p1; }
            const float w0 = pg * p0 / (p0 + p1), w1 = pg * p1 / (p0 + p1);
            const int x0 = gs * 8 + e0, x1 = gs * 8 + e1;
            const int pos0 = (int)atomicAdd(ecnt + x0 * 64, 1u), pos1 = (int)atomicAdd(ecnt + x1 * 64, 1u);
            list[x0 * NTOK + pos0] = 2 * m; list[x1 * NTOK + pos1] = 2 * m + 1;
            tinfo[m * 8 + 0] = x0; tinfo[m * 8 + 1] = pos0; tinfo[m * 8 + 2] = __float_as_int(w0); tinfo[m * 8 + 3] = 0;
            tinfo[m * 8 + 4] = x1; tinfo[m * 8 + 5] = pos1; tinfo[m * 8 + 6] = __float_as_int(w1); tinfo[m * 8 + 7] = 0;
        }
    }
}

__device__ __forceinline__ void nv_conv(const Frame& F, int l) {
    const bf16* P = (const bf16*)(F.ws + WS_PROJ); float* QK = (float*)(F.ws + WS_TMP);
    const float* cw = F.in[3] + (size_t)l * 4 * 2048;
    const size_t total = (size_t)NTOK * 2048, stride = (size_t)F.G * NTHR;
    for (size_t i = (size_t)F.vcu * NTHR + F.tid; i < total; i += stride) {
        const int row = (int)(i >> 11), c = (int)(i & 2047), t = row & (SEQ - 1);
        float a = 0.f;
#pragma unroll
        for (int j = 0; j < 4; ++j) { const int tt = t - 3 + j; if (tt >= 0) a += cw[j * 2048 + c] * bf2f(P[(size_t)(row - 3 + j) * PW + c]); }
        QK[i] = siluf_(a);
    }
}
__device__ __forceinline__ void nv_mlstm(const Frame& F, int l) {
    const bf16* P = (const bf16*)(F.ws + WS_PROJ); const float* QK = (const float*)(F.ws + WS_TMP); float* HR = (float*)(F.ws + WS_TMP + 64 * MiB);
    const int tid = F.tid, v = tid >> 2, kq = tid & 3;
    for (int bh = F.vcu; bh < BATCH * NH; bh += F.G) {
        const int b = bh >> 3, h = bh & 7;
        const float bi = F.in[4][l * NH + h], bfv = F.in[5][l * NH + h];
        float C[32], nn[32], m = 0.f;
#pragma unroll
        for (int j = 0; j < 32; ++j) { C[j] = 0.f; nn[j] = 0.f; }
        for (int t = 0; t < SEQ; ++t) {
            const size_t row = (size_t)b * SEQ + t;
            const float it = bf2f(P[row * PW + C_MI + h]) + bi, ft = bf2f(P[row * PW + C_MF + h]) + bfv;
            const float lf = logsigmoidf_(ft);
            const float mn = fmaxf(lf + m, it), ip = __expf(it - mn), fp = __expf(lf + m - mn); m = mn;
            const float vv = bf2f(P[row * PW + C_MV + h * HD + v]);
            const f32x4* qp = (const f32x4*)(QK + row * 2048 + h * HD + kq * 32);
            const f32x4* kp = (const f32x4*)(QK + row * 2048 + 1024 + h * HD + kq * 32);
            float num = 0.f, den = 0.f;
#pragma unroll
            for (int j4 = 0; j4 < 8; ++j4) { const f32x4 q = qp[j4], k = kp[j4];
#pragma unroll
                for (int c = 0; c < 4; ++c) { const int j = 4 * j4 + c; const float qq = q[c] * 0.08838834764831845f;
                    C[j] = fp * C[j] + ip * vv * k[c]; nn[j] = fp * nn[j] + ip * k[c]; num += C[j] * qq; den += nn[j] * qq; } }
            num += __shfl_xor(num, 1); num += __shfl_xor(num, 2); den += __shfl_xor(den, 1); den += __shfl_xor(den, 2);
            if (kq == 0) HR[row * 1024 + h * HD + v] = num / fmaxf(fabsf(den), __expf(-m));
        }
    }
}
__device__ __forceinline__ void nv_mnorm(const Frame& F, int l) {
    const bf16* P = (const bf16*)(F.ws + WS_PROJ); const float* HR = (const float*)(F.ws + WS_TMP + 64 * MiB); bf16* BR = (bf16*)(F.ws + WS_BR);
    const float* g = F.in[6] + (size_t)l * BW;
    const int gw = GW_ID(F), NGW = GW_N(F), lane = F.lane;
    for (int it = gw; it < NTOK * NH; it += NGW) {
        const size_t row = it >> 3; const int h = it & 7, c = h * HD + 2 * lane;
        const float a = HR[row * 1024 + c], b = HR[row * 1024 + c + 1];
        const float r = 1.0f / sqrtf(wave_sum(a * a + b * b) * (1.f / HD) + EPS);
        const float o0 = a * r * g[c] * sigmoidf_(bf2f(P[row * PW + C_MO + c])), o1 = b * r * g[c + 1] * sigmoidf_(bf2f(P[row * PW + C_MO + c + 1]));
        *(unsigned*)(BR + row * 3072 + c) = pk2(o0, o1);
    }
}
__device__ __forceinline__ unsigned fkey(float f) { const unsigned u = __float_as_uint(f); return (u & 0x80000000u) ? ~u : (u | 0x80000000u); }
__device__ __forceinline__ void select_row(const unsigned (&key)[32], int nvalid, unsigned long long* mrow, int lane) {
    if (nvalid <= TOPK) {
#pragma unroll
        for (int j = 0; j < 32; ++j) { const unsigned long long b = __ballot(lane + 64 * j < nvalid); if (lane == 0) mrow[j] = b; }
        return;
    }
    unsigned T = 0u;
    for (int bit = 31; bit >= 0; --bit) {
        const unsigned cand = T | (1u << bit); int c = 0;
#pragma unroll
        for (int j = 0; j < 32; ++j) c += (key[j] >= cand) ? 1 : 0;
#pragma unroll
        for (int o = 1; o < 64; o <<= 1) c += __shfl_xor(c, o);
        if (c >= TOPK) T = cand;
    }
    int cgt = 0;
#pragma unroll
    for (int j = 0; j < 32; ++j) cgt += (key[j] > T) ? 1 : 0;
#pragma unroll
    for (int o = 1; o < 64; o <<= 1) cgt += __shfl_xor(cgt, o);
    const int need = TOPK - cgt; int run = 0;
    const unsigned long long below = (lane == 0) ? 0ull : (~0ull >> (64 - lane));
#pragma unroll
    for (int j = 0; j < 32; ++j) {
        const bool eq = key[j] == T; const unsigned long long be = __ballot(eq);
        const int rank = run + __popcll(be & below);
        const bool sel = (key[j] > T) || (eq && rank < need);
        run += __popcll(be);
        const unsigned long long b = __ballot(sel); if (lane == 0) mrow[j] = b;
    }
}
__device__ __forceinline__ void nv_index(const Frame& F) {
    const bf16* P = (const bf16*)(F.ws + WS_PROJ); unsigned long long* MK = (unsigned long long*)(F.ws + WS_MASK);
    LAS float* iqL = (LAS float*)(F.lds + F.wave * 12288); LAS float* scL = iqL + 1024;
    const int gw = GW_ID(F), NGW = GW_N(F), lane = F.lane;
    for (int row = gw; row < NTOK; row += NGW) {
        const int t = row & (SEQ - 1), r0 = row - t;
        for (int i = lane; i < 1024; i += 64) iqL[i] = bf2f(P[(size_t)row * PW + C_IQ + i]);
        float w[16];
#pragma unroll
        for (int hh = 0; hh < 16; ++hh) w[hh] = bf2f(P[(size_t)row * PW + C_IW + hh]) * 0.25f;
        LDS_WAIT(); asm volatile("" ::: "memory");
        for (int s = lane; s <= t; s += 64) {
            float d[16];
#pragma unroll
            for (int hh = 0; hh < 16; ++hh) d[hh] = 0.f;
            const v4u* kp = (const v4u*)(P + (size_t)(r0 + s) * PW + C_IK);
#pragma unroll 1
            for (int hf = 0; hf < 2; ++hf) {
                float kr[32];
#pragma unroll
                for (int q = 0; q < 4; ++q) { const v4u x = kp[4 * hf + q]; kr[8 * q] = bflo(x.x); kr[8 * q + 1] = bfhi(x.x); kr[8 * q + 2] = bflo(x.y); kr[8 * q + 3] = bfhi(x.y); kr[8 * q + 4] = bflo(x.z); kr[8 * q + 5] = bfhi(x.z); kr[8 * q + 6] = bflo(x.w); kr[8 * q + 7] = bfhi(x.w); }
#pragma unroll
                for (int hh = 0; hh < 16; ++hh) {
#pragma unroll
                    for (int e = 0; e < 32; ++e) d[hh] += iqL[hh * 64 + hf * 32 + e] * kr[e]; }
            }
            float sc = 0.f;
#pragma unroll
            for (int hh = 0; hh < 16; ++hh) sc += w[hh] * fmaxf(d[hh] * 0.125f, 0.f);
            scL[s] = sc;
        }
        LDS_WAIT(); asm volatile("" ::: "memory");
        unsigned key[32];
#pragma unroll
        for (int j = 0; j < 32; ++j) { const int s = lane + 64 * j; key[j] = (s <= t) ? fkey(scL[s]) : 0u; }
        select_row(key, t + 1, MK + (size_t)row * 32, lane);
        LDS_WAIT(); asm volatile("" ::: "memory");
    }
}
__device__ __forceinline__ void nv_dsa(const Frame& F, int l) {
    const bf16* P = (const bf16*)(F.ws + WS_PROJ); const unsigned long long* MK = (const unsigned long long*)(F.ws + WS_MASK); bf16* BR = (bf16*)(F.ws + WS_BR);
    const float* qg = F.in[7] + l * HD; const float* kg = F.in[8] + l * HD; const float* rb = F.in[19];
    LAS float* lgL = (LAS float*)(F.lds + F.wave * 2048); LAS int* ixL = (LAS int*)(lgL + 256);
    const int gw = GW_ID(F), NGW = GW_N(F), lane = F.lane;
    for (int it = gw; it < NTOK * NH; it += NGW) {
        const int row = it >> 3, h = it & 7, t = row & (SEQ - 1), r0 = row - t, c = h * HD + 2 * lane;
        float q0 = bf2f(P[(size_t)row * PW + C_DQ + c]), q1 = bf2f(P[(size_t)row * PW + C_DQ + c + 1]);
        const float qr = 1.0f / sqrtf(wave_sum(q0 * q0 + q1 * q1) * (1.f / HD) + EPS);
        q0 *= qr * qg[2 * lane]; q1 *= qr * qg[2 * lane + 1];
        const float kg0 = kg[2 * lane], kg1 = kg[2 * lane + 1];
        int cnt = 0; float mx = -3.0e38f;
        for (int wi = 0; wi <= (t >> 6); ++wi) {
            unsigned long long w = MK[(size_t)row * 32 + wi];
            while (w) { const int s = wi * 64 + __builtin_ctzll(w); w &= w - 1;
                const unsigned kk = *(const unsigned*)(P + (size_t)(r0 + s) * PW + C_DK + c);
                const float k0 = bflo(kk), k1 = bfhi(kk);
                const float ss = wave_sum(k0 * k0 + k1 * k1), dd = wave_sum(q0 * k0 * kg0 + q1 * k1 * kg1);
                const float kr = 1.0f / sqrtf(ss * (1.f / HD) + EPS);
                const float lgt = dd * kr * 0.08838834764831845f + rb[t5_bucket(t - s) * NH + h];
                if (lane == 0) { lgL[cnt] = lgt; ixL[cnt] = s; }
                mx = fmaxf(mx, lgt); ++cnt; }
        }
        LDS_WAIT(); asm volatile("" ::: "memory");
        float o0 = 0.f, o1 = 0.f, den = 0.f;
        for (int j = 0; j < cnt; ++j) { const float p = __expf(lgL[j] - mx); const int s = ixL[j];
            const unsigned vv = *(const unsigned*)(P + (size_t)(r0 + s) * PW + C_DV + c);
            o0 += p * bflo(vv); o1 += p * bfhi(vv); den += p; }
        *(unsigned*)(BR + (size_t)row * 3072 + 1024 + c) = pk2(o0 / den, o1 / den);
        LDS_WAIT(); asm volatile("" ::: "memory");
    }
}
__device__ __forceinline__ void nv_sb(const Frame& F) {
    const bf16* P = (const bf16*)(F.ws + WS_PROJ); bf16* BR = (bf16*)(F.ws + WS_BR);
    const int gw = GW_ID(F), NGW = GW_N(F), lane = F.lane;
    for (int it = gw; it < NTOK * NH; it += NGW) {
        const int row = it >> 3, h = it & 7, t = row & (SEQ - 1), r0 = row - t, c = h * HD + 2 * lane;
        const unsigned qq = *(const unsigned*)(P + (size_t)row * PW + C_SQ + c);
        const float q0 = bflo(qq) * 0.08838834764831845f, q1 = bfhi(qq) * 0.08838834764831845f;
        float o0 = 0.f, o1 = 0.f, lp = 0.f;
        for (int s = t - 1; s >= 0; --s) {
            const unsigned kk = *(const unsigned*)(P + (size_t)(r0 + s) * PW + C_SK + c);
            const float z = wave_sum(q0 * bflo(kk) + q1 * bfhi(kk));
            const float a = __expf(logsigmoidf_(z) + lp);
            const unsigned vv = *(const unsigned*)(P + (size_t)(r0 + s) * PW + C_SV + c);
            o0 += a * bflo(vv); o1 += a * bfhi(vv);
            lp += logsigmoidf_(-z);
            if (lp < -80.f) break;
        }
        *(unsigned*)(BR + (size_t)row * 3072 + 2048 + c) = pk2(o0, o1);
    }
}
__device__ __forceinline__ void nv_moe(const Frame& F) {
    const bf16* XN = (const bf16*)(F.ws + WS_XN); bf16* YB = (bf16*)(F.ws + WS_YB); const int* tinfo = tokinfo_ptr(F);
    LAS float* xL = (LAS float*)F.lds; LAS float* hL = xL + 2048;
    const int tid = F.tid;
    for (int slot = F.vcu; slot < 2 * NTOK; slot += F.G) {
        const int m = slot >> 1, k = slot & 1; const int e = tinfo[m * 8 + 4 * k]; const float w = __int_as_float(tinfo[m * 8 + 4 * k + 2]);
        __syncthreads();
        for (int i = tid; i < 2048; i += NTHR) xL[i] = bf2f(XN[(size_t)m * DM + i]);
        __syncthreads();
        { const int f = tid; const bf16* wg = (const bf16*)(F.ws + WS_WGU) + ((size_t)e * 1024 + (f >> 7) * 256 + (f & 127)) * DM; const bf16* wu = wg + (size_t)128 * DM;
          float g = 0.f, u = 0.f;
          for (int k8 = 0; k8 < 256; ++k8) { const v4u a = ((const v4u*)wg)[k8], b = ((const v4u*)wu)[k8]; const LAS float* x = xL + 8 * k8;
              g += x[0] * bflo(a.x) + x[1] * bfhi(a.x) + x[2] * bflo(a.y) + x[3] * bfhi(a.y) + x[4] * bflo(a.z) + x[5] * bfhi(a.z) + x[6] * bflo(a.w) + x[7] * bfhi(a.w);
              u += x[0] * bflo(b.x) + x[1] * bfhi(b.x) + x[2] * bflo(b.y) + x[3] * bfhi(b.y) + x[4] * bflo(b.z) + x[5] * bfhi(b.z) + x[6] * bflo(b.w) + x[7] * bfhi(b.w); }
          hL[f] = bf2f((unsigned short)f2bf(siluf_(g) * u)); }
        __syncthreads();
        { float y[4];
#pragma unroll
          for (int c = 0; c < 4; ++c) { const int d = 4 * tid + c; const bf16* wd = (const bf16*)(F.ws + WS_WDN) + ((size_t)e * DM + d) * DEXP; float a = 0.f;
              for (int k8 = 0; k8 < 64; ++k8) { const v4u x = ((const v4u*)wd)[k8]; const LAS float* hh = hL + 8 * k8;
                  a += hh[0] * bflo(x.x) + hh[1] * bfhi(x.x) + hh[2] * bflo(x.y) + hh[3] * bfhi(x.y) + hh[4] * bflo(x.z) + hh[5] * bfhi(x.z) + hh[6] * bflo(x.w) + hh[7] * bfhi(x.w); }
              y[c] = a * w; }
          v2u o; o.x = pk2(y[0], y[1]); o.y = pk2(y[2], y[3]); *(v2u*)(YB + (size_t)slot * DM + 4 * tid) = o; }
    }
}
template <int LDA, int LDB> struct SchedDense {
    static constexpr bool GATHER = false;
    pg8::TileOrder T; const char* A; const char* B;
    __device__ __forceinline__ bool next(int i, pg8::Unit& u) const { u.e = 0; u.rows = 256; return T.tile(i, u.pm, u.pn); }
    __device__ __forceinline__ const char* a_base(const pg8::Unit& u) const { return A + (size_t)u.pm * 256 * LDA * 2; }
    __device__ __forceinline__ const char* b_base(const pg8::Unit& u) const { return B + (size_t)u.pn * 256 * LDB * 2; }
    __device__ __forceinline__ void a_off(const pg8::Unit&, const int (&R)[2], const int (&C)[2], unsigned (&v0)[2], unsigned (&v1)[2]) const {
#pragma unroll
        for (int i = 0; i < 2; ++i) { v0[i] = (unsigned)(R[i] * LDA + C[i]) * 2u; v1[i] = v0[i] + 128u * LDA * 2u; } }
};
struct EpiProj {
    static constexpr bool PERM = true;
    bf16* O;
    __device__ __forceinline__ void operator()(const f32x4 (&acc)[2][2][4][2], const pg8::Unit& u, int wr, int wc, int fr, int fq) const {
        const int row0 = u.pm * 256 + wr * 64 + fr, col0 = u.pn * 256 + wc * 32 + 8 * fq;
#pragma unroll
        for (int ai = 0; ai < 2; ++ai)
#pragma unroll
            for (int m = 0; m < 4; ++m) { bf16* rowp = O + (size_t)(row0 + ai * 128 + m * 16) * PW + col0;
#pragma unroll
                for (int bj = 0; bj < 2; ++bj) { const f32x4 v0 = acc[ai][bj][m][0], v1 = acc[ai][bj][m][1];
                    v4u w; w.x = cvt_pk_bf16(v0[0], v0[1]); w.y = cvt_pk_bf16(v0[2], v0[3]); w.z = cvt_pk_bf16(v1[0], v1[1]); w.w = cvt_pk_bf16(v1[2], v1[3]);
                    *(v4u*)(rowp + bj * 128) = w; } }
    }
};
struct SchedBranch {
    static constexpr bool GATHER = false;
    pg8::TileOrder T; const char* A; const char* B;
    __device__ __forceinline__ bool next(int i, pg8::Unit& u) const { u.e = i % 3; u.rows = 256; return T.tile(i / 3, u.pm, u.pn); }
    __device__ __forceinline__ const char* a_base(const pg8::Unit& u) const { return A + ((size_t)u.pm * 256 * 3072 + (size_t)u.e * 1024) * 2; }
    __device__ __forceinline__ const char* b_base(const pg8::Unit& u) const { return B + ((size_t)u.e * 2048 + (size_t)u.pn * 256) * 1024 * 2; }
    __device__ __forceinline__ void a_off(const pg8::Unit&, const int (&R)[2], const int (&C)[2], unsigned (&v0)[2], unsigned (&v1)[2]) const {
#pragma unroll
        for (int i = 0; i < 2; ++i) { v0[i] = (unsigned)(R[i] * 3072 + C[i]) * 2u; v1[i] = v0[i] + 128u * 3072u * 2u; } }
};
struct EpiBranch {
    static constexpr bool PERM = true;
    const bf16* P; float* scr; bf16* O;
    __device__ __forceinline__ void operator()(const f32x4 (&acc)[2][2][4][2], const pg8::Unit& u, int wr, int wc, int fr, int fq) const {
        const int row0 = u.pm * 256 + wr * 64 + fr, col0 = u.pn * 256 + wc * 32 + 8 * fq;
#pragma unroll
        for (int ai = 0; ai < 2; ++ai)
#pragma unroll
            for (int m = 0; m < 4; ++m) { const size_t row = (size_t)(row0 + ai * 128 + m * 16);
#pragma unroll
                for (int bj = 0; bj < 2; ++bj) { const int col = col0 + bj * 128;
                    const v4u gw = *(const v4u*)(P + row * PW + C_G + u.e * 2048 + col);
                    f32x4 v0 = acc[ai][bj][m][0], v1 = acc[ai][bj][m][1];
                    v0[0] *= sigmoidf_(bflo(gw.x)); v0[1] *= sigmoidf_(bfhi(gw.x)); v0[2] *= sigmoidf_(bflo(gw.y)); v0[3] *= sigmoidf_(bfhi(gw.y));
                    v1[0] *= sigmoidf_(bflo(gw.z)); v1[1] *= sigmoidf_(bfhi(gw.z)); v1[2] *= sigmoidf_(bflo(gw.w)); v1[3] *= sigmoidf_(bfhi(gw.w));
                    float* sp = scr + row * DM + col;
                    if (u.e > 0) { v0 += *(const f32x4*)sp; v1 += *(const f32x4*)(sp + 4); }
                    if (u.e < 2) { *(f32x4*)sp = v0; *(f32x4*)(sp + 4) = v1; }
                    else { v4u w; w.x = cvt_pk_bf16(v0[0], v0[1]); w.y = cvt_pk_bf16(v0[2], v0[3]); w.z = cvt_pk_bf16(v1[0], v1[1]); w.w = cvt_pk_bf16(v1[2], v1[3]);
                        *(v4u*)(O + row * DM + col) = w; } } }
    }
};
struct EpiOut {
    static constexpr bool PERM = false;
    const float* base; float* out;
    __device__ __forceinline__ void operator()(const f32x4 (&acc)[2][2][4][2], const pg8::Unit& u, int wr, int wc, int fr, int fq) const {
        const int row0 = u.pm * 256 + wr * 64 + fr, col0 = u.pn * 256 + wc * 32 + 4 * fq;
#pragma unroll
        for (int ai = 0; ai < 2; ++ai)
#pragma unroll
            for (int m = 0; m < 4; ++m) { const size_t off = (size_t)(row0 + ai * 128 + m * 16) * DM + col0;
#pragma unroll
                for (int bj = 0; bj < 2; ++bj)
#pragma unroll
                    for (int n = 0; n < 2; ++n) { const f32x4 bs = *(const f32x4*)(base + off + bj * 128 + n * 16); *(f32x4*)(out + off + bj * 128 + n * 16) = bs + acc[ai][bj][m][n]; } }
    }
};

#ifndef OFFMASK
#define OFFMASK 0
#endif
constexpr int PH_CONVW = 0, PH_NORM1 = 1, PH_INPROJ = 2, PH_NVCONV = 3, PH_NVMLSTM = 4, PH_NVMNORM = 5, PH_NVIDX = 6, PH_NVDSA = 7, PH_NVSB = 8,
              PH_BRANCH = 9, PH_OUT = 10, PH_NORM2 = 11, PH_MOE = 12, NPH_L = 13, PH_FINAL = DEPTH * NPH_L, NPH = PH_FINAL + 1;

__global__ void __launch_bounds__(NTHR, 2) fwd_kernel(Args args) {
    extern __shared__ __attribute__((aligned(16))) unsigned char lds_raw[];
    Frame F;
    F.lds = (LAS unsigned char*)lds_raw;
    F.tid = threadIdx.x; F.lane = F.tid & 63; F.wave = __builtin_amdgcn_readfirstlane(F.tid >> 6);
    F.G = gridDim.x; { const int bx = blockIdx.x; F.vcu = (F.G % 8 == 0) ? (bx % 8) * (F.G / 8) + bx / 8 : bx; }
    F.ws = args.ws; F.ctl = (unsigned*)(args.ws + WS_CTL);
#pragma unroll
    for (int i = 0; i < 20; ++i) F.in[i] = args.in[i];
    volatile LAS unsigned* MISC = (volatile LAS unsigned*)(F.lds + LDSCTL_OFF);
    for (int u = F.tid; u < (LDS_BYTES - LDSCTL_OFF) / 4; u += NTHR) ((LAS unsigned*)(F.lds + LDSCTL_OFF))[u] = 0u;
    __syncthreads();
    XcdBarrier bar; bar.bar = F.ctl + CW_BAR; bar.x = 0; bar.st = nullptr;
    if (args.use_bar) bar = xcd_barrier_post(F.ctl + CW_BAR, MISC + 8);
    const int lo = args.ph_lo, hi = args.ph_hi;
#define IN(k) (lo <= (k) && (k) < hi)
#define FRESH() do { int t_ = threadIdx.x; asm volatile("" : "+v"(t_)); F.tid = t_; F.lane = t_ & 63; F.wave = __builtin_amdgcn_readfirstlane(t_ >> 6); } while (0)
#define SEAM(k) do { if (args.use_bar && IN((k) + 1)) xcd_barrier(bar); } while (0)
    for (int l = 0; l < DEPTH; ++l) {
        const int p0 = l * NPH_L;
        if (IN(p0 + PH_CONVW)) { FRESH(); if (!(OFFMASK & (1<<0))) ph_convw(F, l); SEAM(p0 + PH_CONVW); }
        if (IN(p0 + PH_NORM1)) { FRESH(); if (!(OFFMASK & (1<<1))) ph_norm1(F, l); SEAM(p0 + PH_NORM1); }
        if (IN(p0 + PH_INPROJ)) {
            SchedDense<DM, DM> S; S.T.init(NTOK / 256, PW / 256, F.G, (int)blockIdx.x); S.A = (const char*)(F.ws + WS_XN); S.B = (const char*)(F.ws + WS_WIN);
            EpiProj E{(bf16*)(F.ws + WS_PROJ)};
            if (!(OFFMASK & (1<<10))) pg8::gemm_phase<SchedDense<DM, DM>, EpiProj, DM, DM, DM, true>(F.lds, S, E);
            SEAM(p0 + PH_INPROJ);
        }
        if (IN(p0 + PH_NVCONV)) { FRESH(); if (!(OFFMASK & (1<<2))) nv_conv(F, l); SEAM(p0 + PH_NVCONV); }
        if (IN(p0 + PH_NVMLSTM)) { FRESH(); if (!(OFFMASK & (1<<3))) nv_mlstm(F, l); SEAM(p0 + PH_NVMLSTM); }
        if (IN(p0 + PH_NVMNORM)) { FRESH(); if (!(OFFMASK & (1<<4))) nv_mnorm(F, l); SEAM(p0 + PH_NVMNORM); }
        if (IN(p0 + PH_NVIDX)) { FRESH(); if (!(OFFMASK & (1<<5))) nv_index(F); SEAM(p0 + PH_NVIDX); }
        if (IN(p0 + PH_NVDSA)) { FRESH(); if (!(OFFMASK & (1<<6))) nv_dsa(F, l); SEAM(p0 + PH_NVDSA); }
        if (IN(p0 + PH_NVSB)) { FRESH(); if (!(OFFMASK & (1<<7))) nv_sb(F); SEAM(p0 + PH_NVSB); }
        if (IN(p0 + PH_BRANCH)) {
            SchedBranch S; S.T.init(NTOK / 256, DM / 256, F.G, (int)blockIdx.x); S.A = (const char*)(F.ws + WS_BR); S.B = (const char*)(F.ws + WS_WBR);
            EpiBranch E{(const bf16*)(F.ws + WS_PROJ), (float*)(F.ws + WS_X1), (bf16*)(F.ws + WS_MRG)};
            if (!(OFFMASK & (1<<11))) pg8::gemm_phase<SchedBranch, EpiBranch, BW, 3072, BW, true>(F.lds, S, E);
            SEAM(p0 + PH_BRANCH);
        }
        if (IN(p0 + PH_OUT)) {
            SchedDense<DM, DM> S; S.T.init(NTOK / 256, DM / 256, F.G, (int)blockIdx.x); S.A = (const char*)(F.ws + WS_MRG); S.B = (const char*)(F.ws + WS_WOUT);
            EpiOut E{l == 0 ? F.in[0] : (const float*)(F.ws + WS_XA), (float*)(F.ws + WS_X1)};
            if (!(OFFMASK & (1<<12))) pg8::gemm_phase<SchedDense<DM, DM>, EpiOut, DM, DM, DM, true>(F.lds, S, E);
            SEAM(p0 + PH_OUT);
        }
        if (IN(p0 + PH_NORM2)) { FRESH(); if (!(OFFMASK & (1<<8))) ph_norm2(F, l); SEAM(p0 + PH_NORM2); }
        if (IN(p0 + PH_MOE)) { FRESH(); if (!(OFFMASK & (1<<9))) nv_moe(F); SEAM(p0 + PH_MOE); }
    }
    if (IN(PH_FINAL)) { FRESH(); } if (IN(PH_FINAL)) ph_final(F, args.out);
#undef IN
#undef SEAM
}

#ifndef MK_ONE_LAUNCH
#define MK_ONE_LAUNCH 1
#endif
extern "C" void kernel_launch(void* const* d_in, const int* in_sizes, int n_in, void* d_out, int out_size, void* d_ws, size_t ws_size, hipStream_t stream) {
    static int grid = 0;
    if (grid == 0) {
        if (n_in != 20 || in_sizes[0] != NTOK * DM || out_size != NTOK * DM || ws_size < WS_END) { fprintf(stderr, "kernel_launch: shape mismatch (n_in %d, ws %zu < %zu?)\n", n_in, ws_size, (size_t)WS_END); grid = -1; return; }
        int dev = 0, cus = 0, per_cu = 0;
        if (hipGetDevice(&dev) != hipSuccess || hipDeviceGetAttribute(&cus, hipDeviceAttributeMultiprocessorCount, dev) != hipSuccess) { grid = -1; return; }
        if (hipFuncSetAttribute((const void*)fwd_kernel, hipFuncAttributeMaxDynamicSharedMemorySize, LDS_BYTES) != hipSuccess) { fprintf(stderr, "kernel_launch: hipFuncSetAttribute failed\n"); grid = -1; return; }
        if (hipOccupancyMaxActiveBlocksPerMultiprocessor(&per_cu, (const void*)fwd_kernel, NTHR, LDS_BYTES) != hipSuccess || per_cu < 1) fprintf(stderr, "kernel_launch: occupancy query says %d\n", per_cu);
        (void)hipGetLastError();
        grid = cus;
    }
    if (grid < 0) return;
    if (hipMemsetAsync((char*)d_ws + WS_CTL, 0, CTL_ZERO_BYTES, stream) != hipSuccess) return;
    Args a{};
    for (int i = 0; i < 20; ++i) a.in[i] = (const float*)d_in[i];
    a.out = (float*)d_out; a.ws = (unsigned char*)d_ws;
#if MK_ONE_LAUNCH
    a.ph_lo = 0; a.ph_hi = NPH; a.use_bar = 1; a.pad = 0;
    hipLaunchKernelGGL(fwd_kernel, dim3(grid), dim3(NTHR), LDS_BYTES, stream, a);
#else
    for (int ph = 0; ph < NPH; ++ph) { a.ph_lo = ph; a.ph_hi = ph + 1; a.use_bar = 0; a.pad = 0;
        hipLaunchKernelGGL(fwd_kernel, dim3(grid), dim3(NTHR), LDS_BYTES, stream, a); }
#endif
    const hipError_t le = hipPeekAtLastError();
    if (le != hipSuccess) fprintf(stderr, "kernel_launch: launch failed: %s\n", hipGetErrorName(le));
}
```

```cpp
#include <hip/hip_runtime.h>
#include <cstdio>
#include <cstdint>

constexpr int BATCH = 4, SEQ = 2048, DM = 2048, NTOK = BATCH * SEQ, NH = 8, HD = 128, BW = 1024, DEPTH = 2;
constexpr int NIN = 17504, PW = 17664;
constexpr int IDXH = 16, IDXD = 64, TOPK = 256, NEXP = 32, NGRP = 4, EPG = 8, DEXP = 512, MCH = 64, NCH = SEQ / MCH;
constexpr float EPS = 1e-6f;
constexpr int C_MQ = 0, C_MK = 1024, C_MV = 2048, C_MO = 3072, C_DQ = 4096, C_DK = 5120, C_DV = 6144, C_IQ = 7168, C_SQ = 8192, C_SK = 9216, C_SV = 10240,
              C_G = 11264, C_MI = 17408, C_MF = 17416, C_IK = 17424, C_IW = 17488;
__host__ __device__ __forceinline__ int src_col(int c) {
    if (c < 4096) return c;
    if (c < 8192) return c + 16;
    if (c < 17408) return c + 96;
    if (c < 17424) return 4096 + (c - 17408);
    if (c < 17488) return 8208 + (c - 17424);
    if (c < 17504) return 8272 + (c - 17488);
    return -1;
}

constexpr size_t MiB = 1u << 20;
constexpr size_t WS_CTL = 0, CTL_ZERO_BYTES = 1 * MiB;
constexpr size_t WS_WIN = 1 * MiB;
constexpr size_t WS_WBR = WS_WIN + 69 * MiB;
constexpr size_t WS_WOUT = WS_WBR + 12 * MiB;
constexpr size_t WS_WGU = WS_WOUT + 8 * MiB;
constexpr size_t WS_WDN = WS_WGU + 128 * MiB;
constexpr size_t WS_XN = WS_WDN + 64 * MiB;
constexpr size_t WS_XA = WS_XN + 32 * MiB;
constexpr size_t WS_X1 = WS_XA + 64 * MiB;
constexpr size_t WS_PROJ = WS_X1 + 64 * MiB;
constexpr size_t WS_BR = WS_PROJ + 276 * MiB;
constexpr size_t WS_MRG = WS_BR + 48 * MiB;
constexpr size_t WS_MASK = WS_MRG + 32 * MiB;
constexpr size_t WS_MDEL = WS_MASK + 2 * MiB;
constexpr size_t WS_MDN = WS_MDEL + 64 * MiB;
constexpr size_t WS_MST = WS_MDN + 1 * MiB;
constexpr size_t WS_MSN = WS_MST + 32 * MiB;
constexpr size_t WS_HB = WS_MSN + 1 * MiB;
constexpr size_t WS_YB = WS_HB + 16 * MiB;
constexpr size_t WS_LIST = WS_YB + 64 * MiB;
constexpr size_t WS_TMP = WS_LIST + 2 * MiB;
constexpr size_t WS_END = WS_TMP + 96 * MiB;
static_assert(WS_END <= 1100 * MiB, "workspace map");

constexpr int CW_BAR = 4096;
constexpr int CW_ECNT = 16384;

#define GAS __attribute__((address_space(1)))
#define LAS __attribute__((address_space(3)))
typedef unsigned short bf16;
typedef unsigned v4u __attribute__((ext_vector_type(4)));
typedef unsigned v2u __attribute__((ext_vector_type(2)));
typedef float f32x4 __attribute__((ext_vector_type(4)));
typedef float f32x2 __attribute__((ext_vector_type(2)));
typedef float f32x16 __attribute__((ext_vector_type(16)));
typedef short bf16x8 __attribute__((ext_vector_type(8)));
typedef short s16x4 __attribute__((ext_vector_type(4)));
#define RLX_AGENT __ATOMIC_RELAXED, __HIP_MEMORY_SCOPE_AGENT
#define LDS_WAIT() asm volatile("s_waitcnt lgkmcnt(0)" ::: "memory")
#define VM_WAIT() asm volatile("s_waitcnt vmcnt(0)" ::: "memory")
constexpr int NWAVES = 8, NTHR = 512;
constexpr int RING_BYTES = 131072, LDSCTL_OFF = RING_BYTES, LDS_BYTES = 147456;

__device__ __forceinline__ unsigned f2bf(float f) { unsigned u = __builtin_bit_cast(unsigned, f); return (u + 0x7fffu + ((u >> 16) & 1u)) >> 16; }
__device__ __forceinline__ unsigned pk2(float lo, float hi) { return f2bf(lo) | (f2bf(hi) << 16); }
__device__ __forceinline__ float bf2f(unsigned short b) { return __builtin_bit_cast(float, ((unsigned)b) << 16); }
__device__ __forceinline__ float bflo(unsigned w) { return __builtin_bit_cast(float, w << 16); }
__device__ __forceinline__ float bfhi(unsigned w) { return __builtin_bit_cast(float, w & 0xffff0000u); }
__device__ __forceinline__ unsigned cvt_pk_bf16(float lo, float hi) { unsigned r; asm volatile("v_cvt_pk_bf16_f32 %0, %1, %2" : "=v"(r) : "v"(lo), "v"(hi)); return r; }
__device__ __forceinline__ float wave_sum(float v) {
#pragma unroll
    for (int o = 1; o < 64; o <<= 1) v += __shfl_xor(v, o);
    return v;
}
__device__ __forceinline__ float wave_max(float v) {
#pragma unroll
    for (int o = 1; o < 64; o <<= 1) v = fmaxf(v, __shfl_xor(v, o));
    return v;
}
__device__ __forceinline__ float sigmoidf_(float x) { return 1.0f / (1.0f + __expf(-x)); }
__device__ __forceinline__ float siluf_(float x) { return x / (1.0f + __expf(-x)); }
__device__ __forceinline__ float logsigmoidf_(float x) { return fminf(x, 0.f) - log1pf(__expf(-fabsf(x))); }
__device__ __forceinline__ int t5_bucket(int n) {
    if (n < 16) return n;
    return 16 + (n >= 19) + (n >= 21) + (n >= 24) + (n >= 27) + (n >= 31) + (n >= 35) + (n >= 40) + (n >= 46) + (n >= 52) + (n >= 59) + (n >= 67) + (n >= 77) + (n >= 87) + (n >= 99) + (n >= 113);
}
namespace pg8 {
constexpr int BM = 256, BK = 64, HALF = 128, HTB = HALF * BK * 2, STAGE_BYTES = 8 * HTB, NXCD = 8, WGM = 8;
__host__ __device__ __forceinline__ int lds_byte(int r, int c) { const int st = (r >> 4) * 2 + (c >> 5), rr = r & 15, cc = c & 31, ob = rr * 64 + cc * 2; return st * 1024 + (ob ^ (((ob >> 9) & 1) << 5)); }
__host__ __device__ __forceinline__ void stage_rc(int b, int& R, int& C) { const int st = b / 1024, sb = b % 1024, swz = sb ^ (((sb >> 9) & 1) << 5); R = (st >> 1) * 16 + swz / 64; C = (st & 1) * 32 + (swz % 64) / 2; }
__host__ __device__ __forceinline__ int perm32(int rho) { const int n = rho >> 4, i = rho & 15; return 8 * (i >> 2) + 4 * n + (i & 3); }

struct Unit { int pm, pn, e, rows; };

struct TileOrder {
    int nM, nN, nwg, G, c;
    __device__ void init(int nM_, int nN_, int G_, int c_) { nM = nM_; nN = nN_; nwg = nM * nN; G = G_; c = c_; }
    __device__ bool tile(int i, int& pm, int& pn) const {
        const long L = (long)i * G + c; if (L >= nwg) return false;
        int wgid = (int)L; { const int q = nwg / NXCD, r = nwg % NXCD, xcd = wgid % NXCD, off = wgid / NXCD; wgid = (xcd < r ? xcd * (q + 1) : r * (q + 1) + (xcd - r) * q) + off; }
        const int nig = WGM * nN, gid = wgid / nig, fm = gid * WGM, gsz = (nM - fm) < WGM ? (nM - fm) : WGM;
        pm = fm + ((wgid % nig) % gsz); pn = (wgid % nig) / gsz; return true;
    }
};

template <class Sched, class Epi, int K, int LDA, int LDB, bool ALIGN_EPI>
__device__ __forceinline__ void gemm_phase(LAS unsigned char* lds, const Sched& S, const Epi& E) {
    int tid_ = threadIdx.x; asm volatile("" : "+v"(tid_));
    const int tid = tid_, wid = __builtin_amdgcn_readfirstlane(tid >> 6), lane = tid & 63, wr = wid >> 2, wc = wid & 3, fr = lane & 15, fq = lane >> 4;
    constexpr int nt = K / BK;
    static_assert(K % 128 == 0 && K >= 256, "K");
    unsigned voffB[2];
#pragma unroll
    for (int i = 0; i < 2; ++i) { int R, C; stage_rc(tid * 16 + i * 8192, R, C); const int Rb = Epi::PERM ? ((R & ~31) + perm32(R & 31)) : R;
        voffB[i] = (unsigned)(Rb * LDB + C) * 2u; }
    constexpr size_t kstep = (size_t)(BK * 2);
    constexpr size_t hstepB = (size_t)HALF * LDB * 2;
    constexpr size_t hstepA = Sched::GATHER ? 0 : (size_t)HALF * LDA * 2;
    const unsigned ldsw = (unsigned)wid * 1024u;
    const int aoff = lds_byte(wr * 64 + fr, fq * 8), boff = lds_byte(wc * 32 + fr, fq * 8);
#define PG8_SA(b, h) (((b) * 2 + (h)) * HTB)
#define PG8_SB(b, h) ((4 + (b) * 2 + (h)) * HTB)
#define PG8_STAGE(bufoff, gbase, voff) do { _Pragma("unroll") for (int _i = 0; _i < 2; ++_i) \
        __builtin_amdgcn_global_load_lds((const unsigned*)((const char*)(gbase) + (voff)[_i]), (LAS unsigned*)(lds + (bufoff) + ldsw + _i * 8192), 16, 0, 0); } while (0)
#define PG8_LDA(dst, b, h) do { _Pragma("unroll") for (int m = 0; m < 4; ++m) _Pragma("unroll") for (int k = 0; k < 2; ++k) dst[m][k] = *(const LAS bf16x8*)(lds + PG8_SA(b, h) + aoff + m * 2048 + k * 1024); } while (0)
#define PG8_LDB(dst, b, h) do { _Pragma("unroll") for (int n = 0; n < 2; ++n) _Pragma("unroll") for (int k = 0; k < 2; ++k) dst[n][k] = *(const LAS bf16x8*)(lds + PG8_SB(b, h) + boff + n * 2048 + k * 1024); } while (0)
#define PG8_MMA(ai, bj, At, Bt) do { __builtin_amdgcn_s_setprio(1); _Pragma("unroll") for (int m = 0; m < 4; ++m) _Pragma("unroll") for (int n = 0; n < 2; ++n) _Pragma("unroll") for (int k = 0; k < 2; ++k) \
        acc[ai][bj][m][n] = __builtin_amdgcn_mfma_f32_16x16x32_bf16(Bt[n][k], At[m][k], acc[ai][bj][m][n], 0, 0, 0); __builtin_amdgcn_s_setprio(0); } while (0)
#define VA1 (Sched::GATHER ? vA1 : vA0)
#define W0 vA0
#define W1 VA1
#define PG8_WAIT_V(n) asm volatile("s_waitcnt vmcnt(" #n ")" ::: "memory")
#define PG8_WAIT_L(n) asm volatile("s_waitcnt lgkmcnt(" #n ")" ::: "memory")
#define PG8_BAR __builtin_amdgcn_s_barrier()
#define PG8_SCHED __builtin_amdgcn_sched_barrier(0)
    Unit cur, nxt; int ui = 0;
    if (!S.next(0, cur)) return;
    f32x4 acc[2][2][4][2];
#pragma unroll
    for (int a = 0; a < 2; ++a)
#pragma unroll
        for (int b = 0; b < 2; ++b)
#pragma unroll
            for (int m = 0; m < 4; ++m)
#pragma unroll
                for (int n = 0; n < 2; ++n) acc[a][b][m][n] = (f32x4){0.f, 0.f, 0.f, 0.f};
    bf16x8 At[4][2], B0[2][2], B1[2][2];
    unsigned vA0[2], vA1[2];
    S.a_off(cur, tid, vA0, vA1);
    const char* cA = S.a_base(cur); const char* cB = S.b_base(cur);
    PG8_STAGE(PG8_SB(0, 0), cB, voffB); PG8_STAGE(PG8_SB(0, 1), cB + hstepB, voffB); PG8_STAGE(PG8_SA(0, 0), cA, vA0); PG8_STAGE(PG8_SA(0, 1), cA + hstepA, VA1);
    if (wr == 1) PG8_BAR;
    PG8_WAIT_V(2); PG8_BAR;
    PG8_STAGE(PG8_SB(1, 0), cB + kstep, voffB); PG8_STAGE(PG8_SA(1, 0), cA + kstep, vA0); PG8_STAGE(PG8_SB(1, 1), cB + hstepB + kstep, voffB);
    PG8_WAIT_V(6); PG8_BAR;
    for (;;) {
        const bool has_next = S.next(ui + 1, nxt);
        const char* nA = has_next ? S.a_base(nxt) : cA; const char* nB = has_next ? S.b_base(nxt) : cB;
        for (int t = 0; t < nt; t += 2) {
            const bool last = (t == nt - 2);
            const char* a1 = cA + (size_t)(t + 1) * kstep;
            const char* a2 = last ? nA : cA + (size_t)(t + 2) * kstep; const char* b2 = last ? nB : cB + (size_t)(t + 2) * kstep;
            const char* a3 = a2 + kstep; const char* b3 = b2 + kstep;
            PG8_LDB(B0, 0, 0); PG8_LDB(B1, 0, 1); PG8_SCHED; PG8_LDA(At, 0, 0); PG8_STAGE(PG8_SA(1, 1), a1 + hstepA, VA1);
            if constexpr (Sched::GATHER) { if (last && has_next) S.a_off(nxt, tid, vA0, vA1); }
            PG8_WAIT_V(8); PG8_WAIT_L(0); PG8_BAR; PG8_MMA(0, 0, At, B0); PG8_MMA(0, 1, At, B1); PG8_BAR; PG8_SCHED;
            PG8_LDA(At, 0, 1); PG8_STAGE(PG8_SB(0, 0), b2, voffB); PG8_STAGE(PG8_SB(0, 1), b2 + hstepB, voffB); PG8_STAGE(PG8_SA(0, 0), a2, W0);
            PG8_WAIT_V(8); PG8_WAIT_L(0); PG8_BAR; PG8_MMA(1, 0, At, B0); PG8_MMA(1, 1, At, B1); PG8_BAR; PG8_SCHED;
            PG8_LDB(B0, 1, 0); PG8_LDB(B1, 1, 1); PG8_SCHED; PG8_LDA(At, 1, 0); PG8_STAGE(PG8_SA(0, 1), a2 + hstepA, W1);
            PG8_WAIT_V(8); PG8_WAIT_L(0); PG8_BAR; PG8_MMA(0, 0, At, B0); PG8_MMA(0, 1, At, B1); PG8_BAR; PG8_SCHED;
            PG8_LDA(At, 1, 1); PG8_STAGE(PG8_SB(1, 0), b3, voffB); PG8_STAGE(PG8_SB(1, 1), b3 + hstepB, voffB); PG8_STAGE(PG8_SA(1, 0), a3, W0);
            PG8_WAIT_V(8); PG8_WAIT_L(0); PG8_BAR; PG8_MMA(1, 0, At, B0); PG8_MMA(1, 1, At, B1); PG8_BAR; PG8_SCHED;
        }
        if constexpr (ALIGN_EPI) { if (wr == 0) PG8_BAR; }
        { int fr_e = fr, fq_e = fq; asm volatile("" : "+v"(fr_e), "+v"(fq_e));
          E(acc, cur, wr, wc, fr_e, fq_e); }
        if (!has_next) break;
#pragma unroll
        for (int a = 0; a < 2; ++a)
#pragma unroll
            for (int b = 0; b < 2; ++b)
#pragma unroll
                for (int m = 0; m < 4; ++m)
#pragma unroll
                    for (int n = 0; n < 2; ++n) acc[a][b][m][n] = (f32x4){0.f, 0.f, 0.f, 0.f};
        cur = nxt; cA = nA; cB = nB; ++ui;
        if constexpr (ALIGN_EPI) { if (wr == 1) PG8_BAR; }
    }
    PG8_WAIT_V(0);
    if constexpr (!ALIGN_EPI) { if (wr == 0) PG8_BAR; }
    PG8_BAR;
#undef PG8_SA
#undef VA1
#undef W0
#undef W1
#undef PG8_SB
#undef PG8_STAGE
#undef PG8_LDA
#undef PG8_LDB
#undef PG8_MMA
#undef PG8_WAIT_V
#undef PG8_WAIT_L
#undef PG8_BAR
#undef PG8_SCHED
}
}
#define XB_TMO      128
#define XB_XCNT(j)  (256  + 64 * (j))
#define XB_XSUB(j)  (1280 + 64 * (j))
#define XB_XGEN(j)  (2304 + 64 * (j))
#define XB_TOP      3328
#define XB_TOPGEN   3392
#define XCD_BAR_WORDS 3456
#define XB_SPIN_CAP (1u << 18)
__device__ __forceinline__ unsigned xb_ld(unsigned* p)              { return __hip_atomic_load(p, __ATOMIC_RELAXED, __HIP_MEMORY_SCOPE_AGENT); }
__device__ __forceinline__ unsigned xb_add(unsigned* p, unsigned v) { return __hip_atomic_fetch_add(p, v, __ATOMIC_RELAXED, __HIP_MEMORY_SCOPE_AGENT); }
__device__ __forceinline__ unsigned xb_xcc_id() { return (unsigned)__builtin_amdgcn_s_getreg((3 << 11) | 20) & 0xFu; }
#define XB_SPIN(cond, bar) do { unsigned _sp = 0; while (cond) { __builtin_amdgcn_s_sleep(1); \
    if ((++_sp & 255u) == 0u) { if (xb_ld(&(bar)[XB_TMO])) break; if (_sp > XB_SPIN_CAP) { atomicAdd(&(bar)[XB_TMO], 1u); break; } } } } while (0)
struct XcdBarrier { unsigned* bar; unsigned x; volatile LAS unsigned* st; };
__device__ __forceinline__ XcdBarrier xcd_barrier_post(unsigned* bar, volatile LAS unsigned* st) {
    XcdBarrier b; b.bar = bar; b.x = xb_xcc_id(); b.st = st;
    if (threadIdx.x == 0) (void)xb_add(&bar[XB_XCNT(b.x)], 1u);
    return b;
}
__device__ __forceinline__ void xcd_barrier_complete(unsigned* bar, unsigned x, unsigned& nloc, unsigned& nx) {
    const unsigned G = gridDim.x * gridDim.y * gridDim.z;
    unsigned sum, cnt, mine, sp = 0u;
    for (;;) {
        sum = 0u; cnt = 0u; mine = 0u;
#pragma unroll
        for (unsigned j = 0; j < 16; ++j) { const unsigned c = xb_ld(&bar[XB_XCNT(j)]); sum += c; cnt += (c > 0u) ? 1u : 0u; mine = (j == x) ? c : mine; }
        if (sum == G) break;
        __builtin_amdgcn_s_sleep(1);
        if ((++sp & 255u) == 0u) { if (xb_ld(&bar[XB_TMO])) break; if (sp > XB_SPIN_CAP) { atomicAdd(&bar[XB_TMO], 1u); break; } }
    }
    nloc = mine > 0u ? mine : 1u; nx = cnt > 0u ? cnt : 1u;
}
__device__ __forceinline__ void xcd_barrier(const XcdBarrier& b) {
    asm volatile("s_waitcnt vmcnt(0)" ::: "memory");
    __syncthreads();
    if (threadIdx.x == 0) {
        unsigned* bar = b.bar; asm volatile("" : "+s"(bar));
        __builtin_amdgcn_s_waitcnt(0);
        unsigned nloc = b.st[0], nx = b.st[1];
        if (nloc == 0u) { xcd_barrier_complete(bar, b.x, nloc, nx); b.st[0] = nloc; b.st[1] = nx; }
        const unsigned old = xb_add(&bar[XB_XSUB(b.x)], 1u);
        const unsigned gen = old / nloc;
        if (old + 1u == (gen + 1u) * nloc) {
            __builtin_amdgcn_fence(__ATOMIC_RELEASE, "agent");
            asm volatile("s_waitcnt vmcnt(0)" ::: "memory");
            const unsigned og = xb_add(&bar[XB_TOP], 1u);
            const unsigned tg = og / nx;
            if (og + 1u == (tg + 1u) * nx) xb_add(&bar[XB_TOPGEN], 1u);
            else XB_SPIN(xb_ld(&bar[XB_TOPGEN]) == tg, bar);
            __builtin_amdgcn_fence(__ATOMIC_ACQUIRE, "agent");
            xb_add(&bar[XB_XGEN(b.x)], 1u);
            asm volatile("s_waitcnt vmcnt(0)" ::: "memory");
        } else {
            XB_SPIN(xb_ld(&bar[XB_XGEN(b.x)]) == gen, bar);
            __builtin_amdgcn_fence(__ATOMIC_ACQUIRE, "agent");
            asm volatile("s_waitcnt vmcnt(0)" ::: "memory");
        }
    }
    __syncthreads();
}

struct Args { const float* in[20]; float* out; unsigned char* ws; int ph_lo, ph_hi, use_bar, pad; };
struct Frame {
    LAS unsigned char* lds;
    unsigned* ctl;
    int tid, lane, wave, vcu, G;
    unsigned char* ws;
};
__device__ __forceinline__ const float* arg_in(int i) { asm volatile("" : "+s"(i)); return ((const float* const __attribute__((address_space(4)))*)__builtin_amdgcn_kernarg_segment_ptr())[i]; }
__device__ __forceinline__ unsigned char* arg_ws() { int i = 21; asm volatile("" : "+s"(i)); return ((unsigned char* const __attribute__((address_space(4)))*)__builtin_amdgcn_kernarg_segment_ptr())[i]; }
#define GW_ID(F) ((F).vcu * NWAVES + (F).wave)
#define GW_N(F) ((F).G * NWAVES)

__device__ __forceinline__ void cvt_item(const float* W, int ldw, int k0, int srcc, bf16* WT, size_t out_row0, int ldo, LAS float* scr, int lane) {
#pragma unroll 8
    for (int i = 0; i < 32; ++i) { const int kk = 2 * i + (lane >> 5); scr[kk * 33 + (lane & 31)] = srcc >= 0 ? W[(size_t)(k0 + kk) * ldw + srcc] : 0.f; }
    LDS_WAIT(); asm volatile("" ::: "memory");
    const int c = lane & 7;
#pragma unroll
    for (int j = 0; j < 4; ++j) { const int n = (lane >> 3) + 8 * j; const LAS float* s = scr + (8 * c) * 33 + n;
        v4u o; o.x = pk2(s[0 * 33], s[1 * 33]); o.y = pk2(s[2 * 33], s[3 * 33]); o.z = pk2(s[4 * 33], s[5 * 33]); o.w = pk2(s[6 * 33], s[7 * 33]);
        *(v4u*)(WT + (out_row0 + n) * (size_t)ldo + k0 + 8 * c) = o; }
    LDS_WAIT(); asm volatile("" ::: "memory");
}
__device__ __forceinline__ void ph_convw(const Frame& F, int l) {
    LAS float* scr = (LAS float*)(F.lds + F.wave * 16384);
    const int gw = GW_ID(F), NGW = GW_N(F), lane = F.lane, ln = lane & 31;
    constexpr int I_IN = (PW / 32) * 32, I_BR = 3 * 64 * 16, I_OUT = 64 * 32, I_G = 32 * 16 * 32, I_D = 32 * 64 * 8;
    constexpr int NITEMS = I_IN + I_BR + I_OUT + 2 * I_G + I_D;
    for (int it = gw; it < NITEMS; it += NGW) {
        int r = it;
        if (r < I_IN) { const int kb = r / (PW / 32), nb = r % (PW / 32);
            cvt_item(arg_in(2) + (size_t)l * DM * NIN, NIN, 64 * kb, src_col(32 * nb + ln), (bf16*)(F.ws + WS_WIN), (size_t)32 * nb, DM, scr, lane); continue; }
        r -= I_IN;
        if (r < I_BR) { const int n = r / (64 * 16), q = r % (64 * 16), kb = q / 64, nb = q % 64;
            cvt_item(arg_in(9) + ((size_t)l * 3 + n) * BW * DM, DM, 64 * kb, 32 * nb + ln, (bf16*)(F.ws + WS_WBR) + (size_t)n * DM * BW, (size_t)32 * nb, BW, scr, lane); continue; }
        r -= I_BR;
        if (r < I_OUT) { const int kb = r / 64, nb = r % 64;
            cvt_item(arg_in(10) + (size_t)l * DM * DM, DM, 64 * kb, 32 * nb + ln, (bf16*)(F.ws + WS_WOUT), (size_t)32 * nb, DM, scr, lane); continue; }
        r -= I_OUT;
        if (r < 2 * I_G) { const int up = r >= I_G; if (up) r -= I_G; const int e = r / (16 * 32), q = r % (16 * 32), kb = q / 16, nb = q % 16, f0 = 32 * nb;
            cvt_item(arg_in(up ? 17 : 16) + ((size_t)l * NEXP + e) * DM * DEXP, DEXP, 64 * kb, f0 + ln, (bf16*)(F.ws + WS_WGU) + (size_t)e * 1024 * DM,
                     (size_t)((f0 >> 7) * 256 + (up ? 128 : 0) + (f0 & 127)), DM, scr, lane); continue; }
        r -= 2 * I_G;
        { const int e = r / (64 * 8), q = r % (64 * 8), kb = q / 64, nb = q % 64;
            cvt_item(arg_in(18) + ((size_t)l * NEXP + e) * DEXP * DM, DM, 64 * kb, 32 * nb + ln, (bf16*)(F.ws + WS_WDN) + (size_t)e * DM * DEXP, (size_t)32 * nb, DEXP, scr, lane); }
    }
}

__device__ __forceinline__ int* tokinfo_ptr(const Frame& F) { return (int*)(F.ws + WS_LIST + MiB); }

__device__ __forceinline__ void ph_norm1(const Frame& F, int l) {
    const int gw = GW_ID(F), NGW = GW_N(F), lane = F.lane;
    const float* g = arg_in(1) + (size_t)l * DM;
    bf16* XN = (bf16*)(F.ws + WS_XN);
    for (int m = gw; m < NTOK; m += NGW) {
        f32x4 v[8]; float s = 0.f;
        if (l == 0) {
            const f32x4* xr = (const f32x4*)(arg_in(0) + (size_t)m * DM) + lane;
#pragma unroll
            for (int j = 0; j < 8; ++j) v[j] = xr[64 * j];
        } else {
            const f32x4* xr = (const f32x4*)((const float*)(F.ws + WS_X1) + (size_t)m * DM) + lane;
            const v2u* y0 = (const v2u*)((const bf16*)(F.ws + WS_YB) + (size_t)(2 * m) * DM) + lane;
            const v2u* y1 = (const v2u*)((const bf16*)(F.ws + WS_YB) + (size_t)(2 * m + 1) * DM) + lane;
            f32x4* xo = (f32x4*)((float*)(F.ws + WS_XA) + (size_t)m * DM) + lane;
#pragma unroll
            for (int j = 0; j < 8; ++j) { f32x4 x = xr[64 * j]; const v2u a = y0[64 * j], b = y1[64 * j];
                x.x = (x.x + bflo(a.x)) + bflo(b.x); x.y = (x.y + bfhi(a.x)) + bfhi(b.x); x.z = (x.z + bflo(a.y)) + bflo(b.y); x.w = (x.w + bfhi(a.y)) + bfhi(b.y);
                v[j] = x; xo[64 * j] = x; }
        }
#pragma unroll
        for (int j = 0; j < 8; ++j) s += (v[j].x * v[j].x + v[j].y * v[j].y) + (v[j].z * v[j].z + v[j].w * v[j].w);
        const float rstd = 1.0f / sqrtf(wave_sum(s) * (1.f / DM) + EPS);
        v2u* o8 = (v2u*)(XN + (size_t)m * DM) + lane;
        const f32x4* gr = (const f32x4*)g + lane;
#pragma unroll
        for (int j = 0; j < 8; ++j) { const f32x4 gg = gr[64 * j]; v2u o; o.x = pk2(v[j].x * rstd * gg.x, v[j].y * rstd * gg.y); o.y = pk2(v[j].z * rstd * gg.z, v[j].w * rstd * gg.w); o8[64 * j] = o; }
    }
}

__device__ __forceinline__ void ph_final(const Frame& F, float* out) {
    const int gw = GW_ID(F), NGW = GW_N(F), lane = F.lane;
    for (int m = gw; m < NTOK; m += NGW) {
        const f32x4* xr = (const f32x4*)((const float*)(F.ws + WS_X1) + (size_t)m * DM) + lane;
        const v2u* y0 = (const v2u*)((const bf16*)(F.ws + WS_YB) + (size_t)(2 * m) * DM) + lane;
        const v2u* y1 = (const v2u*)((const bf16*)(F.ws + WS_YB) + (size_t)(2 * m + 1) * DM) + lane;
        f32x4* xo = (f32x4*)(out + (size_t)m * DM) + lane;
#pragma unroll
        for (int j = 0; j < 8; ++j) { f32x4 x = xr[64 * j]; const v2u a = y0[64 * j], b = y1[64 * j];
            x.x = (x.x + bflo(a.x)) + bflo(b.x); x.y = (x.y + bfhi(a.x)) + bfhi(b.x); x.z = (x.z + bflo(a.y)) + bflo(b.y); x.w = (x.w + bfhi(a.y)) + bfhi(b.y);
            xo[64 * j] = x; }
    }
}

__device__ __forceinline__ void ph_norm2(const Frame& F, int l) {
    const int gw = GW_ID(F), NGW = GW_N(F), lane = F.lane;
    const float* g = arg_in(11) + (size_t)l * DM;
    const float* wrg = arg_in(12) + (size_t)l * DM * NGRP; const float* brg = arg_in(13) + l * NGRP;
    const float* wre = arg_in(14) + (size_t)l * DM * NEXP; const float* bre = arg_in(15) + l * NEXP;
    bf16* XN = (bf16*)(F.ws + WS_XN);
    int* list = (int*)(F.ws + WS_LIST); int* tinfo = tokinfo_ptr(F);
    unsigned* ecnt = F.ctl + CW_ECNT + l * NEXP * 64;
    for (int m = gw; m < NTOK; m += NGW) {
        f32x4 v[8]; float s = 0.f;
        const f32x4* xr = (const f32x4*)((const float*)(F.ws + WS_X1) + (size_t)m * DM) + lane;
#pragma unroll
        for (int j = 0; j < 8; ++j) { v[j] = xr[64 * j]; s += (v[j].x * v[j].x + v[j].y * v[j].y) + (v[j].z * v[j].z + v[j].w * v[j].w); }
        const float rstd = 1.0f / sqrtf(wave_sum(s) * (1.f / DM) + EPS);
        v2u* o8 = (v2u*)(XN + (size_t)m * DM) + lane;
        const f32x4* gr = (const f32x4*)g + lane;
#pragma unroll
        for (int j = 0; j < 8; ++j) { const f32x4 gg = gr[64 * j]; v2u o; o.x = pk2(v[j].x * rstd * gg.x, v[j].y * rstd * gg.y); o.y = pk2(v[j].z * rstd * gg.z, v[j].w * rstd * gg.w); o8[64 * j] = o; }
        float lg[36];
#pragma unroll
        for (int q = 0; q < 36; ++q) lg[q] = 0.f;
#pragma unroll 1
        for (int j = 0; j < 8; ++j) { const f32x4 gg = gr[64 * j], xx = xr[64 * j]; f32x4 x; x.x = xx.x * rstd * gg.x; x.y = xx.y * rstd * gg.y; x.z = xx.z * rstd * gg.z; x.w = xx.w * rstd * gg.w;
            const int k0 = 4 * lane + 256 * j;
#pragma unroll
            for (int c = 0; c < 4; ++c) { const float xv = x[c];
                const f32x4 wg = *(const f32x4*)(wrg + (size_t)(k0 + c) * NGRP);
                lg[0] += xv * wg.x; lg[1] += xv * wg.y; lg[2] += xv * wg.z; lg[3] += xv * wg.w;
                const f32x4* we = (const f32x4*)(wre + (size_t)(k0 + c) * NEXP);
#pragma unroll
                for (int q = 0; q < 8; ++q) { const f32x4 w = we[q]; lg[4 + 4 * q] += xv * w.x; lg[5 + 4 * q] += xv * w.y; lg[6 + 4 * q] += xv * w.z; lg[7 + 4 * q] += xv * w.w; } } }
#pragma unroll
        for (int q = 0; q < 36; ++q) lg[q] = wave_sum(lg[q]);
        LAS float* lgL = (LAS float*)(F.lds + F.wave * 256);
        if (lane == 0) {
#pragma unroll
            for (int q = 0; q < 36; ++q) lgL[q] = lg[q];
            int gs = 0; float best = lg[0] + brg[0];
#pragma unroll
            for (int q = 1; q < 4; ++q) { const float t = lg[q] + brg[q]; if (t > best) { best = t; gs = q; } }
            float gm = fmaxf(fmaxf(lg[0], lg[1]), fmaxf(lg[2], lg[3])), gsum = 0.f, gsel = 0.f;
#pragma unroll
            for (int q = 0; q < 4; ++q) { const float e = __expf(lg[q] - gm); gsum += e; gsel = (q == gs) ? e : gsel; }
            const float pg = gsel / gsum;
            LDS_WAIT(); asm volatile("" ::: "memory");
            float ein[8];
#pragma unroll
            for (int q = 0; q < 8; ++q) ein[q] = lgL[4 + gs * 8 + q];
            int e0 = 0, e1 = -1; float b0 = -3.0e38f, b1 = -3.0e38f;
#pragma unroll
            for (int q = 0; q < 8; ++q) { const float t = ein[q] + bre[gs * 8 + q];
                if (t > b0) { b1 = b0; e1 = e0; b0 = t; e0 = q; } else if (t > b1) { b1 = t; e1 = q; } }
            float em = ein[0];
#pragma unroll
            for (int q = 1; q < 8; ++q) em = fmaxf(em, ein[q]);
            float p0 = 0.f, p1 = 0.f;
#pragma unroll
            for (int q = 0; q < 8; ++q) { const float e = __expf(ein[q] - em); p0 = (q == e0) ? e : p0; p1 = (q == e1) ? e : p1; }
            const float w0 = pg * p0 / (p0 + p1), w1 = pg * p1 / (p0 + p1);
            const int x0 = gs * 8 + e0, x1 = gs * 8 + e1;
            const int pos0 = (int)atomicAdd(ecnt + x0 * 64, 1u), pos1 = (int)atomicAdd(ecnt + x1 * 64, 1u);
            list[x0 * NTOK + pos0] = 2 * m; list[x1 * NTOK + pos1] = 2 * m + 1;
            tinfo[m * 8 + 0] = x0; tinfo[m * 8 + 1] = pos0; tinfo[m * 8 + 2] = __float_as_int(w0); tinfo[m * 8 + 3] = 0;
            tinfo[m * 8 + 4] = x1; tinfo[m * 8 + 5] = pos1; tinfo[m * 8 + 6] = __float_as_int(w1); tinfo[m * 8 + 7] = 0;
        }
    }
}

__device__ __forceinline__ void nv_conv(const Frame& F, int l) {
    const bf16* P = (const bf16*)(F.ws + WS_PROJ); float* QK = (float*)(F.ws + WS_TMP);
    const float* cw = arg_in(3) + (size_t)l * 4 * 2048;
    const size_t total = (size_t)NTOK * 2048, stride = (size_t)F.G * NTHR;
    for (size_t i = (size_t)F.vcu * NTHR + F.tid; i < total; i += stride) {
        const int row = (int)(i >> 11), c = (int)(i & 2047), t = row & (SEQ - 1);
        float a = 0.f;
#pragma unroll
        for (int j = 0; j < 4; ++j) { const int tt = t - 3 + j; if (tt >= 0) a += cw[j * 2048 + c] * bf2f(P[(size_t)(row - 3 + j) * PW + c]); }
        QK[i] = siluf_(a);
    }
}
__device__ __forceinline__ void nv_mlstm(const Frame& F, int l) {
    const bf16* P = (const bf16*)(F.ws + WS_PROJ); const float* QK = (const float*)(F.ws + WS_TMP); float* HR = (float*)(F.ws + WS_TMP + 64 * MiB);
    const int tid = F.tid, v = tid >> 2, kq = tid & 3;
    for (int bh = F.vcu; bh < BATCH * NH; bh += F.G) {
        const int b = bh >> 3, h = bh & 7;
        const float bi = arg_in(4)[l * NH + h], bfv = arg_in(5)[l * NH + h];
        float C[32], nn[32], m = 0.f;
#pragma unroll
        for (int j = 0; j < 32; ++j) { C[j] = 0.f; nn[j] = 0.f; }
        for (int t = 0; t < SEQ; ++t) {
            const size_t row = (size_t)b * SEQ + t;
            const float it = bf2f(P[row * PW + C_MI + h]) + bi, ft = bf2f(P[row * PW + C_MF + h]) + bfv;
            const float lf = logsigmoidf_(ft);
            const float mn = fmaxf(lf + m, it), ip = __expf(it - mn), fp = __expf(lf + m - mn); m = mn;
            const float vv = bf2f(P[row * PW + C_MV + h * HD + v]);
            const f32x4* qp = (const f32x4*)(QK + row * 2048 + h * HD + kq * 32);
            const f32x4* kp = (const f32x4*)(QK + row * 2048 + 1024 + h * HD + kq * 32);
            float num = 0.f, den = 0.f;
#pragma unroll
            for (int j4 = 0; j4 < 8; ++j4) { const f32x4 q = qp[j4], k = kp[j4];
#pragma unroll
                for (int c = 0; c < 4; ++c) { const int j = 4 * j4 + c; const float qq = q[c] * 0.08838834764831845f;
                    C[j] = fp * C[j] + ip * vv * k[c]; nn[j] = fp * nn[j] + ip * k[c]; num += C[j] * qq; den += nn[j] * qq; } }
            num += __shfl_xor(num, 1); num += __shfl_xor(num, 2); den += __shfl_xor(den, 1); den += __shfl_xor(den, 2);
            if (kq == 0) HR[row * 1024 + h * HD + v] = num / fmaxf(fabsf(den), __expf(-m));
        }
    }
}
__device__ __forceinline__ void nv_mnorm(const Frame& F, int l) {
    const bf16* P = (const bf16*)(F.ws + WS_PROJ); const float* HR = (const float*)(F.ws + WS_TMP + 64 * MiB); bf16* BR = (bf16*)(F.ws + WS_BR);
    const float* g = arg_in(6) + (size_t)l * BW;
    const int gw = GW_ID(F), NGW = GW_N(F), lane = F.lane;
    for (int it = gw; it < NTOK * NH; it += NGW) {
        const size_t row = it >> 3; const int h = it & 7, c = h * HD + 2 * lane;
        const float a = HR[row * 1024 + c], b = HR[row * 1024 + c + 1];
        const float r = 1.0f / sqrtf(wave_sum(a * a + b * b) * (1.f / HD) + EPS);
        const float o0 = a * r * g[c] * sigmoidf_(bf2f(P[row * PW + C_MO + c])), o1 = b * r * g[c + 1] * sigmoidf_(bf2f(P[row * PW + C_MO + c + 1]));
        *(unsigned*)(BR + row * 3072 + c) = pk2(o0, o1);
    }
}
__device__ __forceinline__ unsigned fkey(float f) { const unsigned u = __float_as_uint(f); return (u & 0x80000000u) ? ~u : (u | 0x80000000u); }
__device__ __forceinline__ void select_row(const unsigned (&key)[32], int nvalid, unsigned long long* mrow, int lane) {
    if (nvalid <= TOPK) {
#pragma unroll
        for (int j = 0; j < 32; ++j) { const unsigned long long b = __ballot(lane + 64 * j < nvalid); if (lane == 0) mrow[j] = b; }
        return;
    }
    unsigned T = 0u;
    for (int bit = 31; bit >= 0; --bit) {
        const unsigned cand = T | (1u << bit); int c = 0;
#pragma unroll
        for (int j = 0; j < 32; ++j) c += (key[j] >= cand) ? 1 : 0;
#pragma unroll
        for (int o = 1; o < 64; o <<= 1) c += __shfl_xor(c, o);
        if (c >= TOPK) T = cand;
    }
    int cgt = 0;
#pragma unroll
    for (int j = 0; j < 32; ++j) cgt += (key[j] > T) ? 1 : 0;
#pragma unroll
    for (int o = 1; o < 64; o <<= 1) cgt += __shfl_xor(cgt, o);
    const int need = TOPK - cgt; int run = 0;
    const unsigned long long below = (lane == 0) ? 0ull : (~0ull >> (64 - lane));
#pragma unroll
    for (int j = 0; j < 32; ++j) {
        const bool eq = key[j] == T; const unsigned long long be = __ballot(eq);
        const int rank = run + __popcll(be & below);
        const bool sel = (key[j] > T) || (eq && rank < need);
        run += __popcll(be);
        const unsigned long long b = __ballot(sel); if (lane == 0) mrow[j] = b;
    }
}
__device__ __forceinline__ void nv_index(const Frame& F) {
    const bf16* P = (const bf16*)(F.ws + WS_PROJ); unsigned long long* MK = (unsigned long long*)(F.ws + WS_MASK);
    LAS float* iqL = (LAS float*)(F.lds + F.wave * 12288); LAS float* scL = iqL + 1024;
    const int gw = GW_ID(F), NGW = GW_N(F), lane = F.lane;
    for (int row = gw; row < NTOK; row += NGW) {
        const int t = row & (SEQ - 1), r0 = row - t;
        for (int i = lane; i < 1024; i += 64) iqL[i] = bf2f(P[(size_t)row * PW + C_IQ + i]);
        float w[16];
#pragma unroll
        for (int hh = 0; hh < 16; ++hh) w[hh] = bf2f(P[(size_t)row * PW + C_IW + hh]) * 0.25f;
        LDS_WAIT(); asm volatile("" ::: "memory");
        for (int s = lane; s <= t; s += 64) {
            float d[16];
#pragma unroll
            for (int hh = 0; hh < 16; ++hh) d[hh] = 0.f;
            const v4u* kp = (const v4u*)(P + (size_t)(r0 + s) * PW + C_IK);
#pragma unroll 1
            for (int hf = 0; hf < 2; ++hf) {
                float kr[32];
#pragma unroll
                for (int q = 0; q < 4; ++q) { const v4u x = kp[4 * hf + q]; kr[8 * q] = bflo(x.x); kr[8 * q + 1] = bfhi(x.x); kr[8 * q + 2] = bflo(x.y); kr[8 * q + 3] = bfhi(x.y); kr[8 * q + 4] = bflo(x.z); kr[8 * q + 5] = bfhi(x.z); kr[8 * q + 6] = bflo(x.w); kr[8 * q + 7] = bfhi(x.w); }
#pragma unroll
                for (int hh = 0; hh < 16; ++hh) {
#pragma unroll
                    for (int e = 0; e < 32; ++e) d[hh] += iqL[hh * 64 + hf * 32 + e] * kr[e]; }
            }
            float sc = 0.f;
#pragma unroll
            for (int hh = 0; hh < 16; ++hh) sc += w[hh] * fmaxf(d[hh] * 0.125f, 0.f);
            scL[s] = sc;
        }
        LDS_WAIT(); asm volatile("" ::: "memory");
        unsigned key[32];
#pragma unroll
        for (int j = 0; j < 32; ++j) { const int s = lane + 64 * j; key[j] = (s <= t) ? fkey(scL[s]) : 0u; }
        select_row(key, t + 1, MK + (size_t)row * 32, lane);
        LDS_WAIT(); asm volatile("" ::: "memory");
    }
}
__device__ __forceinline__ void nv_dsa(const Frame& F, int l) {
    const bf16* P = (const bf16*)(F.ws + WS_PROJ); const unsigned long long* MK = (const unsigned long long*)(F.ws + WS_MASK); bf16* BR = (bf16*)(F.ws + WS_BR);
    const float* qg = arg_in(7) + l * HD; const float* kg = arg_in(8) + l * HD; const float* rb = arg_in(19);
    LAS float* lgL = (LAS float*)(F.lds + F.wave * 2048); LAS int* ixL = (LAS int*)(lgL + 256);
    const int gw = GW_ID(F), NGW = GW_N(F), lane = F.lane;
    for (int it = gw; it < NTOK * NH; it += NGW) {
        const int row = it >> 3, h = it & 7, t = row & (SEQ - 1), r0 = row - t, c = h * HD + 2 * lane;
        float q0 = bf2f(P[(size_t)row * PW + C_DQ + c]), q1 = bf2f(P[(size_t)row * PW + C_DQ + c + 1]);
        const float qr = 1.0f / sqrtf(wave_sum(q0 * q0 + q1 * q1) * (1.f / HD) + EPS);
        q0 *= qr * qg[2 * lane]; q1 *= qr * qg[2 * lane + 1];
        const float kg0 = kg[2 * lane], kg1 = kg[2 * lane + 1];
        int cnt = 0; float mx = -3.0e38f;
        for (int wi = 0; wi <= (t >> 6); ++wi) {
            unsigned long long w = MK[(size_t)row * 32 + wi];
            while (w) { const int s = wi * 64 + __builtin_ctzll(w); w &= w - 1;
                const unsigned kk = *(const unsigned*)(P + (size_t)(r0 + s) * PW + C_DK + c);
                const float k0 = bflo(kk), k1 = bfhi(kk);
                const float ss = wave_sum(k0 * k0 + k1 * k1), dd = wave_sum(q0 * k0 * kg0 + q1 * k1 * kg1);
                const float kr = 1.0f / sqrtf(ss * (1.f / HD) + EPS);
                const float lgt = dd * kr * 0.08838834764831845f + rb[t5_bucket(t - s) * NH + h];
                if (lane == 0) { lgL[cnt] = lgt; ixL[cnt] = s; }
                mx = fmaxf(mx, lgt); ++cnt; }
        }
        LDS_WAIT(); asm volatile("" ::: "memory");
        float o0 = 0.f, o1 = 0.f, den = 0.f;
        for (int j = 0; j < cnt; ++j) { const float p = __expf(lgL[j] - mx); const int s = ixL[j];
            const unsigned vv = *(const unsigned*)(P + (size_t)(r0 + s) * PW + C_DV + c);
            o0 += p * bflo(vv); o1 += p * bfhi(vv); den += p; }
        *(unsigned*)(BR + (size_t)row * 3072 + 1024 + c) = pk2(o0 / den, o1 / den);
        LDS_WAIT(); asm volatile("" ::: "memory");
    }
}
__device__ __forceinline__ void nv_sb(const Frame& F) {
    const bf16* P = (const bf16*)(F.ws + WS_PROJ); bf16* BR = (bf16*)(F.ws + WS_BR);
    const int gw = GW_ID(F), NGW = GW_N(F), lane = F.lane;
    for (int it = gw; it < NTOK * NH; it += NGW) {
        const int row = it >> 3, h = it & 7, t = row & (SEQ - 1), r0 = row - t, c = h * HD + 2 * lane;
        const unsigned qq = *(const unsigned*)(P + (size_t)row * PW + C_SQ + c);
        const float q0 = bflo(qq) * 0.08838834764831845f, q1 = bfhi(qq) * 0.08838834764831845f;
        float o0 = 0.f, o1 = 0.f, lp = 0.f;
        for (int s = t - 1; s >= 0; --s) {
            const unsigned kk = *(const unsigned*)(P + (size_t)(r0 + s) * PW + C_SK + c);
            const float z = wave_sum(q0 * bflo(kk) + q1 * bfhi(kk));
            const float a = __expf(logsigmoidf_(z) + lp);
            const unsigned vv = *(const unsigned*)(P + (size_t)(r0 + s) * PW + C_SV + c);
            o0 += a * bflo(vv); o1 += a * bfhi(vv);
            lp += logsigmoidf_(-z);
            if (lp < -80.f) break;
        }
        *(unsigned*)(BR + (size_t)row * 3072 + 2048 + c) = pk2(o0, o1);
    }
}
__device__ __forceinline__ void nv_moe(const Frame& F) {
    const bf16* XN = (const bf16*)(F.ws + WS_XN); bf16* YB = (bf16*)(F.ws + WS_YB); const int* tinfo = tokinfo_ptr(F);
    LAS float* xL = (LAS float*)F.lds; LAS float* hL = xL + 2048;
    const int tid = F.tid;
    for (int slot = F.vcu; slot < 2 * NTOK; slot += F.G) {
        const int m = slot >> 1, k = slot & 1; const int e = tinfo[m * 8 + 4 * k]; const float w = __int_as_float(tinfo[m * 8 + 4 * k + 2]);
        __syncthreads();
        for (int i = tid; i < 2048; i += NTHR) xL[i] = bf2f(XN[(size_t)m * DM + i]);
        __syncthreads();
        { const int f = tid; const bf16* wg = (const bf16*)(F.ws + WS_WGU) + ((size_t)e * 1024 + (f >> 7) * 256 + (f & 127)) * DM; const bf16* wu = wg + (size_t)128 * DM;
          float g = 0.f, u = 0.f;
          for (int k8 = 0; k8 < 256; ++k8) { const v4u a = ((const v4u*)wg)[k8], b = ((const v4u*)wu)[k8]; const LAS float* x = xL + 8 * k8;
              g += x[0] * bflo(a.x) + x[1] * bfhi(a.x) + x[2] * bflo(a.y) + x[3] * bfhi(a.y) + x[4] * bflo(a.z) + x[5] * bfhi(a.z) + x[6] * bflo(a.w) + x[7] * bfhi(a.w);
              u += x[0] * bflo(b.x) + x[1] * bfhi(b.x) + x[2] * bflo(b.y) + x[3] * bfhi(b.y) + x[4] * bflo(b.z) + x[5] * bfhi(b.z) + x[6] * bflo(b.w) + x[7] * bfhi(b.w); }
          hL[f] = bf2f((unsigned short)f2bf(siluf_(g) * u)); }
        __syncthreads();
        { float y[4];
#pragma unroll
          for (int c = 0; c < 4; ++c) { const int d = 4 * tid + c; const bf16* wd = (const bf16*)(F.ws + WS_WDN) + ((size_t)e * DM + d) * DEXP; float a = 0.f;
              for (int k8 = 0; k8 < 64; ++k8) { const v4u x = ((const v4u*)wd)[k8]; const LAS float* hh = hL + 8 * k8;
                  a += hh[0] * bflo(x.x) + hh[1] * bfhi(x.x) + hh[2] * bflo(x.y) + hh[3] * bfhi(x.y) + hh[4] * bflo(x.z) + hh[5] * bfhi(x.z) + hh[6] * bflo(x.w) + hh[7] * bfhi(x.w); }
              y[c] = a * w; }
          v2u o; o.x = pk2(y[0], y[1]); o.y = pk2(y[2], y[3]); *(v2u*)(YB + (size_t)slot * DM + 4 * tid) = o; }
    }
}
constexpr int MOE_TAB_OFF = LDSCTL_OFF + 1024;
__device__ __forceinline__ void moe_tables(const Frame& F, int l) {
    LAS int* tp = (LAS int*)(F.lds + MOE_TAB_OFF); LAS int* cn = tp + 40; LAS int* sb = cn + 40;
    __syncthreads();
    if (F.tid == 0) { int p = 0, s = 0;
        for (int e = 0; e < NEXP; ++e) { const int c = (int)__hip_atomic_load(F.ctl + CW_ECNT + (l * NEXP + e) * 64, RLX_AGENT); tp[e] = p; cn[e] = c; sb[e] = s; p += (c + 255) >> 8; s += c; }
        tp[NEXP] = p; sb[NEXP] = s; }
    __syncthreads();
}
template <int NT> struct SchedMoeBase {
    const LAS int* tp; const LAS int* cn; const LAS int* sb; int G, c;
    __device__ __forceinline__ bool next(int i, pg8::Unit& u) const {
        const int L = i * G + c, total = tp[NEXP] * NT; if (L >= total) return false;
        const int mt = L / NT; u.pn = L % NT; int e = 0;
#pragma unroll 1
        for (int q = 1; q < NEXP; ++q) e = (tp[q] <= mt) ? q : e;
        u.e = e; u.pm = mt - tp[e]; const int r = cn[e] - 256 * u.pm; u.rows = r < 256 ? r : 256; return true;
    }
};
struct SchedMoeUp : SchedMoeBase<4> {
    static constexpr bool GATHER = true;
    const char* A; const char* B; const int* list;
    __device__ __forceinline__ const char* a_base(const pg8::Unit&) const { return A; }
    __device__ __forceinline__ const char* b_base(const pg8::Unit& u) const { return B + ((size_t)u.e * 1024 + (size_t)u.pn * 256) * DM * 2; }
    __device__ __forceinline__ void a_off(const pg8::Unit& u, int tid, unsigned (&v0)[2], unsigned (&v1)[2]) const {
        int R[2], C[2];
#pragma unroll
        for (int i = 0; i < 2; ++i) pg8::stage_rc(tid * 16 + i * 8192, R[i], C[i]);
        const int* le = list + (size_t)u.e * NTOK + 256 * u.pm;
#pragma unroll
        for (int i = 0; i < 2; ++i) { int r0 = R[i], r1 = R[i] + 128; r0 = r0 < u.rows ? r0 : u.rows - 1; r1 = r1 < u.rows ? r1 : u.rows - 1;
            const int t0 = le[r0] >> 1, t1 = le[r1] >> 1;
            v0[i] = (unsigned)(t0 * DM + C[i]) * 2u; v1[i] = (unsigned)(t1 * DM + C[i]) * 2u; }
    }
};
struct EpiMoeUp {
    static constexpr bool PERM = true;
    bf16* HB; const LAS int* sb;
    __device__ __forceinline__ void operator()(const f32x4 (&acc)[2][2][4][2], const pg8::Unit& u, int wr, int wc, int fr, int fq) const {
        const int col0 = u.pn * 128 + wc * 32 + 8 * fq; const size_t slot0 = (size_t)sb[u.e] + 256 * u.pm;
#pragma unroll
        for (int ai = 0; ai < 2; ++ai)
#pragma unroll
            for (int m = 0; m < 4; ++m) { const int r = ai * 128 + wr * 64 + m * 16 + fr;
                if (r < u.rows) { const f32x4 g0 = acc[ai][0][m][0], g1 = acc[ai][0][m][1], u0 = acc[ai][1][m][0], u1 = acc[ai][1][m][1];
                    v4u w; w.x = cvt_pk_bf16(siluf_(g0[0]) * u0[0], siluf_(g0[1]) * u0[1]); w.y = cvt_pk_bf16(siluf_(g0[2]) * u0[2], siluf_(g0[3]) * u0[3]);
                    w.z = cvt_pk_bf16(siluf_(g1[0]) * u1[0], siluf_(g1[1]) * u1[1]); w.w = cvt_pk_bf16(siluf_(g1[2]) * u1[2], siluf_(g1[3]) * u1[3]);
                    *(v4u*)(HB + (slot0 + r) * DEXP + col0) = w; } }
    }
};
struct SchedMoeDown : SchedMoeBase<8> {
    static constexpr bool GATHER = false;
    const char* A; const char* B;
    __device__ __forceinline__ const char* a_base(const pg8::Unit& u) const { return A + ((size_t)sb[u.e] + 256 * u.pm) * DEXP * 2; }
    __device__ __forceinline__ const char* b_base(const pg8::Unit& u) const { return B + ((size_t)u.e * DM + (size_t)u.pn * 256) * DEXP * 2; }
    __device__ __forceinline__ void a_off(const pg8::Unit&, int tid, unsigned (&v0)[2], unsigned (&v1)[2]) const {
        int R[2], C[2];
#pragma unroll
        for (int i = 0; i < 2; ++i) pg8::stage_rc(tid * 16 + i * 8192, R[i], C[i]);
#pragma unroll
        for (int i = 0; i < 2; ++i) { v0[i] = (unsigned)(R[i] * DEXP + C[i]) * 2u; v1[i] = v0[i] + 128u * DEXP * 2u; } }
};
struct EpiMoeDown {
    static constexpr bool PERM = true;
    bf16* YB; const int* list; const int* tinfo;
    __device__ __forceinline__ void operator()(const f32x4 (&acc)[2][2][4][2], const pg8::Unit& u, int wr, int wc, int fr, int fq) const {
        const int col0 = u.pn * 256 + wc * 32 + 8 * fq; const int* le = list + (size_t)u.e * NTOK + 256 * u.pm;
#pragma unroll
        for (int ai = 0; ai < 2; ++ai)
#pragma unroll
            for (int m = 0; m < 4; ++m) { const int r = ai * 128 + wr * 64 + m * 16 + fr;
                if (r < u.rows) { const int ent = le[r]; const float w = __int_as_float(tinfo[(ent >> 1) * 8 + 4 * (ent & 1) + 2]);
#pragma unroll
                    for (int bj = 0; bj < 2; ++bj) { const f32x4 v0 = acc[ai][bj][m][0] * w, v1 = acc[ai][bj][m][1] * w;
                        v4u o; o.x = cvt_pk_bf16(v0[0], v0[1]); o.y = cvt_pk_bf16(v0[2], v0[3]); o.z = cvt_pk_bf16(v1[0], v1[1]); o.w = cvt_pk_bf16(v1[2], v1[3]);
                        *(v4u*)(YB + (size_t)ent * DM + col0 + bj * 128) = o; } } }
    }
};
template <int LDA, int LDB> struct SchedDense {
    static constexpr bool GATHER = false;
    pg8::TileOrder T; const char* A; const char* B;
    __device__ __forceinline__ bool next(int i, pg8::Unit& u) const { u.e = 0; u.rows = 256; return T.tile(i, u.pm, u.pn); }
    __device__ __forceinline__ const char* a_base(const pg8::Unit& u) const { return A + (size_t)u.pm * 256 * LDA * 2; }
    __device__ __forceinline__ const char* b_base(const pg8::Unit& u) const { return B + (size_t)u.pn * 256 * LDB * 2; }
    __device__ __forceinline__ void a_off(const pg8::Unit&, int tid, unsigned (&v0)[2], unsigned (&v1)[2]) const {
        int R[2], C[2];
#pragma unroll
        for (int i = 0; i < 2; ++i) pg8::stage_rc(tid * 16 + i * 8192, R[i], C[i]);
#pragma unroll
        for (int i = 0; i < 2; ++i) { v0[i] = (unsigned)(R[i] * LDA + C[i]) * 2u; v1[i] = v0[i] + 128u * LDA * 2u; } }
};
struct EpiProj {
    static constexpr bool PERM = true;
    bf16* O;
    __device__ __forceinline__ void operator()(const f32x4 (&acc)[2][2][4][2], const pg8::Unit& u, int wr, int wc, int fr, int fq) const {
        const int row0 = u.pm * 256 + wr * 64 + fr, col0 = u.pn * 256 + wc * 32 + 8 * fq;
#pragma unroll
        for (int ai = 0; ai < 2; ++ai)
#pragma unroll
            for (int m = 0; m < 4; ++m) { bf16* rowp = O + (size_t)(row0 + ai * 128 + m * 16) * PW + col0;
#pragma unroll
                for (int bj = 0; bj < 2; ++bj) { const f32x4 v0 = acc[ai][bj][m][0], v1 = acc[ai][bj][m][1];
                    v4u w; w.x = cvt_pk_bf16(v0[0], v0[1]); w.y = cvt_pk_bf16(v0[2], v0[3]); w.z = cvt_pk_bf16(v1[0], v1[1]); w.w = cvt_pk_bf16(v1[2], v1[3]);
                    *(v4u*)(rowp + bj * 128) = w; } }
    }
};
struct SchedBranch {
    static constexpr bool GATHER = false;
    pg8::TileOrder T; const char* A; const char* B;
    __device__ __forceinline__ bool next(int i, pg8::Unit& u) const { u.e = i % 3; u.rows = 256; return T.tile(i / 3, u.pm, u.pn); }
    __device__ __forceinline__ const char* a_base(const pg8::Unit& u) const { return A + ((size_t)u.pm * 256 * 3072 + (size_t)u.e * 1024) * 2; }
    __device__ __forceinline__ const char* b_base(const pg8::Unit& u) const { return B + ((size_t)u.e * 2048 + (size_t)u.pn * 256) * 1024 * 2; }
    __device__ __forceinline__ void a_off(const pg8::Unit&, int tid, unsigned (&v0)[2], unsigned (&v1)[2]) const {
        int R[2], C[2];
#pragma unroll
        for (int i = 0; i < 2; ++i) pg8::stage_rc(tid * 16 + i * 8192, R[i], C[i]);
#pragma unroll
        for (int i = 0; i < 2; ++i) { v0[i] = (unsigned)(R[i] * 3072 + C[i]) * 2u; v1[i] = v0[i] + 128u * 3072u * 2u; } }
};
struct EpiBranch {
    static constexpr bool PERM = true;
    const bf16* P; float* scr; bf16* O;
    __device__ __forceinline__ void operator()(const f32x4 (&acc)[2][2][4][2], const pg8::Unit& u, int wr, int wc, int fr, int fq) const {
        const int row0 = u.pm * 256 + wr * 64 + fr, col0 = u.pn * 256 + wc * 32 + 8 * fq;
#pragma unroll
        for (int ai = 0; ai < 2; ++ai)
#pragma unroll
            for (int m = 0; m < 4; ++m) { const size_t row = (size_t)(row0 + ai * 128 + m * 16);
#pragma unroll
                for (int bj = 0; bj < 2; ++bj) { const int col = col0 + bj * 128;
                    const v4u gw = *(const v4u*)(P + row * PW + C_G + u.e * 2048 + col);
                    f32x4 v0 = acc[ai][bj][m][0], v1 = acc[ai][bj][m][1];
                    v0[0] *= sigmoidf_(bflo(gw.x)); v0[1] *= sigmoidf_(bfhi(gw.x)); v0[2] *= sigmoidf_(bflo(gw.y)); v0[3] *= sigmoidf_(bfhi(gw.y));
                    v1[0] *= sigmoidf_(bflo(gw.z)); v1[1] *= sigmoidf_(bfhi(gw.z)); v1[2] *= sigmoidf_(bflo(gw.w)); v1[3] *= sigmoidf_(bfhi(gw.w));
                    float* sp = scr + row * DM + col;
                    if (u.e > 0) { v0 += *(const f32x4*)sp; v1 += *(const f32x4*)(sp + 4); }
                    if (u.e < 2) { *(f32x4*)sp = v0; *(f32x4*)(sp + 4) = v1; }
                    else { v4u w; w.x = cvt_pk_bf16(v0[0], v0[1]); w.y = cvt_pk_bf16(v0[2], v0[3]); w.z = cvt_pk_bf16(v1[0], v1[1]); w.w = cvt_pk_bf16(v1[2], v1[3]);
                        *(v4u*)(O + row * DM + col) = w; } } }
    }
};
struct EpiOut {
    static constexpr bool PERM = false;
    const float* base; float* out;
    __device__ __forceinline__ void operator()(const f32x4 (&acc)[2][2][4][2], const pg8::Unit& u, int wr, int wc, int fr, int fq) const {
        const int row0 = u.pm * 256 + wr * 64 + fr, col0 = u.pn * 256 + wc * 32 + 4 * fq;
#pragma unroll
        for (int ai = 0; ai < 2; ++ai)
#pragma unroll
            for (int m = 0; m < 4; ++m) { const size_t off = (size_t)(row0 + ai * 128 + m * 16) * DM + col0;
#pragma unroll
                for (int bj = 0; bj < 2; ++bj)
#pragma unroll
                    for (int n = 0; n < 2; ++n) { const f32x4 bs = *(const f32x4*)(base + off + bj * 128 + n * 16); *(f32x4*)(out + off + bj * 128 + n * 16) = bs + acc[ai][bj][m][n]; } }
    }
};

#ifndef MK_NAIVE_MOE
#define MK_NAIVE_MOE 0
#endif
#ifndef OFFMASK
#define OFFMASK 0
#endif
constexpr int PH_CONVW = 0, PH_NORM1 = 1, PH_INPROJ = 2, PH_NVCONV = 3, PH_NVMLSTM = 4, PH_NVMNORM = 5, PH_NVIDX = 6, PH_NVDSA = 7, PH_NVSB = 8,
              PH_BRANCH = 9, PH_OUT = 10, PH_NORM2 = 11, PH_MOE = 12, PH_MOED = 13, NPH_L = 14, PH_FINAL = DEPTH * NPH_L, NPH = PH_FINAL + 1;

__global__ void __launch_bounds__(NTHR, 2) fwd_kernel(Args args) {
    extern __shared__ __attribute__((aligned(16))) unsigned char lds_raw[];
    Frame F;
    F.lds = (LAS unsigned char*)lds_raw;
    F.tid = threadIdx.x; F.lane = F.tid & 63; F.wave = __builtin_amdgcn_readfirstlane(F.tid >> 6);
    F.G = gridDim.x; { const int bx = blockIdx.x; F.vcu = (F.G % 8 == 0) ? (bx % 8) * (F.G / 8) + bx / 8 : bx; }
    F.ws = args.ws; F.ctl = (unsigned*)(args.ws + WS_CTL);
    volatile LAS unsigned* MISC = (volatile LAS unsigned*)(F.lds + LDSCTL_OFF);
    for (int u = F.tid; u < (LDS_BYTES - LDSCTL_OFF) / 4; u += NTHR) ((LAS unsigned*)(F.lds + LDSCTL_OFF))[u] = 0u;
    __syncthreads();
    XcdBarrier bar; bar.bar = F.ctl + CW_BAR; bar.x = 0; bar.st = nullptr;
    if (args.use_bar) bar = xcd_barrier_post(F.ctl + CW_BAR, MISC + 8);
    const int lo = args.ph_lo, hi = args.ph_hi;
#define IN(k) (lo <= (k) && (k) < hi)
#define FRESH() do { int t_ = threadIdx.x; asm volatile("" : "+v"(t_)); F.tid = t_; F.lane = t_ & 63; F.wave = __builtin_amdgcn_readfirstlane(t_ >> 6); F.ws = arg_ws(); F.ctl = (unsigned*)(F.ws + WS_CTL); } while (0)
#define SEAM(k) do { if (args.use_bar && IN((k) + 1)) xcd_barrier(bar); } while (0)
    for (int l = 0; l < DEPTH; ++l) {
        const int p0 = l * NPH_L;
        if (IN(p0 + PH_CONVW)) { FRESH(); if (!(OFFMASK & (1<<0))) ph_convw(F, l); SEAM(p0 + PH_CONVW); }
        if (IN(p0 + PH_NORM1)) { FRESH(); if (!(OFFMASK & (1<<1))) ph_norm1(F, l); SEAM(p0 + PH_NORM1); }
        if (IN(p0 + PH_INPROJ)) {
            SchedDense<DM, DM> S; S.T.init(NTOK / 256, PW / 256, F.G, (int)blockIdx.x); S.A = (const char*)(F.ws + WS_XN); S.B = (const char*)(F.ws + WS_WIN);
            EpiProj E{(bf16*)(F.ws + WS_PROJ)};
            if (!(OFFMASK & (1<<10))) pg8::gemm_phase<SchedDense<DM, DM>, EpiProj, DM, DM, DM, true>(F.lds, S, E);
            SEAM(p0 + PH_INPROJ);
        }
        if (IN(p0 + PH_NVCONV)) { FRESH(); if (!(OFFMASK & (1<<2))) nv_conv(F, l); SEAM(p0 + PH_NVCONV); }
        if (IN(p0 + PH_NVMLSTM)) { FRESH(); if (!(OFFMASK & (1<<3))) nv_mlstm(F, l); SEAM(p0 + PH_NVMLSTM); }
        if (IN(p0 + PH_NVMNORM)) { FRESH(); if (!(OFFMASK & (1<<4))) nv_mnorm(F, l); SEAM(p0 + PH_NVMNORM); }
        if (IN(p0 + PH_NVIDX)) { FRESH(); if (!(OFFMASK & (1<<5))) nv_index(F); SEAM(p0 + PH_NVIDX); }
        if (IN(p0 + PH_NVDSA)) { FRESH(); if (!(OFFMASK & (1<<6))) nv_dsa(F, l); SEAM(p0 + PH_NVDSA); }
        if (IN(p0 + PH_NVSB)) { FRESH(); if (!(OFFMASK & (1<<7))) nv_sb(F); SEAM(p0 + PH_NVSB); }
        if (IN(p0 + PH_BRANCH)) {
            SchedBranch S; S.T.init(NTOK / 256, DM / 256, F.G, (int)blockIdx.x); S.A = (const char*)(F.ws + WS_BR); S.B = (const char*)(F.ws + WS_WBR);
            EpiBranch E{(const bf16*)(F.ws + WS_PROJ), (float*)(F.ws + WS_X1), (bf16*)(F.ws + WS_MRG)};
            if (!(OFFMASK & (1<<11))) pg8::gemm_phase<SchedBranch, EpiBranch, BW, 3072, BW, true>(F.lds, S, E);
            SEAM(p0 + PH_BRANCH);
        }
        if (IN(p0 + PH_OUT)) {
            SchedDense<DM, DM> S; S.T.init(NTOK / 256, DM / 256, F.G, (int)blockIdx.x); S.A = (const char*)(F.ws + WS_MRG); S.B = (const char*)(F.ws + WS_WOUT);
            EpiOut E{l == 0 ? arg_in(0) : (const float*)(F.ws + WS_XA), (float*)(F.ws + WS_X1)};
            if (!(OFFMASK & (1<<12))) pg8::gemm_phase<SchedDense<DM, DM>, EpiOut, DM, DM, DM, true>(F.lds, S, E);
            SEAM(p0 + PH_OUT);
        }
        if (IN(p0 + PH_NORM2)) { FRESH(); if (!(OFFMASK & (1<<8))) ph_norm2(F, l); SEAM(p0 + PH_NORM2); }
        if (IN(p0 + PH_MOE)) { FRESH();
#if MK_NAIVE_MOE
            nv_moe(F);
#else
            moe_tables(F, l);
            SchedMoeUp S; S.tp = (const LAS int*)(F.lds + MOE_TAB_OFF); S.cn = S.tp + 40; S.sb = S.cn + 40; S.G = F.G; S.c = (int)blockIdx.x;
            S.A = (const char*)(F.ws + WS_XN); S.B = (const char*)(F.ws + WS_WGU); S.list = (const int*)(F.ws + WS_LIST);
            EpiMoeUp E{(bf16*)(F.ws + WS_HB), S.sb};
            if (!(OFFMASK & (1<<13))) pg8::gemm_phase<SchedMoeUp, EpiMoeUp, DM, DM, DM, true>(F.lds, S, E);
#endif
            SEAM(p0 + PH_MOE); }
        if (IN(p0 + PH_MOED)) { FRESH();
#if !MK_NAIVE_MOE
            moe_tables(F, l);
            SchedMoeDown S; S.tp = (const LAS int*)(F.lds + MOE_TAB_OFF); S.cn = S.tp + 40; S.sb = S.cn + 40; S.G = F.G; S.c = (int)blockIdx.x;
            S.A = (const char*)(F.ws + WS_HB); S.B = (const char*)(F.ws + WS_WDN);
            EpiMoeDown E{(bf16*)(F.ws + WS_YB), (const int*)(F.ws + WS_LIST), (const int*)tokinfo_ptr(F)};
            if (!(OFFMASK & (1<<14))) pg8::gemm_phase<SchedMoeDown, EpiMoeDown, DEXP, DEXP, DEXP, true>(F.lds, S, E);
#endif
            SEAM(p0 + PH_MOED); }
    }
    if (IN(PH_FINAL)) { FRESH(); } if (IN(PH_FINAL)) ph_final(F, args.out);
#undef IN
#undef SEAM
}

#ifndef MK_ONE_LAUNCH
#define MK_ONE_LAUNCH 1
#endif
extern "C" void kernel_launch(void* const* d_in, const int* in_sizes, int n_in, void* d_out, int out_size, void* d_ws, size_t ws_size, hipStream_t stream) {
    static int grid = 0;
    if (grid == 0) {
        if (n_in != 20 || in_sizes[0] != NTOK * DM || out_size != NTOK * DM || ws_size < WS_END) { fprintf(stderr, "kernel_launch: shape mismatch (n_in %d, ws %zu < %zu?)\n", n_in, ws_size, (size_t)WS_END); grid = -1; return; }
        int dev = 0, cus = 0, per_cu = 0;
        if (hipGetDevice(&dev) != hipSuccess || hipDeviceGetAttribute(&cus, hipDeviceAttributeMultiprocessorCount, dev) != hipSuccess) { grid = -1; return; }
        if (hipFuncSetAttribute((const void*)fwd_kernel, hipFuncAttributeMaxDynamicSharedMemorySize, LDS_BYTES) != hipSuccess) { fprintf(stderr, "kernel_launch: hipFuncSetAttribute failed\n"); grid = -1; return; }
        if (hipOccupancyMaxActiveBlocksPerMultiprocessor(&per_cu, (const void*)fwd_kernel, NTHR, LDS_BYTES) != hipSuccess || per_cu < 1) fprintf(stderr, "kernel_launch: occupancy query says %d\n", per_cu);
        (void)hipGetLastError();
        grid = cus;
    }
    if (grid < 0) return;
    if (hipMemsetAsync((char*)d_ws + WS_CTL, 0, CTL_ZERO_BYTES, stream) != hipSuccess) return;
    Args a{};
    for (int i = 0; i < 20; ++i) a.in[i] = (const float*)d_in[i];
    a.out = (float*)d_out; a.ws = (unsigned char*)d_ws;
#if MK_ONE_LAUNCH
    a.ph_lo = 0; a.ph_hi = NPH; a.use_bar = 1; a.pad = 0;
    hipLaunchKernelGGL(fwd_kernel, dim3(grid), dim3(NTHR), LDS_BYTES, stream, a);
#else
    for (int ph = 0; ph < NPH; ++ph) { a.ph_lo = ph; a.ph_hi = ph + 1; a.use_bar = 0; a.pad = 0;
        hipLaunchKernelGGL(fwd_kernel, dim3(grid), dim3(NTHR), LDS_BYTES, stream, a); }
#endif
    const hipError_t le = hipPeekAtLastError();
    if (le != hipSuccess) fprintf(stderr, "kernel_launch: launch failed: %s\n", hipGetErrorName(le));
}
```

```cpp
#include <hip/hip_runtime.h>
#include <cstdio>
#include <cstdint>

constexpr int BATCH = 4, SEQ = 2048, DM = 2048, NTOK = BATCH * SEQ, NH = 8, HD = 128, BW = 1024, DEPTH = 2;
constexpr int NIN = 17504, PW = 17664;
constexpr int IDXH = 16, IDXD = 64, TOPK = 256, NEXP = 32, NGRP = 4, EPG = 8, DEXP = 512, MCH = 64, NCH = SEQ / MCH;
constexpr float EPS = 1e-6f;
constexpr int C_MQ = 0, C_MK = 1024, C_MV = 2048, C_MO = 3072, C_DQ = 4096, C_DK = 5120, C_DV = 6144, C_IQ = 7168, C_SQ = 8192, C_SK = 9216, C_SV = 10240,
              C_G = 11264, C_MI = 17408, C_MF = 17416, C_IK = 17424, C_IW = 17488;
__host__ __device__ __forceinline__ int src_col(int c) {
    if (c < 4096) return c;
    if (c < 8192) return c + 16;
    if (c < 17408) return c + 96;
    if (c < 17424) return 4096 + (c - 17408);
    if (c < 17488) return 8208 + (c - 17424);
    if (c < 17504) return 8272 + (c - 17488);
    return -1;
}

constexpr size_t MiB = 1u << 20;
constexpr size_t WS_CTL = 0, CTL_ZERO_BYTES = 1 * MiB;
constexpr size_t WS_WIN = 1 * MiB;
constexpr size_t WS_WBR = WS_WIN + 69 * MiB;
constexpr size_t WS_WOUT = WS_WBR + 12 * MiB;
constexpr size_t WS_WGU = WS_WOUT + 8 * MiB;
constexpr size_t WS_WDN = WS_WGU + 128 * MiB;
constexpr size_t WS_XN = WS_WDN + 64 * MiB;
constexpr size_t WS_XA = WS_XN + 32 * MiB;
constexpr size_t WS_X1 = WS_XA + 64 * MiB;
constexpr size_t WS_PROJ = WS_X1 + 64 * MiB;
constexpr size_t WS_BR = WS_PROJ + 276 * MiB;
constexpr size_t WS_MRG = WS_BR + 48 * MiB;
constexpr size_t WS_MASK = WS_MRG + 32 * MiB;
constexpr size_t WS_MDEL = WS_MASK + 2 * MiB;
constexpr size_t WS_MDN = WS_MDEL + 64 * MiB;
constexpr size_t WS_MST = WS_MDN + 1 * MiB;
constexpr size_t WS_MSN = WS_MST + 32 * MiB;
constexpr size_t WS_HB = WS_MSN + 1 * MiB;
constexpr size_t WS_YB = WS_HB + 16 * MiB;
constexpr size_t WS_LIST = WS_YB + 64 * MiB;
constexpr size_t WS_TMP = WS_LIST + 2 * MiB;
constexpr size_t WS_END = WS_TMP + 96 * MiB;
static_assert(WS_END <= 1100 * MiB, "workspace map");

constexpr int CW_BAR = 4096;
constexpr int CW_ECNT = 16384;

#define GAS __attribute__((address_space(1)))
#define LAS __attribute__((address_space(3)))
typedef unsigned short bf16;
typedef unsigned v4u __attribute__((ext_vector_type(4)));
typedef unsigned v2u __attribute__((ext_vector_type(2)));
typedef float f32x4 __attribute__((ext_vector_type(4)));
typedef float f32x2 __attribute__((ext_vector_type(2)));
typedef float f32x16 __attribute__((ext_vector_type(16)));
typedef short bf16x8 __attribute__((ext_vector_type(8)));
typedef short s16x4 __attribute__((ext_vector_type(4)));
#define RLX_AGENT __ATOMIC_RELAXED, __HIP_MEMORY_SCOPE_AGENT
#define LDS_WAIT() asm volatile("s_waitcnt lgkmcnt(0)" ::: "memory")
#define VM_WAIT() asm volatile("s_waitcnt vmcnt(0)" ::: "memory")
constexpr int NWAVES = 8, NTHR = 512;
constexpr int RING_BYTES = 131072, LDSCTL_OFF = RING_BYTES, LDS_BYTES = 147456;

__device__ __forceinline__ unsigned f2bf(float f) { unsigned u = __builtin_bit_cast(unsigned, f); return (u + 0x7fffu + ((u >> 16) & 1u)) >> 16; }
__device__ __forceinline__ unsigned pk2(float lo, float hi) { return f2bf(lo) | (f2bf(hi) << 16); }
__device__ __forceinline__ float bf2f(unsigned short b) { return __builtin_bit_cast(float, ((unsigned)b) << 16); }
__device__ __forceinline__ float bflo(unsigned w) { return __builtin_bit_cast(float, w << 16); }
__device__ __forceinline__ float bfhi(unsigned w) { return __builtin_bit_cast(float, w & 0xffff0000u); }
__device__ __forceinline__ unsigned cvt_pk_bf16(float lo, float hi) { unsigned r; asm volatile("v_cvt_pk_bf16_f32 %0, %1, %2" : "=v"(r) : "v"(lo), "v"(hi)); return r; }
__device__ __forceinline__ float wave_sum(float v) {
#pragma unroll
    for (int o = 1; o < 64; o <<= 1) v += __shfl_xor(v, o);
    return v;
}
__device__ __forceinline__ float wave_max(float v) {
#pragma unroll
    for (int o = 1; o < 64; o <<= 1) v = fmaxf(v, __shfl_xor(v, o));
    return v;
}
__device__ __forceinline__ float sigmoidf_(float x) { return 1.0f / (1.0f + __expf(-x)); }
__device__ __forceinline__ float siluf_(float x) { return x / (1.0f + __expf(-x)); }
__device__ __forceinline__ float logsigmoidf_(float x) { return fminf(x, 0.f) - log1pf(__expf(-fabsf(x))); }
__device__ __forceinline__ int t5_bucket(int n) {
    if (n < 16) return n;
    return 16 + (n >= 19) + (n >= 21) + (n >= 24) + (n >= 27) + (n >= 31) + (n >= 35) + (n >= 40) + (n >= 46) + (n >= 52) + (n >= 59) + (n >= 67) + (n >= 77) + (n >= 87) + (n >= 99) + (n >= 113);
}
namespace pg8 {
constexpr int BM = 256, BK = 64, HALF = 128, HTB = HALF * BK * 2, STAGE_BYTES = 8 * HTB, NXCD = 8, WGM = 8;
__host__ __device__ __forceinline__ int lds_byte(int r, int c) { const int st = (r >> 4) * 2 + (c >> 5), rr = r & 15, cc = c & 31, ob = rr * 64 + cc * 2; return st * 1024 + (ob ^ (((ob >> 9) & 1) << 5)); }
__host__ __device__ __forceinline__ void stage_rc(int b, int& R, int& C) { const int st = b / 1024, sb = b % 1024, swz = sb ^ (((sb >> 9) & 1) << 5); R = (st >> 1) * 16 + swz / 64; C = (st & 1) * 32 + (swz % 64) / 2; }
__host__ __device__ __forceinline__ int perm32(int rho) { const int n = rho >> 4, i = rho & 15; return 8 * (i >> 2) + 4 * n + (i & 3); }

struct Unit { int pm, pn, e, rows; };

struct TileOrder {
    int nM, nN, nwg, G, c;
    __device__ void init(int nM_, int nN_, int G_, int c_) { nM = nM_; nN = nN_; nwg = nM * nN; G = G_; c = c_; }
    __device__ bool tile(int i, int& pm, int& pn) const {
        const long L = (long)i * G + c; if (L >= nwg) return false;
        int wgid = (int)L; { const int q = nwg / NXCD, r = nwg % NXCD, xcd = wgid % NXCD, off = wgid / NXCD; wgid = (xcd < r ? xcd * (q + 1) : r * (q + 1) + (xcd - r) * q) + off; }
        const int nig = WGM * nN, gid = wgid / nig, fm = gid * WGM, gsz = (nM - fm) < WGM ? (nM - fm) : WGM;
        pm = fm + ((wgid % nig) % gsz); pn = (wgid % nig) / gsz; return true;
    }
};

template <class Sched, class Epi, int K, int LDA, int LDB, bool ALIGN_EPI>
__device__ __forceinline__ void gemm_phase(LAS unsigned char* lds, const Sched& S, const Epi& E) {
    int tid_ = threadIdx.x; asm volatile("" : "+v"(tid_));
    const int tid = tid_, wid = __builtin_amdgcn_readfirstlane(tid >> 6), lane = tid & 63, wr = wid >> 2, wc = wid & 3, fr = lane & 15, fq = lane >> 4;
    constexpr int nt = K / BK;
    static_assert(K % 128 == 0 && K >= 256, "K");
    unsigned voffB[2];
#pragma unroll
    for (int i = 0; i < 2; ++i) { int R, C; stage_rc(tid * 16 + i * 8192, R, C); const int Rb = Epi::PERM ? ((R & ~31) + perm32(R & 31)) : R;
        voffB[i] = (unsigned)(Rb * LDB + C) * 2u; }
    constexpr size_t kstep = (size_t)(BK * 2);
    constexpr size_t hstepB = (size_t)HALF * LDB * 2;
    constexpr size_t hstepA = Sched::GATHER ? 0 : (size_t)HALF * LDA * 2;
    const unsigned ldsw = (unsigned)wid * 1024u;
    const int aoff = lds_byte(wr * 64 + fr, fq * 8), boff = lds_byte(wc * 32 + fr, fq * 8);
#define PG8_SA(b, h) (((b) * 2 + (h)) * HTB)
#define PG8_SB(b, h) ((4 + (b) * 2 + (h)) * HTB)
#define PG8_STAGE(bufoff, gbase, voff) do { _Pragma("unroll") for (int _i = 0; _i < 2; ++_i) \
        __builtin_amdgcn_global_load_lds((const unsigned*)((const char*)(gbase) + (voff)[_i]), (LAS unsigned*)(lds + (bufoff) + ldsw + _i * 8192), 16, 0, 0); } while (0)
#define PG8_LDA(dst, b, h) do { _Pragma("unroll") for (int m = 0; m < 4; ++m) _Pragma("unroll") for (int k = 0; k < 2; ++k) dst[m][k] = *(const LAS bf16x8*)(lds + PG8_SA(b, h) + aoff + m * 2048 + k * 1024); } while (0)
#define PG8_LDB(dst, b, h) do { _Pragma("unroll") for (int n = 0; n < 2; ++n) _Pragma("unroll") for (int k = 0; k < 2; ++k) dst[n][k] = *(const LAS bf16x8*)(lds + PG8_SB(b, h) + boff + n * 2048 + k * 1024); } while (0)
#define PG8_MMA(ai, bj, At, Bt) do { __builtin_amdgcn_s_setprio(1); _Pragma("unroll") for (int m = 0; m < 4; ++m) _Pragma("unroll") for (int n = 0; n < 2; ++n) _Pragma("unroll") for (int k = 0; k < 2; ++k) \
        acc[ai][bj][m][n] = __builtin_amdgcn_mfma_f32_16x16x32_bf16(Bt[n][k], At[m][k], acc[ai][bj][m][n], 0, 0, 0); __builtin_amdgcn_s_setprio(0); } while (0)
#define VA1 (Sched::GATHER ? vA1 : vA0)
#define W0 vA0
#define W1 VA1
#define PG8_WAIT_V(n) asm volatile("s_waitcnt vmcnt(" #n ")" ::: "memory")
#define PG8_WAIT_L(n) asm volatile("s_waitcnt lgkmcnt(" #n ")" ::: "memory")
#define PG8_BAR __builtin_amdgcn_s_barrier()
#define PG8_SCHED __builtin_amdgcn_sched_barrier(0)
    Unit cur, nxt; int ui = 0;
    if (!S.next(0, cur)) return;
    f32x4 acc[2][2][4][2];
#pragma unroll
    for (int a = 0; a < 2; ++a)
#pragma unroll
        for (int b = 0; b < 2; ++b)
#pragma unroll
            for (int m = 0; m < 4; ++m)
#pragma unroll
                for (int n = 0; n < 2; ++n) acc[a][b][m][n] = (f32x4){0.f, 0.f, 0.f, 0.f};
    bf16x8 At[4][2], B0[2][2], B1[2][2];
    unsigned vA0[2], vA1[2];
    S.a_off(cur, tid, vA0, vA1);
    const char* cA = S.a_base(cur); const char* cB = S.b_base(cur);
    PG8_STAGE(PG8_SB(0, 0), cB, voffB); PG8_STAGE(PG8_SB(0, 1), cB + hstepB, voffB); PG8_STAGE(PG8_SA(0, 0), cA, vA0); PG8_STAGE(PG8_SA(0, 1), cA + hstepA, VA1);
    if (wr == 1) PG8_BAR;
    PG8_WAIT_V(2); PG8_BAR;
    PG8_STAGE(PG8_SB(1, 0), cB + kstep, voffB); PG8_STAGE(PG8_SA(1, 0), cA + kstep, vA0); PG8_STAGE(PG8_SB(1, 1), cB + hstepB + kstep, voffB);
    PG8_WAIT_V(6); PG8_BAR;
    for (;;) {
        const bool has_next = S.next(ui + 1, nxt);
        const char* nA = has_next ? S.a_base(nxt) : cA; const char* nB = has_next ? S.b_base(nxt) : cB;
        for (int t = 0; t < nt; t += 2) {
            const bool last = (t == nt - 2);
            const char* a1 = cA + (size_t)(t + 1) * kstep;
            const char* a2 = last ? nA : cA + (size_t)(t + 2) * kstep; const char* b2 = last ? nB : cB + (size_t)(t + 2) * kstep;
            const char* a3 = a2 + kstep; const char* b3 = b2 + kstep;
            PG8_LDB(B0, 0, 0); PG8_LDB(B1, 0, 1); PG8_SCHED; PG8_LDA(At, 0, 0); PG8_STAGE(PG8_SA(1, 1), a1 + hstepA, VA1);
            if constexpr (Sched::GATHER) { if (last && has_next) S.a_off(nxt, tid, vA0, vA1); }
            PG8_WAIT_V(8); PG8_WAIT_L(0); PG8_BAR; PG8_MMA(0, 0, At, B0); PG8_MMA(0, 1, At, B1); PG8_BAR; PG8_SCHED;
            PG8_LDA(At, 0, 1); PG8_STAGE(PG8_SB(0, 0), b2, voffB); PG8_STAGE(PG8_SB(0, 1), b2 + hstepB, voffB); PG8_STAGE(PG8_SA(0, 0), a2, W0);
            PG8_WAIT_V(8); PG8_WAIT_L(0); PG8_BAR; PG8_MMA(1, 0, At, B0); PG8_MMA(1, 1, At, B1); PG8_BAR; PG8_SCHED;
            PG8_LDB(B0, 1, 0); PG8_LDB(B1, 1, 1); PG8_SCHED; PG8_LDA(At, 1, 0); PG8_STAGE(PG8_SA(0, 1), a2 + hstepA, W1);
            PG8_WAIT_V(8); PG8_WAIT_L(0); PG8_BAR; PG8_MMA(0, 0, At, B0); PG8_MMA(0, 1, At, B1); PG8_BAR; PG8_SCHED;
            PG8_LDA(At, 1, 1); PG8_STAGE(PG8_SB(1, 0), b3, voffB); PG8_STAGE(PG8_SB(1, 1), b3 + hstepB, voffB); PG8_STAGE(PG8_SA(1, 0), a3, W0);
            PG8_WAIT_V(8); PG8_WAIT_L(0); PG8_BAR; PG8_MMA(1, 0, At, B0); PG8_MMA(1, 1, At, B1); PG8_BAR; PG8_SCHED;
        }
        if constexpr (ALIGN_EPI) { if (wr == 0) PG8_BAR; }
        { int fr_e = fr, fq_e = fq; asm volatile("" : "+v"(fr_e), "+v"(fq_e));
          E(acc, cur, wr, wc, fr_e, fq_e); }
        if (!has_next) break;
#pragma unroll
        for (int a = 0; a < 2; ++a)
#pragma unroll
            for (int b = 0; b < 2; ++b)
#pragma unroll
                for (int m = 0; m < 4; ++m)
#pragma unroll
                    for (int n = 0; n < 2; ++n) acc[a][b][m][n] = (f32x4){0.f, 0.f, 0.f, 0.f};
        cur = nxt; cA = nA; cB = nB; ++ui;
        if constexpr (ALIGN_EPI) { if (wr == 1) PG8_BAR; }
    }
    PG8_WAIT_V(0);
    if constexpr (!ALIGN_EPI) { if (wr == 0) PG8_BAR; }
    PG8_BAR;
#undef PG8_SA
#undef VA1
#undef W0
#undef W1
#undef PG8_SB
#undef PG8_STAGE
#undef PG8_LDA
#undef PG8_LDB
#undef PG8_MMA
#undef PG8_WAIT_V
#undef PG8_WAIT_L
#undef PG8_BAR
#undef PG8_SCHED
}
}
#define XB_TMO      128
#define XB_XCNT(j)  (256  + 64 * (j))
#define XB_XSUB(j)  (1280 + 64 * (j))
#define XB_XGEN(j)  (2304 + 64 * (j))
#define XB_TOP      3328
#define XB_TOPGEN   3392
#define XCD_BAR_WORDS 3456
#define XB_SPIN_CAP (1u << 18)
__device__ __forceinline__ unsigned xb_ld(unsigned* p)              { return __hip_atomic_load(p, __ATOMIC_RELAXED, __HIP_MEMORY_SCOPE_AGENT); }
__device__ __forceinline__ unsigned xb_add(unsigned* p, unsigned v) { return __hip_atomic_fetch_add(p, v, __ATOMIC_RELAXED, __HIP_MEMORY_SCOPE_AGENT); }
__device__ __forceinline__ unsigned xb_xcc_id() { return (unsigned)__builtin_amdgcn_s_getreg((3 << 11) | 20) & 0xFu; }
#define XB_SPIN(cond, bar) do { unsigned _sp = 0; while (cond) { __builtin_amdgcn_s_sleep(1); \
    if ((++_sp & 255u) == 0u) { if (xb_ld(&(bar)[XB_TMO])) break; if (_sp > XB_SPIN_CAP) { atomicAdd(&(bar)[XB_TMO], 1u); break; } } } } while (0)
struct XcdBarrier { unsigned* bar; unsigned x; volatile LAS unsigned* st; };
__device__ __forceinline__ XcdBarrier xcd_barrier_post(unsigned* bar, volatile LAS unsigned* st) {
    XcdBarrier b; b.bar = bar; b.x = xb_xcc_id(); b.st = st;
    if (threadIdx.x == 0) (void)xb_add(&bar[XB_XCNT(b.x)], 1u);
    return b;
}
__device__ __forceinline__ void xcd_barrier_complete(unsigned* bar, unsigned x, unsigned& nloc, unsigned& nx) {
    const unsigned G = gridDim.x * gridDim.y * gridDim.z;
    unsigned sum, cnt, mine, sp = 0u;
    for (;;) {
        sum = 0u; cnt = 0u; mine = 0u;
#pragma unroll
        for (unsigned j = 0; j < 16; ++j) { const unsigned c = xb_ld(&bar[XB_XCNT(j)]); sum += c; cnt += (c > 0u) ? 1u : 0u; mine = (j == x) ? c : mine; }
        if (sum == G) break;
        __builtin_amdgcn_s_sleep(1);
        if ((++sp & 255u) == 0u) { if (xb_ld(&bar[XB_TMO])) break; if (sp > XB_SPIN_CAP) { atomicAdd(&bar[XB_TMO], 1u); break; } }
    }
    nloc = mine > 0u ? mine : 1u; nx = cnt > 0u ? cnt : 1u;
}
__device__ __forceinline__ void xcd_barrier(const XcdBarrier& b) {
    asm volatile("s_waitcnt vmcnt(0)" ::: "memory");
    __syncthreads();
    if (threadIdx.x == 0) {
        unsigned* bar = b.bar; asm volatile("" : "+s"(bar));
        __builtin_amdgcn_s_waitcnt(0);
        unsigned nloc = b.st[0], nx = b.st[1];
        if (nloc == 0u) { xcd_barrier_complete(bar, b.x, nloc, nx); b.st[0] = nloc; b.st[1] = nx; }
        const unsigned old = xb_add(&bar[XB_XSUB(b.x)], 1u);
        const unsigned gen = old / nloc;
        if (old + 1u == (gen + 1u) * nloc) {
            __builtin_amdgcn_fence(__ATOMIC_RELEASE, "agent");
            asm volatile("s_waitcnt vmcnt(0)" ::: "memory");
            const unsigned og = xb_add(&bar[XB_TOP], 1u);
            const unsigned tg = og / nx;
            if (og + 1u == (tg + 1u) * nx) xb_add(&bar[XB_TOPGEN], 1u);
            else XB_SPIN(xb_ld(&bar[XB_TOPGEN]) == tg, bar);
            __builtin_amdgcn_fence(__ATOMIC_ACQUIRE, "agent");
            xb_add(&bar[XB_XGEN(b.x)], 1u);
            asm volatile("s_waitcnt vmcnt(0)" ::: "memory");
        } else {
            XB_SPIN(xb_ld(&bar[XB_XGEN(b.x)]) == gen, bar);
            __builtin_amdgcn_fence(__ATOMIC_ACQUIRE, "agent");
            asm volatile("s_waitcnt vmcnt(0)" ::: "memory");
        }
    }
    __syncthreads();
}

struct Args { const float* in[20]; float* out; unsigned char* ws; int ph_lo, ph_hi, use_bar, pad; };
struct Frame {
    LAS unsigned char* lds;
    unsigned* ctl;
    int tid, lane, wave, vcu, G;
    unsigned char* ws;
};
__device__ __forceinline__ const float* arg_in(int i) { asm volatile("" : "+s"(i)); return ((const float* const __attribute__((address_space(4)))*)__builtin_amdgcn_kernarg_segment_ptr())[i]; }
__device__ __forceinline__ unsigned char* arg_ws() { int i = 21; asm volatile("" : "+s"(i)); return ((unsigned char* const __attribute__((address_space(4)))*)__builtin_amdgcn_kernarg_segment_ptr())[i]; }
#define GW_ID(F) ((F).vcu * NWAVES + (F).wave)
#define GW_N(F) ((F).G * NWAVES)

__device__ __forceinline__ void cvt_item(const float* W, int ldw, int k0, int srcc, bf16* WT, size_t out_row0, int ldo, LAS float* scr, int lane) {
#pragma unroll 8
    for (int i = 0; i < 32; ++i) { const int kk = 2 * i + (lane >> 5); scr[kk * 33 + (lane & 31)] = srcc >= 0 ? W[(size_t)(k0 + kk) * ldw + srcc] : 0.f; }
    LDS_WAIT(); asm volatile("" ::: "memory");
    const int c = lane & 7;
#pragma unroll
    for (int j = 0; j < 4; ++j) { const int n = (lane >> 3) + 8 * j; const LAS float* s = scr + (8 * c) * 33 + n;
        v4u o; o.x = pk2(s[0 * 33], s[1 * 33]); o.y = pk2(s[2 * 33], s[3 * 33]); o.z = pk2(s[4 * 33], s[5 * 33]); o.w = pk2(s[6 * 33], s[7 * 33]);
        *(v4u*)(WT + (out_row0 + n) * (size_t)ldo + k0 + 8 * c) = o; }
    LDS_WAIT(); asm volatile("" ::: "memory");
}
__device__ __forceinline__ void ph_convw(const Frame& F, int l) {
    LAS float* scr = (LAS float*)(F.lds + F.wave * 16384);
    const int gw = GW_ID(F), NGW = GW_N(F), lane = F.lane, ln = lane & 31;
    constexpr int I_IN = (PW / 32) * 32, I_BR = 3 * 64 * 16, I_OUT = 64 * 32, I_G = 32 * 16 * 32, I_D = 32 * 64 * 8;
    constexpr int NITEMS = I_IN + I_BR + I_OUT + 2 * I_G + I_D;
    for (int it = gw; it < NITEMS; it += NGW) {
        int r = it;
        if (r < I_IN) { const int kb = r / (PW / 32), nb = r % (PW / 32);
            cvt_item(arg_in(2) + (size_t)l * DM * NIN, NIN, 64 * kb, src_col(32 * nb + ln), (bf16*)(F.ws + WS_WIN), (size_t)32 * nb, DM, scr, lane); continue; }
        r -= I_IN;
        if (r < I_BR) { const int n = r / (64 * 16), q = r % (64 * 16), kb = q / 64, nb = q % 64;
            cvt_item(arg_in(9) + ((size_t)l * 3 + n) * BW * DM, DM, 64 * kb, 32 * nb + ln, (bf16*)(F.ws + WS_WBR) + (size_t)n * DM * BW, (size_t)32 * nb, BW, scr, lane); continue; }
        r -= I_BR;
        if (r < I_OUT) { const int kb = r / 64, nb = r % 64;
            cvt_item(arg_in(10) + (size_t)l * DM * DM, DM, 64 * kb, 32 * nb + ln, (bf16*)(F.ws + WS_WOUT), (size_t)32 * nb, DM, scr, lane); continue; }
        r -= I_OUT;
        if (r < 2 * I_G) { const int up = r >= I_G; if (up) r -= I_G; const int e = r / (16 * 32), q = r % (16 * 32), kb = q / 16, nb = q % 16, f0 = 32 * nb;
            cvt_item(arg_in(up ? 17 : 16) + ((size_t)l * NEXP + e) * DM * DEXP, DEXP, 64 * kb, f0 + ln, (bf16*)(F.ws + WS_WGU) + (size_t)e * 1024 * DM,
                     (size_t)((f0 >> 7) * 256 + (up ? 128 : 0) + (f0 & 127)), DM, scr, lane); continue; }
        r -= 2 * I_G;
        { const int e = r / (64 * 8), q = r % (64 * 8), kb = q / 64, nb = q % 64;
            cvt_item(arg_in(18) + ((size_t)l * NEXP + e) * DEXP * DM, DM, 64 * kb, 32 * nb + ln, (bf16*)(F.ws + WS_WDN) + (size_t)e * DM * DEXP, (size_t)32 * nb, DEXP, scr, lane); }
    }
}

__device__ __forceinline__ int* tokinfo_ptr(const Frame& F) { return (int*)(F.ws + WS_LIST + MiB); }

__device__ __forceinline__ void ph_norm1(const Frame& F, int l) {
    const int gw = GW_ID(F), NGW = GW_N(F), lane = F.lane;
    const float* g = arg_in(1) + (size_t)l * DM;
    bf16* XN = (bf16*)(F.ws + WS_XN);
    for (int m = gw; m < NTOK; m += NGW) {
        f32x4 v[8]; float s = 0.f;
        if (l == 0) {
            const f32x4* xr = (const f32x4*)(arg_in(0) + (size_t)m * DM) + lane;
#pragma unroll
            for (int j = 0; j < 8; ++j) v[j] = xr[64 * j];
        } else {
            const f32x4* xr = (const f32x4*)((const float*)(F.ws + WS_X1) + (size_t)m * DM) + lane;
            const v2u* y0 = (const v2u*)((const bf16*)(F.ws + WS_YB) + (size_t)(2 * m) * DM) + lane;
            const v2u* y1 = (const v2u*)((const bf16*)(F.ws + WS_YB) + (size_t)(2 * m + 1) * DM) + lane;
            f32x4* xo = (f32x4*)((float*)(F.ws + WS_XA) + (size_t)m * DM) + lane;
#pragma unroll
            for (int j = 0; j < 8; ++j) { f32x4 x = xr[64 * j]; const v2u a = y0[64 * j], b = y1[64 * j];
                x.x = (x.x + bflo(a.x)) + bflo(b.x); x.y = (x.y + bfhi(a.x)) + bfhi(b.x); x.z = (x.z + bflo(a.y)) + bflo(b.y); x.w = (x.w + bfhi(a.y)) + bfhi(b.y);
                v[j] = x; xo[64 * j] = x; }
        }
#pragma unroll
        for (int j = 0; j < 8; ++j) s += (v[j].x * v[j].x + v[j].y * v[j].y) + (v[j].z * v[j].z + v[j].w * v[j].w);
        const float rstd = 1.0f / sqrtf(wave_sum(s) * (1.f / DM) + EPS);
        v2u* o8 = (v2u*)(XN + (size_t)m * DM) + lane;
        const f32x4* gr = (const f32x4*)g + lane;
#pragma unroll
        for (int j = 0; j < 8; ++j) { const f32x4 gg = gr[64 * j]; v2u o; o.x = pk2(v[j].x * rstd * gg.x, v[j].y * rstd * gg.y); o.y = pk2(v[j].z * rstd * gg.z, v[j].w * rstd * gg.w); o8[64 * j] = o; }
    }
}

__device__ __forceinline__ void ph_final(const Frame& F, float* out) {
    const int gw = GW_ID(F), NGW = GW_N(F), lane = F.lane;
    for (int m = gw; m < NTOK; m += NGW) {
        const f32x4* xr = (const f32x4*)((const float*)(F.ws + WS_X1) + (size_t)m * DM) + lane;
        const v2u* y0 = (const v2u*)((const bf16*)(F.ws + WS_YB) + (size_t)(2 * m) * DM) + lane;
        const v2u* y1 = (const v2u*)((const bf16*)(F.ws + WS_YB) + (size_t)(2 * m + 1) * DM) + lane;
        f32x4* xo = (f32x4*)(out + (size_t)m * DM) + lane;
#pragma unroll
        for (int j = 0; j < 8; ++j) { f32x4 x = xr[64 * j]; const v2u a = y0[64 * j], b = y1[64 * j];
            x.x = (x.x + bflo(a.x)) + bflo(b.x); x.y = (x.y + bfhi(a.x)) + bfhi(b.x); x.z = (x.z + bflo(a.y)) + bflo(b.y); x.w = (x.w + bfhi(a.y)) + bfhi(b.y);
            xo[64 * j] = x; }
    }
}

__device__ __forceinline__ void ph_norm2(const Frame& F, int l) {
    const int gw = GW_ID(F), NGW = GW_N(F), lane = F.lane;
    const float* g = arg_in(11) + (size_t)l * DM;
    const float* wrg = arg_in(12) + (size_t)l * DM * NGRP; const float* brg = arg_in(13) + l * NGRP;
    const float* wre = arg_in(14) + (size_t)l * DM * NEXP; const float* bre = arg_in(15) + l * NEXP;
    bf16* XN = (bf16*)(F.ws + WS_XN);
    int* list = (int*)(F.ws + WS_LIST); int* tinfo = tokinfo_ptr(F);
    unsigned* ecnt = F.ctl + CW_ECNT + l * NEXP * 64;
    for (int m = gw; m < NTOK; m += NGW) {
        f32x4 v[8]; float s = 0.f;
        const f32x4* xr = (const f32x4*)((const float*)(F.ws + WS_X1) + (size_t)m * DM) + lane;
#pragma unroll
        for (int j = 0; j < 8; ++j) { v[j] = xr[64 * j]; s += (v[j].x * v[j].x + v[j].y * v[j].y) + (v[j].z * v[j].z + v[j].w * v[j].w); }
        const float rstd = 1.0f / sqrtf(wave_sum(s) * (1.f / DM) + EPS);
        v2u* o8 = (v2u*)(XN + (size_t)m * DM) + lane;
        const f32x4* gr = (const f32x4*)g + lane;
#pragma unroll
        for (int j = 0; j < 8; ++j) { const f32x4 gg = gr[64 * j]; v2u o; o.x = pk2(v[j].x * rstd * gg.x, v[j].y * rstd * gg.y); o.y = pk2(v[j].z * rstd * gg.z, v[j].w * rstd * gg.w); o8[64 * j] = o; }
        float lg[36];
#pragma unroll
        for (int q = 0; q < 36; ++q) lg[q] = 0.f;
#pragma unroll 1
        for (int j = 0; j < 8; ++j) { const f32x4 gg = gr[64 * j], xx = xr[64 * j]; f32x4 x; x.x = xx.x * rstd * gg.x; x.y = xx.y * rstd * gg.y; x.z = xx.z * rstd * gg.z; x.w = xx.w * rstd * gg.w;
            const int k0 = 4 * lane + 256 * j;
#pragma unroll
            for (int c = 0; c < 4; ++c) { const float xv = x[c];
                const f32x4 wg = *(const f32x4*)(wrg + (size_t)(k0 + c) * NGRP);
                lg[0] += xv * wg.x; lg[1] += xv * wg.y; lg[2] += xv * wg.z; lg[3] += xv * wg.w;
                const f32x4* we = (const f32x4*)(wre + (size_t)(k0 + c) * NEXP);
#pragma unroll
                for (int q = 0; q < 8; ++q) { const f32x4 w = we[q]; lg[4 + 4 * q] += xv * w.x; lg[5 + 4 * q] += xv * w.y; lg[6 + 4 * q] += xv * w.z; lg[7 + 4 * q] += xv * w.w; } } }
#pragma unroll
        for (int q = 0; q < 36; ++q) lg[q] = wave_sum(lg[q]);
        LAS float* lgL = (LAS float*)(F.lds + F.wave * 256);
        if (lane == 0) {
#pragma unroll
            for (int q = 0; q < 36; ++q) lgL[q] = lg[q];
            int gs = 0; float best = lg[0] + brg[0];
#pragma unroll
            for (int q = 1; q < 4; ++q) { const float t = lg[q] + brg[q]; if (t > best) { best = t; gs = q; } }
            float gm = fmaxf(fmaxf(lg[0], lg[1]), fmaxf(lg[2], lg[3])), gsum = 0.f, gsel = 0.f;
#pragma unroll
            for (int q = 0; q < 4; ++q) { const float e = __expf(lg[q] - gm); gsum += e; gsel = (q == gs) ? e : gsel; }
            const float pg = gsel / gsum;
            LDS_WAIT(); asm volatile("" ::: "memory");
            float ein[8];
#pragma unroll
            for (int q = 0; q < 8; ++q) ein[q] = lgL[4 + gs * 8 + q];
            int e0 = 0, e1 = -1; float b0 = -3.0e38f, b1 = -3.0e38f;
#pragma unroll
            for (int q = 0; q < 8; ++q) { const float t = ein[q] + bre[gs * 8 + q];
                if (t > b0) { b1 = b0; e1 = e0; b0 = t; e0 = q; } else if (t > b1) { b1 = t; e1 = q; } }
            float em = ein[0];
#pragma unroll
            for (int q = 1; q < 8; ++q) em = fmaxf(em, ein[q]);
            float p0 = 0.f, p1 = 0.f;
#pragma unroll
            for (int q = 0; q < 8; ++q) { const float e = __expf(ein[q] - em); p0 = (q == e0) ? e : p0; p1 = (q == e1) ? e : p1; }
            const float w0 = pg * p0 / (p0 + p1), w1 = pg * p1 / (p0 + p1);
            const int x0 = gs * 8 + e0, x1 = gs * 8 + e1;
            const int pos0 = (int)atomicAdd(ecnt + x0 * 64, 1u), pos1 = (int)atomicAdd(ecnt + x1 * 64, 1u);
            list[x0 * NTOK + pos0] = 2 * m; list[x1 * NTOK + pos1] = 2 * m + 1;
            tinfo[m * 8 + 0] = x0; tinfo[m * 8 + 1] = pos0; tinfo[m * 8 + 2] = __float_as_int(w0); tinfo[m * 8 + 3] = 0;
            tinfo[m * 8 + 4] = x1; tinfo[m * 8 + 5] = pos1; tinfo[m * 8 + 6] = __float_as_int(w1); tinfo[m * 8 + 7] = 0;
        }
    }
}

__device__ __forceinline__ void nv_conv(const Frame& F, int l) {
    const bf16* P = (const bf16*)(F.ws + WS_PROJ); float* QK = (float*)(F.ws + WS_TMP);
    const float* cw = arg_in(3) + (size_t)l * 4 * 2048;
    const size_t total = (size_t)NTOK * 2048, stride = (size_t)F.G * NTHR;
    for (size_t i = (size_t)F.vcu * NTHR + F.tid; i < total; i += stride) {
        const int row = (int)(i >> 11), c = (int)(i & 2047), t = row & (SEQ - 1);
        float a = 0.f;
#pragma unroll
        for (int j = 0; j < 4; ++j) { const int tt = t - 3 + j; if (tt >= 0) a += cw[j * 2048 + c] * bf2f(P[(size_t)(row - 3 + j) * PW + c]); }
        QK[i] = siluf_(a);
    }
}
__device__ __forceinline__ void nv_mlstm(const Frame& F, int l) {
    const bf16* P = (const bf16*)(F.ws + WS_PROJ); const float* QK = (const float*)(F.ws + WS_TMP); float* HR = (float*)(F.ws + WS_TMP + 64 * MiB);
    const int tid = F.tid, v = tid >> 2, kq = tid & 3;
    for (int bh = F.vcu; bh < BATCH * NH; bh += F.G) {
        const int b = bh >> 3, h = bh & 7;
        const float bi = arg_in(4)[l * NH + h], bfv = arg_in(5)[l * NH + h];
        float C[32], nn[32], m = 0.f;
#pragma unroll
        for (int j = 0; j < 32; ++j) { C[j] = 0.f; nn[j] = 0.f; }
        for (int t = 0; t < SEQ; ++t) {
            const size_t row = (size_t)b * SEQ + t;
            const float it = bf2f(P[row * PW + C_MI + h]) + bi, ft = bf2f(P[row * PW + C_MF + h]) + bfv;
            const float lf = logsigmoidf_(ft);
            const float mn = fmaxf(lf + m, it), ip = __expf(it - mn), fp = __expf(lf + m - mn); m = mn;
            const float vv = bf2f(P[row * PW + C_MV + h * HD + v]);
            const f32x4* qp = (const f32x4*)(QK + row * 2048 + h * HD + kq * 32);
            const f32x4* kp = (const f32x4*)(QK + row * 2048 + 1024 + h * HD + kq * 32);
            float num = 0.f, den = 0.f;
#pragma unroll
            for (int j4 = 0; j4 < 8; ++j4) { const f32x4 q = qp[j4], k = kp[j4];
#pragma unroll
                for (int c = 0; c < 4; ++c) { const int j = 4 * j4 + c; const float qq = q[c] * 0.08838834764831845f;
                    C[j] = fp * C[j] + ip * vv * k[c]; nn[j] = fp * nn[j] + ip * k[c]; num += C[j] * qq; den += nn[j] * qq; } }
            num += __shfl_xor(num, 1); num += __shfl_xor(num, 2); den += __shfl_xor(den, 1); den += __shfl_xor(den, 2);
            if (kq == 0) HR[row * 1024 + h * HD + v] = num / fmaxf(fabsf(den), __expf(-m));
        }
    }
}
__device__ __forceinline__ void nv_mnorm(const Frame& F, int l) {
    const bf16* P = (const bf16*)(F.ws + WS_PROJ); const float* HR = (const float*)(F.ws + WS_TMP + 64 * MiB); bf16* BR = (bf16*)(F.ws + WS_BR);
    const float* g = arg_in(6) + (size_t)l * BW;
    const int gw = GW_ID(F), NGW = GW_N(F), lane = F.lane;
    for (int it = gw; it < NTOK * NH; it += NGW) {
        const size_t row = it >> 3; const int h = it & 7, c = h * HD + 2 * lane;
        const float a = HR[row * 1024 + c], b = HR[row * 1024 + c + 1];
        const float r = 1.0f / sqrtf(wave_sum(a * a + b * b) * (1.f / HD) + EPS);
        const float o0 = a * r * g[c] * sigmoidf_(bf2f(P[row * PW + C_MO + c])), o1 = b * r * g[c + 1] * sigmoidf_(bf2f(P[row * PW + C_MO + c + 1]));
        *(unsigned*)(BR + row * 3072 + c) = pk2(o0, o1);
    }
}
__device__ __forceinline__ unsigned fkey(float f) { const unsigned u = __float_as_uint(f); return (u & 0x80000000u) ? ~u : (u | 0x80000000u); }
__device__ __forceinline__ void select_row(const unsigned (&key)[32], int nvalid, unsigned long long* mrow, int lane) {
    if (nvalid <= TOPK) {
#pragma unroll
        for (int j = 0; j < 32; ++j) { const unsigned long long b = __ballot(lane + 64 * j < nvalid); if (lane == 0) mrow[j] = b; }
        return;
    }
    unsigned T = 0u;
    for (int bit = 31; bit >= 0; --bit) {
        const unsigned cand = T | (1u << bit); int c = 0;
#pragma unroll
        for (int j = 0; j < 32; ++j) c += (key[j] >= cand) ? 1 : 0;
#pragma unroll
        for (int o = 1; o < 64; o <<= 1) c += __shfl_xor(c, o);
        if (c >= TOPK) T = cand;
    }
    int cgt = 0;
#pragma unroll
    for (int j = 0; j < 32; ++j) cgt += (key[j] > T) ? 1 : 0;
#pragma unroll
    for (int o = 1; o < 64; o <<= 1) cgt += __shfl_xor(cgt, o);
    const int need = TOPK - cgt; int run = 0;
    const unsigned long long below = (lane == 0) ? 0ull : (~0ull >> (64 - lane));
#pragma unroll
    for (int j = 0; j < 32; ++j) {
        const bool eq = key[j] == T; const unsigned long long be = __ballot(eq);
        const int rank = run + __popcll(be & below);
        const bool sel = (key[j] > T) || (eq && rank < need);
        run += __popcll(be);
        const unsigned long long b = __ballot(sel); if (lane == 0) mrow[j] = b;
    }
}
__device__ __forceinline__ void nv_index(const Frame& F) {
    const bf16* P = (const bf16*)(F.ws + WS_PROJ); unsigned long long* MK = (unsigned long long*)(F.ws + WS_MASK);
    LAS float* iqL = (LAS float*)(F.lds + F.wave * 12288); LAS float* scL = iqL + 1024;
    const int gw = GW_ID(F), NGW = GW_N(F), lane = F.lane;
    for (int row = gw; row < NTOK; row += NGW) {
        const int t = row & (SEQ - 1), r0 = row - t;
        for (int i = lane; i < 1024; i += 64) iqL[i] = bf2f(P[(size_t)row * PW + C_IQ + i]);
        float w[16];
#pragma unroll
        for (int hh = 0; hh < 16; ++hh) w[hh] = bf2f(P[(size_t)row * PW + C_IW + hh]) * 0.25f;
        LDS_WAIT(); asm volatile("" ::: "memory");
        for (int s = lane; s <= t; s += 64) {
            float d[16];
#pragma unroll
            for (int hh = 0; hh < 16; ++hh) d[hh] = 0.f;
            const v4u* kp = (const v4u*)(P + (size_t)(r0 + s) * PW + C_IK);
#pragma unroll 1
            for (int hf = 0; hf < 2; ++hf) {
                float kr[32];
#pragma unroll
                for (int q = 0; q < 4; ++q) { const v4u x = kp[4 * hf + q]; kr[8 * q] = bflo(x.x); kr[8 * q + 1] = bfhi(x.x); kr[8 * q + 2] = bflo(x.y); kr[8 * q + 3] = bfhi(x.y); kr[8 * q + 4] = bflo(x.z); kr[8 * q + 5] = bfhi(x.z); kr[8 * q + 6] = bflo(x.w); kr[8 * q + 7] = bfhi(x.w); }
#pragma unroll
                for (int hh = 0; hh < 16; ++hh) {
#pragma unroll
                    for (int e = 0; e < 32; ++e) d[hh] += iqL[hh * 64 + hf * 32 + e] * kr[e]; }
            }
            float sc = 0.f;
#pragma unroll
            for (int hh = 0; hh < 16; ++hh) sc += w[hh] * fmaxf(d[hh] * 0.125f, 0.f);
            scL[s] = sc;
        }
        LDS_WAIT(); asm volatile("" ::: "memory");
        unsigned key[32];
#pragma unroll
        for (int j = 0; j < 32; ++j) { const int s = lane + 64 * j; key[j] = (s <= t) ? fkey(scL[s]) : 0u; }
        select_row(key, t + 1, MK + (size_t)row * 32, lane);
        LDS_WAIT(); asm volatile("" ::: "memory");
    }
}
__device__ __forceinline__ void nv_dsa(const Frame& F, int l) {
    const bf16* P = (const bf16*)(F.ws + WS_PROJ); const unsigned long long* MK = (const unsigned long long*)(F.ws + WS_MASK); bf16* BR = (bf16*)(F.ws + WS_BR);
    const float* qg = arg_in(7) + l * HD; const float* kg = arg_in(8) + l * HD; const float* rb = arg_in(19);
    LAS float* lgL = (LAS float*)(F.lds + F.wave * 2048); LAS int* ixL = (LAS int*)(lgL + 256);
    const int gw = GW_ID(F), NGW = GW_N(F), lane = F.lane;
    for (int it = gw; it < NTOK * NH; it += NGW) {
        const int row = it >> 3, h = it & 7, t = row & (SEQ - 1), r0 = row - t, c = h * HD + 2 * lane;
        float q0 = bf2f(P[(size_t)row * PW + C_DQ + c]), q1 = bf2f(P[(size_t)row * PW + C_DQ + c + 1]);
        const float qr = 1.0f / sqrtf(wave_sum(q0 * q0 + q1 * q1) * (1.f / HD) + EPS);
        q0 *= qr * qg[2 * lane]; q1 *= qr * qg[2 * lane + 1];
        const float kg0 = kg[2 * lane], kg1 = kg[2 * lane + 1];
        int cnt = 0; float mx = -3.0e38f;
        for (int wi = 0; wi <= (t >> 6); ++wi) {
            unsigned long long w = MK[(size_t)row * 32 + wi];
            while (w) { const int s = wi * 64 + __builtin_ctzll(w); w &= w - 1;
                const unsigned kk = *(const unsigned*)(P + (size_t)(r0 + s) * PW + C_DK + c);
                const float k0 = bflo(kk), k1 = bfhi(kk);
                const float ss = wave_sum(k0 * k0 + k1 * k1), dd = wave_sum(q0 * k0 * kg0 + q1 * k1 * kg1);
                const float kr = 1.0f / sqrtf(ss * (1.f / HD) + EPS);
                const float lgt = dd * kr * 0.08838834764831845f + rb[t5_bucket(t - s) * NH + h];
                if (lane == 0) { lgL[cnt] = lgt; ixL[cnt] = s; }
                mx = fmaxf(mx, lgt); ++cnt; }
        }
        LDS_WAIT(); asm volatile("" ::: "memory");
        float o0 = 0.f, o1 = 0.f, den = 0.f;
        for (int j = 0; j < cnt; ++j) { const float p = __expf(lgL[j] - mx); const int s = ixL[j];
            const unsigned vv = *(const unsigned*)(P + (size_t)(r0 + s) * PW + C_DV + c);
            o0 += p * bflo(vv); o1 += p * bfhi(vv); den += p; }
        *(unsigned*)(BR + (size_t)row * 3072 + 1024 + c) = pk2(o0 / den, o1 / den);
        LDS_WAIT(); asm volatile("" ::: "memory");
    }
}
__device__ __forceinline__ void nv_sb(const Frame& F) {
    const bf16* P = (const bf16*)(F.ws + WS_PROJ); bf16* BR = (bf16*)(F.ws + WS_BR);
    const int gw = GW_ID(F), NGW = GW_N(F), lane = F.lane;
    for (int it = gw; it < NTOK * NH; it += NGW) {
        const int row = it >> 3, h = it & 7, t = row & (SEQ - 1), r0 = row - t, c = h * HD + 2 * lane;
        const unsigned qq = *(const unsigned*)(P + (size_t)row * PW + C_SQ + c);
        const float q0 = bflo(qq) * 0.08838834764831845f, q1 = bfhi(qq) * 0.08838834764831845f;
        float o0 = 0.f, o1 = 0.f, lp = 0.f;
        for (int s = t - 1; s >= 0; --s) {
            const unsigned kk = *(const unsigned*)(P + (size_t)(r0 + s) * PW + C_SK + c);
            const float z = wave_sum(q0 * bflo(kk) + q1 * bfhi(kk));
            const float a = __expf(logsigmoidf_(z) + lp);
            const unsigned vv = *(const unsigned*)(P + (size_t)(r0 + s) * PW + C_SV + c);
            o0 += a * bflo(vv); o1 += a * bfhi(vv);
            lp += logsigmoidf_(-z);
            if (lp < -80.f) break;
        }
        *(unsigned*)(BR + (size_t)row * 3072 + 2048 + c) = pk2(o0, o1);
    }
}
__device__ __forceinline__ void nv_moe(const Frame& F) {
    const bf16* XN = (const bf16*)(F.ws + WS_XN); bf16* YB = (bf16*)(F.ws + WS_YB); const int* tinfo = tokinfo_ptr(F);
    LAS float* xL = (LAS float*)F.lds; LAS float* hL = xL + 2048;
    const int tid = F.tid;
    for (int slot = F.vcu; slot < 2 * NTOK; slot += F.G) {
        const int m = slot >> 1, k = slot & 1; const int e = tinfo[m * 8 + 4 * k]; const float w = __int_as_float(tinfo[m * 8 + 4 * k + 2]);
        __syncthreads();
        for (int i = tid; i < 2048; i += NTHR) xL[i] = bf2f(XN[(size_t)m * DM + i]);
        __syncthreads();
        { const int f = tid; const bf16* wg = (const bf16*)(F.ws + WS_WGU) + ((size_t)e * 1024 + (f >> 7) * 256 + (f & 127)) * DM; const bf16* wu = wg + (size_t)128 * DM;
          float g = 0.f, u = 0.f;
          for (int k8 = 0; k8 < 256; ++k8) { const v4u a = ((const v4u*)wg)[k8], b = ((const v4u*)wu)[k8]; const LAS float* x = xL + 8 * k8;
              g += x[0] * bflo(a.x) + x[1] * bfhi(a.x) + x[2] * bflo(a.y) + x[3] * bfhi(a.y) + x[4] * bflo(a.z) + x[5] * bfhi(a.z) + x[6] * bflo(a.w) + x[7] * bfhi(a.w);
              u += x[0] * bflo(b.x) + x[1] * bfhi(b.x) + x[2] * bflo(b.y) + x[3] * bfhi(b.y) + x[4] * bflo(b.z) + x[5] * bfhi(b.z) + x[6] * bflo(b.w) + x[7] * bfhi(b.w); }
          hL[f] = bf2f((unsigned short)f2bf(siluf_(g) * u)); }
        __syncthreads();
        { float y[4];
#pragma unroll
          for (int c = 0; c < 4; ++c) { const int d = 4 * tid + c; const bf16* wd = (const bf16*)(F.ws + WS_WDN) + ((size_t)e * DM + d) * DEXP; float a = 0.f;
              for (int k8 = 0; k8 < 64; ++k8) { const v4u x = ((const v4u*)wd)[k8]; const LAS float* hh = hL + 8 * k8;
                  a += hh[0] * bflo(x.x) + hh[1] * bfhi(x.x) + hh[2] * bflo(x.y) + hh[3] * bfhi(x.y) + hh[4] * bflo(x.z) + hh[5] * bfhi(x.z) + hh[6] * bflo(x.w) + hh[7] * bfhi(x.w); }
              y[c] = a * w; }
          v2u o; o.x = pk2(y[0], y[1]); o.y = pk2(y[2], y[3]); *(v2u*)(YB + (size_t)slot * DM + 4 * tid) = o; }
    }
}
constexpr int MOE_TAB_OFF = LDSCTL_OFF + 1024;
__device__ __forceinline__ void moe_tables(const Frame& F, int l) {
    LAS int* tp = (LAS int*)(F.lds + MOE_TAB_OFF); LAS int* cn = tp + 40; LAS int* sb = cn + 40;
    __syncthreads();
    if (F.tid == 0) { int p = 0, s = 0;
        for (int e = 0; e < NEXP; ++e) { const int c = (int)__hip_atomic_load(F.ctl + CW_ECNT + (l * NEXP + e) * 64, RLX_AGENT); tp[e] = p; cn[e] = c; sb[e] = s; p += (c + 255) >> 8; s += c; }
        tp[NEXP] = p; sb[NEXP] = s; }
    __syncthreads();
}
template <int NT> struct SchedMoeBase {
    const LAS int* tp; const LAS int* cn; const LAS int* sb; int G, c;
    __device__ __forceinline__ bool next(int i, pg8::Unit& u) const {
        const int L = i * G + c, total = tp[NEXP] * NT; if (L >= total) return false;
        const int mt = L / NT; u.pn = L % NT; int e = 0;
#pragma unroll 1
        for (int q = 1; q < NEXP; ++q) e = (tp[q] <= mt) ? q : e;
        u.e = e; u.pm = mt - tp[e]; const int r = cn[e] - 256 * u.pm; u.rows = r < 256 ? r : 256; return true;
    }
};
struct SchedMoeUp : SchedMoeBase<4> {
    static constexpr bool GATHER = true;
    const char* A; const char* B; const int* list;
    __device__ __forceinline__ const char* a_base(const pg8::Unit&) const { return A; }
    __device__ __forceinline__ const char* b_base(const pg8::Unit& u) const { return B + ((size_t)u.e * 1024 + (size_t)u.pn * 256) * DM * 2; }
    __device__ __forceinline__ void a_off(const pg8::Unit& u, int tid, unsigned (&v0)[2], unsigned (&v1)[2]) const {
        int R[2], C[2];
#pragma unroll
        for (int i = 0; i < 2; ++i) pg8::stage_rc(tid * 16 + i * 8192, R[i], C[i]);
        const int* le = list + (size_t)u.e * NTOK + 256 * u.pm;
#pragma unroll
        for (int i = 0; i < 2; ++i) { int r0 = R[i], r1 = R[i] + 128; r0 = r0 < u.rows ? r0 : u.rows - 1; r1 = r1 < u.rows ? r1 : u.rows - 1;
            const int t0 = le[r0] >> 1, t1 = le[r1] >> 1;
            v0[i] = (unsigned)(t0 * DM + C[i]) * 2u; v1[i] = (unsigned)(t1 * DM + C[i]) * 2u; }
    }
};
struct EpiMoeUp {
    static constexpr bool PERM = true;
    bf16* HB; const LAS int* sb;
    __device__ __forceinline__ void operator()(const f32x4 (&acc)[2][2][4][2], const pg8::Unit& u, int wr, int wc, int fr, int fq) const {
        const int col0 = u.pn * 128 + wc * 32 + 8 * fq; const size_t slot0 = (size_t)sb[u.e] + 256 * u.pm;
#pragma unroll
        for (int ai = 0; ai < 2; ++ai)
#pragma unroll
            for (int m = 0; m < 4; ++m) { const int r = ai * 128 + wr * 64 + m * 16 + fr;
                if (r < u.rows) { const f32x4 g0 = acc[ai][0][m][0], g1 = acc[ai][0][m][1], u0 = acc[ai][1][m][0], u1 = acc[ai][1][m][1];
                    v4u w; w.x = cvt_pk_bf16(siluf_(g0[0]) * u0[0], siluf_(g0[1]) * u0[1]); w.y = cvt_pk_bf16(siluf_(g0[2]) * u0[2], siluf_(g0[3]) * u0[3]);
                    w.z = cvt_pk_bf16(siluf_(g1[0]) * u1[0], siluf_(g1[1]) * u1[1]); w.w = cvt_pk_bf16(siluf_(g1[2]) * u1[2], siluf_(g1[3]) * u1[3]);
                    *(v4u*)(HB + (slot0 + r) * DEXP + col0) = w; } }
    }
};
struct SchedMoeDown : SchedMoeBase<8> {
    static constexpr bool GATHER = false;
    const char* A; const char* B;
    __device__ __forceinline__ const char* a_base(const pg8::Unit& u) const { return A + ((size_t)sb[u.e] + 256 * u.pm) * DEXP * 2; }
    __device__ __forceinline__ const char* b_base(const pg8::Unit& u) const { return B + ((size_t)u.e * DM + (size_t)u.pn * 256) * DEXP * 2; }
    __device__ __forceinline__ void a_off(const pg8::Unit&, int tid, unsigned (&v0)[2], unsigned (&v1)[2]) const {
        int R[2], C[2];
#pragma unroll
        for (int i = 0; i < 2; ++i) pg8::stage_rc(tid * 16 + i * 8192, R[i], C[i]);
#pragma unroll
        for (int i = 0; i < 2; ++i) { v0[i] = (unsigned)(R[i] * DEXP + C[i]) * 2u; v1[i] = v0[i] + 128u * DEXP * 2u; } }
};
struct EpiMoeDown {
    static constexpr bool PERM = true;
    bf16* YB; const int* list; const int* tinfo;
    __device__ __forceinline__ void operator()(const f32x4 (&acc)[2][2][4][2], const pg8::Unit& u, int wr, int wc, int fr, int fq) const {
        const int col0 = u.pn * 256 + wc * 32 + 8 * fq; const int* le = list + (size_t)u.e * NTOK + 256 * u.pm;
#pragma unroll
        for (int ai = 0; ai < 2; ++ai)
#pragma unroll
            for (int m = 0; m < 4; ++m) { const int r = ai * 128 + wr * 64 + m * 16 + fr;
                if (r < u.rows) { const int ent = le[r]; const float w = __int_as_float(tinfo[(ent >> 1) * 8 + 4 * (ent & 1) + 2]);
#pragma unroll
                    for (int bj = 0; bj < 2; ++bj) { const f32x4 v0 = acc[ai][bj][m][0] * w, v1 = acc[ai][bj][m][1] * w;
                        v4u o; o.x = cvt_pk_bf16(v0[0], v0[1]); o.y = cvt_pk_bf16(v0[2], v0[3]); o.z = cvt_pk_bf16(v1[0], v1[1]); o.w = cvt_pk_bf16(v1[2], v1[3]);
                        *(v4u*)(YB + (size_t)ent * DM + col0 + bj * 128) = o; } } }
    }
};
#define KSWZ(row, colB) ((row) * 256 + ((colB) ^ (((row) & 7) << 4)))
#define SBAR() __builtin_amdgcn_sched_barrier(0)
__device__ __forceinline__ int crow(int r, int hi) { return (r & 3) + 8 * (r >> 2) + 4 * hi; }
__device__ __forceinline__ void qkt64(f32x16& p0, f32x16& p1, const LAS char* Ks, const bf16x8* qr, int r32, int hi) {
    p0 = f32x16{}; p1 = f32x16{};
#pragma unroll
    for (int d0 = 0; d0 < 8; ++d0) { const int cb = (d0 * 16 + hi * 8) * 2;
        const bf16x8 b0 = *(const LAS bf16x8*)(Ks + KSWZ(r32, cb));
        const bf16x8 b1 = *(const LAS bf16x8*)(Ks + KSWZ(32 + r32, cb));
        p0 = __builtin_amdgcn_mfma_f32_32x32x16_bf16(b0, qr[d0], p0, 0, 0, 0);
        p1 = __builtin_amdgcn_mfma_f32_32x32x16_bf16(b1, qr[d0], p1, 0, 0, 0); }
}
__device__ __forceinline__ void qkt32(f32x16& p0, const LAS char* Ks, const bf16x8* qr, int r32, int hi) {
    p0 = f32x16{};
#pragma unroll
    for (int d0 = 0; d0 < 8; ++d0) { const int cb = (d0 * 16 + hi * 8) * 2;
        const bf16x8 b0 = *(const LAS bf16x8*)(Ks + KSWZ(r32, cb));
        p0 = __builtin_amdgcn_mfma_f32_32x32x16_bf16(b0, qr[d0], p0, 0, 0, 0); }
}
__device__ __forceinline__ int v_st(int k, int c) { const int kk = (k & ~0xC) | ((k & 4) << 1) | ((k & 8) >> 1); return ((kk >> 3) * 4 + (c >> 5)) * 512 + ((kk & 7) * 32 + (c & 31)) * 2; }
__device__ __forceinline__ int v_rd_base(int lane) { return ((lane & 3) << 3) | (((lane >> 2) & 3) << 6) | (((lane >> 4) & 1) << 5) | (((lane >> 5) & 1) << 8); }
constexpr int v_rd_off(int d0, int ks, int half) { return d0 * 512 + ks * 4096 + half * 2048; }
template <int OFF> __device__ __forceinline__ s16x4 tr_read(int vb) {
    s16x4 r; asm volatile("ds_read_b64_tr_b16 %0, %1 offset:%2" : "=&v"(r) : "v"(vb), "i"(OFF) : "memory"); return r;
}
__device__ __forceinline__ s16x4 tr_read_dyn(unsigned addr) { s16x4 r; asm volatile("ds_read_b64_tr_b16 %0, %1" : "=&v"(r) : "v"(addr) : "memory"); return r; }
template <int D0> __device__ __forceinline__ void pv_one(f32x16& od, int vb, bf16x8 pa0, bf16x8 pa1, bf16x8 pa2, bf16x8 pa3) {
    const s16x4 l0 = tr_read<v_rd_off(D0, 0, 0)>(vb), h0 = tr_read<v_rd_off(D0, 0, 1)>(vb), l1 = tr_read<v_rd_off(D0, 1, 0)>(vb), h1 = tr_read<v_rd_off(D0, 1, 1)>(vb);
    const s16x4 l2 = tr_read<v_rd_off(D0, 2, 0)>(vb), h2 = tr_read<v_rd_off(D0, 2, 1)>(vb), l3 = tr_read<v_rd_off(D0, 3, 0)>(vb), h3 = tr_read<v_rd_off(D0, 3, 1)>(vb);
    asm volatile("s_waitcnt lgkmcnt(0)" ::: "memory"); SBAR();
#define PKV(L, H) (bf16x8){L[0], L[1], L[2], L[3], H[0], H[1], H[2], H[3]}
    od = __builtin_amdgcn_mfma_f32_32x32x16_bf16(pa0, PKV(l0, h0), od, 0, 0, 0);
    od = __builtin_amdgcn_mfma_f32_32x32x16_bf16(pa1, PKV(l1, h1), od, 0, 0, 0);
    od = __builtin_amdgcn_mfma_f32_32x32x16_bf16(pa2, PKV(l2, h2), od, 0, 0, 0);
    od = __builtin_amdgcn_mfma_f32_32x32x16_bf16(pa3, PKV(l3, h3), od, 0, 0, 0);
}
template <int D0> __device__ __forceinline__ void pv_one_lo(f32x16& od, int vb, bf16x8 pa0, bf16x8 pa1) {
    const s16x4 l0 = tr_read<v_rd_off(D0, 0, 0)>(vb), h0 = tr_read<v_rd_off(D0, 0, 1)>(vb), l1 = tr_read<v_rd_off(D0, 1, 0)>(vb), h1 = tr_read<v_rd_off(D0, 1, 1)>(vb);
    asm volatile("s_waitcnt lgkmcnt(0)" ::: "memory"); SBAR();
    od = __builtin_amdgcn_mfma_f32_32x32x16_bf16(pa0, PKV(l0, h0), od, 0, 0, 0);
    od = __builtin_amdgcn_mfma_f32_32x32x16_bf16(pa1, PKV(l1, h1), od, 0, 0, 0);
}
__device__ __forceinline__ void pv_all(f32x16* o, int vb, bf16x8 pa0, bf16x8 pa1, bf16x8 pa2, bf16x8 pa3) {
    pv_one<0>(o[0], vb, pa0, pa1, pa2, pa3); pv_one<1>(o[1], vb, pa0, pa1, pa2, pa3); pv_one<2>(o[2], vb, pa0, pa1, pa2, pa3); pv_one<3>(o[3], vb, pa0, pa1, pa2, pa3);
}
#define PK4(P, BASE, OUT) do { unsigned a0_ = cvt_pk_bf16(P[BASE + 0], P[BASE + 1]), a1_ = cvt_pk_bf16(P[BASE + 2], P[BASE + 3]);   \
    unsigned b0_ = cvt_pk_bf16(P[BASE + 4], P[BASE + 5]), b1_ = cvt_pk_bf16(P[BASE + 6], P[BASE + 7]);                              \
    auto r0_ = __builtin_amdgcn_permlane32_swap(a0_, b0_, false, false); auto r1_ = __builtin_amdgcn_permlane32_swap(a1_, b1_, false, false); \
    v4u w_ = {r0_[0], r1_[0], r0_[1], r1_[1]}; OUT = *reinterpret_cast<bf16x8*>(&w_); } while (0)
__device__ __forceinline__ float pair_sum(float v) { auto rr = __builtin_amdgcn_permlane32_swap(__float_as_uint(v), __float_as_uint(v), false, false); return __uint_as_float(rr[0]) + __uint_as_float(rr[1]); }
__device__ __forceinline__ float pair_max(float v) { auto rr = __builtin_amdgcn_permlane32_swap(__float_as_uint(v), __float_as_uint(v), false, false); return fmaxf(__uint_as_float(rr[0]), __uint_as_float(rr[1])); }
__device__ __forceinline__ unsigned off_b(unsigned row, unsigned ch) { return 256u * row + 16u * (ch ^ (((row & 3) << 2) | ((row >> 2) & 3))); }
__device__ __forceinline__ unsigned trb_addr(unsigned lane, unsigned c, unsigned ks, unsigned t) {
    const unsigned h = lane >> 5, blk = (lane >> 4) & 1, q = (lane & 15) >> 2, p = lane & 3;
    return off_b(16 * ks + 8 * h + 4 * t + q, 4 * c + 2 * blk + (p >> 1)) + 8 * (p & 1);
}

constexpr int ML_TAB_OFF = LDSCTL_OFF + 2048;
struct MTabs { LAS float* sum; LAS float* g; LAS float* b; LAS float* pm; LAS float* mprev; LAS float* mend; };
__device__ __forceinline__ MTabs mtabs(const Frame& F) { MTabs T; T.sum = (LAS float*)(F.lds + ML_TAB_OFF); T.g = T.sum + 64; T.b = T.g + 256; T.pm = T.b + 256; T.mprev = T.pm + 256; T.mend = T.mprev + 4; return T; }
__device__ __forceinline__ float* gif_ptr(const Frame& F) { return (float*)(F.ws + WS_MSN + 512 * 1024); }
__device__ __forceinline__ void mchain(const Frame& F, int l, int bh, int cr, const MTabs& T) {
    const int b = bh >> 3, h = bh & 7, lane = F.lane, nchunk = 4 * cr + 4;
    const float bi = arg_in(4)[l * NH + h], bfv = arg_in(5)[l * NH + h];
    const float* gif = gif_ptr(F);
    __syncthreads();
    for (int j = F.wave; j < nchunk; j += NWAVES) {
        const size_t row = (size_t)b * SEQ + 64 * j + lane;
        const float it = gif[row * 16 + h] + bi, lf = logsigmoidf_(gif[row * 16 + 8 + h] + bfv);
        float bc = lf;
#pragma unroll
        for (int o = 1; o < 64; o <<= 1) { const float t = __shfl_up(bc, o); bc += (lane >= o) ? t : 0.f; }
        const float g = it - bc; float pm = g;
#pragma unroll
        for (int o = 1; o < 64; o <<= 1) { const float t = __shfl_up(pm, o); pm = (lane >= o) ? fmaxf(pm, t) : pm; }
        if (lane == 63) { T.sum[2 * j] = bc; T.sum[2 * j + 1] = pm; }
        if (j >= 4 * cr) { const int ci = j - 4 * cr; T.g[ci * 64 + lane] = g; T.b[ci * 64 + lane] = bc; T.pm[ci * 64 + lane] = pm; }
    }
    __syncthreads();
    if (F.tid == 0) { float m = 0.f;
        for (int j = 0; j < nchunk; ++j) { const float me = fmaxf(m, T.sum[2 * j + 1]);
            if (j >= 4 * cr) { T.mprev[j - 4 * cr] = m; T.mend[j - 4 * cr] = me; }
            m = T.sum[2 * j] + me; } }
    __syncthreads();
}
__device__ __forceinline__ void conv8(const bf16* P, const float* cw, size_t row, int t, int col0, int ch0, float sc, float (&o)[8]) {
#pragma unroll
    for (int e = 0; e < 8; ++e) o[e] = 0.f;
#pragma unroll
    for (int j = 0; j < 4; ++j) { const int tt = t - 3 + j;
        if (tt >= 0) { const v4u x = *(const v4u*)(P + (row - 3 + j) * PW + col0); const f32x4 w0 = *(const f32x4*)(cw + j * 2048 + ch0), w1 = *(const f32x4*)(cw + j * 2048 + ch0 + 4);
            o[0] += w0.x * bflo(x.x); o[1] += w0.y * bfhi(x.x); o[2] += w0.z * bflo(x.y); o[3] += w0.w * bfhi(x.y);
            o[4] += w1.x * bflo(x.z); o[5] += w1.y * bfhi(x.z); o[6] += w1.z * bflo(x.w); o[7] += w1.w * bfhi(x.w); } }
#pragma unroll
    for (int e = 0; e < 8; ++e) o[e] = siluf_(o[e]) * sc;
}
__device__ __forceinline__ void ml_delta(const Frame& F, int l) {
    const bf16* P = (const bf16*)(F.ws + WS_PROJ); const float* cw = arg_in(3) + (size_t)l * 4 * 2048;
    float* DEL = (float*)(F.ws + WS_MDEL); float* DN = (float*)(F.ws + WS_MDN); float* DEC = DN + 32 * 32 * 128;
    const int wave = F.wave;
    const MTabs T = mtabs(F);
    for (int blk = F.vcu; blk < 256; blk += F.G) {
        int tid = F.tid; asm volatile("" : "+v"(tid));
        const int lane = tid & 63;
        const int bh = blk >> 3, cr = blk & 7, b = bh >> 3, h = bh & 7;
        mchain(F, l, bh, cr, T);
#pragma unroll 1
        for (int it = tid; it < 4 * 64 * 16; it += NTHR) { const int ci = it >> 10, s = (it >> 4) & 63, ch = it & 15, t = 64 * (4 * cr + ci) + s; const size_t row = (size_t)b * SEQ + t;
            float kv[8]; conv8(P, cw, row, t, C_MK + h * HD + 8 * ch, 1024 + h * HD + 8 * ch, 1.f, kv);
            v4u o; o.x = pk2(kv[0], kv[1]); o.y = pk2(kv[2], kv[3]); o.z = pk2(kv[4], kv[5]); o.w = pk2(kv[6], kv[7]);
            *(LAS v4u*)(F.lds + ci * 32768 + off_b(s, ch)) = o;
            const float ws = __expf(T.g[ci * 64 + s] - T.mend[ci]);
            const v4u x = *(const v4u*)(P + row * PW + C_MV + h * HD + 8 * ch);
            o.x = pk2(ws * bflo(x.x), ws * bfhi(x.x)); o.y = pk2(ws * bflo(x.y), ws * bfhi(x.y)); o.z = pk2(ws * bflo(x.z), ws * bfhi(x.z)); o.w = pk2(ws * bflo(x.w), ws * bfhi(x.w));
            *(LAS v4u*)(F.lds + ci * 32768 + 16384 + off_b(s, ch)) = o; }
        __syncthreads();
        const int vb = wave >> 1, kh = wave & 1, r32 = lane & 31, hi = lane >> 5;
        const unsigned ldsb = (unsigned)(size_t)F.lds;
#pragma unroll 1
        for (int ci = 0; ci < 4; ++ci) { const int c = 4 * cr + ci; if (c == NCH - 1) break;
            f32x16 a0 = {}, a1 = {};
#pragma unroll
            for (int ks = 0; ks < 4; ++ks) {
                const s16x4 al = tr_read_dyn(ldsb + ci * 32768 + 16384 + trb_addr(lane, vb, ks, 0)), ah = tr_read_dyn(ldsb + ci * 32768 + 16384 + trb_addr(lane, vb, ks, 1));
                const s16x4 bl0 = tr_read_dyn(ldsb + ci * 32768 + trb_addr(lane, 2 * kh, ks, 0)), bh0 = tr_read_dyn(ldsb + ci * 32768 + trb_addr(lane, 2 * kh, ks, 1));
                const s16x4 bl1 = tr_read_dyn(ldsb + ci * 32768 + trb_addr(lane, 2 * kh + 1, ks, 0)), bh1 = tr_read_dyn(ldsb + ci * 32768 + trb_addr(lane, 2 * kh + 1, ks, 1));
                asm volatile("s_waitcnt lgkmcnt(0)" ::: "memory"); SBAR();
                a0 = __builtin_amdgcn_mfma_f32_32x32x16_bf16(PKV(al, ah), PKV(bl0, bh0), a0, 0, 0, 0);
                a1 = __builtin_amdgcn_mfma_f32_32x32x16_bf16(PKV(al, ah), PKV(bl1, bh1), a1, 0, 0, 0); }
            float* dp = DEL + ((size_t)(bh * 32 + c) * 128) * 128;
#pragma unroll
            for (int r = 0; r < 16; ++r) { const int v = 32 * vb + crow(r, hi); dp[(size_t)v * 128 + 64 * kh + r32] = a0[r]; dp[(size_t)v * 128 + 64 * kh + 32 + r32] = a1[r]; }
        }
        { const int ci = tid >> 7, k = tid & 127, c = 4 * cr + ci;
          if (c < NCH - 1) { float a = 0.f; const float me = T.mend[ci];
              for (int s = 0; s < 64; ++s) a += __expf(T.g[ci * 64 + s] - me) * bf2f(*(const LAS unsigned short*)(F.lds + ci * 32768 + off_b(s, k >> 3) + 2 * (k & 7)));
              DN[(size_t)(bh * 32 + c) * 128 + k] = a;
              if (k == 0) DEC[bh * 32 + c] = __expf(T.mprev[ci] - me); } }
        __syncthreads();
    }
}
__device__ __forceinline__ void ml_scan(const Frame& F) {
    const float* DEL = (const float*)(F.ws + WS_MDEL); const float* DN = (const float*)(F.ws + WS_MDN); const float* DEC = DN + 32 * 32 * 128;
    bf16* ST = (bf16*)(F.ws + WS_MST); float* SN = (float*)(F.ws + WS_MSN);
    const int gt = F.vcu * NTHR + F.tid, NT = F.G * NTHR;
    for (int e4 = gt; e4 < 32 * 4096; e4 += NT) { const int bh = e4 >> 12, q = e4 & 4095;
        f32x4 acc = {0.f, 0.f, 0.f, 0.f};
#pragma unroll 4
        for (int c = 0; c < NCH - 1; ++c) { const float d = DEC[bh * 32 + c]; const f32x4 x = *(const f32x4*)(DEL + ((size_t)(bh * 32 + c) * 4096 + q) * 4);
            acc = acc * d + x; v2u o; o.x = pk2(acc.x, acc.y); o.y = pk2(acc.z, acc.w); *(v2u*)(ST + ((size_t)(bh * 32 + c + 1) * 4096 + q) * 4) = o; } }
    for (int e = gt; e < 32 * 128; e += NT) { const int bh = e >> 7, k = e & 127; float acc = 0.f;
        for (int c = 0; c < NCH - 1; ++c) { acc = acc * DEC[bh * 32 + c] + DN[(size_t)(bh * 32 + c) * 128 + k]; SN[(size_t)(bh * 32 + c + 1) * 128 + k] = acc; } }
}
__device__ __forceinline__ void ml_out(const Frame& F, int l) {
    const bf16* P = (const bf16*)(F.ws + WS_PROJ); const float* cw = arg_in(3) + (size_t)l * 4 * 2048; bf16* BR = (bf16*)(F.ws + WS_BR);
    const bf16* ST = (const bf16*)(F.ws + WS_MST); const float* SN = (const float*)(F.ws + WS_MSN); const float* gain = arg_in(6) + (size_t)l * BW;
    const int wave = F.wave;
    const MTabs T = mtabs(F);
    LAS float* rowL = (LAS float*)(F.lds + ML_TAB_OFF + 4096) + wave * 32;
    for (int blk = F.vcu; blk < 256; blk += F.G) {
        int tid = F.tid; asm volatile("" : "+v"(tid));
        const int lane = tid & 63, r32 = lane & 31, hi = lane >> 5;
        const int bh = blk >> 3, cr = blk & 7, b = bh >> 3, h = bh & 7;
        mchain(F, l, bh, cr, T);
#pragma unroll 1
        for (int it = tid; it < 4 * 64 * 16; it += NTHR) { const int ci = it >> 10, s = (it >> 4) & 63, ch = it & 15, t = 64 * (4 * cr + ci) + s; const size_t row = (size_t)b * SEQ + t;
            float kv[8]; conv8(P, cw, row, t, C_MK + h * HD + 8 * ch, 1024 + h * HD + 8 * ch, 1.f, kv);
            v4u o; o.x = pk2(kv[0], kv[1]); o.y = pk2(kv[2], kv[3]); o.z = pk2(kv[4], kv[5]); o.w = pk2(kv[6], kv[7]);
            *(LAS v4u*)(F.lds + ci * 32768 + KSWZ(s, ch * 16)) = o;
            *(LAS v4u*)(F.lds + ci * 32768 + 16384 + v_st(s, ch * 8)) = *(const v4u*)(P + row * PW + C_MV + h * HD + 8 * ch); }
        __syncthreads();
        const int ci = wave >> 1, rh = wave & 1, c = 4 * cr + ci, tau = 32 * rh + r32, t = 64 * c + tau; const size_t row = (size_t)b * SEQ + t;
        bf16x8 qr[8];
#pragma unroll
        for (int d0 = 0; d0 < 8; ++d0) { float qv[8]; conv8(P, cw, row, t, C_MQ + h * HD + 16 * d0 + 8 * hi, h * HD + 16 * d0 + 8 * hi, 0.08838834764831845f, qv);
            v4u o; o.x = pk2(qv[0], qv[1]); o.y = pk2(qv[2], qv[3]); o.z = pk2(qv[4], qv[5]); o.w = pk2(qv[6], qv[7]); qr[d0] = *reinterpret_cast<bf16x8*>(&o); asm volatile("" ::: "memory"); }
        const float mprev = T.mprev[ci], Mt = fmaxf(mprev, T.pm[ci * 64 + tau]), winter = __expf(mprev - Mt), flo = __expf(-T.b[ci * 64 + tau] - Mt);
        const LAS char* Kc = (const LAS char*)(F.lds + ci * 32768);
        const int vbase = (int)(size_t)(F.lds + ci * 32768 + 16384) + v_rd_base(lane);
        f32x16 o[4] = {}; f32x16 p0, p1; float ps = 0.f; bf16x8 pa0, pa1, pa2, pa3;
        const LAS f32x4* g4 = (const LAS f32x4*)(T.g + ci * 64);
        if (rh == 0) { qkt32(p0, Kc, qr, r32, hi);
#pragma unroll
            for (int q = 0; q < 4; ++q) { const f32x4 gg = g4[2 * q + hi];
#pragma unroll
                for (int e = 0; e < 4; ++e) { const int r = 4 * q + e, s = crow(r, hi); const float wgt = (s <= tau) ? __expf(gg[e] - Mt) : 0.f; p0[r] *= wgt; ps += p0[r]; } }
            PK4(p0, 0, pa0); PK4(p0, 8, pa1);
            pv_one_lo<0>(o[0], vbase, pa0, pa1); pv_one_lo<1>(o[1], vbase, pa0, pa1); pv_one_lo<2>(o[2], vbase, pa0, pa1); pv_one_lo<3>(o[3], vbase, pa0, pa1);
        } else { qkt64(p0, p1, Kc, qr, r32, hi);
#pragma unroll
            for (int q = 0; q < 4; ++q) { const f32x4 gg = g4[2 * q + hi], gh = g4[8 + 2 * q + hi];
#pragma unroll
                for (int e = 0; e < 4; ++e) { const int r = 4 * q + e, s = crow(r, hi); p0[r] *= __expf(gg[e] - Mt); ps += p0[r];
                    const float wgt = (32 + s <= tau) ? __expf(gh[e] - Mt) : 0.f; p1[r] *= wgt; ps += p1[r]; } }
            PK4(p0, 0, pa0); PK4(p0, 8, pa1); PK4(p1, 0, pa2); PK4(p1, 8, pa3);
            pv_all(o, vbase, pa0, pa1, pa2, pa3);
        }
        ps = pair_sum(ps);
        float nq = 0.f;
        if (c > 0) {
            const bf16* Sc = ST + (size_t)(bh * 32 + c) * 16384; const float* nc = SN + (size_t)(bh * 32 + c) * 128;
#pragma unroll
            for (int ks = 0; ks < 8; ++ks) { const v4u qq = *reinterpret_cast<const v4u*>(&qr[ks]);
                const f32x4 n0 = *(const f32x4*)(nc + 16 * ks + 8 * hi), n1 = *(const f32x4*)(nc + 16 * ks + 8 * hi + 4);
                nq += bflo(qq.x) * n0.x + bfhi(qq.x) * n0.y + bflo(qq.y) * n0.z + bfhi(qq.y) * n0.w + bflo(qq.z) * n1.x + bfhi(qq.z) * n1.y + bflo(qq.w) * n1.z + bfhi(qq.w) * n1.w;
                v4u sq; sq.x = pk2(bflo(qq.x) * winter, bfhi(qq.x) * winter); sq.y = pk2(bflo(qq.y) * winter, bfhi(qq.y) * winter); sq.z = pk2(bflo(qq.z) * winter, bfhi(qq.z) * winter); sq.w = pk2(bflo(qq.w) * winter, bfhi(qq.w) * winter);
                const bf16x8 qs = *reinterpret_cast<const bf16x8*>(&sq);
#pragma unroll
                for (int d0 = 0; d0 < 4; ++d0) { const bf16x8 cf = *(const bf16x8*)(Sc + (size_t)(32 * d0 + r32) * 128 + 16 * ks + 8 * hi);
                    o[d0] = __builtin_amdgcn_mfma_f32_32x32x16_bf16(qs, cf, o[d0], 0, 0, 0); }
                asm volatile("" ::: "memory"); }
            nq = pair_sum(nq);
        }
        const float den = winter * nq + ps, rinv = 1.0f / fmaxf(fabsf(den), flo);
        if (hi == 0) rowL[r32] = rinv;
        LDS_WAIT(); asm volatile("" ::: "memory");
        float ss[16];
#pragma unroll
        for (int r = 0; r < 16; ++r) { const float ri = rowL[crow(r, hi)]; float a = 0.f;
#pragma unroll
            for (int d0 = 0; d0 < 4; ++d0) { o[d0][r] *= ri; a += o[d0][r] * o[d0][r]; }
            ss[r] = a; }
#pragma unroll
        for (int r = 0; r < 16; ++r) {
#pragma unroll
            for (int of = 1; of < 32; of <<= 1) ss[r] += __shfl_xor(ss[r], of);
            ss[r] = 1.0f / sqrtf(ss[r] * (1.f / HD) + EPS); }
        const size_t row0 = (size_t)b * SEQ + 64 * c + 32 * rh;
#pragma unroll
        for (int d0 = 0; d0 < 4; ++d0) { const int col = h * HD + 32 * d0 + r32; const float gn = gain[col];
#pragma unroll
            for (int r = 0; r < 16; ++r) { const size_t rr = row0 + crow(r, hi);
                const float og = sigmoidf_(bf2f(P[rr * PW + C_MO + col]));
                BR[rr * 3072 + col] = (bf16)f2bf(o[d0][r] * ss[r] * gn * og); }
            asm volatile("" ::: "memory"); }
        __syncthreads();
    }
}
template <int LDA, int LDB> struct SchedDense {
    static constexpr bool GATHER = false;
    pg8::TileOrder T; const char* A; const char* B;
    __device__ __forceinline__ bool next(int i, pg8::Unit& u) const { u.e = 0; u.rows = 256; return T.tile(i, u.pm, u.pn); }
    __device__ __forceinline__ const char* a_base(const pg8::Unit& u) const { return A + (size_t)u.pm * 256 * LDA * 2; }
    __device__ __forceinline__ const char* b_base(const pg8::Unit& u) const { return B + (size_t)u.pn * 256 * LDB * 2; }
    __device__ __forceinline__ void a_off(const pg8::Unit&, int tid, unsigned (&v0)[2], unsigned (&v1)[2]) const {
        int R[2], C[2];
#pragma unroll
        for (int i = 0; i < 2; ++i) pg8::stage_rc(tid * 16 + i * 8192, R[i], C[i]);
#pragma unroll
        for (int i = 0; i < 2; ++i) { v0[i] = (unsigned)(R[i] * LDA + C[i]) * 2u; v1[i] = v0[i] + 128u * LDA * 2u; } }
};
struct EpiProj {
    static constexpr bool PERM = true;
    bf16* O; float* GIF;
    __device__ __forceinline__ void operator()(const f32x4 (&acc)[2][2][4][2], const pg8::Unit& u, int wr, int wc, int fr, int fq) const {
        const int row0 = u.pm * 256 + wr * 64 + fr, col0 = u.pn * 256 + wc * 32 + 8 * fq;
#pragma unroll
        for (int ai = 0; ai < 2; ++ai)
#pragma unroll
            for (int m = 0; m < 4; ++m) { bf16* rowp = O + (size_t)(row0 + ai * 128 + m * 16) * PW + col0;
#pragma unroll
                for (int bj = 0; bj < 2; ++bj) { const f32x4 v0 = acc[ai][bj][m][0], v1 = acc[ai][bj][m][1];
                    v4u w; w.x = cvt_pk_bf16(v0[0], v0[1]); w.y = cvt_pk_bf16(v0[2], v0[3]); w.z = cvt_pk_bf16(v1[0], v1[1]); w.w = cvt_pk_bf16(v1[2], v1[3]);
                    *(v4u*)(rowp + bj * 128) = w;
                    if (u.pn == PW / 256 - 1 && bj == 0 && wc == 0 && fq < 2) { float* gp = GIF + (size_t)(row0 + ai * 128 + m * 16) * 16 + 8 * fq; *(f32x4*)gp = v0; *(f32x4*)(gp + 4) = v1; } } }
    }
};
struct SchedBranch {
    static constexpr bool GATHER = false;
    pg8::TileOrder T; const char* A; const char* B;
    __device__ __forceinline__ bool next(int i, pg8::Unit& u) const { u.e = i % 3; u.rows = 256; return T.tile(i / 3, u.pm, u.pn); }
    __device__ __forceinline__ const char* a_base(const pg8::Unit& u) const { return A + ((size_t)u.pm * 256 * 3072 + (size_t)u.e * 1024) * 2; }
    __device__ __forceinline__ const char* b_base(const pg8::Unit& u) const { return B + ((size_t)u.e * 2048 + (size_t)u.pn * 256) * 1024 * 2; }
    __device__ __forceinline__ void a_off(const pg8::Unit&, int tid, unsigned (&v0)[2], unsigned (&v1)[2]) const {
        int R[2], C[2];
#pragma unroll
        for (int i = 0; i < 2; ++i) pg8::stage_rc(tid * 16 + i * 8192, R[i], C[i]);
#pragma unroll
        for (int i = 0; i < 2; ++i) { v0[i] = (unsigned)(R[i] * 3072 + C[i]) * 2u; v1[i] = v0[i] + 128u * 3072u * 2u; } }
};
struct EpiBranch {
    static constexpr bool PERM = true;
    const bf16* P; float* scr; bf16* O;
    __device__ __forceinline__ void operator()(const f32x4 (&acc)[2][2][4][2], const pg8::Unit& u, int wr, int wc, int fr, int fq) const {
        const int row0 = u.pm * 256 + wr * 64 + fr, col0 = u.pn * 256 + wc * 32 + 8 * fq;
#pragma unroll
        for (int ai = 0; ai < 2; ++ai)
#pragma unroll
            for (int m = 0; m < 4; ++m) { const size_t row = (size_t)(row0 + ai * 128 + m * 16);
#pragma unroll
                for (int bj = 0; bj < 2; ++bj) { const int col = col0 + bj * 128;
                    const v4u gw = *(const v4u*)(P + row * PW + C_G + u.e * 2048 + col);
                    f32x4 v0 = acc[ai][bj][m][0], v1 = acc[ai][bj][m][1];
                    v0[0] *= sigmoidf_(bflo(gw.x)); v0[1] *= sigmoidf_(bfhi(gw.x)); v0[2] *= sigmoidf_(bflo(gw.y)); v0[3] *= sigmoidf_(bfhi(gw.y));
                    v1[0] *= sigmoidf_(bflo(gw.z)); v1[1] *= sigmoidf_(bfhi(gw.z)); v1[2] *= sigmoidf_(bflo(gw.w)); v1[3] *= sigmoidf_(bfhi(gw.w));
                    float* sp = scr + row * DM + col;
                    if (u.e > 0) { v0 += *(const f32x4*)sp; v1 += *(const f32x4*)(sp + 4); }
                    if (u.e < 2) { *(f32x4*)sp = v0; *(f32x4*)(sp + 4) = v1; }
                    else { v4u w; w.x = cvt_pk_bf16(v0[0], v0[1]); w.y = cvt_pk_bf16(v0[2], v0[3]); w.z = cvt_pk_bf16(v1[0], v1[1]); w.w = cvt_pk_bf16(v1[2], v1[3]);
                        *(v4u*)(O + row * DM + col) = w; } } }
    }
};
struct EpiOut {
    static constexpr bool PERM = false;
    const float* base; float* out;
    __device__ __forceinline__ void operator()(const f32x4 (&acc)[2][2][4][2], const pg8::Unit& u, int wr, int wc, int fr, int fq) const {
        const int row0 = u.pm * 256 + wr * 64 + fr, col0 = u.pn * 256 + wc * 32 + 4 * fq;
#pragma unroll
        for (int ai = 0; ai < 2; ++ai)
#pragma unroll
            for (int m = 0; m < 4; ++m) { const size_t off = (size_t)(row0 + ai * 128 + m * 16) * DM + col0;
#pragma unroll
                for (int bj = 0; bj < 2; ++bj)
#pragma unroll
                    for (int n = 0; n < 2; ++n) { const f32x4 bs = *(const f32x4*)(base + off + bj * 128 + n * 16); *(f32x4*)(out + off + bj * 128 + n * 16) = bs + acc[ai][bj][m][n]; } }
    }
};

#ifndef MK_NAIVE_MOE
#define MK_NAIVE_MOE 0
#endif
#ifndef OFFMASK
#define OFFMASK 0
#endif
constexpr int PH_CONVW = 0, PH_NORM1 = 1, PH_INPROJ = 2, PH_NVCONV = 3, PH_NVMLSTM = 4, PH_NVMNORM = 5, PH_NVIDX = 6, PH_NVDSA = 7, PH_NVSB = 8,
              PH_BRANCH = 9, PH_OUT = 10, PH_NORM2 = 11, PH_MOE = 12, PH_MOED = 13, NPH_L = 14, PH_FINAL = DEPTH * NPH_L, NPH = PH_FINAL + 1;

__global__ void __launch_bounds__(NTHR, 2) fwd_kernel(Args args) {
    extern __shared__ __attribute__((aligned(16))) unsigned char lds_raw[];
    Frame F;
    F.lds = (LAS unsigned char*)lds_raw;
    F.tid = threadIdx.x; F.lane = F.tid & 63; F.wave = __builtin_amdgcn_readfirstlane(F.tid >> 6);
    F.G = gridDim.x; { const int bx = blockIdx.x; F.vcu = (F.G % 8 == 0) ? (bx % 8) * (F.G / 8) + bx / 8 : bx; }
    F.ws = args.ws; F.ctl = (unsigned*)(args.ws + WS_CTL);
    volatile LAS unsigned* MISC = (volatile LAS unsigned*)(F.lds + LDSCTL_OFF);
    for (int u = F.tid; u < (LDS_BYTES - LDSCTL_OFF) / 4; u += NTHR) ((LAS unsigned*)(F.lds + LDSCTL_OFF))[u] = 0u;
    __syncthreads();
    XcdBarrier bar; bar.bar = F.ctl + CW_BAR; bar.x = 0; bar.st = nullptr;
    if (args.use_bar) bar = xcd_barrier_post(F.ctl + CW_BAR, MISC + 8);
    const int lo = args.ph_lo, hi = args.ph_hi;
#define IN(k) (lo <= (k) && (k) < hi)
#define FRESH() do { int t_ = threadIdx.x; asm volatile("" : "+v"(t_)); F.tid = t_; F.lane = t_ & 63; F.wave = __builtin_amdgcn_readfirstlane(t_ >> 6); F.ws = arg_ws(); F.ctl = (unsigned*)(F.ws + WS_CTL); } while (0)
#define SEAM(k) do { if (args.use_bar && IN((k) + 1)) xcd_barrier(bar); } while (0)
    for (int l = 0; l < DEPTH; ++l) {
        const int p0 = l * NPH_L;
        if (IN(p0 + PH_CONVW)) { FRESH(); if (!(OFFMASK & (1<<0))) ph_convw(F, l); SEAM(p0 + PH_CONVW); }
        if (IN(p0 + PH_NORM1)) { FRESH(); if (!(OFFMASK & (1<<1))) ph_norm1(F, l); SEAM(p0 + PH_NORM1); }
        if (IN(p0 + PH_INPROJ)) {
            SchedDense<DM, DM> S; S.T.init(NTOK / 256, PW / 256, F.G, (int)blockIdx.x); S.A = (const char*)(F.ws + WS_XN); S.B = (const char*)(F.ws + WS_WIN);
            EpiProj E{(bf16*)(F.ws + WS_PROJ), gif_ptr(F)};
            if (!(OFFMASK & (1<<10))) pg8::gemm_phase<SchedDense<DM, DM>, EpiProj, DM, DM, DM, true>(F.lds, S, E);
            SEAM(p0 + PH_INPROJ);
        }
        if (IN(p0 + PH_NVCONV)) { FRESH(); if (!(OFFMASK & (1<<2))) ml_delta(F, l); SEAM(p0 + PH_NVCONV); }
        if (IN(p0 + PH_NVMLSTM)) { FRESH(); if (!(OFFMASK & (1<<3))) ml_scan(F); SEAM(p0 + PH_NVMLSTM); }
        if (IN(p0 + PH_NVMNORM)) { FRESH(); if (!(OFFMASK & (1<<4))) ml_out(F, l); SEAM(p0 + PH_NVMNORM); }
        if (IN(p0 + PH_NVIDX)) { FRESH(); if (!(OFFMASK & (1<<5))) nv_index(F); SEAM(p0 + PH_NVIDX); }
        if (IN(p0 + PH_NVDSA)) { FRESH(); if (!(OFFMASK & (1<<6))) nv_dsa(F, l); SEAM(p0 + PH_NVDSA); }
        if (IN(p0 + PH_NVSB)) { FRESH(); if (!(OFFMASK & (1<<7))) nv_sb(F); SEAM(p0 + PH_NVSB); }
        if (IN(p0 + PH_BRANCH)) {
            SchedBranch S; S.T.init(NTOK / 256, DM / 256, F.G, (int)blockIdx.x); S.A = (const char*)(F.ws + WS_BR); S.B = (const char*)(F.ws + WS_WBR);
            EpiBranch E{(const bf16*)(F.ws + WS_PROJ), (float*)(F.ws + WS_X1), (bf16*)(F.ws + WS_MRG)};
            if (!(OFFMASK & (1<<11))) pg8::gemm_phase<SchedBranch, EpiBranch, BW, 3072, BW, true>(F.lds, S, E);
            SEAM(p0 + PH_BRANCH);
        }
        if (IN(p0 + PH_OUT)) {
            SchedDense<DM, DM> S; S.T.init(NTOK / 256, DM / 256, F.G, (int)blockIdx.x); S.A = (const char*)(F.ws + WS_MRG); S.B = (const char*)(F.ws + WS_WOUT);
            EpiOut E{l == 0 ? arg_in(0) : (const float*)(F.ws + WS_XA), (float*)(F.ws + WS_X1)};
            if (!(OFFMASK & (1<<12))) pg8::gemm_phase<SchedDense<DM, DM>, EpiOut, DM, DM, DM, true>(F.lds, S, E);
            SEAM(p0 + PH_OUT);
        }
        if (IN(p0 + PH_NORM2)) { FRESH(); if (!(OFFMASK & (1<<8))) ph_norm2(F, l); SEAM(p0 + PH_NORM2); }
        if (IN(p0 + PH_MOE)) { FRESH();
#if MK_NAIVE_MOE
            nv_moe(F);
#else
            moe_tables(F, l);
            SchedMoeUp S; S.tp = (const LAS int*)(F.lds + MOE_TAB_OFF); S.cn = S.tp + 40; S.sb = S.cn + 40; S.G = F.G; S.c = (int)blockIdx.x;
            S.A = (const char*)(F.ws + WS_XN); S.B = (const char*)(F.ws + WS_WGU); S.list = (const int*)(F.ws + WS_LIST);
            EpiMoeUp E{(bf16*)(F.ws + WS_HB), S.sb};
            if (!(OFFMASK & (1<<13))) pg8::gemm_phase<SchedMoeUp, EpiMoeUp, DM, DM, DM, true>(F.lds, S, E);
#endif
            SEAM(p0 + PH_MOE); }
        if (IN(p0 + PH_MOED)) { FRESH();
#if !MK_NAIVE_MOE
            moe_tables(F, l);
            SchedMoeDown S; S.tp = (const LAS int*)(F.lds + MOE_TAB_OFF); S.cn = S.tp + 40; S.sb = S.cn + 40; S.G = F.G; S.c = (int)blockIdx.x;
            S.A = (const char*)(F.ws + WS_HB); S.B = (const char*)(F.ws + WS_WDN);
            EpiMoeDown E{(bf16*)(F.ws + WS_YB), (const int*)(F.ws + WS_LIST), (const int*)tokinfo_ptr(F)};
            if (!(OFFMASK & (1<<14))) pg8::gemm_phase<SchedMoeDown, EpiMoeDown, DEXP, DEXP, DEXP, true>(F.lds, S, E);
#endif
            SEAM(p0 + PH_MOED); }
    }
    if (IN(PH_FINAL)) { FRESH(); } if (IN(PH_FINAL)) ph_final(F, args.out);
#undef IN
#undef SEAM
}

#ifndef MK_ONE_LAUNCH
#define MK_ONE_LAUNCH 1
#endif
extern "C" void kernel_launch(void* const* d_in, const int* in_sizes, int n_in, void* d_out, int out_size, void* d_ws, size_t ws_size, hipStream_t stream) {
    static int grid = 0;
    if (grid == 0) {
        if (n_in != 20 || in_sizes[0] != NTOK * DM || out_size != NTOK * DM || ws_size < WS_END) { fprintf(stderr, "kernel_launch: shape mismatch (n_in %d, ws %zu < %zu?)\n", n_in, ws_size, (size_t)WS_END); grid = -1; return; }
        int dev = 0, cus = 0, per_cu = 0;
        if (hipGetDevice(&dev) != hipSuccess || hipDeviceGetAttribute(&cus, hipDeviceAttributeMultiprocessorCount, dev) != hipSuccess) { grid = -1; return; }
        if (hipFuncSetAttribute((const void*)fwd_kernel, hipFuncAttributeMaxDynamicSharedMemorySize, LDS_BYTES) != hipSuccess) { fprintf(stderr, "kernel_launch: hipFuncSetAttribute failed\n"); grid = -1; return; }
        if (hipOccupancyMaxActiveBlocksPerMultiprocessor(&per_cu, (const void*)fwd_kernel, NTHR, LDS_BYTES) != hipSuccess || per_cu < 1) fprintf(stderr, "kernel_launch: occupancy query says %d\n", per_cu);
        (void)hipGetLastError();
        grid = cus;
    }
    if (grid < 0) return;
    if (hipMemsetAsync((char*)d_ws + WS_CTL, 0, CTL_ZERO_BYTES, stream) != hipSuccess) return;
    Args a{};
    for (int i = 0; i < 20; ++i) a.in[i] = (const float*)d_in[i];
    a.out = (float*)d_out; a.ws = (unsigned char*)d_ws;
#if MK_ONE_LAUNCH
    a.ph_lo = 0; a.ph_hi = NPH; a.use_bar = 1; a.pad = 0;
    hipLaunchKernelGGL(fwd_kernel, dim3(grid), dim3(NTHR), LDS_BYTES, stream, a);
#else
    for (int ph = 0; ph < NPH; ++ph) { a.ph_lo = ph; a.ph_hi = ph + 1; a.use_bar = 0; a.pad = 0;
        hipLaunchKernelGGL(fwd_kernel, dim3(grid), dim3(NTHR), LDS_BYTES, stream, a); }
#endif
    const hipError_t le = hipPeekAtLastError();
    if (le != hipSuccess) fprintf(stderr, "kernel_launch: launch failed: %s\n", hipGetErrorName(le));
}
```

```cpp
#include <hip/hip_runtime.h>
#include <cstdio>
#include <cstdint>

constexpr int BATCH = 4, SEQ = 2048, DM = 2048, NTOK = BATCH * SEQ, NH = 8, HD = 128, BW = 1024, DEPTH = 2;
constexpr int NIN = 17504, PW = 17664;
constexpr int IDXH = 16, IDXD = 64, TOPK = 256, NEXP = 32, NGRP = 4, EPG = 8, DEXP = 512, MCH = 64, NCH = SEQ / MCH;
constexpr float EPS = 1e-6f;
constexpr int C_MQ = 0, C_MK = 1024, C_MV = 2048, C_MO = 3072, C_DQ = 4096, C_DK = 5120, C_DV = 6144, C_IQ = 7168, C_SQ = 8192, C_SK = 9216, C_SV = 10240,
              C_G = 11264, C_MI = 17408, C_MF = 17416, C_IK = 17424, C_IW = 17488;
__host__ __device__ __forceinline__ int src_col(int c) {
    if (c < 4096) return c;
    if (c < 8192) return c + 16;
    if (c < 17408) return c + 96;
    if (c < 17424) return 4096 + (c - 17408);
    if (c < 17488) return 8208 + (c - 17424);
    if (c < 17504) return 8272 + (c - 17488);
    return -1;
}

constexpr size_t MiB = 1u << 20;
constexpr size_t WS_CTL = 0, CTL_ZERO_BYTES = 1 * MiB;
constexpr size_t WS_WIN = 1 * MiB;
constexpr size_t WS_WBR = WS_WIN + 69 * MiB;
constexpr size_t WS_WOUT = WS_WBR + 12 * MiB;
constexpr size_t WS_WGU = WS_WOUT + 8 * MiB;
constexpr size_t WS_WDN = WS_WGU + 128 * MiB;
constexpr size_t WS_XN = WS_WDN + 64 * MiB;
constexpr size_t WS_XA = WS_XN + 32 * MiB;
constexpr size_t WS_X1 = WS_XA + 64 * MiB;
constexpr size_t WS_PROJ = WS_X1 + 64 * MiB;
constexpr size_t WS_BR = WS_PROJ + 276 * MiB;
constexpr size_t WS_MRG = WS_BR + 48 * MiB;
constexpr size_t WS_MASK = WS_MRG + 32 * MiB;
constexpr size_t WS_MDEL = WS_MASK + 2 * MiB;
constexpr size_t WS_MDN = WS_MDEL + 64 * MiB;
constexpr size_t WS_MST = WS_MDN + 1 * MiB;
constexpr size_t WS_MSN = WS_MST + 32 * MiB;
constexpr size_t WS_HB = WS_MSN + 1 * MiB;
constexpr size_t WS_YB = WS_HB + 16 * MiB;
constexpr size_t WS_LIST = WS_YB + 64 * MiB;
constexpr size_t WS_TMP = WS_LIST + 2 * MiB;
constexpr size_t WS_END = WS_TMP + 96 * MiB;
static_assert(WS_END <= 1100 * MiB, "workspace map");

constexpr int CW_BAR = 4096;
constexpr int CW_ECNT = 16384;

#define GAS __attribute__((address_space(1)))
#define LAS __attribute__((address_space(3)))
typedef unsigned short bf16;
typedef unsigned v4u __attribute__((ext_vector_type(4)));
typedef unsigned v2u __attribute__((ext_vector_type(2)));
typedef float f32x4 __attribute__((ext_vector_type(4)));
typedef float f32x2 __attribute__((ext_vector_type(2)));
typedef float f32x16 __attribute__((ext_vector_type(16)));
typedef short bf16x8 __attribute__((ext_vector_type(8)));
typedef short s16x4 __attribute__((ext_vector_type(4)));
#define RLX_AGENT __ATOMIC_RELAXED, __HIP_MEMORY_SCOPE_AGENT
#define LDS_WAIT() asm volatile("s_waitcnt lgkmcnt(0)" ::: "memory")
#define VM_WAIT() asm volatile("s_waitcnt vmcnt(0)" ::: "memory")
constexpr int NWAVES = 8, NTHR = 512;
constexpr int RING_BYTES = 131072, LDSCTL_OFF = RING_BYTES, LDS_BYTES = 147456;

__device__ __forceinline__ unsigned f2bf(float f) { unsigned u = __builtin_bit_cast(unsigned, f); return (u + 0x7fffu + ((u >> 16) & 1u)) >> 16; }
__device__ __forceinline__ unsigned pk2(float lo, float hi) { return f2bf(lo) | (f2bf(hi) << 16); }
__device__ __forceinline__ float bf2f(unsigned short b) { return __builtin_bit_cast(float, ((unsigned)b) << 16); }
__device__ __forceinline__ float bflo(unsigned w) { return __builtin_bit_cast(float, w << 16); }
__device__ __forceinline__ float bfhi(unsigned w) { return __builtin_bit_cast(float, w & 0xffff0000u); }
__device__ __forceinline__ unsigned cvt_pk_bf16(float lo, float hi) { unsigned r; asm volatile("v_cvt_pk_bf16_f32 %0, %1, %2" : "=v"(r) : "v"(lo), "v"(hi)); return r; }
__device__ __forceinline__ float wave_sum(float v) {
#pragma unroll
    for (int o = 1; o < 64; o <<= 1) v += __shfl_xor(v, o);
    return v;
}
__device__ __forceinline__ float wave_max(float v) {
#pragma unroll
    for (int o = 1; o < 64; o <<= 1) v = fmaxf(v, __shfl_xor(v, o));
    return v;
}
__device__ __forceinline__ float sigmoidf_(float x) { return 1.0f / (1.0f + __expf(-x)); }
__device__ __forceinline__ float siluf_(float x) { return x / (1.0f + __expf(-x)); }
__device__ __forceinline__ float logsigmoidf_(float x) { return fminf(x, 0.f) - log1pf(__expf(-fabsf(x))); }
__device__ __forceinline__ int t5_bucket(int n) {
    if (n < 16) return n;
    return 16 + (n >= 19) + (n >= 21) + (n >= 24) + (n >= 27) + (n >= 31) + (n >= 35) + (n >= 40) + (n >= 46) + (n >= 52) + (n >= 59) + (n >= 67) + (n >= 77) + (n >= 87) + (n >= 99) + (n >= 113);
}
namespace pg8 {
constexpr int BM = 256, BK = 64, HALF = 128, HTB = HALF * BK * 2, STAGE_BYTES = 8 * HTB, NXCD = 8, WGM = 8;
__host__ __device__ __forceinline__ int lds_byte(int r, int c) { const int st = (r >> 4) * 2 + (c >> 5), rr = r & 15, cc = c & 31, ob = rr * 64 + cc * 2; return st * 1024 + (ob ^ (((ob >> 9) & 1) << 5)); }
__host__ __device__ __forceinline__ void stage_rc(int b, int& R, int& C) { const int st = b / 1024, sb = b % 1024, swz = sb ^ (((sb >> 9) & 1) << 5); R = (st >> 1) * 16 + swz / 64; C = (st & 1) * 32 + (swz % 64) / 2; }
__host__ __device__ __forceinline__ int perm32(int rho) { const int n = rho >> 4, i = rho & 15; return 8 * (i >> 2) + 4 * n + (i & 3); }

struct Unit { int pm, pn, e, rows; };

struct TileOrder {
    int nM, nN, nwg, G, c;
    __device__ void init(int nM_, int nN_, int G_, int c_) { nM = nM_; nN = nN_; nwg = nM * nN; G = G_; c = c_; }
    __device__ bool tile(int i, int& pm, int& pn) const {
        const long L = (long)i * G + c; if (L >= nwg) return false;
        int wgid = (int)L; { const int q = nwg / NXCD, r = nwg % NXCD, xcd = wgid % NXCD, off = wgid / NXCD; wgid = (xcd < r ? xcd * (q + 1) : r * (q + 1) + (xcd - r) * q) + off; }
        const int nig = WGM * nN, gid = wgid / nig, fm = gid * WGM, gsz = (nM - fm) < WGM ? (nM - fm) : WGM;
        pm = fm + ((wgid % nig) % gsz); pn = (wgid % nig) / gsz; return true;
    }
};

template <class Sched, class Epi, int K, int LDA, int LDB, bool ALIGN_EPI>
__device__ __forceinline__ void gemm_phase(LAS unsigned char* lds, const Sched& S, const Epi& E, int tid_in) {
    int tid_ = tid_in; asm volatile("" : "+v"(tid_));
    const int tid = tid_, wid = __builtin_amdgcn_readfirstlane(tid >> 6), lane = tid & 63, wr = wid >> 2, wc = wid & 3, fr = lane & 15, fq = lane >> 4;
    constexpr int nt = K / BK;
    static_assert(K % 128 == 0 && K >= 256, "K");
    unsigned voffB[2];
#pragma unroll
    for (int i = 0; i < 2; ++i) { int R, C; stage_rc(tid * 16 + i * 8192, R, C); const int Rb = Epi::PERM ? ((R & ~31) + perm32(R & 31)) : R;
        voffB[i] = (unsigned)(Rb * LDB + C) * 2u; }
    constexpr size_t kstep = (size_t)(BK * 2);
    constexpr size_t hstepB = (size_t)HALF * LDB * 2;
    constexpr size_t hstepA = Sched::GATHER ? 0 : (size_t)HALF * LDA * 2;
    const unsigned ldsw = (unsigned)wid * 1024u;
    const int aoff = lds_byte(wr * 64 + fr, fq * 8), boff = lds_byte(wc * 32 + fr, fq * 8);
#define PG8_SA(b, h) (((b) * 2 + (h)) * HTB)
#define PG8_SB(b, h) ((4 + (b) * 2 + (h)) * HTB)
#define PG8_STAGE(bufoff, gbase, voff) do { _Pragma("unroll") for (int _i = 0; _i < 2; ++_i) \
        __builtin_amdgcn_global_load_lds((const unsigned*)((const char*)(gbase) + (voff)[_i]), (LAS unsigned*)(lds + (bufoff) + ldsw + _i * 8192), 16, 0, 0); } while (0)
#define PG8_LDA(dst, b, h) do { _Pragma("unroll") for (int m = 0; m < 4; ++m) _Pragma("unroll") for (int k = 0; k < 2; ++k) dst[m][k] = *(const LAS bf16x8*)(lds + PG8_SA(b, h) + aoff + m * 2048 + k * 1024); } while (0)
#define PG8_LDB(dst, b, h) do { _Pragma("unroll") for (int n = 0; n < 2; ++n) _Pragma("unroll") for (int k = 0; k < 2; ++k) dst[n][k] = *(const LAS bf16x8*)(lds + PG8_SB(b, h) + boff + n * 2048 + k * 1024); } while (0)
#define PG8_MMA(ai, bj, At, Bt) do { __builtin_amdgcn_s_setprio(1); _Pragma("unroll") for (int m = 0; m < 4; ++m) _Pragma("unroll") for (int n = 0; n < 2; ++n) _Pragma("unroll") for (int k = 0; k < 2; ++k) \
        acc[ai][bj][m][n] = __builtin_amdgcn_mfma_f32_16x16x32_bf16(Bt[n][k], At[m][k], acc[ai][bj][m][n], 0, 0, 0); __builtin_amdgcn_s_setprio(0); } while (0)
#define VA1 (Sched::GATHER ? vA1 : vA0)
#define W0 vA0
#define W1 VA1
#define PG8_WAIT_V(n) asm volatile("s_waitcnt vmcnt(" #n ")" ::: "memory")
#define PG8_WAIT_L(n) asm volatile("s_waitcnt lgkmcnt(" #n ")" ::: "memory")
#define PG8_BAR __builtin_amdgcn_s_barrier()
#define PG8_SCHED __builtin_amdgcn_sched_barrier(0)
    Unit cur, nxt; int ui = 0;
    if (!S.next(0, cur)) return;
    f32x4 acc[2][2][4][2];
#pragma unroll
    for (int a = 0; a < 2; ++a)
#pragma unroll
        for (int b = 0; b < 2; ++b)
#pragma unroll
            for (int m = 0; m < 4; ++m)
#pragma unroll
                for (int n = 0; n < 2; ++n) acc[a][b][m][n] = (f32x4){0.f, 0.f, 0.f, 0.f};
    bf16x8 At[4][2], B0[2][2], B1[2][2];
    unsigned vA0[2], vA1[2];
    S.a_off(cur, tid, vA0, vA1);
    const char* cA = S.a_base(cur); const char* cB = S.b_base(cur);
    PG8_STAGE(PG8_SB(0, 0), cB, voffB); PG8_STAGE(PG8_SB(0, 1), cB + hstepB, voffB); PG8_STAGE(PG8_SA(0, 0), cA, vA0); PG8_STAGE(PG8_SA(0, 1), cA + hstepA, VA1);
    if (wr == 1) PG8_BAR;
    PG8_WAIT_V(2); PG8_BAR;
    PG8_STAGE(PG8_SB(1, 0), cB + kstep, voffB); PG8_STAGE(PG8_SA(1, 0), cA + kstep, vA0); PG8_STAGE(PG8_SB(1, 1), cB + hstepB + kstep, voffB);
    PG8_WAIT_V(6); PG8_BAR;
    for (;;) {
        const bool has_next = S.next(ui + 1, nxt);
        const char* nA = has_next ? S.a_base(nxt) : cA; const char* nB = has_next ? S.b_base(nxt) : cB;
        for (int t = 0; t < nt; t += 2) {
            const bool last = (t == nt - 2);
            const char* a1 = cA + (size_t)(t + 1) * kstep;
            const char* a2 = last ? nA : cA + (size_t)(t + 2) * kstep; const char* b2 = last ? nB : cB + (size_t)(t + 2) * kstep;
            const char* a3 = a2 + kstep; const char* b3 = b2 + kstep;
            PG8_LDB(B0, 0, 0); PG8_LDB(B1, 0, 1); PG8_SCHED; PG8_LDA(At, 0, 0); PG8_STAGE(PG8_SA(1, 1), a1 + hstepA, VA1);
            if constexpr (Sched::GATHER) { if (last && has_next) S.a_off(nxt, tid, vA0, vA1); }
            PG8_WAIT_V(8); PG8_WAIT_L(0); PG8_BAR; PG8_MMA(0, 0, At, B0); PG8_MMA(0, 1, At, B1); PG8_BAR; PG8_SCHED;
            PG8_LDA(At, 0, 1); PG8_STAGE(PG8_SB(0, 0), b2, voffB); PG8_STAGE(PG8_SB(0, 1), b2 + hstepB, voffB); PG8_STAGE(PG8_SA(0, 0), a2, W0);
            PG8_WAIT_V(8); PG8_WAIT_L(0); PG8_BAR; PG8_MMA(1, 0, At, B0); PG8_MMA(1, 1, At, B1); PG8_BAR; PG8_SCHED;
            PG8_LDB(B0, 1, 0); PG8_LDB(B1, 1, 1); PG8_SCHED; PG8_LDA(At, 1, 0); PG8_STAGE(PG8_SA(0, 1), a2 + hstepA, W1);
            PG8_WAIT_V(8); PG8_WAIT_L(0); PG8_BAR; PG8_MMA(0, 0, At, B0); PG8_MMA(0, 1, At, B1); PG8_BAR; PG8_SCHED;
            PG8_LDA(At, 1, 1); PG8_STAGE(PG8_SB(1, 0), b3, voffB); PG8_STAGE(PG8_SB(1, 1), b3 + hstepB, voffB); PG8_STAGE(PG8_SA(1, 0), a3, W0);
            PG8_WAIT_V(8); PG8_WAIT_L(0); PG8_BAR; PG8_MMA(1, 0, At, B0); PG8_MMA(1, 1, At, B1); PG8_BAR; PG8_SCHED;
        }
        if constexpr (ALIGN_EPI) { if (wr == 0) PG8_BAR; }
        { int fr_e = fr, fq_e = fq; asm volatile("" : "+v"(fr_e), "+v"(fq_e));
          E(acc, cur, wr, wc, fr_e, fq_e); }
        if (!has_next) break;
#pragma unroll
        for (int a = 0; a < 2; ++a)
#pragma unroll
            for (int b = 0; b < 2; ++b)
#pragma unroll
                for (int m = 0; m < 4; ++m)
#pragma unroll
                    for (int n = 0; n < 2; ++n) acc[a][b][m][n] = (f32x4){0.f, 0.f, 0.f, 0.f};
        cur = nxt; cA = nA; cB = nB; ++ui;
        if constexpr (ALIGN_EPI) { if (wr == 1) PG8_BAR; }
    }
    PG8_WAIT_V(0);
    if constexpr (!ALIGN_EPI) { if (wr == 0) PG8_BAR; }
    PG8_BAR;
#undef PG8_SA
#undef VA1
#undef W0
#undef W1
#undef PG8_SB
#undef PG8_STAGE
#undef PG8_LDA
#undef PG8_LDB
#undef PG8_MMA
#undef PG8_WAIT_V
#undef PG8_WAIT_L
#undef PG8_BAR
#undef PG8_SCHED
}
}
#define XB_TMO      128
#define XB_XCNT(j)  (256  + 64 * (j))
#define XB_XSUB(j)  (1280 + 64 * (j))
#define XB_XGEN(j)  (2304 + 64 * (j))
#define XB_TOP      3328
#define XB_TOPGEN   3392
#define XCD_BAR_WORDS 3456
#define XB_SPIN_CAP (1u << 18)
__device__ __forceinline__ unsigned xb_ld(unsigned* p)              { return __hip_atomic_load(p, __ATOMIC_RELAXED, __HIP_MEMORY_SCOPE_AGENT); }
__device__ __forceinline__ unsigned xb_add(unsigned* p, unsigned v) { return __hip_atomic_fetch_add(p, v, __ATOMIC_RELAXED, __HIP_MEMORY_SCOPE_AGENT); }
__device__ __forceinline__ unsigned xb_xcc_id() { return (unsigned)__builtin_amdgcn_s_getreg((3 << 11) | 20) & 0xFu; }
#define XB_SPIN(cond, bar) do { unsigned _sp = 0; while (cond) { __builtin_amdgcn_s_sleep(1); \
    if ((++_sp & 255u) == 0u) { if (xb_ld(&(bar)[XB_TMO])) break; if (_sp > XB_SPIN_CAP) { atomicAdd(&(bar)[XB_TMO], 1u); break; } } } } while (0)
struct XcdBarrier { unsigned* bar; unsigned x; volatile LAS unsigned* st; };
__device__ __forceinline__ XcdBarrier xcd_barrier_post(unsigned* bar, volatile LAS unsigned* st) {
    XcdBarrier b; b.bar = bar; b.x = xb_xcc_id(); b.st = st;
    if (threadIdx.x == 0) (void)xb_add(&bar[XB_XCNT(b.x)], 1u);
    return b;
}
__device__ __forceinline__ void xcd_barrier_complete(unsigned* bar, unsigned x, unsigned& nloc, unsigned& nx) {
    const unsigned G = gridDim.x * gridDim.y * gridDim.z;
    unsigned sum, cnt, mine, sp = 0u;
    for (;;) {
        sum = 0u; cnt = 0u; mine = 0u;
#pragma unroll
        for (unsigned j = 0; j < 16; ++j) { const unsigned c = xb_ld(&bar[XB_XCNT(j)]); sum += c; cnt += (c > 0u) ? 1u : 0u; mine = (j == x) ? c : mine; }
        if (sum == G) break;
        __builtin_amdgcn_s_sleep(1);
        if ((++sp & 255u) == 0u) { if (xb_ld(&bar[XB_TMO])) break; if (sp > XB_SPIN_CAP) { atomicAdd(&bar[XB_TMO], 1u); break; } }
    }
    nloc = mine > 0u ? mine : 1u; nx = cnt > 0u ? cnt : 1u;
}
__device__ __forceinline__ void xcd_barrier(const XcdBarrier& b, int tid) {
    asm volatile("s_waitcnt vmcnt(0)" ::: "memory");
    __syncthreads();
    if (tid == 0) {
        unsigned* bar = b.bar; asm volatile("" : "+s"(bar));
        __builtin_amdgcn_s_waitcnt(0);
        unsigned nloc = b.st[0], nx = b.st[1];
        if (nloc == 0u) { xcd_barrier_complete(bar, b.x, nloc, nx); b.st[0] = nloc; b.st[1] = nx; }
        const unsigned old = xb_add(&bar[XB_XSUB(b.x)], 1u);
        const unsigned gen = old / nloc;
        if (old + 1u == (gen + 1u) * nloc) {
            __builtin_amdgcn_fence(__ATOMIC_RELEASE, "agent");
            asm volatile("s_waitcnt vmcnt(0)" ::: "memory");
            const unsigned og = xb_add(&bar[XB_TOP], 1u);
            const unsigned tg = og / nx;
            if (og + 1u == (tg + 1u) * nx) xb_add(&bar[XB_TOPGEN], 1u);
            else XB_SPIN(xb_ld(&bar[XB_TOPGEN]) == tg, bar);
            __builtin_amdgcn_fence(__ATOMIC_ACQUIRE, "agent");
            xb_add(&bar[XB_XGEN(b.x)], 1u);
            asm volatile("s_waitcnt vmcnt(0)" ::: "memory");
        } else {
            XB_SPIN(xb_ld(&bar[XB_XGEN(b.x)]) == gen, bar);
            __builtin_amdgcn_fence(__ATOMIC_ACQUIRE, "agent");
            asm volatile("s_waitcnt vmcnt(0)" ::: "memory");
        }
    }
    __syncthreads();
}

struct Args { const float* in[20]; float* out; unsigned char* ws; int ph_lo, ph_hi, use_bar, pad; };
struct Frame {
    LAS unsigned char* lds;
    unsigned* ctl;
    int wave, vcu, G;
    unsigned char* ws;
};
__device__ __forceinline__ int fresh_lane() { int l_; asm volatile("v_mbcnt_lo_u32_b32 %0, -1, 0\n\tv_mbcnt_hi_u32_b32 %0, -1, %0" : "=v"(l_)); return l_; }
__device__ __forceinline__ const float* arg_in(int i) { asm volatile("" : "+s"(i)); return ((const float* const __attribute__((address_space(4)))*)__builtin_amdgcn_kernarg_segment_ptr())[i]; }
__device__ __forceinline__ unsigned char* arg_ws() { int i = 21; asm volatile("" : "+s"(i)); return ((unsigned char* const __attribute__((address_space(4)))*)__builtin_amdgcn_kernarg_segment_ptr())[i]; }
#define GW_ID(F) ((F).vcu * NWAVES + (F).wave)
#define GW_N(F) ((F).G * NWAVES)

__device__ __forceinline__ void cvt_item(const float* W, int ldw, int k0, int srcc, bf16* WT, size_t out_row0, int ldo, LAS float* scr, int lane) {
#pragma unroll 8
    for (int i = 0; i < 32; ++i) { const int kk = 2 * i + (lane >> 5); scr[kk * 33 + (lane & 31)] = srcc >= 0 ? W[(size_t)(k0 + kk) * ldw + srcc] : 0.f; }
    LDS_WAIT(); asm volatile("" ::: "memory");
    const int c = lane & 7;
#pragma unroll
    for (int j = 0; j < 4; ++j) { const int n = (lane >> 3) + 8 * j; const LAS float* s = scr + (8 * c) * 33 + n;
        v4u o; o.x = pk2(s[0 * 33], s[1 * 33]); o.y = pk2(s[2 * 33], s[3 * 33]); o.z = pk2(s[4 * 33], s[5 * 33]); o.w = pk2(s[6 * 33], s[7 * 33]);
        *(v4u*)(WT + (out_row0 + n) * (size_t)ldo + k0 + 8 * c) = o; }
    LDS_WAIT(); asm volatile("" ::: "memory");
}
__device__ __forceinline__ void ph_convw(const Frame& F, int l) {
    LAS float* scr = (LAS float*)(F.lds + F.wave * 16384);
    const int gw = GW_ID(F), NGW = GW_N(F), lane = fresh_lane(), ln = lane & 31;
    constexpr int I_IN = (PW / 32) * 32, I_BR = 3 * 64 * 16, I_OUT = 64 * 32, I_G = 32 * 16 * 32, I_D = 32 * 64 * 8;
    constexpr int NITEMS = I_IN + I_BR + I_OUT + 2 * I_G + I_D;
    for (int it = gw; it < NITEMS; it += NGW) {
        int r = it;
        if (r < I_IN) { const int kb = r / (PW / 32), nb = r % (PW / 32);
            cvt_item(arg_in(2) + (size_t)l * DM * NIN, NIN, 64 * kb, src_col(32 * nb + ln), (bf16*)(F.ws + WS_WIN), (size_t)32 * nb, DM, scr, lane); continue; }
        r -= I_IN;
        if (r < I_BR) { const int n = r / (64 * 16), q = r % (64 * 16), kb = q / 64, nb = q % 64;
            cvt_item(arg_in(9) + ((size_t)l * 3 + n) * BW * DM, DM, 64 * kb, 32 * nb + ln, (bf16*)(F.ws + WS_WBR) + (size_t)n * DM * BW, (size_t)32 * nb, BW, scr, lane); continue; }
        r -= I_BR;
        if (r < I_OUT) { const int kb = r / 64, nb = r % 64;
            cvt_item(arg_in(10) + (size_t)l * DM * DM, DM, 64 * kb, 32 * nb + ln, (bf16*)(F.ws + WS_WOUT), (size_t)32 * nb, DM, scr, lane); continue; }
        r -= I_OUT;
        if (r < 2 * I_G) { const int up = r >= I_G; if (up) r -= I_G; const int e = r / (16 * 32), q = r % (16 * 32), kb = q / 16, nb = q % 16, f0 = 32 * nb;
            cvt_item(arg_in(up ? 17 : 16) + ((size_t)l * NEXP + e) * DM * DEXP, DEXP, 64 * kb, f0 + ln, (bf16*)(F.ws + WS_WGU) + (size_t)e * 1024 * DM,
                     (size_t)((f0 >> 7) * 256 + (up ? 128 : 0) + (f0 & 127)), DM, scr, lane); continue; }
        r -= 2 * I_G;
        { const int e = r / (64 * 8), q = r % (64 * 8), kb = q / 64, nb = q % 64;
            cvt_item(arg_in(18) + ((size_t)l * NEXP + e) * DEXP * DM, DM, 64 * kb, 32 * nb + ln, (bf16*)(F.ws + WS_WDN) + (size_t)e * DM * DEXP, (size_t)32 * nb, DEXP, scr, lane); }
    }
}

__device__ __forceinline__ int* tokinfo_ptr(const Frame& F) { return (int*)(F.ws + WS_LIST + MiB); }

__device__ __forceinline__ void ph_norm1(const Frame& F, int l) {
    const int gw = GW_ID(F), NGW = GW_N(F), lane = fresh_lane();
    const float* g = arg_in(1) + (size_t)l * DM;
    bf16* XN = (bf16*)(F.ws + WS_XN);
    for (int m = gw; m < NTOK; m += NGW) {
        f32x4 v[8]; float s = 0.f;
        if (l == 0) {
            const f32x4* xr = (const f32x4*)(arg_in(0) + (size_t)m * DM) + lane;
#pragma unroll
            for (int j = 0; j < 8; ++j) v[j] = xr[64 * j];
        } else {
            const f32x4* xr = (const f32x4*)((const float*)(F.ws + WS_X1) + (size_t)m * DM) + lane;
            const v2u* y0 = (const v2u*)((const bf16*)(F.ws + WS_YB) + (size_t)(2 * m) * DM) + lane;
            const v2u* y1 = (const v2u*)((const bf16*)(F.ws + WS_YB) + (size_t)(2 * m + 1) * DM) + lane;
            f32x4* xo = (f32x4*)((float*)(F.ws + WS_XA) + (size_t)m * DM) + lane;
#pragma unroll
            for (int j = 0; j < 8; ++j) { f32x4 x = xr[64 * j]; const v2u a = y0[64 * j], b = y1[64 * j];
                x.x = (x.x + bflo(a.x)) + bflo(b.x); x.y = (x.y + bfhi(a.x)) + bfhi(b.x); x.z = (x.z + bflo(a.y)) + bflo(b.y); x.w = (x.w + bfhi(a.y)) + bfhi(b.y);
                v[j] = x; xo[64 * j] = x; }
        }
#pragma unroll
        for (int j = 0; j < 8; ++j) s += (v[j].x * v[j].x + v[j].y * v[j].y) + (v[j].z * v[j].z + v[j].w * v[j].w);
        const float rstd = 1.0f / sqrtf(wave_sum(s) * (1.f / DM) + EPS);
        v2u* o8 = (v2u*)(XN + (size_t)m * DM) + lane;
        const f32x4* gr = (const f32x4*)g + lane;
#pragma unroll
        for (int j = 0; j < 8; ++j) { const f32x4 gg = gr[64 * j]; v2u o; o.x = pk2(v[j].x * rstd * gg.x, v[j].y * rstd * gg.y); o.y = pk2(v[j].z * rstd * gg.z, v[j].w * rstd * gg.w); o8[64 * j] = o; }
    }
}

__device__ __forceinline__ void ph_final(const Frame& F, float* out) {
    const int gw = GW_ID(F), NGW = GW_N(F), lane = fresh_lane();
    for (int m = gw; m < NTOK; m += NGW) {
        const f32x4* xr = (const f32x4*)((const float*)(F.ws + WS_X1) + (size_t)m * DM) + lane;
        const v2u* y0 = (const v2u*)((const bf16*)(F.ws + WS_YB) + (size_t)(2 * m) * DM) + lane;
        const v2u* y1 = (const v2u*)((const bf16*)(F.ws + WS_YB) + (size_t)(2 * m + 1) * DM) + lane;
        f32x4* xo = (f32x4*)(out + (size_t)m * DM) + lane;
#pragma unroll
        for (int j = 0; j < 8; ++j) { f32x4 x = xr[64 * j]; const v2u a = y0[64 * j], b = y1[64 * j];
            x.x = (x.x + bflo(a.x)) + bflo(b.x); x.y = (x.y + bfhi(a.x)) + bfhi(b.x); x.z = (x.z + bflo(a.y)) + bflo(b.y); x.w = (x.w + bfhi(a.y)) + bfhi(b.y);
            xo[64 * j] = x; }
    }
}

__device__ __forceinline__ void ph_norm2(const Frame& F, int l) {
    const int gw = GW_ID(F), NGW = GW_N(F), lane = fresh_lane();
    const float* g = arg_in(11) + (size_t)l * DM;
    const float* wrg = arg_in(12) + (size_t)l * DM * NGRP; const float* brg = arg_in(13) + l * NGRP;
    const float* wre = arg_in(14) + (size_t)l * DM * NEXP; const float* bre = arg_in(15) + l * NEXP;
    bf16* XN = (bf16*)(F.ws + WS_XN);
    int* list = (int*)(F.ws + WS_LIST); int* tinfo = tokinfo_ptr(F);
    unsigned* ecnt = F.ctl + CW_ECNT + l * NEXP * 64;
    for (int m = gw; m < NTOK; m += NGW) {
        f32x4 v[8]; float s = 0.f;
        const f32x4* xr = (const f32x4*)((const float*)(F.ws + WS_X1) + (size_t)m * DM) + lane;
#pragma unroll
        for (int j = 0; j < 8; ++j) { v[j] = xr[64 * j]; s += (v[j].x * v[j].x + v[j].y * v[j].y) + (v[j].z * v[j].z + v[j].w * v[j].w); }
        const float rstd = 1.0f / sqrtf(wave_sum(s) * (1.f / DM) + EPS);
        v2u* o8 = (v2u*)(XN + (size_t)m * DM) + lane;
        const f32x4* gr = (const f32x4*)g + lane;
#pragma unroll
        for (int j = 0; j < 8; ++j) { const f32x4 gg = gr[64 * j]; v2u o; o.x = pk2(v[j].x * rstd * gg.x, v[j].y * rstd * gg.y); o.y = pk2(v[j].z * rstd * gg.z, v[j].w * rstd * gg.w); o8[64 * j] = o; }
        float lg[36];
#pragma unroll
        for (int q = 0; q < 36; ++q) lg[q] = 0.f;
#pragma unroll 1
        for (int j = 0; j < 8; ++j) { const f32x4 gg = gr[64 * j], xx = xr[64 * j]; f32x4 x; x.x = xx.x * rstd * gg.x; x.y = xx.y * rstd * gg.y; x.z = xx.z * rstd * gg.z; x.w = xx.w * rstd * gg.w;
            const int k0 = 4 * lane + 256 * j;
#pragma unroll
            for (int c = 0; c < 4; ++c) { const float xv = x[c];
                const f32x4 wg = *(const f32x4*)(wrg + (size_t)(k0 + c) * NGRP);
                lg[0] += xv * wg.x; lg[1] += xv * wg.y; lg[2] += xv * wg.z; lg[3] += xv * wg.w;
                const f32x4* we = (const f32x4*)(wre + (size_t)(k0 + c) * NEXP);
#pragma unroll
                for (int q = 0; q < 8; ++q) { const f32x4 w = we[q]; lg[4 + 4 * q] += xv * w.x; lg[5 + 4 * q] += xv * w.y; lg[6 + 4 * q] += xv * w.z; lg[7 + 4 * q] += xv * w.w; } } }
#pragma unroll
        for (int q = 0; q < 36; ++q) lg[q] = wave_sum(lg[q]);
        LAS float* lgL = (LAS float*)(F.lds + F.wave * 256);
        if (lane == 0) {
#pragma unroll
            for (int q = 0; q < 36; ++q) lgL[q] = lg[q];
            int gs = 0; float best = lg[0] + brg[0];
#pragma unroll
            for (int q = 1; q < 4; ++q) { const float t = lg[q] + brg[q]; if (t > best) { best = t; gs = q; } }
            float gm = fmaxf(fmaxf(lg[0], lg[1]), fmaxf(lg[2], lg[3])), gsum = 0.f, gsel = 0.f;
#pragma unroll
            for (int q = 0; q < 4; ++q) { const float e = __expf(lg[q] - gm); gsum += e; gsel = (q == gs) ? e : gsel; }
            const float pg = gsel / gsum;
            LDS_WAIT(); asm volatile("" ::: "memory");
            float ein[8];
#pragma unroll
            for (int q = 0; q < 8; ++q) ein[q] = lgL[4 + gs * 8 + q];
            int e0 = 0, e1 = -1; float b0 = -3.0e38f, b1 = -3.0e38f;
#pragma unroll
            for (int q = 0; q < 8; ++q) { const float t = ein[q] + bre[gs * 8 + q];
                if (t > b0) { b1 = b0; e1 = e0; b0 = t; e0 = q; } else if (t > b1) { b1 = t; e1 = q; } }
            float em = ein[0];
#pragma unroll
            for (int q = 1; q < 8; ++q) em = fmaxf(em, ein[q]);
            float p0 = 0.f, p1 = 0.f;
#pragma unroll
            for (int q = 0; q < 8; ++q) { const float e = __expf(ein[q] - em); p0 = (q == e0) ? e : p0; p1 = (q == e1) ? e : p1; }
            const float w0 = pg * p0 / (p0 + p1), w1 = pg * p1 / (p0 + p1);
            const int x0 = gs * 8 + e0, x1 = gs * 8 + e1;
            const int pos0 = (int)atomicAdd(ecnt + x0 * 64, 1u), pos1 = (int)atomicAdd(ecnt + x1 * 64, 1u);
            list[x0 * NTOK + pos0] = 2 * m; list[x1 * NTOK + pos1] = 2 * m + 1;
            tinfo[m * 8 + 0] = x0; tinfo[m * 8 + 1] = pos0; tinfo[m * 8 + 2] = __float_as_int(w0); tinfo[m * 8 + 3] = 0;
            tinfo[m * 8 + 4] = x1; tinfo[m * 8 + 5] = pos1; tinfo[m * 8 + 6] = __float_as_int(w1); tinfo[m * 8 + 7] = 0;
        }
    }
}

__device__ __forceinline__ void nv_conv(const Frame& F, int l) {
    const bf16* P = (const bf16*)(F.ws + WS_PROJ); float* QK = (float*)(F.ws + WS_TMP);
    const float* cw = arg_in(3) + (size_t)l * 4 * 2048;
    const size_t total = (size_t)NTOK * 2048, stride = (size_t)F.G * NTHR;
    for (size_t i = (size_t)F.vcu * NTHR + (F.wave * 64 + fresh_lane()); i < total; i += stride) {
        const int row = (int)(i >> 11), c = (int)(i & 2047), t = row & (SEQ - 1);
        float a = 0.f;
#pragma unroll
        for (int j = 0; j < 4; ++j) { const int tt = t - 3 + j; if (tt >= 0) a += cw[j * 2048 + c] * bf2f(P[(size_t)(row - 3 + j) * PW + c]); }
        QK[i] = siluf_(a);
    }
}
__device__ __forceinline__ void nv_mlstm(const Frame& F, int l) {
    const bf16* P = (const bf16*)(F.ws + WS_PROJ); const float* QK = (const float*)(F.ws + WS_TMP); float* HR = (float*)(F.ws + WS_TMP + 64 * MiB);
    const int tid = (F.wave * 64 + fresh_lane()), v = tid >> 2, kq = tid & 3;
    for (int bh = F.vcu; bh < BATCH * NH; bh += F.G) {
        const int b = bh >> 3, h = bh & 7;
        const float bi = arg_in(4)[l * NH + h], bfv = arg_in(5)[l * NH + h];
        float C[32], nn[32], m = 0.f;
#pragma unroll
        for (int j = 0; j < 32; ++j) { C[j] = 0.f; nn[j] = 0.f; }
        for (int t = 0; t < SEQ; ++t) {
            const size_t row = (size_t)b * SEQ + t;
            const float it = bf2f(P[row * PW + C_MI + h]) + bi, ft = bf2f(P[row * PW + C_MF + h]) + bfv;
            const float lf = logsigmoidf_(ft);
            const float mn = fmaxf(lf + m, it), ip = __expf(it - mn), fp = __expf(lf + m - mn); m = mn;
            const float vv = bf2f(P[row * PW + C_MV + h * HD + v]);
            const f32x4* qp = (const f32x4*)(QK + row * 2048 + h * HD + kq * 32);
            const f32x4* kp = (const f32x4*)(QK + row * 2048 + 1024 + h * HD + kq * 32);
            float num = 0.f, den = 0.f;
#pragma unroll
            for (int j4 = 0; j4 < 8; ++j4) { const f32x4 q = qp[j4], k = kp[j4];
#pragma unroll
                for (int c = 0; c < 4; ++c) { const int j = 4 * j4 + c; const float qq = q[c] * 0.08838834764831845f;
                    C[j] = fp * C[j] + ip * vv * k[c]; nn[j] = fp * nn[j] + ip * k[c]; num += C[j] * qq; den += nn[j] * qq; } }
            num += __shfl_xor(num, 1); num += __shfl_xor(num, 2); den += __shfl_xor(den, 1); den += __shfl_xor(den, 2);
            if (kq == 0) HR[row * 1024 + h * HD + v] = num / fmaxf(fabsf(den), __expf(-m));
        }
    }
}
__device__ __forceinline__ void nv_mnorm(const Frame& F, int l) {
    const bf16* P = (const bf16*)(F.ws + WS_PROJ); const float* HR = (const float*)(F.ws + WS_TMP + 64 * MiB); bf16* BR = (bf16*)(F.ws + WS_BR);
    const float* g = arg_in(6) + (size_t)l * BW;
    const int gw = GW_ID(F), NGW = GW_N(F), lane = fresh_lane();
    for (int it = gw; it < NTOK * NH; it += NGW) {
        const size_t row = it >> 3; const int h = it & 7, c = h * HD + 2 * lane;
        const float a = HR[row * 1024 + c], b = HR[row * 1024 + c + 1];
        const float r = 1.0f / sqrtf(wave_sum(a * a + b * b) * (1.f / HD) + EPS);
        const float o0 = a * r * g[c] * sigmoidf_(bf2f(P[row * PW + C_MO + c])), o1 = b * r * g[c + 1] * sigmoidf_(bf2f(P[row * PW + C_MO + c + 1]));
        *(unsigned*)(BR + row * 3072 + c) = pk2(o0, o1);
    }
}
__device__ __forceinline__ unsigned fkey(float f) { const unsigned u = __float_as_uint(f); return (u & 0x80000000u) ? ~u : (u | 0x80000000u); }
__device__ __forceinline__ void select_row(const unsigned (&key)[32], int nvalid, unsigned long long* mrow, int lane) {
    if (nvalid <= TOPK) {
#pragma unroll
        for (int j = 0; j < 32; ++j) { const unsigned long long b = __ballot(lane + 64 * j < nvalid); if (lane == 0) mrow[j] = b; }
        return;
    }
    unsigned T = 0u;
    for (int bit = 31; bit >= 0; --bit) {
        const unsigned cand = T | (1u << bit); int c = 0;
#pragma unroll
        for (int j = 0; j < 32; ++j) c += (key[j] >= cand) ? 1 : 0;
#pragma unroll
        for (int o = 1; o < 64; o <<= 1) c += __shfl_xor(c, o);
        if (c >= TOPK) T = cand;
    }
    int cgt = 0;
#pragma unroll
    for (int j = 0; j < 32; ++j) cgt += (key[j] > T) ? 1 : 0;
#pragma unroll
    for (int o = 1; o < 64; o <<= 1) cgt += __shfl_xor(cgt, o);
    const int need = TOPK - cgt; int run = 0;
    const unsigned long long below = (lane == 0) ? 0ull : (~0ull >> (64 - lane));
#pragma unroll
    for (int j = 0; j < 32; ++j) {
        const bool eq = key[j] == T; const unsigned long long be = __ballot(eq);
        const int rank = run + __popcll(be & below);
        const bool sel = (key[j] > T) || (eq && rank < need);
        run += __popcll(be);
        const unsigned long long b = __ballot(sel); if (lane == 0) mrow[j] = b;
    }
}
__device__ __forceinline__ void nv_index(const Frame& F) {
    const bf16* P = (const bf16*)(F.ws + WS_PROJ); unsigned long long* MK = (unsigned long long*)(F.ws + WS_MASK);
    LAS float* iqL = (LAS float*)(F.lds + F.wave * 12288); LAS float* scL = iqL + 1024;
    const int gw = GW_ID(F), NGW = GW_N(F), lane = fresh_lane();
    for (int row = gw; row < NTOK; row += NGW) {
        const int t = row & (SEQ - 1), r0 = row - t;
        for (int i = lane; i < 1024; i += 64) iqL[i] = bf2f(P[(size_t)row * PW + C_IQ + i]);
        float w[16];
#pragma unroll
        for (int hh = 0; hh < 16; ++hh) w[hh] = bf2f(P[(size_t)row * PW + C_IW + hh]) * 0.25f;
        LDS_WAIT(); asm volatile("" ::: "memory");
        for (int s = lane; s <= t; s += 64) {
            float d[16];
#pragma unroll
            for (int hh = 0; hh < 16; ++hh) d[hh] = 0.f;
            const v4u* kp = (const v4u*)(P + (size_t)(r0 + s) * PW + C_IK);
#pragma unroll 1
            for (int hf = 0; hf < 2; ++hf) {
                float kr[32];
#pragma unroll
                for (int q = 0; q < 4; ++q) { const v4u x = kp[4 * hf + q]; kr[8 * q] = bflo(x.x); kr[8 * q + 1] = bfhi(x.x); kr[8 * q + 2] = bflo(x.y); kr[8 * q + 3] = bfhi(x.y); kr[8 * q + 4] = bflo(x.z); kr[8 * q + 5] = bfhi(x.z); kr[8 * q + 6] = bflo(x.w); kr[8 * q + 7] = bfhi(x.w); }
#pragma unroll
                for (int hh = 0; hh < 16; ++hh) {
#pragma unroll
                    for (int e = 0; e < 32; ++e) d[hh] += iqL[hh * 64 + hf * 32 + e] * kr[e]; }
            }
            float sc = 0.f;
#pragma unroll
            for (int hh = 0; hh < 16; ++hh) sc += w[hh] * fmaxf(d[hh] * 0.125f, 0.f);
            scL[s] = sc;
        }
        LDS_WAIT(); asm volatile("" ::: "memory");
        unsigned key[32];
#pragma unroll
        for (int j = 0; j < 32; ++j) { const int s = lane + 64 * j; key[j] = (s <= t) ? fkey(scL[s]) : 0u; }
        select_row(key, t + 1, MK + (size_t)row * 32, lane);
        LDS_WAIT(); asm volatile("" ::: "memory");
    }
}
__device__ __forceinline__ void nv_dsa(const Frame& F, int l) {
    const bf16* P = (const bf16*)(F.ws + WS_PROJ); const unsigned long long* MK = (const unsigned long long*)(F.ws + WS_MASK); bf16* BR = (bf16*)(F.ws + WS_BR);
    const float* qg = arg_in(7) + l * HD; const float* kg = arg_in(8) + l * HD; const float* rb = arg_in(19);
    LAS float* lgL = (LAS float*)(F.lds + F.wave * 2048); LAS int* ixL = (LAS int*)(lgL + 256);
    const int gw = GW_ID(F), NGW = GW_N(F), lane = fresh_lane();
    for (int it = gw; it < NTOK * NH; it += NGW) {
        const int row = it >> 3, h = it & 7, t = row & (SEQ - 1), r0 = row - t, c = h * HD + 2 * lane;
        float q0 = bf2f(P[(size_t)row * PW + C_DQ + c]), q1 = bf2f(P[(size_t)row * PW + C_DQ + c + 1]);
        const float qr = 1.0f / sqrtf(wave_sum(q0 * q0 + q1 * q1) * (1.f / HD) + EPS);
        q0 *= qr * qg[2 * lane]; q1 *= qr * qg[2 * lane + 1];
        const float kg0 = kg[2 * lane], kg1 = kg[2 * lane + 1];
        int cnt = 0; float mx = -3.0e38f;
        for (int wi = 0; wi <= (t >> 6); ++wi) {
            unsigned long long w = MK[(size_t)row * 32 + wi];
            while (w) { const int s = wi * 64 + __builtin_ctzll(w); w &= w - 1;
                const unsigned kk = *(const unsigned*)(P + (size_t)(r0 + s) * PW + C_DK + c);
                const float k0 = bflo(kk), k1 = bfhi(kk);
                const float ss = wave_sum(k0 * k0 + k1 * k1), dd = wave_sum(q0 * k0 * kg0 + q1 * k1 * kg1);
                const float kr = 1.0f / sqrtf(ss * (1.f / HD) + EPS);
                const float lgt = dd * kr * 0.08838834764831845f + rb[t5_bucket(t - s) * NH + h];
                if (lane == 0) { lgL[cnt] = lgt; ixL[cnt] = s; }
                mx = fmaxf(mx, lgt); ++cnt; }
        }
        LDS_WAIT(); asm volatile("" ::: "memory");
        float o0 = 0.f, o1 = 0.f, den = 0.f;
        for (int j = 0; j < cnt; ++j) { const float p = __expf(lgL[j] - mx); const int s = ixL[j];
            const unsigned vv = *(const unsigned*)(P + (size_t)(r0 + s) * PW + C_DV + c);
            o0 += p * bflo(vv); o1 += p * bfhi(vv); den += p; }
        *(unsigned*)(BR + (size_t)row * 3072 + 1024 + c) = pk2(o0 / den, o1 / den);
        LDS_WAIT(); asm volatile("" ::: "memory");
    }
}
__device__ __forceinline__ void nv_sb(const Frame& F) {
    const bf16* P = (const bf16*)(F.ws + WS_PROJ); bf16* BR = (bf16*)(F.ws + WS_BR);
    const int gw = GW_ID(F), NGW = GW_N(F), lane = fresh_lane();
    for (int it = gw; it < NTOK * NH; it += NGW) {
        const int row = it >> 3, h = it & 7, t = row & (SEQ - 1), r0 = row - t, c = h * HD + 2 * lane;
        const unsigned qq = *(const unsigned*)(P + (size_t)row * PW + C_SQ + c);
        const float q0 = bflo(qq) * 0.08838834764831845f, q1 = bfhi(qq) * 0.08838834764831845f;
        float o0 = 0.f, o1 = 0.f, lp = 0.f;
        for (int s = t - 1; s >= 0; --s) {
            const unsigned kk = *(const unsigned*)(P + (size_t)(r0 + s) * PW + C_SK + c);
            const float z = wave_sum(q0 * bflo(kk) + q1 * bfhi(kk));
            const float a = __expf(logsigmoidf_(z) + lp);
            const unsigned vv = *(const unsigned*)(P + (size_t)(r0 + s) * PW + C_SV + c);
            o0 += a * bflo(vv); o1 += a * bfhi(vv);
            lp += logsigmoidf_(-z);
            if (lp < -80.f) break;
        }
        *(unsigned*)(BR + (size_t)row * 3072 + 2048 + c) = pk2(o0, o1);
    }
}
__device__ __forceinline__ void nv_moe(const Frame& F) {
    const bf16* XN = (const bf16*)(F.ws + WS_XN); bf16* YB = (bf16*)(F.ws + WS_YB); const int* tinfo = tokinfo_ptr(F);
    LAS float* xL = (LAS float*)F.lds; LAS float* hL = xL + 2048;
    const int tid = (F.wave * 64 + fresh_lane());
    for (int slot = F.vcu; slot < 2 * NTOK; slot += F.G) {
        const int m = slot >> 1, k = slot & 1; const int e = tinfo[m * 8 + 4 * k]; const float w = __int_as_float(tinfo[m * 8 + 4 * k + 2]);
        __syncthreads();
        for (int i = tid; i < 2048; i += NTHR) xL[i] = bf2f(XN[(size_t)m * DM + i]);
        __syncthreads();
        { const int f = tid; const bf16* wg = (const bf16*)(F.ws + WS_WGU) + ((size_t)e * 1024 + (f >> 7) * 256 + (f & 127)) * DM; const bf16* wu = wg + (size_t)128 * DM;
          float g = 0.f, u = 0.f;
          for (int k8 = 0; k8 < 256; ++k8) { const v4u a = ((const v4u*)wg)[k8], b = ((const v4u*)wu)[k8]; const LAS float* x = xL + 8 * k8;
              g += x[0] * bflo(a.x) + x[1] * bfhi(a.x) + x[2] * bflo(a.y) + x[3] * bfhi(a.y) + x[4] * bflo(a.z) + x[5] * bfhi(a.z) + x[6] * bflo(a.w) + x[7] * bfhi(a.w);
              u += x[0] * bflo(b.x) + x[1] * bfhi(b.x) + x[2] * bflo(b.y) + x[3] * bfhi(b.y) + x[4] * bflo(b.z) + x[5] * bfhi(b.z) + x[6] * bflo(b.w) + x[7] * bfhi(b.w); }
          hL[f] = bf2f((unsigned short)f2bf(siluf_(g) * u)); }
        __syncthreads();
        { float y[4];
#pragma unroll
          for (int c = 0; c < 4; ++c) { const int d = 4 * tid + c; const bf16* wd = (const bf16*)(F.ws + WS_WDN) + ((size_t)e * DM + d) * DEXP; float a = 0.f;
              for (int k8 = 0; k8 < 64; ++k8) { const v4u x = ((const v4u*)wd)[k8]; const LAS float* hh = hL + 8 * k8;
                  a += hh[0] * bflo(x.x) + hh[1] * bfhi(x.x) + hh[2] * bflo(x.y) + hh[3] * bfhi(x.y) + hh[4] * bflo(x.z) + hh[5] * bfhi(x.z) + hh[6] * bflo(x.w) + hh[7] * bfhi(x.w); }
              y[c] = a * w; }
          v2u o; o.x = pk2(y[0], y[1]); o.y = pk2(y[2], y[3]); *(v2u*)(YB + (size_t)slot * DM + 4 * tid) = o; }
    }
}
constexpr int MOE_TAB_OFF = LDSCTL_OFF + 1024;
__device__ __forceinline__ void moe_tables(const Frame& F, int l) {
    LAS int* tp = (LAS int*)(F.lds + MOE_TAB_OFF); LAS int* cn = tp + 40; LAS int* sb = cn + 40;
    __syncthreads();
    if ((F.wave * 64 + fresh_lane()) == 0) { int p = 0, s = 0;
        for (int e = 0; e < NEXP; ++e) { const int c = (int)__hip_atomic_load(F.ctl + CW_ECNT + (l * NEXP + e) * 64, RLX_AGENT); tp[e] = p; cn[e] = c; sb[e] = s; p += (c + 255) >> 8; s += c; }
        tp[NEXP] = p; sb[NEXP] = s; }
    __syncthreads();
}
template <int NT> struct SchedMoeBase {
    const LAS int* tp; const LAS int* cn; const LAS int* sb; int G, c;
    __device__ __forceinline__ bool next(int i, pg8::Unit& u) const {
        const int L = i * G + c, total = tp[NEXP] * NT; if (L >= total) return false;
        const int mt = L / NT; u.pn = L % NT; int e = 0;
#pragma unroll 1
        for (int q = 1; q < NEXP; ++q) e = (tp[q] <= mt) ? q : e;
        u.e = e; u.pm = mt - tp[e]; const int r = cn[e] - 256 * u.pm; u.rows = r < 256 ? r : 256; return true;
    }
};
struct SchedMoeUp : SchedMoeBase<4> {
    static constexpr bool GATHER = true;
    const char* A; const char* B; const int* list;
    __device__ __forceinline__ const char* a_base(const pg8::Unit&) const { return A; }
    __device__ __forceinline__ const char* b_base(const pg8::Unit& u) const { return B + ((size_t)u.e * 1024 + (size_t)u.pn * 256) * DM * 2; }
    __device__ __forceinline__ void a_off(const pg8::Unit& u, int tid, unsigned (&v0)[2], unsigned (&v1)[2]) const {
        int R[2], C[2];
#pragma unroll
        for (int i = 0; i < 2; ++i) pg8::stage_rc(tid * 16 + i * 8192, R[i], C[i]);
        const int* le = list + (size_t)u.e * NTOK + 256 * u.pm;
#pragma unroll
        for (int i = 0; i < 2; ++i) { int r0 = R[i], r1 = R[i] + 128; r0 = r0 < u.rows ? r0 : u.rows - 1; r1 = r1 < u.rows ? r1 : u.rows - 1;
            const int t0 = le[r0] >> 1, t1 = le[r1] >> 1;
            v0[i] = (unsigned)(t0 * DM + C[i]) * 2u; v1[i] = (unsigned)(t1 * DM + C[i]) * 2u; }
    }
};
struct EpiMoeUp {
    static constexpr bool PERM = true;
    bf16* HB; const LAS int* sb;
    __device__ __forceinline__ void operator()(const f32x4 (&acc)[2][2][4][2], const pg8::Unit& u, int wr, int wc, int fr, int fq) const {
        const int col0 = u.pn * 128 + wc * 32 + 8 * fq; const size_t slot0 = (size_t)sb[u.e] + 256 * u.pm;
#pragma unroll
        for (int ai = 0; ai < 2; ++ai)
#pragma unroll
            for (int m = 0; m < 4; ++m) { const int r = ai * 128 + wr * 64 + m * 16 + fr;
                if (r < u.rows) { const f32x4 g0 = acc[ai][0][m][0], g1 = acc[ai][0][m][1], u0 = acc[ai][1][m][0], u1 = acc[ai][1][m][1];
                    v4u w; w.x = cvt_pk_bf16(siluf_(g0[0]) * u0[0], siluf_(g0[1]) * u0[1]); w.y = cvt_pk_bf16(siluf_(g0[2]) * u0[2], siluf_(g0[3]) * u0[3]);
                    w.z = cvt_pk_bf16(siluf_(g1[0]) * u1[0], siluf_(g1[1]) * u1[1]); w.w = cvt_pk_bf16(siluf_(g1[2]) * u1[2], siluf_(g1[3]) * u1[3]);
                    *(v4u*)(HB + (slot0 + r) * DEXP + col0) = w; } }
    }
};
struct SchedMoeDown : SchedMoeBase<8> {
    static constexpr bool GATHER = false;
    const char* A; const char* B;
    __device__ __forceinline__ const char* a_base(const pg8::Unit& u) const { return A + ((size_t)sb[u.e] + 256 * u.pm) * DEXP * 2; }
    __device__ __forceinline__ const char* b_base(const pg8::Unit& u) const { return B + ((size_t)u.e * DM + (size_t)u.pn * 256) * DEXP * 2; }
    __device__ __forceinline__ void a_off(const pg8::Unit&, int tid, unsigned (&v0)[2], unsigned (&v1)[2]) const {
        int R[2], C[2];
#pragma unroll
        for (int i = 0; i < 2; ++i) pg8::stage_rc(tid * 16 + i * 8192, R[i], C[i]);
#pragma unroll
        for (int i = 0; i < 2; ++i) { v0[i] = (unsigned)(R[i] * DEXP + C[i]) * 2u; v1[i] = v0[i] + 128u * DEXP * 2u; } }
};
struct EpiMoeDown {
    static constexpr bool PERM = true;
    bf16* YB; const int* list; const int* tinfo;
    __device__ __forceinline__ void operator()(const f32x4 (&acc)[2][2][4][2], const pg8::Unit& u, int wr, int wc, int fr, int fq) const {
        const int col0 = u.pn * 256 + wc * 32 + 8 * fq; const int* le = list + (size_t)u.e * NTOK + 256 * u.pm;
#pragma unroll
        for (int ai = 0; ai < 2; ++ai)
#pragma unroll
            for (int m = 0; m < 4; ++m) { const int r = ai * 128 + wr * 64 + m * 16 + fr;
                if (r < u.rows) { const int ent = le[r]; const float w = __int_as_float(tinfo[(ent >> 1) * 8 + 4 * (ent & 1) + 2]);
#pragma unroll
                    for (int bj = 0; bj < 2; ++bj) { const f32x4 v0 = acc[ai][bj][m][0] * w, v1 = acc[ai][bj][m][1] * w;
                        v4u o; o.x = cvt_pk_bf16(v0[0], v0[1]); o.y = cvt_pk_bf16(v0[2], v0[3]); o.z = cvt_pk_bf16(v1[0], v1[1]); o.w = cvt_pk_bf16(v1[2], v1[3]);
                        *(v4u*)(YB + (size_t)ent * DM + col0 + bj * 128) = o; } } }
    }
};
#define KSWZ(row, colB) ((row) * 256 + ((colB) ^ (((row) & 7) << 4)))
#define SBAR() __builtin_amdgcn_sched_barrier(0)
__device__ __forceinline__ int crow(int r, int hi) { return (r & 3) + 8 * (r >> 2) + 4 * hi; }
__device__ __forceinline__ void qkt64(f32x16& p0, f32x16& p1, const LAS char* Ks, const bf16x8* qr, int r32, int hi) {
    p0 = f32x16{}; p1 = f32x16{};
#pragma unroll
    for (int d0 = 0; d0 < 8; ++d0) { const int cb = (d0 * 16 + hi * 8) * 2;
        const bf16x8 b0 = *(const LAS bf16x8*)(Ks + KSWZ(r32, cb));
        const bf16x8 b1 = *(const LAS bf16x8*)(Ks + KSWZ(32 + r32, cb));
        p0 = __builtin_amdgcn_mfma_f32_32x32x16_bf16(b0, qr[d0], p0, 0, 0, 0);
        p1 = __builtin_amdgcn_mfma_f32_32x32x16_bf16(b1, qr[d0], p1, 0, 0, 0); }
}
__device__ __forceinline__ void qkt32(f32x16& p0, const LAS char* Ks, const bf16x8* qr, int r32, int hi) {
    p0 = f32x16{};
#pragma unroll
    for (int d0 = 0; d0 < 8; ++d0) { const int cb = (d0 * 16 + hi * 8) * 2;
        const bf16x8 b0 = *(const LAS bf16x8*)(Ks + KSWZ(r32, cb));
        p0 = __builtin_amdgcn_mfma_f32_32x32x16_bf16(b0, qr[d0], p0, 0, 0, 0); }
}
__device__ __forceinline__ int v_st(int k, int c) { const int kk = (k & ~0xC) | ((k & 4) << 1) | ((k & 8) >> 1); return ((kk >> 3) * 4 + (c >> 5)) * 512 + ((kk & 7) * 32 + (c & 31)) * 2; }
__device__ __forceinline__ int v_rd_base(int lane) { return ((lane & 3) << 3) | (((lane >> 2) & 3) << 6) | (((lane >> 4) & 1) << 5) | (((lane >> 5) & 1) << 8); }
constexpr int v_rd_off(int d0, int ks, int half) { return d0 * 512 + ks * 4096 + half * 2048; }
template <int OFF> __device__ __forceinline__ s16x4 tr_read(int vb) {
    s16x4 r; asm volatile("ds_read_b64_tr_b16 %0, %1 offset:%2" : "=&v"(r) : "v"(vb), "i"(OFF) : "memory"); return r;
}
__device__ __forceinline__ s16x4 tr_read_dyn(unsigned addr) { s16x4 r; asm volatile("ds_read_b64_tr_b16 %0, %1" : "=&v"(r) : "v"(addr) : "memory"); return r; }
template <int D0> __device__ __forceinline__ void pv_one(f32x16& od, int vb, bf16x8 pa0, bf16x8 pa1, bf16x8 pa2, bf16x8 pa3) {
    const s16x4 l0 = tr_read<v_rd_off(D0, 0, 0)>(vb), h0 = tr_read<v_rd_off(D0, 0, 1)>(vb), l1 = tr_read<v_rd_off(D0, 1, 0)>(vb), h1 = tr_read<v_rd_off(D0, 1, 1)>(vb);
    const s16x4 l2 = tr_read<v_rd_off(D0, 2, 0)>(vb), h2 = tr_read<v_rd_off(D0, 2, 1)>(vb), l3 = tr_read<v_rd_off(D0, 3, 0)>(vb), h3 = tr_read<v_rd_off(D0, 3, 1)>(vb);
    asm volatile("s_waitcnt lgkmcnt(0)" ::: "memory"); SBAR();
#define PKV(L, H) (bf16x8){L[0], L[1], L[2], L[3], H[0], H[1], H[2], H[3]}
    od = __builtin_amdgcn_mfma_f32_32x32x16_bf16(pa0, PKV(l0, h0), od, 0, 0, 0);
    od = __builtin_amdgcn_mfma_f32_32x32x16_bf16(pa1, PKV(l1, h1), od, 0, 0, 0);
    od = __builtin_amdgcn_mfma_f32_32x32x16_bf16(pa2, PKV(l2, h2), od, 0, 0, 0);
    od = __builtin_amdgcn_mfma_f32_32x32x16_bf16(pa3, PKV(l3, h3), od, 0, 0, 0);
}
template <int D0> __device__ __forceinline__ void pv_one_lo(f32x16& od, int vb, bf16x8 pa0, bf16x8 pa1) {
    const s16x4 l0 = tr_read<v_rd_off(D0, 0, 0)>(vb), h0 = tr_read<v_rd_off(D0, 0, 1)>(vb), l1 = tr_read<v_rd_off(D0, 1, 0)>(vb), h1 = tr_read<v_rd_off(D0, 1, 1)>(vb);
    asm volatile("s_waitcnt lgkmcnt(0)" ::: "memory"); SBAR();
    od = __builtin_amdgcn_mfma_f32_32x32x16_bf16(pa0, PKV(l0, h0), od, 0, 0, 0);
    od = __builtin_amdgcn_mfma_f32_32x32x16_bf16(pa1, PKV(l1, h1), od, 0, 0, 0);
}
__device__ __forceinline__ void pv_all(f32x16* o, int vb, bf16x8 pa0, bf16x8 pa1, bf16x8 pa2, bf16x8 pa3) {
    pv_one<0>(o[0], vb, pa0, pa1, pa2, pa3); pv_one<1>(o[1], vb, pa0, pa1, pa2, pa3); pv_one<2>(o[2], vb, pa0, pa1, pa2, pa3); pv_one<3>(o[3], vb, pa0, pa1, pa2, pa3);
}
#define PK4(P, BASE, OUT) do { unsigned a0_ = cvt_pk_bf16(P[BASE + 0], P[BASE + 1]), a1_ = cvt_pk_bf16(P[BASE + 2], P[BASE + 3]);   \
    unsigned b0_ = cvt_pk_bf16(P[BASE + 4], P[BASE + 5]), b1_ = cvt_pk_bf16(P[BASE + 6], P[BASE + 7]);                              \
    auto r0_ = __builtin_amdgcn_permlane32_swap(a0_, b0_, false, false); auto r1_ = __builtin_amdgcn_permlane32_swap(a1_, b1_, false, false); \
    v4u w_ = {r0_[0], r1_[0], r0_[1], r1_[1]}; OUT = *reinterpret_cast<bf16x8*>(&w_); } while (0)
__device__ __forceinline__ float pair_sum(float v) { auto rr = __builtin_amdgcn_permlane32_swap(__float_as_uint(v), __float_as_uint(v), false, false); return __uint_as_float(rr[0]) + __uint_as_float(rr[1]); }
__device__ __forceinline__ float pair_max(float v) { auto rr = __builtin_amdgcn_permlane32_swap(__float_as_uint(v), __float_as_uint(v), false, false); return fmaxf(__uint_as_float(rr[0]), __uint_as_float(rr[1])); }
__device__ __forceinline__ unsigned off_b(unsigned row, unsigned ch) { return 256u * row + 16u * (ch ^ (((row & 3) << 2) | ((row >> 2) & 3))); }
__device__ __forceinline__ unsigned trb_addr(unsigned lane, unsigned c, unsigned ks, unsigned t) {
    const unsigned h = lane >> 5, blk = (lane >> 4) & 1, q = (lane & 15) >> 2, p = lane & 3;
    return off_b(16 * ks + 8 * h + 4 * t + q, 4 * c + 2 * blk + (p >> 1)) + 8 * (p & 1);
}

constexpr int ML_TAB_OFF = LDSCTL_OFF + 2048;
struct MTabs { LAS float* sum; LAS float* g; LAS float* b; LAS float* pm; LAS float* mprev; LAS float* mend; };
__device__ __forceinline__ MTabs mtabs(const Frame& F) { MTabs T; T.sum = (LAS float*)(F.lds + ML_TAB_OFF); T.g = T.sum + 64; T.b = T.g + 256; T.pm = T.b + 256; T.mprev = T.pm + 256; T.mend = T.mprev + 4; return T; }
__device__ __forceinline__ float* gif_ptr(const Frame& F) { return (float*)(F.ws + WS_MSN + 512 * 1024); }
__device__ __forceinline__ void mchain(const Frame& F, int l, int bh, int cr, const MTabs& T) {
    const int b = bh >> 3, h = bh & 7, lane = fresh_lane(), nchunk = 4 * cr + 4;
    const float bi = arg_in(4)[l * NH + h], bfv = arg_in(5)[l * NH + h];
    const float* gif = gif_ptr(F);
    __syncthreads();
    for (int j = F.wave; j < nchunk; j += NWAVES) {
        const size_t row = (size_t)b * SEQ + 64 * j + lane;
        const float it = gif[row * 16 + h] + bi, lf = logsigmoidf_(gif[row * 16 + 8 + h] + bfv);
        float bc = lf;
#pragma unroll
        for (int o = 1; o < 64; o <<= 1) { const float t = __shfl_up(bc, o); bc += (lane >= o) ? t : 0.f; }
        const float g = it - bc; float pm = g;
#pragma unroll
        for (int o = 1; o < 64; o <<= 1) { const float t = __shfl_up(pm, o); pm = (lane >= o) ? fmaxf(pm, t) : pm; }
        if (lane == 63) { T.sum[2 * j] = bc; T.sum[2 * j + 1] = pm; }
        if (j >= 4 * cr) { const int ci = j - 4 * cr; T.g[ci * 64 + lane] = g; T.b[ci * 64 + lane] = bc; T.pm[ci * 64 + lane] = pm; }
    }
    __syncthreads();
    if ((F.wave * 64 + fresh_lane()) == 0) { float m = 0.f;
        for (int j = 0; j < nchunk; ++j) { const float me = fmaxf(m, T.sum[2 * j + 1]);
            if (j >= 4 * cr) { T.mprev[j - 4 * cr] = m; T.mend[j - 4 * cr] = me; }
            m = T.sum[2 * j] + me; } }
    __syncthreads();
}
__device__ __forceinline__ void conv8(const bf16* P, const float* cw, size_t row, int t, int col0, int ch0, float sc, float (&o)[8]) {
#pragma unroll
    for (int e = 0; e < 8; ++e) o[e] = 0.f;
#pragma unroll
    for (int j = 0; j < 4; ++j) { const int tt = t - 3 + j;
        if (tt >= 0) { const v4u x = *(const v4u*)(P + (row - 3 + j) * PW + col0); const f32x4 w0 = *(const f32x4*)(cw + j * 2048 + ch0), w1 = *(const f32x4*)(cw + j * 2048 + ch0 + 4);
            o[0] += w0.x * bflo(x.x); o[1] += w0.y * bfhi(x.x); o[2] += w0.z * bflo(x.y); o[3] += w0.w * bfhi(x.y);
            o[4] += w1.x * bflo(x.z); o[5] += w1.y * bfhi(x.z); o[6] += w1.z * bflo(x.w); o[7] += w1.w * bfhi(x.w); } }
#pragma unroll
    for (int e = 0; e < 8; ++e) o[e] = siluf_(o[e]) * sc;
}
__device__ __forceinline__ void ml_delta(const Frame& F, int l) {
    const bf16* P = (const bf16*)(F.ws + WS_PROJ); const float* cw = arg_in(3) + (size_t)l * 4 * 2048;
    float* DEL = (float*)(F.ws + WS_MDEL); float* DN = (float*)(F.ws + WS_MDN); float* DEC = DN + 32 * 32 * 128;
    const int wave = F.wave;
    const MTabs T = mtabs(F);
    for (int blk = F.vcu; blk < 256; blk += F.G) {
        const int tid = F.wave * 64 + fresh_lane();
        const int lane = tid & 63;
        const int bh = blk >> 3, cr = blk & 7, b = bh >> 3, h = bh & 7;
        mchain(F, l, bh, cr, T);
#pragma unroll 1
        for (int it = tid; it < 4 * 64 * 16; it += NTHR) { const int ci = it >> 10, s = (it >> 4) & 63, ch = it & 15, t = 64 * (4 * cr + ci) + s; const size_t row = (size_t)b * SEQ + t;
            float kv[8]; conv8(P, cw, row, t, C_MK + h * HD + 8 * ch, 1024 + h * HD + 8 * ch, 1.f, kv);
            v4u o; o.x = pk2(kv[0], kv[1]); o.y = pk2(kv[2], kv[3]); o.z = pk2(kv[4], kv[5]); o.w = pk2(kv[6], kv[7]);
            *(LAS v4u*)(F.lds + ci * 32768 + off_b(s, ch)) = o;
            const float ws = __expf(T.g[ci * 64 + s] - T.mend[ci]);
            const v4u x = *(const v4u*)(P + row * PW + C_MV + h * HD + 8 * ch);
            o.x = pk2(ws * bflo(x.x), ws * bfhi(x.x)); o.y = pk2(ws * bflo(x.y), ws * bfhi(x.y)); o.z = pk2(ws * bflo(x.z), ws * bfhi(x.z)); o.w = pk2(ws * bflo(x.w), ws * bfhi(x.w));
            *(LAS v4u*)(F.lds + ci * 32768 + 16384 + off_b(s, ch)) = o; }
        __syncthreads();
        const int vb = wave >> 1, kh = wave & 1, r32 = lane & 31, hi = lane >> 5;
        const unsigned ldsb = (unsigned)(size_t)F.lds;
#pragma unroll 1
        for (int ci = 0; ci < 4; ++ci) { const int c = 4 * cr + ci; if (c == NCH - 1) break;
            f32x16 a0 = {}, a1 = {};
#pragma unroll
            for (int ks = 0; ks < 4; ++ks) {
                const s16x4 al = tr_read_dyn(ldsb + ci * 32768 + 16384 + trb_addr(lane, vb, ks, 0)), ah = tr_read_dyn(ldsb + ci * 32768 + 16384 + trb_addr(lane, vb, ks, 1));
                const s16x4 bl0 = tr_read_dyn(ldsb + ci * 32768 + trb_addr(lane, 2 * kh, ks, 0)), bh0 = tr_read_dyn(ldsb + ci * 32768 + trb_addr(lane, 2 * kh, ks, 1));
                const s16x4 bl1 = tr_read_dyn(ldsb + ci * 32768 + trb_addr(lane, 2 * kh + 1, ks, 0)), bh1 = tr_read_dyn(ldsb + ci * 32768 + trb_addr(lane, 2 * kh + 1, ks, 1));
                asm volatile("s_waitcnt lgkmcnt(0)" ::: "memory"); SBAR();
                a0 = __builtin_amdgcn_mfma_f32_32x32x16_bf16(PKV(al, ah), PKV(bl0, bh0), a0, 0, 0, 0);
                a1 = __builtin_amdgcn_mfma_f32_32x32x16_bf16(PKV(al, ah), PKV(bl1, bh1), a1, 0, 0, 0); }
            float* dp = DEL + ((size_t)(bh * 32 + c) * 128) * 128;
#pragma unroll
            for (int r = 0; r < 16; ++r) { const int v = 32 * vb + crow(r, hi); dp[(size_t)v * 128 + 64 * kh + r32] = a0[r]; dp[(size_t)v * 128 + 64 * kh + 32 + r32] = a1[r]; }
        }
        { const int ci = tid >> 7, k = tid & 127, c = 4 * cr + ci;
          if (c < NCH - 1) { float a = 0.f; const float me = T.mend[ci];
              for (int s = 0; s < 64; ++s) a += __expf(T.g[ci * 64 + s] - me) * bf2f(*(const LAS unsigned short*)(F.lds + ci * 32768 + off_b(s, k >> 3) + 2 * (k & 7)));
              DN[(size_t)(bh * 32 + c) * 128 + k] = a;
              if (k == 0) DEC[bh * 32 + c] = __expf(T.mprev[ci] - me); } }
        __syncthreads();
    }
}
__device__ __forceinline__ void ml_scan(const Frame& F) {
    const float* DEL = (const float*)(F.ws + WS_MDEL); const float* DN = (const float*)(F.ws + WS_MDN); const float* DEC = DN + 32 * 32 * 128;
    bf16* ST = (bf16*)(F.ws + WS_MST); float* SN = (float*)(F.ws + WS_MSN);
    const int gt = F.vcu * NTHR + (F.wave * 64 + fresh_lane()), NT = F.G * NTHR;
    for (int e4 = gt; e4 < 32 * 4096; e4 += NT) { const int bh = e4 >> 12, q = e4 & 4095;
        f32x4 acc = {0.f, 0.f, 0.f, 0.f};
#pragma unroll 4
        for (int c = 0; c < NCH - 1; ++c) { const float d = DEC[bh * 32 + c]; const f32x4 x = *(const f32x4*)(DEL + ((size_t)(bh * 32 + c) * 4096 + q) * 4);
            acc = acc * d + x; v2u o; o.x = pk2(acc.x, acc.y); o.y = pk2(acc.z, acc.w); *(v2u*)(ST + ((size_t)(bh * 32 + c + 1) * 4096 + q) * 4) = o; } }
    for (int e = gt; e < 32 * 128; e += NT) { const int bh = e >> 7, k = e & 127; float acc = 0.f;
        for (int c = 0; c < NCH - 1; ++c) { acc = acc * DEC[bh * 32 + c] + DN[(size_t)(bh * 32 + c) * 128 + k]; SN[(size_t)(bh * 32 + c + 1) * 128 + k] = acc; } }
}
__device__ __forceinline__ void ml_out(const Frame& F, int l) {
    const bf16* P = (const bf16*)(F.ws + WS_PROJ); const float* cw = arg_in(3) + (size_t)l * 4 * 2048; bf16* BR = (bf16*)(F.ws + WS_BR);
    const bf16* ST = (const bf16*)(F.ws + WS_MST); const float* SN = (const float*)(F.ws + WS_MSN); const float* gain = arg_in(6) + (size_t)l * BW;
    const int wave = F.wave;
    const MTabs T = mtabs(F);
    LAS float* rowL = (LAS float*)(F.lds + ML_TAB_OFF + 4096) + wave * 32;
    for (int blk = F.vcu; blk < 256; blk += F.G) {
        const int tid = F.wave * 64 + fresh_lane();
        const int lane = tid & 63, r32 = lane & 31, hi = lane >> 5;
        const int bh = blk >> 3, cr = blk & 7, b = bh >> 3, h = bh & 7;
        mchain(F, l, bh, cr, T);
#pragma unroll 1
        for (int it = tid; it < 4 * 64 * 16; it += NTHR) { const int ci = it >> 10, s = (it >> 4) & 63, ch = it & 15, t = 64 * (4 * cr + ci) + s; const size_t row = (size_t)b * SEQ + t;
            float kv[8]; conv8(P, cw, row, t, C_MK + h * HD + 8 * ch, 1024 + h * HD + 8 * ch, 1.f, kv);
            v4u o; o.x = pk2(kv[0], kv[1]); o.y = pk2(kv[2], kv[3]); o.z = pk2(kv[4], kv[5]); o.w = pk2(kv[6], kv[7]);
            *(LAS v4u*)(F.lds + ci * 32768 + KSWZ(s, ch * 16)) = o;
            *(LAS v4u*)(F.lds + ci * 32768 + 16384 + v_st(s, ch * 8)) = *(const v4u*)(P + row * PW + C_MV + h * HD + 8 * ch); }
        __syncthreads();
        const int ci = wave >> 1, rh = wave & 1, c = 4 * cr + ci, tau = 32 * rh + r32, t = 64 * c + tau; const size_t row = (size_t)b * SEQ + t;
        bf16x8 qr[8];
#pragma unroll
        for (int d0 = 0; d0 < 8; ++d0) { float qv[8]; conv8(P, cw, row, t, C_MQ + h * HD + 16 * d0 + 8 * hi, h * HD + 16 * d0 + 8 * hi, 0.08838834764831845f, qv);
            v4u o; o.x = pk2(qv[0], qv[1]); o.y = pk2(qv[2], qv[3]); o.z = pk2(qv[4], qv[5]); o.w = pk2(qv[6], qv[7]); qr[d0] = *reinterpret_cast<bf16x8*>(&o); asm volatile("" ::: "memory"); }
        const float mprev = T.mprev[ci], Mt = fmaxf(mprev, T.pm[ci * 64 + tau]), winter = __expf(mprev - Mt), flo = __expf(-T.b[ci * 64 + tau] - Mt);
        const LAS char* Kc = (const LAS char*)(F.lds + ci * 32768);
        const int vbase = (int)(size_t)(F.lds + ci * 32768 + 16384) + v_rd_base(lane);
        f32x16 o[4] = {}; f32x16 p0, p1; float ps = 0.f; bf16x8 pa0, pa1, pa2, pa3;
        const LAS f32x4* g4 = (const LAS f32x4*)(T.g + ci * 64);
        if (rh == 0) { qkt32(p0, Kc, qr, r32, hi);
#pragma unroll
            for (int q = 0; q < 4; ++q) { const f32x4 gg = g4[2 * q + hi];
#pragma unroll
                for (int e = 0; e < 4; ++e) { const int r = 4 * q + e, s = crow(r, hi); const float wgt = (s <= tau) ? __expf(gg[e] - Mt) : 0.f; p0[r] *= wgt; ps += p0[r]; } }
            PK4(p0, 0, pa0); PK4(p0, 8, pa1);
            pv_one_lo<0>(o[0], vbase, pa0, pa1); pv_one_lo<1>(o[1], vbase, pa0, pa1); pv_one_lo<2>(o[2], vbase, pa0, pa1); pv_one_lo<3>(o[3], vbase, pa0, pa1);
        } else { qkt64(p0, p1, Kc, qr, r32, hi);
#pragma unroll
            for (int q = 0; q < 4; ++q) { const f32x4 gg = g4[2 * q + hi], gh = g4[8 + 2 * q + hi];
#pragma unroll
                for (int e = 0; e < 4; ++e) { const int r = 4 * q + e, s = crow(r, hi); p0[r] *= __expf(gg[e] - Mt); ps += p0[r];
                    const float wgt = (32 + s <= tau) ? __expf(gh[e] - Mt) : 0.f; p1[r] *= wgt; ps += p1[r]; } }
            PK4(p0, 0, pa0); PK4(p0, 8, pa1); PK4(p1, 0, pa2); PK4(p1, 8, pa3);
            pv_all(o, vbase, pa0, pa1, pa2, pa3);
        }
        ps = pair_sum(ps);
        float nq = 0.f;
        if (c > 0) {
            const bf16* Sc = ST + (size_t)(bh * 32 + c) * 16384; const float* nc = SN + (size_t)(bh * 32 + c) * 128;
#pragma unroll
            for (int ks = 0; ks < 8; ++ks) { const v4u qq = *reinterpret_cast<const v4u*>(&qr[ks]);
                const f32x4 n0 = *(const f32x4*)(nc + 16 * ks + 8 * hi), n1 = *(const f32x4*)(nc + 16 * ks + 8 * hi + 4);
                nq += bflo(qq.x) * n0.x + bfhi(qq.x) * n0.y + bflo(qq.y) * n0.z + bfhi(qq.y) * n0.w + bflo(qq.z) * n1.x + bfhi(qq.z) * n1.y + bflo(qq.w) * n1.z + bfhi(qq.w) * n1.w;
                v4u sq; sq.x = pk2(bflo(qq.x) * winter, bfhi(qq.x) * winter); sq.y = pk2(bflo(qq.y) * winter, bfhi(qq.y) * winter); sq.z = pk2(bflo(qq.z) * winter, bfhi(qq.z) * winter); sq.w = pk2(bflo(qq.w) * winter, bfhi(qq.w) * winter);
                const bf16x8 qs = *reinterpret_cast<const bf16x8*>(&sq);
#pragma unroll
                for (int d0 = 0; d0 < 4; ++d0) { const bf16x8 cf = *(const bf16x8*)(Sc + (size_t)(32 * d0 + r32) * 128 + 16 * ks + 8 * hi);
                    o[d0] = __builtin_amdgcn_mfma_f32_32x32x16_bf16(qs, cf, o[d0], 0, 0, 0); }
                asm volatile("" ::: "memory"); }
            nq = pair_sum(nq);
        }
        const float den = winter * nq + ps, rinv = 1.0f / fmaxf(fabsf(den), flo);
        if (hi == 0) rowL[r32] = rinv;
        LDS_WAIT(); asm volatile("" ::: "memory");
        float ss[16];
#pragma unroll
        for (int r = 0; r < 16; ++r) { const float ri = rowL[crow(r, hi)]; float a = 0.f;
#pragma unroll
            for (int d0 = 0; d0 < 4; ++d0) { o[d0][r] *= ri; a += o[d0][r] * o[d0][r]; }
            ss[r] = a; }
#pragma unroll
        for (int r = 0; r < 16; ++r) {
#pragma unroll
            for (int of = 1; of < 32; of <<= 1) ss[r] += __shfl_xor(ss[r], of);
            ss[r] = 1.0f / sqrtf(ss[r] * (1.f / HD) + EPS); }
        const size_t row0 = (size_t)b * SEQ + 64 * c + 32 * rh;
#pragma unroll
        for (int d0 = 0; d0 < 4; ++d0) { const int col = h * HD + 32 * d0 + r32; const float gn = gain[col];
#pragma unroll
            for (int r = 0; r < 16; ++r) { const size_t rr = row0 + crow(r, hi);
                const float og = sigmoidf_(bf2f(P[rr * PW + C_MO + col]));
                BR[rr * 3072 + col] = (bf16)f2bf(o[d0][r] * ss[r] * gn * og); }
            asm volatile("" ::: "memory"); }
        __syncthreads();
    }
}
__device__ __forceinline__ void dsa_index(const Frame& F) {
    const bf16* P = (const bf16*)(F.ws + WS_PROJ); unsigned long long* MK = (unsigned long long*)(F.ws + WS_MASK);
    LAS float* SL = (LAS float*)(F.lds + F.wave * 16384);
    const int gw = GW_ID(F), NGW = GW_N(F);
    for (int wu = gw; wu < 2048; wu += NGW) {
        const int lane = fresh_lane();
        const int m = lane & 31, hi = lane >> 5, qa = (m >> 2) & 1, head = (m & 3) + 4 * (m >> 3);
        const int b = wu >> 9, jj = wu & 511;
#pragma unroll 1
        for (int half = 0; half < 2; ++half) {
            const int tp = half ? 1023 - jj : jj, t0 = 2 * tp; const size_t rb = (size_t)b * SEQ;
            bf16x8 afr[4];
#pragma unroll
            for (int ks = 0; ks < 4; ++ks) afr[ks] = *(const bf16x8*)(P + (rb + t0 + qa) * PW + C_IQ + head * 64 + 16 * ks + 8 * hi);
            float wr[16];
            { const v4u w0 = *(const v4u*)(P + (rb + t0 + hi) * PW + C_IW), w1 = *(const v4u*)(P + (rb + t0 + hi) * PW + C_IW + 8);
              wr[0] = bflo(w0.x); wr[1] = bfhi(w0.x); wr[2] = bflo(w0.y); wr[3] = bfhi(w0.y); wr[4] = bflo(w0.z); wr[5] = bfhi(w0.z); wr[6] = bflo(w0.w); wr[7] = bfhi(w0.w);
              wr[8] = bflo(w1.x); wr[9] = bfhi(w1.x); wr[10] = bflo(w1.y); wr[11] = bfhi(w1.y); wr[12] = bflo(w1.z); wr[13] = bfhi(w1.z); wr[14] = bflo(w1.w); wr[15] = bfhi(w1.w);
#pragma unroll
              for (int r = 0; r < 16; ++r) wr[r] *= 0.03125f; }
            const int nkb = (t0 + 1) / 32 + 1;
#pragma unroll 2
            for (int kb = 0; kb < nkb; ++kb) {
                const bf16* kp = P + (rb + 32 * kb + m) * PW + C_IK + 8 * hi;
                f32x16 acc = {};
#pragma unroll
                for (int ks = 0; ks < 4; ++ks) acc = __builtin_amdgcn_mfma_f32_32x32x16_bf16(afr[ks], *(const bf16x8*)(kp + 16 * ks), acc, 0, 0, 0);
                float sc = 0.f;
#pragma unroll
                for (int r = 0; r < 16; ++r) sc += wr[r] * fmaxf(acc[r], 0.f);
                SL[hi * 2048 + 32 * kb + m] = sc;
            }
            LDS_WAIT(); asm volatile("" ::: "memory");
#pragma unroll 1
            for (int q = 0; q < 2; ++q) { const int t = t0 + q; unsigned key[32];
#pragma unroll
                for (int j = 0; j < 32; ++j) { const int s = lane + 64 * j; key[j] = (s <= t) ? fkey(SL[q * 2048 + s]) : 0u; }
                select_row(key, t + 1, MK + (rb + t) * 32, lane); }
            LDS_WAIT(); asm volatile("" ::: "memory");
        }
    }
}

struct KVRegs { v4u k0, k1, v0, v1; };
__device__ __forceinline__ void kv_load(KVRegs& R, const bf16* Kp, const bf16* Vp, size_t row0, int sr, int sc) {
    R.k0 = *(const v4u*)(Kp + (row0 + sr) * PW + sc); R.k1 = *(const v4u*)(Kp + (row0 + 32 + sr) * PW + sc);
    R.v0 = *(const v4u*)(Vp + (row0 + sr) * PW + sc); R.v1 = *(const v4u*)(Vp + (row0 + 32 + sr) * PW + sc);
}
__device__ __forceinline__ v4u knorm8(v4u x, const float (&kg)[8]) {
    float f[8] = {bflo(x.x), bfhi(x.x), bflo(x.y), bfhi(x.y), bflo(x.z), bfhi(x.z), bflo(x.w), bfhi(x.w)};
    float s = 0.f;
#pragma unroll
    for (int e = 0; e < 8; ++e) s += f[e] * f[e];
    s += __shfl_xor(s, 1); s += __shfl_xor(s, 2); s += __shfl_xor(s, 4); s += __shfl_xor(s, 8);
    const float r = 1.0f / sqrtf(s * (1.f / HD) + EPS);
    v4u o; o.x = pk2(f[0] * r * kg[0], f[1] * r * kg[1]); o.y = pk2(f[2] * r * kg[2], f[3] * r * kg[3]); o.z = pk2(f[4] * r * kg[4], f[5] * r * kg[5]); o.w = pk2(f[6] * r * kg[6], f[7] * r * kg[7]);
    return o;
}
template <bool NORM> __device__ __forceinline__ void kv_write(const KVRegs& R, LAS unsigned char* buf, int sr, int sc, const float (&kg)[8]) {
    *(LAS v4u*)(buf + KSWZ(sr, sc * 2)) = NORM ? knorm8(R.k0, kg) : R.k0; *(LAS v4u*)(buf + KSWZ(32 + sr, sc * 2)) = NORM ? knorm8(R.k1, kg) : R.k1;
    *(LAS v4u*)(buf + 16384 + v_st(sr, sc)) = R.v0; *(LAS v4u*)(buf + 16384 + v_st(32 + sr, sc)) = R.v1;
}
constexpr int AT_TAB_OFF = LDSCTL_OFF + 8192;

__device__ __forceinline__ void dsa_attn(const Frame& F, int l) {
    const bf16* P = (const bf16*)(F.ws + WS_PROJ); const unsigned long long* MK = (const unsigned long long*)(F.ws + WS_MASK); bf16* BR = (bf16*)(F.ws + WS_BR);
    const float* qg = arg_in(7) + l * HD; const float* kgp = arg_in(8) + l * HD; const float* rbias = arg_in(19);
    LAS float* biasL = (LAS float*)(F.lds + AT_TAB_OFF); LAS float* rowL = biasL + 128 + F.wave * 32;
    constexpr float C = 0.08838834764831845f * 1.4426950408889634f;
    for (int u = F.vcu; u < 256; u += F.G) {
        const int tid = F.wave * 64 + fresh_lane();
        const int lane = tid & 63, wave = F.wave, r32 = lane & 31, hi = lane >> 5, sr = tid >> 4, sc = (tid & 15) * 8;
        const int b = u >> 6, h = (u >> 3) & 7, qb = 7 - (u & 7), q0 = qb * 256, NT = 4 * (qb + 1); const size_t rb = (size_t)b * SEQ;
        __syncthreads();
        if (tid < 128) biasL[tid] = rbias[t5_bucket(tid) * NH + h] * 1.4426950408889634f;
        float kg[8];
#pragma unroll
        for (int e = 0; e < 8; ++e) kg[e] = kgp[sc + e];
        const int tq = q0 + 32 * wave + r32; bf16x8 qr[8];
        { v4u xs[8]; float s = 0.f;
#pragma unroll
          for (int d0 = 0; d0 < 8; ++d0) { const v4u x = *(const v4u*)(P + (rb + tq) * PW + C_DQ + h * HD + 16 * d0 + 8 * hi); xs[d0] = x;
              s += bflo(x.x) * bflo(x.x) + bfhi(x.x) * bfhi(x.x) + bflo(x.y) * bflo(x.y) + bfhi(x.y) * bfhi(x.y) + bflo(x.z) * bflo(x.z) + bfhi(x.z) * bfhi(x.z) + bflo(x.w) * bflo(x.w) + bfhi(x.w) * bfhi(x.w); }
          const float r = 1.0f / sqrtf(pair_sum(s) * (1.f / HD) + EPS);
#pragma unroll
          for (int d0 = 0; d0 < 8; ++d0) { const f32x4 g0 = *(const f32x4*)(qg + 16 * d0 + 8 * hi), g1 = *(const f32x4*)(qg + 16 * d0 + 8 * hi + 4); const v4u x = xs[d0];
              v4u o; o.x = pk2(bflo(x.x) * r * g0.x, bfhi(x.x) * r * g0.y); o.y = pk2(bflo(x.y) * r * g0.z, bfhi(x.y) * r * g0.w);
              o.z = pk2(bflo(x.z) * r * g1.x, bfhi(x.z) * r * g1.y); o.w = pk2(bflo(x.w) * r * g1.z, bfhi(x.w) * r * g1.w); qr[d0] = *reinterpret_cast<bf16x8*>(&o); } }
        const bf16* Kp = P + C_DK + h * HD; const bf16* Vp = P + C_DV + h * HD;
        KVRegs R; kv_load(R, Kp, Vp, rb, sr, sc); kv_write<true>(R, F.lds, sr, sc, kg);
        __syncthreads();
        float m_reg = -1e30f, l_reg = 0.f; f32x16 o[4] = {};
        const float b31 = biasL[127];
        for (int j = 0; j < NT; ++j) {
            LAS unsigned char* buf = F.lds + (j & 1) * 32768;
            if (j + 1 < NT) kv_load(R, Kp, Vp, rb + 64 * (j + 1), sr, sc);
            if (64 * j <= q0 + 32 * wave + 31) {
                const unsigned long long mw = MK[(rb + tq) * 32 + j]; const unsigned mlo = (unsigned)mw, mhi = (unsigned)(mw >> 32);
                f32x16 p0, p1; qkt64(p0, p1, (const LAS char*)buf, qr, r32, hi);
                const int rel0 = tq - 64 * j;
                const bool nearb = (q0 + 32 * wave - (64 * j + 63)) < 113;
                float pmax = -1e30f;
#pragma unroll
                for (int r = 0; r < 16; ++r) { const int kk = crow(r, hi);
                    float b0 = b31, b1 = b31;
                    if (nearb) { int i0 = rel0 - kk, i1 = rel0 - kk - 32; i0 = i0 < 0 ? 0 : (i0 > 127 ? 127 : i0); i1 = i1 < 0 ? 0 : (i1 > 127 ? 127 : i1); b0 = biasL[i0]; b1 = biasL[i1]; }
                    p0[r] = ((mlo >> kk) & 1u) ? fmaf(p0[r], C, b0) : -1e30f; p1[r] = ((mhi >> kk) & 1u) ? fmaf(p1[r], C, b1) : -1e30f;
                    pmax = fmaxf(pmax, fmaxf(p0[r], p1[r])); }
                pmax = pair_max(pmax);
                const float mn = fmaxf(m_reg, pmax), alpha = __builtin_amdgcn_exp2f(m_reg - mn); m_reg = mn;
                float ps = 0.f;
#pragma unroll
                for (int r = 0; r < 16; ++r) { const int kk = crow(r, hi);
                    p0[r] = ((mlo >> kk) & 1u) ? __builtin_amdgcn_exp2f(p0[r] - mn) : 0.f; p1[r] = ((mhi >> kk) & 1u) ? __builtin_amdgcn_exp2f(p1[r] - mn) : 0.f; ps += p0[r] + p1[r]; }
                l_reg = l_reg * alpha + pair_sum(ps);
                if (__any(alpha < 1.f)) { if (hi == 0) rowL[r32] = alpha; LDS_WAIT(); asm volatile("" ::: "memory");
#pragma unroll
                    for (int r = 0; r < 16; ++r) { const float a = rowL[crow(r, hi)];
#pragma unroll
                        for (int d = 0; d < 4; ++d) o[d][r] *= a; }
                    LDS_WAIT(); asm volatile("" ::: "memory"); }
                bf16x8 pa0, pa1, pa2, pa3; PK4(p0, 0, pa0); PK4(p0, 8, pa1); PK4(p1, 0, pa2); PK4(p1, 8, pa3);
                pv_all(o, (int)(size_t)(buf + 16384) + v_rd_base(lane), pa0, pa1, pa2, pa3);
            }
            if (j + 1 < NT) kv_write<true>(R, F.lds + ((j + 1) & 1) * 32768, sr, sc, kg);
            __syncthreads();
        }
        if (hi == 0) rowL[r32] = 1.0f / l_reg;
        LDS_WAIT(); asm volatile("" ::: "memory");
        const size_t row0 = rb + q0 + 32 * wave;
#pragma unroll
        for (int r = 0; r < 16; ++r) { const float a = rowL[crow(r, hi)]; bf16* op = BR + (row0 + crow(r, hi)) * 3072 + 1024 + h * HD + r32;
#pragma unroll
            for (int d = 0; d < 4; ++d) op[32 * d] = (bf16)f2bf(o[d][r] * a); }
    }
}

__device__ __forceinline__ void sb_attn(const Frame& F) {
    const bf16* P = (const bf16*)(F.ws + WS_PROJ); bf16* BR = (bf16*)(F.ws + WS_BR);
    LAS unsigned* flagL = (LAS unsigned*)(F.lds + AT_TAB_OFF + 2048);
    for (int u = F.vcu; u < 256; u += F.G) {
        const int tid = F.wave * 64 + fresh_lane();
        const int lane = tid & 63, wave = F.wave, r32 = lane & 31, hi = lane >> 5, sr = tid >> 4, sc = (tid & 15) * 8;
        const int b = u >> 6, h = (u >> 3) & 7, qb = u & 7, q0 = qb * 256, NT = 4 * (qb + 1); const size_t rb = (size_t)b * SEQ;
        const float kgd[8] = {1.f, 1.f, 1.f, 1.f, 1.f, 1.f, 1.f, 1.f};
        const int tq = q0 + 32 * wave + r32; bf16x8 qr[8];
#pragma unroll
        for (int d0 = 0; d0 < 8; ++d0) { const v4u x = *(const v4u*)(P + (rb + tq) * PW + C_SQ + h * HD + 16 * d0 + 8 * hi); const float s = 0.08838834764831845f;
            v4u o; o.x = pk2(bflo(x.x) * s, bfhi(x.x) * s); o.y = pk2(bflo(x.y) * s, bfhi(x.y) * s); o.z = pk2(bflo(x.z) * s, bfhi(x.z) * s); o.w = pk2(bflo(x.w) * s, bfhi(x.w) * s); qr[d0] = *reinterpret_cast<bf16x8*>(&o); }
        const bf16* Kp = P + C_SK + h * HD; const bf16* Vp = P + C_SV + h * HD;
        __syncthreads();
        KVRegs R; kv_load(R, Kp, Vp, rb + 64 * (NT - 1), sr, sc); kv_write<false>(R, F.lds, sr, sc, kgd);
        __syncthreads();
        float carry = 1.f; f32x16 o[4] = {};
        int it = 0;
        for (int j = NT - 1; j >= 0; --j, ++it) {
            LAS unsigned char* buf = F.lds + (it & 1) * 32768;
            if (j > 0) kv_load(R, Kp, Vp, rb + 64 * (j - 1), sr, sc);
            if (64 * j < q0 + 32 * wave + 31) {
                f32x16 p0, p1; qkt64(p0, p1, (const LAS char*)buf, qr, r32, hi);
                const int rel0 = tq - 64 * j;
                float To[8];
#pragma unroll
                for (int a = 0; a < 8; ++a) {
                    float n[4], sg[4];
#pragma unroll
                    for (int e = 0; e < 4; ++e) { const int r = 4 * (a & 3) + e, kk = crow(r, hi) + (a >= 4 ? 32 : 0);
                        float z = (a >= 4) ? p1[r] : p0[r]; z = fminf(fmaxf(z, -60.f), 60.f);
                        const float ex = __builtin_amdgcn_exp2f(-z * 1.4426950408889634f), s1 = __builtin_amdgcn_rcpf(1.f + ex);
                        const bool ok = kk < rel0; sg[e] = ok ? s1 : 0.f; n[e] = ok ? ex * s1 : 1.f; }
                    const float e2 = n[3], e1 = e2 * n[2], e0 = e1 * n[1]; To[a] = e0 * n[0];
                    if (a >= 4) { p1[4 * (a & 3) + 3] = sg[3]; p1[4 * (a & 3) + 2] = sg[2] * e2; p1[4 * (a & 3) + 1] = sg[1] * e1; p1[4 * (a & 3)] = sg[0] * e0; }
                    else { p0[4 * a + 3] = sg[3]; p0[4 * a + 2] = sg[2] * e2; p0[4 * a + 1] = sg[1] * e1; p0[4 * a] = sg[0] * e0; }
                }
                float run = carry;
#pragma unroll
                for (int a = 7; a >= 0; --a) { const float Tp = __shfl_xor(To[a], 32);
                    const float E = hi ? run : run * Tp; run = run * To[a] * Tp;
#pragma unroll
                    for (int e = 0; e < 4; ++e) { if (a >= 4) p1[4 * (a & 3) + e] *= E; else p0[4 * a + e] *= E; } }
                carry = run;
                bf16x8 pa0, pa1, pa2, pa3; PK4(p0, 0, pa0); PK4(p0, 8, pa1); PK4(p1, 0, pa2); PK4(p1, 8, pa3);
                pv_all(o, (int)(size_t)(buf + 16384) + v_rd_base(lane), pa0, pa1, pa2, pa3);
            }
            if (lane == 0) flagL[(it & 1) * 8 + wave] = __all(carry < 1e-30f) ? 1u : 0u;
            if (j > 0) kv_write<false>(R, F.lds + ((it + 1) & 1) * 32768, sr, sc, kgd);
            __syncthreads();
            unsigned done = 1u;
#pragma unroll
            for (int w = 0; w < 8; ++w) done &= flagL[(it & 1) * 8 + w];
            if (done) break;
        }
        const size_t row0 = rb + q0 + 32 * wave;
#pragma unroll
        for (int r = 0; r < 16; ++r) { bf16* op = BR + (row0 + crow(r, hi)) * 3072 + 2048 + h * HD + r32;
#pragma unroll
            for (int d = 0; d < 4; ++d) op[32 * d] = (bf16)f2bf(o[d][r]); }
    }
}
template <int LDA, int LDB> struct SchedDense {
    static constexpr bool GATHER = false;
    pg8::TileOrder T; const char* A; const char* B;
    __device__ __forceinline__ bool next(int i, pg8::Unit& u) const { u.e = 0; u.rows = 256; return T.tile(i, u.pm, u.pn); }
    __device__ __forceinline__ const char* a_base(const pg8::Unit& u) const { return A + (size_t)u.pm * 256 * LDA * 2; }
    __device__ __forceinline__ const char* b_base(const pg8::Unit& u) const { return B + (size_t)u.pn * 256 * LDB * 2; }
    __device__ __forceinline__ void a_off(const pg8::Unit&, int tid, unsigned (&v0)[2], unsigned (&v1)[2]) const {
        int R[2], C[2];
#pragma unroll
        for (int i = 0; i < 2; ++i) pg8::stage_rc(tid * 16 + i * 8192, R[i], C[i]);
#pragma unroll
        for (int i = 0; i < 2; ++i) { v0[i] = (unsigned)(R[i] * LDA + C[i]) * 2u; v1[i] = v0[i] + 128u * LDA * 2u; } }
};
struct EpiProj {
    static constexpr bool PERM = true;
    bf16* O; float* GIF;
    __device__ __forceinline__ void operator()(const f32x4 (&acc)[2][2][4][2], const pg8::Unit& u, int wr, int wc, int fr, int fq) const {
        const int row0 = u.pm * 256 + wr * 64 + fr, col0 = u.pn * 256 + wc * 32 + 8 * fq;
#pragma unroll
        for (int ai = 0; ai < 2; ++ai)
#pragma unroll
            for (int m = 0; m < 4; ++m) { bf16* rowp = O + (size_t)(row0 + ai * 128 + m * 16) * PW + col0;
#pragma unroll
                for (int bj = 0; bj < 2; ++bj) { const f32x4 v0 = acc[ai][bj][m][0], v1 = acc[ai][bj][m][1];
                    v4u w; w.x = cvt_pk_bf16(v0[0], v0[1]); w.y = cvt_pk_bf16(v0[2], v0[3]); w.z = cvt_pk_bf16(v1[0], v1[1]); w.w = cvt_pk_bf16(v1[2], v1[3]);
                    *(v4u*)(rowp + bj * 128) = w;
                    if (u.pn == PW / 256 - 1 && bj == 0 && wc == 0 && fq < 2) { float* gp = GIF + (size_t)(row0 + ai * 128 + m * 16) * 16 + 8 * fq; *(f32x4*)gp = v0; *(f32x4*)(gp + 4) = v1; } } }
    }
};
struct SchedBranch {
    static constexpr bool GATHER = false;
    pg8::TileOrder T; const char* A; const char* B;
    __device__ __forceinline__ bool next(int i, pg8::Unit& u) const { u.e = i % 3; u.rows = 256; return T.tile(i / 3, u.pm, u.pn); }
    __device__ __forceinline__ const char* a_base(const pg8::Unit& u) const { return A + ((size_t)u.pm * 256 * 3072 + (size_t)u.e * 1024) * 2; }
    __device__ __forceinline__ const char* b_base(const pg8::Unit& u) const { return B + ((size_t)u.e * 2048 + (size_t)u.pn * 256) * 1024 * 2; }
    __device__ __forceinline__ void a_off(const pg8::Unit&, int tid, unsigned (&v0)[2], unsigned (&v1)[2]) const {
        int R[2], C[2];
#pragma unroll
        for (int i = 0; i < 2; ++i) pg8::stage_rc(tid * 16 + i * 8192, R[i], C[i]);
#pragma unroll
        for (int i = 0; i < 2; ++i) { v0[i] = (unsigned)(R[i] * 3072 + C[i]) * 2u; v1[i] = v0[i] + 128u * 3072u * 2u; } }
};
struct EpiBranch {
    static constexpr bool PERM = true;
    const bf16* P; float* scr; bf16* O;
    __device__ __forceinline__ void operator()(const f32x4 (&acc)[2][2][4][2], const pg8::Unit& u, int wr, int wc, int fr, int fq) const {
        const int row0 = u.pm * 256 + wr * 64 + fr, col0 = u.pn * 256 + wc * 32 + 8 * fq;
#pragma unroll
        for (int ai = 0; ai < 2; ++ai)
#pragma unroll
            for (int m = 0; m < 4; ++m) { const size_t row = (size_t)(row0 + ai * 128 + m * 16);
#pragma unroll
                for (int bj = 0; bj < 2; ++bj) { const int col = col0 + bj * 128;
                    const v4u gw = *(const v4u*)(P + row * PW + C_G + u.e * 2048 + col);
                    f32x4 v0 = acc[ai][bj][m][0], v1 = acc[ai][bj][m][1];
                    v0[0] *= sigmoidf_(bflo(gw.x)); v0[1] *= sigmoidf_(bfhi(gw.x)); v0[2] *= sigmoidf_(bflo(gw.y)); v0[3] *= sigmoidf_(bfhi(gw.y));
                    v1[0] *= sigmoidf_(bflo(gw.z)); v1[1] *= sigmoidf_(bfhi(gw.z)); v1[2] *= sigmoidf_(bflo(gw.w)); v1[3] *= sigmoidf_(bfhi(gw.w));
                    float* sp = scr + row * DM + col;
                    if (u.e > 0) { v0 += *(const f32x4*)sp; v1 += *(const f32x4*)(sp + 4); }
                    if (u.e < 2) { *(f32x4*)sp = v0; *(f32x4*)(sp + 4) = v1; }
                    else { v4u w; w.x = cvt_pk_bf16(v0[0], v0[1]); w.y = cvt_pk_bf16(v0[2], v0[3]); w.z = cvt_pk_bf16(v1[0], v1[1]); w.w = cvt_pk_bf16(v1[2], v1[3]);
                        *(v4u*)(O + row * DM + col) = w; } } }
    }
};
struct EpiOut {
    static constexpr bool PERM = false;
    const float* base; float* out;
    __device__ __forceinline__ void operator()(const f32x4 (&acc)[2][2][4][2], const pg8::Unit& u, int wr, int wc, int fr, int fq) const {
        const int row0 = u.pm * 256 + wr * 64 + fr, col0 = u.pn * 256 + wc * 32 + 4 * fq;
#pragma unroll
        for (int ai = 0; ai < 2; ++ai)
#pragma unroll
            for (int m = 0; m < 4; ++m) { const size_t off = (size_t)(row0 + ai * 128 + m * 16) * DM + col0;
#pragma unroll
                for (int bj = 0; bj < 2; ++bj)
#pragma unroll
                    for (int n = 0; n < 2; ++n) { const f32x4 bs = *(const f32x4*)(base + off + bj * 128 + n * 16); *(f32x4*)(out + off + bj * 128 + n * 16) = bs + acc[ai][bj][m][n]; } }
    }
};

#ifndef MK_NAIVE_MOE
#define MK_NAIVE_MOE 0
#endif
#ifndef OFFMASK
#define OFFMASK 0
#endif
constexpr int PH_CONVW = 0, PH_NORM1 = 1, PH_INPROJ = 2, PH_NVCONV = 3, PH_NVMLSTM = 4, PH_NVMNORM = 5, PH_NVIDX = 6, PH_NVDSA = 7, PH_NVSB = 8,
              PH_BRANCH = 9, PH_OUT = 10, PH_NORM2 = 11, PH_MOE = 12, PH_MOED = 13, NPH_L = 14, PH_FINAL = DEPTH * NPH_L, NPH = PH_FINAL + 1;

__global__ void __launch_bounds__(NTHR, 2) fwd_kernel(Args args) {
    extern __shared__ __attribute__((aligned(16))) unsigned char lds_raw[];
    Frame F;
    F.lds = (LAS unsigned char*)lds_raw;
    F.wave = __builtin_amdgcn_readfirstlane((int)threadIdx.x >> 6);
    const int wave0 = F.wave;
    F.G = gridDim.x; { const int bx = blockIdx.x; F.vcu = (F.G % 8 == 0) ? (bx % 8) * (F.G / 8) + bx / 8 : bx; }
    F.ws = args.ws; F.ctl = (unsigned*)(args.ws + WS_CTL);
    volatile LAS unsigned* MISC = (volatile LAS unsigned*)(F.lds + LDSCTL_OFF);
    for (int u = threadIdx.x; u < (LDS_BYTES - LDSCTL_OFF) / 4; u += NTHR) ((LAS unsigned*)(F.lds + LDSCTL_OFF))[u] = 0u;
    __syncthreads();
    XcdBarrier bar; bar.bar = F.ctl + CW_BAR; bar.x = 0; bar.st = nullptr;
    if (args.use_bar) bar = xcd_barrier_post(F.ctl + CW_BAR, MISC + 8);
    const int lo = args.ph_lo, hi = args.ph_hi;
#define IN(k) (lo <= (k) && (k) < hi)
#define FRESH() do { F.wave = wave0; F.ws = arg_ws(); F.ctl = (unsigned*)(F.ws + WS_CTL); } while (0)
#define SEAM(k) do { if (args.use_bar && IN((k) + 1)) { FRESH(); xcd_barrier(bar, (F.wave * 64 + fresh_lane())); } } while (0)
    for (int l = 0; l < DEPTH; ++l) {
        const int p0 = l * NPH_L;
        if (IN(p0 + PH_CONVW)) { FRESH(); if (!(OFFMASK & (1<<0))) ph_convw(F, l); SEAM(p0 + PH_CONVW); }
        if (IN(p0 + PH_NORM1)) { FRESH(); if (!(OFFMASK & (1<<1))) ph_norm1(F, l); SEAM(p0 + PH_NORM1); }
        if (IN(p0 + PH_INPROJ)) {
            SchedDense<DM, DM> S; S.T.init(NTOK / 256, PW / 256, F.G, (int)blockIdx.x); S.A = (const char*)(F.ws + WS_XN); S.B = (const char*)(F.ws + WS_WIN);
            EpiProj E{(bf16*)(F.ws + WS_PROJ), gif_ptr(F)};
            if (!(OFFMASK & (1<<10))) pg8::gemm_phase<SchedDense<DM, DM>, EpiProj, DM, DM, DM, true>(F.lds, S, E, (F.wave * 64 + fresh_lane()));
            SEAM(p0 + PH_INPROJ);
        }
        if (IN(p0 + PH_NVCONV)) { FRESH(); if (!(OFFMASK & (1<<2))) ml_delta(F, l); SEAM(p0 + PH_NVCONV); }
        if (IN(p0 + PH_NVMLSTM)) { FRESH(); if (!(OFFMASK & (1<<3))) ml_scan(F); SEAM(p0 + PH_NVMLSTM); }
        if (IN(p0 + PH_NVMNORM)) { FRESH(); if (!(OFFMASK & (1<<4))) ml_out(F, l); SEAM(p0 + PH_NVMNORM); }
        if (IN(p0 + PH_NVIDX)) { FRESH(); if (!(OFFMASK & (1<<5))) dsa_index(F); SEAM(p0 + PH_NVIDX); }
        if (IN(p0 + PH_NVDSA)) { FRESH(); if (!(OFFMASK & (1<<6))) dsa_attn(F, l); SEAM(p0 + PH_NVDSA); }
        if (IN(p0 + PH_NVSB)) { FRESH(); if (!(OFFMASK & (1<<7))) sb_attn(F); SEAM(p0 + PH_NVSB); }
        if (IN(p0 + PH_BRANCH)) {
            SchedBranch S; S.T.init(NTOK / 256, DM / 256, F.G, (int)blockIdx.x); S.A = (const char*)(F.ws + WS_BR); S.B = (const char*)(F.ws + WS_WBR);
            EpiBranch E{(const bf16*)(F.ws + WS_PROJ), (float*)(F.ws + WS_X1), (bf16*)(F.ws + WS_MRG)};
            if (!(OFFMASK & (1<<11))) pg8::gemm_phase<SchedBranch, EpiBranch, BW, 3072, BW, true>(F.lds, S, E, (F.wave * 64 + fresh_lane()));
            SEAM(p0 + PH_BRANCH);
        }
        if (IN(p0 + PH_OUT)) {
            SchedDense<DM, DM> S; S.T.init(NTOK / 256, DM / 256, F.G, (int)blockIdx.x); S.A = (const char*)(F.ws + WS_MRG); S.B = (const char*)(F.ws + WS_WOUT);
            EpiOut E{l == 0 ? arg_in(0) : (const float*)(F.ws + WS_XA), (float*)(F.ws + WS_X1)};
            if (!(OFFMASK & (1<<12))) pg8::gemm_phase<SchedDense<DM, DM>, EpiOut, DM, DM, DM, true>(F.lds, S, E, (F.wave * 64 + fresh_lane()));
            SEAM(p0 + PH_OUT);
        }
        if (IN(p0 + PH_NORM2)) { FRESH(); if (!(OFFMASK & (1<<8))) ph_norm2(F, l); SEAM(p0 + PH_NORM2); }
        if (IN(p0 + PH_MOE)) { FRESH();
#if MK_NAIVE_MOE
            nv_moe(F);
#else
            moe_tables(F, l);
            SchedMoeUp S; S.tp = (const LAS int*)(F.lds + MOE_TAB_OFF); S.cn = S.tp + 40; S.sb = S.cn + 40; S.G = F.G; S.c = (int)blockIdx.x;
            S.A = (const char*)(F.ws + WS_XN); S.B = (const char*)(F.ws + WS_WGU); S.list = (const int*)(F.ws + WS_LIST);
            EpiMoeUp E{(bf16*)(F.ws + WS_HB), S.sb};
            if (!(OFFMASK & (1<<13))) pg8::gemm_phase<SchedMoeUp, EpiMoeUp, DM, DM, DM, true>(F.lds, S, E, (F.wave * 64 + fresh_lane()));
#endif
            SEAM(p0 + PH_MOE); }
        if (IN(p0 + PH_MOED)) { FRESH();
#if !MK_NAIVE_MOE
            moe_tables(F, l);
            SchedMoeDown S; S.tp = (const LAS int*)(F.lds + MOE_TAB_OFF); S.cn = S.tp + 40; S.sb = S.cn + 40; S.G = F.G; S.c = (int)blockIdx.x;
            S.A = (const char*)(F.ws + WS_HB); S.B = (const char*)(F.ws + WS_WDN);
            EpiMoeDown E{(bf16*)(F.ws + WS_YB), (const int*)(F.ws + WS_LIST), (const int*)tokinfo_ptr(F)};
            if (!(OFFMASK & (1<<14))) pg8::gemm_phase<SchedMoeDown, EpiMoeDown, DEXP, DEXP, DEXP, true>(F.lds, S, E, (F.wave * 64 + fresh_lane()));
#endif
            SEAM(p0 + PH_MOED); }
    }
    if (IN(PH_FINAL)) { FRESH(); } if (IN(PH_FINAL)) ph_final(F, args.out);
#undef IN
#undef SEAM
}

#ifndef MK_ONE_LAUNCH
#define MK_ONE_LAUNCH 1
#endif
extern "C" void kernel_launch(void* const* d_in, const int* in_sizes, int n_in, void* d_out, int out_size, void* d_ws, size_t ws_size, hipStream_t stream) {
    static int grid = 0;
    if (grid == 0) {
        if (n_in != 20 || in_sizes[0] != NTOK * DM || out_size != NTOK * DM || ws_size < WS_END) { fprintf(stderr, "kernel_launch: shape mismatch (n_in %d, ws %zu < %zu?)\n", n_in, ws_size, (size_t)WS_END); grid = -1; return; }
        int dev = 0, cus = 0, per_cu = 0;
        if (hipGetDevice(&dev) != hipSuccess || hipDeviceGetAttribute(&cus, hipDeviceAttributeMultiprocessorCount, dev) != hipSuccess) { grid = -1; return; }
        if (hipFuncSetAttribute((const void*)fwd_kernel, hipFuncAttributeMaxDynamicSharedMemorySize, LDS_BYTES) != hipSuccess) { fprintf(stderr, "kernel_launch: hipFuncSetAttribute failed\n"); grid = -1; return; }
        if (hipOccupancyMaxActiveBlocksPerMultiprocessor(&per_cu, (const void*)fwd_kernel, NTHR, LDS_BYTES) != hipSuccess || per_cu < 1) fprintf(stderr, "kernel_launch: occupancy query says %d\n", per_cu);
        (void)hipGetLastError();
        grid = cus;
    }
    if (grid < 0) return;
    if (hipMemsetAsync((char*)d_ws + WS_CTL, 0, CTL_ZERO_BYTES, stream) != hipSuccess) return;
    Args a{};
    for (int i = 0; i < 20; ++i) a.in[i] = (const float*)d_in[i];
    a.out = (float*)d_out; a.ws = (unsigned char*)d_ws;
#if MK_ONE_LAUNCH
    a.ph_lo = 0; a.ph_hi = NPH; a.use_bar = 1; a.pad = 0;
    hipLaunchKernelGGL(fwd_kernel, dim3(grid), dim3(NTHR), LDS_BYTES, stream, a);
#else
    for (int ph = 0; ph < NPH; ++ph) { a.ph_lo = ph; a.ph_hi = ph + 1; a.use_bar = 0; a.pad = 0;
        hipLaunchKernelGGL(fwd_kernel, dim3(grid), dim3(NTHR), LDS_BYTES, stream, a); }
#endif
    const hipError_t le = hipPeekAtLastError();
    if (le != hipSuccess) fprintf(stderr, "kernel_launch: launch failed: %s\n", hipGetErrorName(le));
}
```

```cpp
#define PROBE_MASK 0x0
#include <hip/hip_runtime.h>
#include <cstdio>
#include <cstdint>

constexpr int BATCH = 4, SEQ = 2048, DM = 2048, NTOK = BATCH * SEQ, NH = 8, HD = 128, BW = 1024, DEPTH = 2;
constexpr int NIN = 17504, PW = 17664;
constexpr int IDXH = 16, IDXD = 64, TOPK = 256, NEXP = 32, NGRP = 4, EPG = 8, DEXP = 512, MCH = 64, NCH = SEQ / MCH;
constexpr float EPS = 1e-6f;
constexpr int C_MQ = 0, C_MK = 1024, C_MV = 2048, C_MO = 3072, C_DQ = 4096, C_DK = 5120, C_DV = 6144, C_IQ = 7168, C_SQ = 8192, C_SK = 9216, C_SV = 10240,
              C_G = 11264, C_MI = 17408, C_MF = 17416, C_IK = 17424, C_IW = 17488;
__host__ __device__ __forceinline__ int src_col(int c) {
    if (c < 4096) return c;
    if (c < 8192) return c + 16;
    if (c < 17408) return c + 96;
    if (c < 17424) return 4096 + (c - 17408);
    if (c < 17488) return 8208 + (c - 17424);
    if (c < 17504) return 8272 + (c - 17488);
    return -1;
}

constexpr size_t MiB = 1u << 20;
constexpr size_t WS_CTL = 0, CTL_ZERO_BYTES = 1 * MiB;
constexpr size_t WS_WIN = 1 * MiB;
constexpr size_t WS_WBR = WS_WIN + 69 * MiB;
constexpr size_t WS_WOUT = WS_WBR + 12 * MiB;
constexpr size_t WS_WGU = WS_WOUT + 8 * MiB;
constexpr size_t WS_WDN = WS_WGU + 128 * MiB;
constexpr size_t WS_XN = WS_WDN + 64 * MiB;
constexpr size_t WS_XA = WS_XN + 32 * MiB;
constexpr size_t WS_X1 = WS_XA + 64 * MiB;
constexpr size_t WS_PROJ = WS_X1 + 64 * MiB;
constexpr size_t WS_BR = WS_PROJ + 276 * MiB;
constexpr size_t WS_MRG = WS_BR + 48 * MiB;
constexpr size_t WS_MASK = WS_MRG + 32 * MiB;
constexpr size_t WS_MDEL = WS_MASK + 2 * MiB;
constexpr size_t WS_MDN = WS_MDEL + 64 * MiB;
constexpr size_t WS_MST = WS_MDN + 1 * MiB;
constexpr size_t WS_MSN = WS_MST + 32 * MiB;
constexpr size_t WS_HB = WS_MSN + 1 * MiB;
constexpr size_t WS_YB = WS_HB + 16 * MiB;
constexpr size_t WS_LIST = WS_YB + 64 * MiB;
constexpr size_t WS_TMP = WS_LIST + 2 * MiB;
constexpr size_t WS_END = WS_TMP + 96 * MiB;
static_assert(WS_END <= 1100 * MiB, "workspace map");

constexpr int CW_BAR = 4096;
constexpr int CW_ECNT = 16384;

#define GAS __attribute__((address_space(1)))
#define LAS __attribute__((address_space(3)))
typedef unsigned short bf16;
typedef unsigned v4u __attribute__((ext_vector_type(4)));
typedef unsigned v2u __attribute__((ext_vector_type(2)));
typedef float f32x4 __attribute__((ext_vector_type(4)));
typedef float f32x2 __attribute__((ext_vector_type(2)));
typedef float f32x16 __attribute__((ext_vector_type(16)));
typedef short bf16x8 __attribute__((ext_vector_type(8)));
typedef short s16x4 __attribute__((ext_vector_type(4)));
#define RLX_AGENT __ATOMIC_RELAXED, __HIP_MEMORY_SCOPE_AGENT
#define LDS_WAIT() asm volatile("s_waitcnt lgkmcnt(0)" ::: "memory")
#define VM_WAIT() asm volatile("s_waitcnt vmcnt(0)" ::: "memory")
constexpr int NWAVES = 8, NTHR = 512;
constexpr int RING_BYTES = 131072, LDSCTL_OFF = RING_BYTES, LDS_BYTES = 147456;

__device__ __forceinline__ unsigned f2bf(float f) { unsigned u = __builtin_bit_cast(unsigned, f); return (u + 0x7fffu + ((u >> 16) & 1u)) >> 16; }
__device__ __forceinline__ unsigned pk2(float lo, float hi) { return f2bf(lo) | (f2bf(hi) << 16); }
__device__ __forceinline__ float bf2f(unsigned short b) { return __builtin_bit_cast(float, ((unsigned)b) << 16); }
__device__ __forceinline__ float bflo(unsigned w) { return __builtin_bit_cast(float, w << 16); }
__device__ __forceinline__ float bfhi(unsigned w) { return __builtin_bit_cast(float, w & 0xffff0000u); }
__device__ __forceinline__ unsigned cvt_pk_bf16(float lo, float hi) { unsigned r; asm volatile("v_cvt_pk_bf16_f32 %0, %1, %2" : "=v"(r) : "v"(lo), "v"(hi)); return r; }
__device__ __forceinline__ float wave_sum(float v) {
#pragma unroll
    for (int o = 1; o < 64; o <<= 1) v += __shfl_xor(v, o);
    return v;
}
__device__ __forceinline__ float wave_max(float v) {
#pragma unroll
    for (int o = 1; o < 64; o <<= 1) v = fmaxf(v, __shfl_xor(v, o));
    return v;
}
__device__ __forceinline__ float sigmoidf_(float x) { return 1.0f / (1.0f + __expf(-x)); }
__device__ __forceinline__ float siluf_(float x) { return x / (1.0f + __expf(-x)); }
__device__ __forceinline__ float logsigmoidf_(float x) { return fminf(x, 0.f) - log1pf(__expf(-fabsf(x))); }
__device__ __forceinline__ int t5_bucket(int n) {
    if (n < 16) return n;
    return 16 + (n >= 19) + (n >= 21) + (n >= 24) + (n >= 27) + (n >= 31) + (n >= 35) + (n >= 40) + (n >= 46) + (n >= 52) + (n >= 59) + (n >= 67) + (n >= 77) + (n >= 87) + (n >= 99) + (n >= 113);
}
namespace pg8 {
constexpr int BM = 256, BK = 64, HALF = 128, HTB = HALF * BK * 2, STAGE_BYTES = 8 * HTB, NXCD = 8, WGM = 8;
__host__ __device__ __forceinline__ int lds_byte(int r, int c) { const int st = (r >> 4) * 2 + (c >> 5), rr = r & 15, cc = c & 31, ob = rr * 64 + cc * 2; return st * 1024 + (ob ^ (((ob >> 9) & 1) << 5)); }
__host__ __device__ __forceinline__ void stage_rc(int b, int& R, int& C) { const int st = b / 1024, sb = b % 1024, swz = sb ^ (((sb >> 9) & 1) << 5); R = (st >> 1) * 16 + swz / 64; C = (st & 1) * 32 + (swz % 64) / 2; }
__host__ __device__ __forceinline__ int perm32(int rho) { const int n = rho >> 4, i = rho & 15; return 8 * (i >> 2) + 4 * n + (i & 3); }

struct Unit { int pm, pn, e, rows; };

struct TileOrder {
    int nM, nN, nwg, G, c;
    __device__ void init(int nM_, int nN_, int G_, int c_) { nM = nM_; nN = nN_; nwg = nM * nN; G = G_; c = c_; }
    __device__ bool tile(int i, int& pm, int& pn) const {
        const long L = (long)i * G + c; if (L >= nwg) return false;
        int wgid = (int)L; { const int q = nwg / NXCD, r = nwg % NXCD, xcd = wgid % NXCD, off = wgid / NXCD; wgid = (xcd < r ? xcd * (q + 1) : r * (q + 1) + (xcd - r) * q) + off; }
        const int nig = WGM * nN, gid = wgid / nig, fm = gid * WGM, gsz = (nM - fm) < WGM ? (nM - fm) : WGM;
        pm = fm + ((wgid % nig) % gsz); pn = (wgid % nig) / gsz; return true;
    }
};

template <class Sched, class Epi, int K, int LDA, int LDB, bool ALIGN_EPI>
__device__ __forceinline__ void gemm_phase(LAS unsigned char* lds, const Sched& S, const Epi& E, int tid_in) {
    int tid_ = tid_in; asm volatile("" : "+v"(tid_));
    const int tid = tid_, wid = __builtin_amdgcn_readfirstlane(tid >> 6), lane = tid & 63, wr = wid >> 2, wc = wid & 3, fr = lane & 15, fq = lane >> 4;
    constexpr int nt = K / BK;
    static_assert(K % 128 == 0 && K >= 256, "K");
    unsigned voffB[2];
#pragma unroll
    for (int i = 0; i < 2; ++i) { int R, C; stage_rc(tid * 16 + i * 8192, R, C); const int Rb = Epi::PERM ? ((R & ~31) + perm32(R & 31)) : R;
        voffB[i] = (unsigned)(Rb * LDB + C) * 2u; }
    constexpr size_t kstep = (size_t)(BK * 2);
    constexpr size_t hstepB = (size_t)HALF * LDB * 2;
    constexpr size_t hstepA = Sched::GATHER ? 0 : (size_t)HALF * LDA * 2;
    const unsigned ldsw = (unsigned)wid * 1024u;
    const int aoff = lds_byte(wr * 64 + fr, fq * 8), boff = lds_byte(wc * 32 + fr, fq * 8);
#define PG8_SA(b, h) (((b) * 2 + (h)) * HTB)
#define PG8_SB(b, h) ((4 + (b) * 2 + (h)) * HTB)
#define PG8_STAGE(bufoff, gbase, voff) do { _Pragma("unroll") for (int _i = 0; _i < 2; ++_i) \
        __builtin_amdgcn_global_load_lds((const unsigned*)((const char*)(gbase) + (voff)[_i]), (LAS unsigned*)(lds + (bufoff) + ldsw + _i * 8192), 16, 0, 0); } while (0)
#define PG8_LDA(dst, b, h) do { _Pragma("unroll") for (int m = 0; m < 4; ++m) _Pragma("unroll") for (int k = 0; k < 2; ++k) dst[m][k] = *(const LAS bf16x8*)(lds + PG8_SA(b, h) + aoff + m * 2048 + k * 1024); } while (0)
#define PG8_LDB(dst, b, h) do { _Pragma("unroll") for (int n = 0; n < 2; ++n) _Pragma("unroll") for (int k = 0; k < 2; ++k) dst[n][k] = *(const LAS bf16x8*)(lds + PG8_SB(b, h) + boff + n * 2048 + k * 1024); } while (0)
#define PG8_MMA(ai, bj, At, Bt) do { __builtin_amdgcn_s_setprio(1); _Pragma("unroll") for (int m = 0; m < 4; ++m) _Pragma("unroll") for (int n = 0; n < 2; ++n) _Pragma("unroll") for (int k = 0; k < 2; ++k) \
        acc[ai][bj][m][n] = __builtin_amdgcn_mfma_f32_16x16x32_bf16(Bt[n][k], At[m][k], acc[ai][bj][m][n], 0, 0, 0); __builtin_amdgcn_s_setprio(0); } while (0)
#define VA1 (Sched::GATHER ? vA1 : vA0)
#define W0 vA0
#define W1 VA1
#define PG8_WAIT_V(n) asm volatile("s_waitcnt vmcnt(" #n ")" ::: "memory")
#define PG8_WAIT_L(n) asm volatile("s_waitcnt lgkmcnt(" #n ")" ::: "memory")
#define PG8_BAR __builtin_amdgcn_s_barrier()
#define PG8_SCHED __builtin_amdgcn_sched_barrier(0)
    Unit cur, nxt; int ui = 0;
    if (!S.next(0, cur)) return;
    f32x4 acc[2][2][4][2];
#pragma unroll
    for (int a = 0; a < 2; ++a)
#pragma unroll
        for (int b = 0; b < 2; ++b)
#pragma unroll
            for (int m = 0; m < 4; ++m)
#pragma unroll
                for (int n = 0; n < 2; ++n) acc[a][b][m][n] = (f32x4){0.f, 0.f, 0.f, 0.f};
    bf16x8 At[4][2], B0[2][2], B1[2][2];
    unsigned vA0[2], vA1[2];
    S.a_off(cur, tid, vA0, vA1);
    const char* cA = S.a_base(cur); const char* cB = S.b_base(cur);
    PG8_STAGE(PG8_SB(0, 0), cB, voffB); PG8_STAGE(PG8_SB(0, 1), cB + hstepB, voffB); PG8_STAGE(PG8_SA(0, 0), cA, vA0); PG8_STAGE(PG8_SA(0, 1), cA + hstepA, VA1);
    if (wr == 1) PG8_BAR;
    PG8_WAIT_V(2); PG8_BAR;
    PG8_STAGE(PG8_SB(1, 0), cB + kstep, voffB); PG8_STAGE(PG8_SA(1, 0), cA + kstep, vA0); PG8_STAGE(PG8_SB(1, 1), cB + hstepB + kstep, voffB);
    PG8_WAIT_V(6); PG8_BAR;
    for (;;) {
        const bool has_next = S.next(ui + 1, nxt);
        const char* nA = has_next ? S.a_base(nxt) : cA; const char* nB = has_next ? S.b_base(nxt) : cB;
        for (int t = 0; t < nt; t += 2) {
            const bool last = (t == nt - 2);
            const char* a1 = cA + (size_t)(t + 1) * kstep;
            const char* a2 = last ? nA : cA + (size_t)(t + 2) * kstep; const char* b2 = last ? nB : cB + (size_t)(t + 2) * kstep;
            const char* a3 = a2 + kstep; const char* b3 = b2 + kstep;
            PG8_LDB(B0, 0, 0); PG8_LDB(B1, 0, 1); PG8_SCHED; PG8_LDA(At, 0, 0); PG8_STAGE(PG8_SA(1, 1), a1 + hstepA, VA1);
            if constexpr (Sched::GATHER) { if (last && has_next) S.a_off(nxt, tid, vA0, vA1); }
            PG8_WAIT_V(8); PG8_WAIT_L(0); PG8_BAR; PG8_MMA(0, 0, At, B0); PG8_MMA(0, 1, At, B1); PG8_BAR; PG8_SCHED;
            PG8_LDA(At, 0, 1); PG8_STAGE(PG8_SB(0, 0), b2, voffB); PG8_STAGE(PG8_SB(0, 1), b2 + hstepB, voffB); PG8_STAGE(PG8_SA(0, 0), a2, W0);
            PG8_WAIT_V(8); PG8_WAIT_L(0); PG8_BAR; PG8_MMA(1, 0, At, B0); PG8_MMA(1, 1, At, B1); PG8_BAR; PG8_SCHED;
            PG8_LDB(B0, 1, 0); PG8_LDB(B1, 1, 1); PG8_SCHED; PG8_LDA(At, 1, 0); PG8_STAGE(PG8_SA(0, 1), a2 + hstepA, W1);
            PG8_WAIT_V(8); PG8_WAIT_L(0); PG8_BAR; PG8_MMA(0, 0, At, B0); PG8_MMA(0, 1, At, B1); PG8_BAR; PG8_SCHED;
            PG8_LDA(At, 1, 1); PG8_STAGE(PG8_SB(1, 0), b3, voffB); PG8_STAGE(PG8_SB(1, 1), b3 + hstepB, voffB); PG8_STAGE(PG8_SA(1, 0), a3, W0);
            PG8_WAIT_V(8); PG8_WAIT_L(0); PG8_BAR; PG8_MMA(1, 0, At, B0); PG8_MMA(1, 1, At, B1); PG8_BAR; PG8_SCHED;
        }
        if constexpr (ALIGN_EPI) { if (wr == 0) PG8_BAR; }
        { int fr_e = fr, fq_e = fq; asm volatile("" : "+v"(fr_e), "+v"(fq_e));
          E(acc, cur, wr, wc, fr_e, fq_e); }
        if (!has_next) break;
#pragma unroll
        for (int a = 0; a < 2; ++a)
#pragma unroll
            for (int b = 0; b < 2; ++b)
#pragma unroll
                for (int m = 0; m < 4; ++m)
#pragma unroll
                    for (int n = 0; n < 2; ++n) acc[a][b][m][n] = (f32x4){0.f, 0.f, 0.f, 0.f};
        cur = nxt; cA = nA; cB = nB; ++ui;
        if constexpr (ALIGN_EPI) { if (wr == 1) PG8_BAR; }
    }
    PG8_WAIT_V(0);
    if constexpr (!ALIGN_EPI) { if (wr == 0) PG8_BAR; }
    PG8_BAR;
#undef PG8_SA
#undef VA1
#undef W0
#undef W1
#undef PG8_SB
#undef PG8_STAGE
#undef PG8_LDA
#undef PG8_LDB
#undef PG8_MMA
#undef PG8_WAIT_V
#undef PG8_WAIT_L
#undef PG8_BAR
#undef PG8_SCHED
}
}
#define XB_TMO      128
#define XB_XCNT(j)  (256  + 64 * (j))
#define XB_XSUB(j)  (1280 + 64 * (j))
#define XB_XGEN(j)  (2304 + 64 * (j))
#define XB_TOP      3328
#define XB_TOPGEN   3392
#define XCD_BAR_WORDS 3456
#define XB_SPIN_CAP (1u << 18)
__device__ __forceinline__ unsigned xb_ld(unsigned* p)              { return __hip_atomic_load(p, __ATOMIC_RELAXED, __HIP_MEMORY_SCOPE_AGENT); }
__device__ __forceinline__ unsigned xb_add(unsigned* p, unsigned v) { return __hip_atomic_fetch_add(p, v, __ATOMIC_RELAXED, __HIP_MEMORY_SCOPE_AGENT); }
__device__ __forceinline__ unsigned xb_xcc_id() { return (unsigned)__builtin_amdgcn_s_getreg((3 << 11) | 20) & 0xFu; }
#define XB_SPIN(cond, bar) do { unsigned _sp = 0; while (cond) { __builtin_amdgcn_s_sleep(1); \
    if ((++_sp & 255u) == 0u) { if (xb_ld(&(bar)[XB_TMO])) break; if (_sp > XB_SPIN_CAP) { atomicAdd(&(bar)[XB_TMO], 1u); break; } } } } while (0)
struct XcdBarrier { unsigned* bar; unsigned x; volatile LAS unsigned* st; };
__device__ __forceinline__ XcdBarrier xcd_barrier_post(unsigned* bar, volatile LAS unsigned* st) {
    XcdBarrier b; b.bar = bar; b.x = xb_xcc_id(); b.st = st;
    if (threadIdx.x == 0) (void)xb_add(&bar[XB_XCNT(b.x)], 1u);
    return b;
}
__device__ __forceinline__ void xcd_barrier_complete(unsigned* bar, unsigned x, unsigned& nloc, unsigned& nx) {
    const unsigned G = gridDim.x * gridDim.y * gridDim.z;
    unsigned sum, cnt, mine, sp = 0u;
    for (;;) {
        sum = 0u; cnt = 0u; mine = 0u;
#pragma unroll
        for (unsigned j = 0; j < 16; ++j) { const unsigned c = xb_ld(&bar[XB_XCNT(j)]); sum += c; cnt += (c > 0u) ? 1u : 0u; mine = (j == x) ? c : mine; }
        if (sum == G) break;
        __builtin_amdgcn_s_sleep(1);
        if ((++sp & 255u) == 0u) { if (xb_ld(&bar[XB_TMO])) break; if (sp > XB_SPIN_CAP) { atomicAdd(&bar[XB_TMO], 1u); break; } }
    }
    nloc = mine > 0u ? mine : 1u; nx = cnt > 0u ? cnt : 1u;
}
__device__ __forceinline__ void xcd_barrier(const XcdBarrier& b, int tid) {
    asm volatile("s_waitcnt vmcnt(0)" ::: "memory");
    __syncthreads();
    if (tid == 0) {
        unsigned* bar = b.bar; asm volatile("" : "+s"(bar));
        __builtin_amdgcn_s_waitcnt(0);
        unsigned nloc = b.st[0], nx = b.st[1];
        if (nloc == 0u) { xcd_barrier_complete(bar, b.x, nloc, nx); b.st[0] = nloc; b.st[1] = nx; }
        const unsigned old = xb_add(&bar[XB_XSUB(b.x)], 1u);
        const unsigned gen = old / nloc;
        if (old + 1u == (gen + 1u) * nloc) {
            __builtin_amdgcn_fence(__ATOMIC_RELEASE, "agent");
            asm volatile("s_waitcnt vmcnt(0)" ::: "memory");
            const unsigned og = xb_add(&bar[XB_TOP], 1u);
            const unsigned tg = og / nx;
            if (og + 1u == (tg + 1u) * nx) xb_add(&bar[XB_TOPGEN], 1u);
            else XB_SPIN(xb_ld(&bar[XB_TOPGEN]) == tg, bar);
            __builtin_amdgcn_fence(__ATOMIC_ACQUIRE, "agent");
            xb_add(&bar[XB_XGEN(b.x)], 1u);
            asm volatile("s_waitcnt vmcnt(0)" ::: "memory");
        } else {
            XB_SPIN(xb_ld(&bar[XB_XGEN(b.x)]) == gen, bar);
            __builtin_amdgcn_fence(__ATOMIC_ACQUIRE, "agent");
            asm volatile("s_waitcnt vmcnt(0)" ::: "memory");
        }
    }
    __syncthreads();
}

struct Args { const float* in[20]; float* out; unsigned char* ws; int ph_lo, ph_hi, use_bar; unsigned reps; };
struct Frame {
    LAS unsigned char* lds;
    unsigned* ctl;
    int wave, vcu, G;
    unsigned char* ws;
};
__device__ __forceinline__ int fresh_lane() { int l_; asm volatile("v_mbcnt_lo_u32_b32 %0, -1, 0\n\tv_mbcnt_hi_u32_b32 %0, -1, %0" : "=v"(l_)); return l_; }
__device__ __forceinline__ const float* arg_in(int i) { asm volatile("" : "+s"(i)); return ((const float* const __attribute__((address_space(4)))*)__builtin_amdgcn_kernarg_segment_ptr())[i]; }
__device__ __forceinline__ unsigned char* arg_ws() { int i = 21; asm volatile("" : "+s"(i)); return ((unsigned char* const __attribute__((address_space(4)))*)__builtin_amdgcn_kernarg_segment_ptr())[i]; }
#define GW_ID(F) ((F).vcu * NWAVES + (F).wave)
#define GW_N(F) ((F).G * NWAVES)

__device__ __forceinline__ void cvt_item(const float* W, int ldw, int k0, int srcc, bf16* WT, size_t out_row0, int ldo, LAS float* scr, int lane) {
#pragma unroll 8
    for (int i = 0; i < 32; ++i) { const int kk = 2 * i + (lane >> 5); scr[kk * 33 + (lane & 31)] = srcc >= 0 ? W[(size_t)(k0 + kk) * ldw + srcc] : 0.f; }
    LDS_WAIT(); asm volatile("" ::: "memory");
    const int c = lane & 7;
#pragma unroll
    for (int j = 0; j < 4; ++j) { const int n = (lane >> 3) + 8 * j; const LAS float* s = scr + (8 * c) * 33 + n;
        v4u o; o.x = pk2(s[0 * 33], s[1 * 33]); o.y = pk2(s[2 * 33], s[3 * 33]); o.z = pk2(s[4 * 33], s[5 * 33]); o.w = pk2(s[6 * 33], s[7 * 33]);
        *(v4u*)(WT + (out_row0 + n) * (size_t)ldo + k0 + 8 * c) = o; }
    LDS_WAIT(); asm volatile("" ::: "memory");
}
__device__ __forceinline__ void ph_convw(const Frame& F, int l) {
    LAS float* scr = (LAS float*)(F.lds + F.wave * 16384);
    const int gw = GW_ID(F), NGW = GW_N(F), lane = fresh_lane(), ln = lane & 31;
    constexpr int I_IN = (PW / 32) * 32, I_BR = 3 * 64 * 16, I_OUT = 64 * 32, I_G = 32 * 16 * 32, I_D = 32 * 64 * 8;
    constexpr int NITEMS = I_IN + I_BR + I_OUT + 2 * I_G + I_D;
    for (int it = gw; it < NITEMS; it += NGW) {
        int r = it;
        if (r < I_IN) { const int kb = r / (PW / 32), nb = r % (PW / 32);
            cvt_item(arg_in(2) + (size_t)l * DM * NIN, NIN, 64 * kb, src_col(32 * nb + ln), (bf16*)(F.ws + WS_WIN), (size_t)32 * nb, DM, scr, lane); continue; }
        r -= I_IN;
        if (r < I_BR) { const int n = r / (64 * 16), q = r % (64 * 16), kb = q / 64, nb = q % 64;
            cvt_item(arg_in(9) + ((size_t)l * 3 + n) * BW * DM, DM, 64 * kb, 32 * nb + ln, (bf16*)(F.ws + WS_WBR) + (size_t)n * DM * BW, (size_t)32 * nb, BW, scr, lane); continue; }
        r -= I_BR;
        if (r < I_OUT) { const int kb = r / 64, nb = r % 64;
            cvt_item(arg_in(10) + (size_t)l * DM * DM, DM, 64 * kb, 32 * nb + ln, (bf16*)(F.ws + WS_WOUT), (size_t)32 * nb, DM, scr, lane); continue; }
        r -= I_OUT;
        if (r < 2 * I_G) { const int up = r >= I_G; if (up) r -= I_G; const int e = r / (16 * 32), q = r % (16 * 32), kb = q / 16, nb = q % 16, f0 = 32 * nb;
            cvt_item(arg_in(up ? 17 : 16) + ((size_t)l * NEXP + e) * DM * DEXP, DEXP, 64 * kb, f0 + ln, (bf16*)(F.ws + WS_WGU) + (size_t)e * 1024 * DM,
                     (size_t)((f0 >> 7) * 256 + (up ? 128 : 0) + (f0 & 127)), DM, scr, lane); continue; }
        r -= 2 * I_G;
        { const int e = r / (64 * 8), q = r % (64 * 8), kb = q / 64, nb = q % 64;
            cvt_item(arg_in(18) + ((size_t)l * NEXP + e) * DEXP * DM, DM, 64 * kb, 32 * nb + ln, (bf16*)(F.ws + WS_WDN) + (size_t)e * DM * DEXP, (size_t)32 * nb, DEXP, scr, lane); }
    }
}

__device__ __forceinline__ int* tokinfo_ptr(const Frame& F) { return (int*)(F.ws + WS_LIST + MiB); }

__device__ __forceinline__ void ph_norm1(const Frame& F, int l) {
    const int gw = GW_ID(F), NGW = GW_N(F), lane = fresh_lane();
    const float* g = arg_in(1) + (size_t)l * DM;
    bf16* XN = (bf16*)(F.ws + WS_XN);
    for (int m = gw; m < NTOK; m += NGW) {
        f32x4 v[8]; float s = 0.f;
        if (l == 0) {
            const f32x4* xr = (const f32x4*)(arg_in(0) + (size_t)m * DM) + lane;
#pragma unroll
            for (int j = 0; j < 8; ++j) v[j] = xr[64 * j];
        } else {
            const f32x4* xr = (const f32x4*)((const float*)(F.ws + WS_X1) + (size_t)m * DM) + lane;
            const v2u* y0 = (const v2u*)((const bf16*)(F.ws + WS_YB) + (size_t)(2 * m) * DM) + lane;
            const v2u* y1 = (const v2u*)((const bf16*)(F.ws + WS_YB) + (size_t)(2 * m + 1) * DM) + lane;
            f32x4* xo = (f32x4*)((float*)(F.ws + WS_XA) + (size_t)m * DM) + lane;
#pragma unroll
            for (int j = 0; j < 8; ++j) { f32x4 x = xr[64 * j]; const v2u a = y0[64 * j], b = y1[64 * j];
                x.x = (x.x + bflo(a.x)) + bflo(b.x); x.y = (x.y + bfhi(a.x)) + bfhi(b.x); x.z = (x.z + bflo(a.y)) + bflo(b.y); x.w = (x.w + bfhi(a.y)) + bfhi(b.y);
                v[j] = x; xo[64 * j] = x; }
        }
#pragma unroll
        for (int j = 0; j < 8; ++j) s += (v[j].x * v[j].x + v[j].y * v[j].y) + (v[j].z * v[j].z + v[j].w * v[j].w);
        const float rstd = 1.0f / sqrtf(wave_sum(s) * (1.f / DM) + EPS);
        v2u* o8 = (v2u*)(XN + (size_t)m * DM) + lane;
        const f32x4* gr = (const f32x4*)g + lane;
#pragma unroll
        for (int j = 0; j < 8; ++j) { const f32x4 gg = gr[64 * j]; v2u o; o.x = pk2(v[j].x * rstd * gg.x, v[j].y * rstd * gg.y); o.y = pk2(v[j].z * rstd * gg.z, v[j].w * rstd * gg.w); o8[64 * j] = o; }
    }
}

__device__ __forceinline__ void ph_final(const Frame& F, float* out) {
    const int gw = GW_ID(F), NGW = GW_N(F), lane = fresh_lane();
    for (int m = gw; m < NTOK; m += NGW) {
        const f32x4* xr = (const f32x4*)((const float*)(F.ws + WS_X1) + (size_t)m * DM) + lane;
        const v2u* y0 = (const v2u*)((const bf16*)(F.ws + WS_YB) + (size_t)(2 * m) * DM) + lane;
        const v2u* y1 = (const v2u*)((const bf16*)(F.ws + WS_YB) + (size_t)(2 * m + 1) * DM) + lane;
        f32x4* xo = (f32x4*)(out + (size_t)m * DM) + lane;
#pragma unroll
        for (int j = 0; j < 8; ++j) { f32x4 x = xr[64 * j]; const v2u a = y0[64 * j], b = y1[64 * j];
            x.x = (x.x + bflo(a.x)) + bflo(b.x); x.y = (x.y + bfhi(a.x)) + bfhi(b.x); x.z = (x.z + bflo(a.y)) + bflo(b.y); x.w = (x.w + bfhi(a.y)) + bfhi(b.y);
            xo[64 * j] = x; }
    }
}

__device__ __forceinline__ void ph_norm2(const Frame& F, int l) {
    const int gw = GW_ID(F), NGW = GW_N(F), lane = fresh_lane();
    const float* g = arg_in(11) + (size_t)l * DM;
    const float* wrg = arg_in(12) + (size_t)l * DM * NGRP; const float* brg = arg_in(13) + l * NGRP;
    const float* wre = arg_in(14) + (size_t)l * DM * NEXP; const float* bre = arg_in(15) + l * NEXP;
    bf16* XN = (bf16*)(F.ws + WS_XN);
    int* list = (int*)(F.ws + WS_LIST); int* tinfo = tokinfo_ptr(F);
    unsigned* ecnt = F.ctl + CW_ECNT + l * NEXP * 64;
    for (int m = gw; m < NTOK; m += NGW) {
        f32x4 v[8]; float s = 0.f;
        const f32x4* xr = (const f32x4*)((const float*)(F.ws + WS_X1) + (size_t)m * DM) + lane;
#pragma unroll
        for (int j = 0; j < 8; ++j) { v[j] = xr[64 * j]; s += (v[j].x * v[j].x + v[j].y * v[j].y) + (v[j].z * v[j].z + v[j].w * v[j].w); }
        const float rstd = 1.0f / sqrtf(wave_sum(s) * (1.f / DM) + EPS);
        v2u* o8 = (v2u*)(XN + (size_t)m * DM) + lane;
        const f32x4* gr = (const f32x4*)g + lane;
#pragma unroll
        for (int j = 0; j < 8; ++j) { const f32x4 gg = gr[64 * j]; v2u o; o.x = pk2(v[j].x * rstd * gg.x, v[j].y * rstd * gg.y); o.y = pk2(v[j].z * rstd * gg.z, v[j].w * rstd * gg.w); o8[64 * j] = o; }
        float lg[36];
#pragma unroll
        for (int q = 0; q < 36; ++q) lg[q] = 0.f;
#pragma unroll 1
        for (int j = 0; j < 8; ++j) { const f32x4 gg = gr[64 * j], xx = xr[64 * j]; f32x4 x; x.x = xx.x * rstd * gg.x; x.y = xx.y * rstd * gg.y; x.z = xx.z * rstd * gg.z; x.w = xx.w * rstd * gg.w;
            const int k0 = 4 * lane + 256 * j;
#pragma unroll
            for (int c = 0; c < 4; ++c) { const float xv = x[c];
                const f32x4 wg = *(const f32x4*)(wrg + (size_t)(k0 + c) * NGRP);
                lg[0] += xv * wg.x; lg[1] += xv * wg.y; lg[2] += xv * wg.z; lg[3] += xv * wg.w;
                const f32x4* we = (const f32x4*)(wre + (size_t)(k0 + c) * NEXP);
#pragma unroll
                for (int q = 0; q < 8; ++q) { const f32x4 w = we[q]; lg[4 + 4 * q] += xv * w.x; lg[5 + 4 * q] += xv * w.y; lg[6 + 4 * q] += xv * w.z; lg[7 + 4 * q] += xv * w.w; } } }
#pragma unroll
        for (int q = 0; q < 36; ++q) lg[q] = wave_sum(lg[q]);
        LAS float* lgL = (LAS float*)(F.lds + F.wave * 256);
        if (lane == 0) {
#pragma unroll
            for (int q = 0; q < 36; ++q) lgL[q] = lg[q];
            int gs = 0; float best = lg[0] + brg[0];
#pragma unroll
            for (int q = 1; q < 4; ++q) { const float t = lg[q] + brg[q]; if (t > best) { best = t; gs = q; } }
            float gm = fmaxf(fmaxf(lg[0], lg[1]), fmaxf(lg[2], lg[3])), gsum = 0.f, gsel = 0.f;
#pragma unroll
            for (int q = 0; q < 4; ++q) { const float e = __expf(lg[q] - gm); gsum += e; gsel = (q == gs) ? e : gsel; }
            const float pg = gsel / gsum;
            LDS_WAIT(); asm volatile("" ::: "memory");
            float ein[8];
#pragma unroll
            for (int q = 0; q < 8; ++q) ein[q] = lgL[4 + gs * 8 + q];
            int e0 = 0, e1 = -1; float b0 = -3.0e38f, b1 = -3.0e38f;
#pragma unroll
            for (int q = 0; q < 8; ++q) { const float t = ein[q] + bre[gs * 8 + q];
                if (t > b0) { b1 = b0; e1 = e0; b0 = t; e0 = q; } else if (t > b1) { b1 = t; e1 = q; } }
            float em = ein[0];
#pragma unroll
            for (int q = 1; q < 8; ++q) em = fmaxf(em, ein[q]);
            float p0 = 0.f, p1 = 0.f;
#pragma unroll
            for (int q = 0; q < 8; ++q) { const float e = __expf(ein[q] - em); p0 = (q == e0) ? e : p0; p1 = (q == e1) ? e : p1; }
            const float w0 = pg * p0 / (p0 + p1), w1 = pg * p1 / (p0 + p1);
            const int x0 = gs * 8 + e0, x1 = gs * 8 + e1;
            const int pos0 = (int)atomicAdd(ecnt + x0 * 64, 1u), pos1 = (int)atomicAdd(ecnt + x1 * 64, 1u);
            list[x0 * NTOK + pos0] = 2 * m; list[x1 * NTOK + pos1] = 2 * m + 1;
            tinfo[m * 8 + 0] = x0; tinfo[m * 8 + 1] = pos0; tinfo[m * 8 + 2] = __float_as_int(w0); tinfo[m * 8 + 3] = 0;
            tinfo[m * 8 + 4] = x1; tinfo[m * 8 + 5] = pos1; tinfo[m * 8 + 6] = __float_as_int(w1); tinfo[m * 8 + 7] = 0;
        }
    }
}

__device__ __forceinline__ void nv_conv(const Frame& F, int l) {
    const bf16* P = (const bf16*)(F.ws + WS_PROJ); float* QK = (float*)(F.ws + WS_TMP);
    const float* cw = arg_in(3) + (size_t)l * 4 * 2048;
    const size_t total = (size_t)NTOK * 2048, stride = (size_t)F.G * NTHR;
    for (size_t i = (size_t)F.vcu * NTHR + (F.wave * 64 + fresh_lane()); i < total; i += stride) {
        const int row = (int)(i >> 11), c = (int)(i & 2047), t = row & (SEQ - 1);
        float a = 0.f;
#pragma unroll
        for (int j = 0; j < 4; ++j) { const int tt = t - 3 + j; if (tt >= 0) a += cw[j * 2048 + c] * bf2f(P[(size_t)(row - 3 + j) * PW + c]); }
        QK[i] = siluf_(a);
    }
}
__device__ __forceinline__ void nv_mlstm(const Frame& F, int l) {
    const bf16* P = (const bf16*)(F.ws + WS_PROJ); const float* QK = (const float*)(F.ws + WS_TMP); float* HR = (float*)(F.ws + WS_TMP + 64 * MiB);
    const int tid = (F.wave * 64 + fresh_lane()), v = tid >> 2, kq = tid & 3;
    for (int bh = F.vcu; bh < BATCH * NH; bh += F.G) {
        const int b = bh >> 3, h = bh & 7;
        const float bi = arg_in(4)[l * NH + h], bfv = arg_in(5)[l * NH + h];
        float C[32], nn[32], m = 0.f;
#pragma unroll
        for (int j = 0; j < 32; ++j) { C[j] = 0.f; nn[j] = 0.f; }
        for (int t = 0; t < SEQ; ++t) {
            const size_t row = (size_t)b * SEQ + t;
            const float it = bf2f(P[row * PW + C_MI + h]) + bi, ft = bf2f(P[row * PW + C_MF + h]) + bfv;
            const float lf = logsigmoidf_(ft);
            const float mn = fmaxf(lf + m, it), ip = __expf(it - mn), fp = __expf(lf + m - mn); m = mn;
            const float vv = bf2f(P[row * PW + C_MV + h * HD + v]);
            const f32x4* qp = (const f32x4*)(QK + row * 2048 + h * HD + kq * 32);
            const f32x4* kp = (const f32x4*)(QK + row * 2048 + 1024 + h * HD + kq * 32);
            float num = 0.f, den = 0.f;
#pragma unroll
            for (int j4 = 0; j4 < 8; ++j4) { const f32x4 q = qp[j4], k = kp[j4];
#pragma unroll
                for (int c = 0; c < 4; ++c) { const int j = 4 * j4 + c; const float qq = q[c] * 0.08838834764831845f;
                    C[j] = fp * C[j] + ip * vv * k[c]; nn[j] = fp * nn[j] + ip * k[c]; num += C[j] * qq; den += nn[j] * qq; } }
            num += __shfl_xor(num, 1); num += __shfl_xor(num, 2); den += __shfl_xor(den, 1); den += __shfl_xor(den, 2);
            if (kq == 0) HR[row * 1024 + h * HD + v] = num / fmaxf(fabsf(den), __expf(-m));
        }
    }
}
__device__ __forceinline__ void nv_mnorm(const Frame& F, int l) {
    const bf16* P = (const bf16*)(F.ws + WS_PROJ); const float* HR = (const float*)(F.ws + WS_TMP + 64 * MiB); bf16* BR = (bf16*)(F.ws + WS_BR);
    const float* g = arg_in(6) + (size_t)l * BW;
    const int gw = GW_ID(F), NGW = GW_N(F), lane = fresh_lane();
    for (int it = gw; it < NTOK * NH; it += NGW) {
        const size_t row = it >> 3; const int h = it & 7, c = h * HD + 2 * lane;
        const float a = HR[row * 1024 + c], b = HR[row * 1024 + c + 1];
        const float r = 1.0f / sqrtf(wave_sum(a * a + b * b) * (1.f / HD) + EPS);
        const float o0 = a * r * g[c] * sigmoidf_(bf2f(P[row * PW + C_MO + c])), o1 = b * r * g[c + 1] * sigmoidf_(bf2f(P[row * PW + C_MO + c + 1]));
        *(unsigned*)(BR + row * 3072 + c) = pk2(o0, o1);
    }
}
__device__ __forceinline__ unsigned fkey(float f) { const unsigned u = __float_as_uint(f); return (u & 0x80000000u) ? ~u : (u | 0x80000000u); }
__device__ __forceinline__ void select_row(const unsigned (&key)[32], int nvalid, unsigned long long* mrow, int lane) {
    if (nvalid <= TOPK) {
#pragma unroll
        for (int j = 0; j < 32; ++j) { const unsigned long long b = __ballot(lane + 64 * j < nvalid); if (lane == 0) mrow[j] = b; }
        return;
    }
    unsigned T = 0u;
    for (int bit = 31; bit >= 0; --bit) {
        const unsigned cand = T | (1u << bit); int c = 0;
#pragma unroll
        for (int j = 0; j < 32; ++j) c += (key[j] >= cand) ? 1 : 0;
#pragma unroll
        for (int o = 1; o < 64; o <<= 1) c += __shfl_xor(c, o);
        if (c >= TOPK) T = cand;
    }
    int cgt = 0;
#pragma unroll
    for (int j = 0; j < 32; ++j) cgt += (key[j] > T) ? 1 : 0;
#pragma unroll
    for (int o = 1; o < 64; o <<= 1) cgt += __shfl_xor(cgt, o);
    const int need = TOPK - cgt; int run = 0;
    const unsigned long long below = (lane == 0) ? 0ull : (~0ull >> (64 - lane));
#pragma unroll
    for (int j = 0; j < 32; ++j) {
        const bool eq = key[j] == T; const unsigned long long be = __ballot(eq);
        const int rank = run + __popcll(be & below);
        const bool sel = (key[j] > T) || (eq && rank < need);
        run += __popcll(be);
        const unsigned long long b = __ballot(sel); if (lane == 0) mrow[j] = b;
    }
}
__device__ __forceinline__ void nv_index(const Frame& F) {
    const bf16* P = (const bf16*)(F.ws + WS_PROJ); unsigned long long* MK = (unsigned long long*)(F.ws + WS_MASK);
    LAS float* iqL = (LAS float*)(F.lds + F.wave * 12288); LAS float* scL = iqL + 1024;
    const int gw = GW_ID(F), NGW = GW_N(F), lane = fresh_lane();
    for (int row = gw; row < NTOK; row += NGW) {
        const int t = row & (SEQ - 1), r0 = row - t;
        for (int i = lane; i < 1024; i += 64) iqL[i] = bf2f(P[(size_t)row * PW + C_IQ + i]);
        float w[16];
#pragma unroll
        for (int hh = 0; hh < 16; ++hh) w[hh] = bf2f(P[(size_t)row * PW + C_IW + hh]) * 0.25f;
        LDS_WAIT(); asm volatile("" ::: "memory");
        for (int s = lane; s <= t; s += 64) {
            float d[16];
#pragma unroll
            for (int hh = 0; hh < 16; ++hh) d[hh] = 0.f;
            const v4u* kp = (const v4u*)(P + (size_t)(r0 + s) * PW + C_IK);
#pragma unroll 1
            for (int hf = 0; hf < 2; ++hf) {
                float kr[32];
#pragma unroll
                for (int q = 0; q < 4; ++q) { const v4u x = kp[4 * hf + q]; kr[8 * q] = bflo(x.x); kr[8 * q + 1] = bfhi(x.x); kr[8 * q + 2] = bflo(x.y); kr[8 * q + 3] = bfhi(x.y); kr[8 * q + 4] = bflo(x.z); kr[8 * q + 5] = bfhi(x.z); kr[8 * q + 6] = bflo(x.w); kr[8 * q + 7] = bfhi(x.w); }
#pragma unroll
                for (int hh = 0; hh < 16; ++hh) {
#pragma unroll
                    for (int e = 0; e < 32; ++e) d[hh] += iqL[hh * 64 + hf * 32 + e] * kr[e]; }
            }
            float sc = 0.f;
#pragma unroll
            for (int hh = 0; hh < 16; ++hh) sc += w[hh] * fmaxf(d[hh] * 0.125f, 0.f);
            scL[s] = sc;
        }
        LDS_WAIT(); asm volatile("" ::: "memory");
        unsigned key[32];
#pragma unroll
        for (int j = 0; j < 32; ++j) { const int s = lane + 64 * j; key[j] = (s <= t) ? fkey(scL[s]) : 0u; }
        select_row(key, t + 1, MK + (size_t)row * 32, lane);
        LDS_WAIT(); asm volatile("" ::: "memory");
    }
}
__device__ __forceinline__ void nv_dsa(const Frame& F, int l) {
    const bf16* P = (const bf16*)(F.ws + WS_PROJ); const unsigned long long* MK = (const unsigned long long*)(F.ws + WS_MASK); bf16* BR = (bf16*)(F.ws + WS_BR);
    const float* qg = arg_in(7) + l * HD; const float* kg = arg_in(8) + l * HD; const float* rb = arg_in(19);
    LAS float* lgL = (LAS float*)(F.lds + F.wave * 2048); LAS int* ixL = (LAS int*)(lgL + 256);
    const int gw = GW_ID(F), NGW = GW_N(F), lane = fresh_lane();
    for (int it = gw; it < NTOK * NH; it += NGW) {
        const int row = it >> 3, h = it & 7, t = row & (SEQ - 1), r0 = row - t, c = h * HD + 2 * lane;
        float q0 = bf2f(P[(size_t)row * PW + C_DQ + c]), q1 = bf2f(P[(size_t)row * PW + C_DQ + c + 1]);
        const float qr = 1.0f / sqrtf(wave_sum(q0 * q0 + q1 * q1) * (1.f / HD) + EPS);
        q0 *= qr * qg[2 * lane]; q1 *= qr * qg[2 * lane + 1];
        const float kg0 = kg[2 * lane], kg1 = kg[2 * lane + 1];
        int cnt = 0; float mx = -3.0e38f;
        for (int wi = 0; wi <= (t >> 6); ++wi) {
            unsigned long long w = MK[(size_t)row * 32 + wi];
            while (w) { const int s = wi * 64 + __builtin_ctzll(w); w &= w - 1;
                const unsigned kk = *(const unsigned*)(P + (size_t)(r0 + s) * PW + C_DK + c);
                const float k0 = bflo(kk), k1 = bfhi(kk);
                const float ss = wave_sum(k0 * k0 + k1 * k1), dd = wave_sum(q0 * k0 * kg0 + q1 * k1 * kg1);
                const float kr = 1.0f / sqrtf(ss * (1.f / HD) + EPS);
                const float lgt = dd * kr * 0.08838834764831845f + rb[t5_bucket(t - s) * NH + h];
                if (lane == 0) { lgL[cnt] = lgt; ixL[cnt] = s; }
                mx = fmaxf(mx, lgt); ++cnt; }
        }
        LDS_WAIT(); asm volatile("" ::: "memory");
        float o0 = 0.f, o1 = 0.f, den = 0.f;
        for (int j = 0; j < cnt; ++j) { const float p = __expf(lgL[j] - mx); const int s = ixL[j];
            const unsigned vv = *(const unsigned*)(P + (size_t)(r0 + s) * PW + C_DV + c);
            o0 += p * bflo(vv); o1 += p * bfhi(vv); den += p; }
        *(unsigned*)(BR + (size_t)row * 3072 + 1024 + c) = pk2(o0 / den, o1 / den);
        LDS_WAIT(); asm volatile("" ::: "memory");
    }
}
__device__ __forceinline__ void nv_sb(const Frame& F) {
    const bf16* P = (const bf16*)(F.ws + WS_PROJ); bf16* BR = (bf16*)(F.ws + WS_BR);
    const int gw = GW_ID(F), NGW = GW_N(F), lane = fresh_lane();
    for (int it = gw; it < NTOK * NH; it += NGW) {
        const int row = it >> 3, h = it & 7, t = row & (SEQ - 1), r0 = row - t, c = h * HD + 2 * lane;
        const unsigned qq = *(const unsigned*)(P + (size_t)row * PW + C_SQ + c);
        const float q0 = bflo(qq) * 0.08838834764831845f, q1 = bfhi(qq) * 0.08838834764831845f;
        float o0 = 0.f, o1 = 0.f, lp = 0.f;
        for (int s = t - 1; s >= 0; --s) {
            const unsigned kk = *(const unsigned*)(P + (size_t)(r0 + s) * PW + C_SK + c);
            const float z = wave_sum(q0 * bflo(kk) + q1 * bfhi(kk));
            const float a = __expf(logsigmoidf_(z) + lp);
            const unsigned vv = *(const unsigned*)(P + (size_t)(r0 + s) * PW + C_SV + c);
            o0 += a * bflo(vv); o1 += a * bfhi(vv);
            lp += logsigmoidf_(-z);
            if (lp < -80.f) break;
        }
        *(unsigned*)(BR + (size_t)row * 3072 + 2048 + c) = pk2(o0, o1);
    }
}
__device__ __forceinline__ void nv_moe(const Frame& F) {
    const bf16* XN = (const bf16*)(F.ws + WS_XN); bf16* YB = (bf16*)(F.ws + WS_YB); const int* tinfo = tokinfo_ptr(F);
    LAS float* xL = (LAS float*)F.lds; LAS float* hL = xL + 2048;
    const int tid = (F.wave * 64 + fresh_lane());
    for (int slot = F.vcu; slot < 2 * NTOK; slot += F.G) {
        const int m = slot >> 1, k = slot & 1; const int e = tinfo[m * 8 + 4 * k]; const float w = __int_as_float(tinfo[m * 8 + 4 * k + 2]);
        __syncthreads();
        for (int i = tid; i < 2048; i += NTHR) xL[i] = bf2f(XN[(size_t)m * DM + i]);
        __syncthreads();
        { const int f = tid; const bf16* wg = (const bf16*)(F.ws + WS_WGU) + ((size_t)e * 1024 + (f >> 7) * 256 + (f & 127)) * DM; const bf16* wu = wg + (size_t)128 * DM;
          float g = 0.f, u = 0.f;
          for (int k8 = 0; k8 < 256; ++k8) { const v4u a = ((const v4u*)wg)[k8], b = ((const v4u*)wu)[k8]; const LAS float* x = xL + 8 * k8;
              g += x[0] * bflo(a.x) + x[1] * bfhi(a.x) + x[2] * bflo(a.y) + x[3] * bfhi(a.y) + x[4] * bflo(a.z) + x[5] * bfhi(a.z) + x[6] * bflo(a.w) + x[7] * bfhi(a.w);
              u += x[0] * bflo(b.x) + x[1] * bfhi(b.x) + x[2] * bflo(b.y) + x[3] * bfhi(b.y) + x[4] * bflo(b.z) + x[5] * bfhi(b.z) + x[6] * bflo(b.w) + x[7] * bfhi(b.w); }
          hL[f] = bf2f((unsigned short)f2bf(siluf_(g) * u)); }
        __syncthreads();
        { float y[4];
#pragma unroll
          for (int c = 0; c < 4; ++c) { const int d = 4 * tid + c; const bf16* wd = (const bf16*)(F.ws + WS_WDN) + ((size_t)e * DM + d) * DEXP; float a = 0.f;
              for (int k8 = 0; k8 < 64; ++k8) { const v4u x = ((const v4u*)wd)[k8]; const LAS float* hh = hL + 8 * k8;
                  a += hh[0] * bflo(x.x) + hh[1] * bfhi(x.x) + hh[2] * bflo(x.y) + hh[3] * bfhi(x.y) + hh[4] * bflo(x.z) + hh[5] * bfhi(x.z) + hh[6] * bflo(x.w) + hh[7] * bfhi(x.w); }
              y[c] = a * w; }
          v2u o; o.x = pk2(y[0], y[1]); o.y = pk2(y[2], y[3]); *(v2u*)(YB + (size_t)slot * DM + 4 * tid) = o; }
    }
}
constexpr int MOE_TAB_OFF = LDSCTL_OFF + 1024;
__device__ __forceinline__ void moe_tables(const Frame& F, int l) {
    LAS int* tp = (LAS int*)(F.lds + MOE_TAB_OFF); LAS int* cn = tp + 40; LAS int* sb = cn + 40;
    __syncthreads();
    if ((F.wave * 64 + fresh_lane()) == 0) { int p = 0, s = 0;
        for (int e = 0; e < NEXP; ++e) { const int c = (int)__hip_atomic_load(F.ctl + CW_ECNT + (l * NEXP + e) * 64, RLX_AGENT); tp[e] = p; cn[e] = c; sb[e] = s; p += (c + 255) >> 8; s += c; }
        tp[NEXP] = p; sb[NEXP] = s; }
    __syncthreads();
}
template <int NT> struct SchedMoeBase {
    const LAS int* tp; const LAS int* cn; const LAS int* sb; int G, c;
    __device__ __forceinline__ bool next(int i, pg8::Unit& u) const {
        const int L = i * G + c, total = tp[NEXP] * NT; if (L >= total) return false;
        const int mt = L / NT; u.pn = L % NT; int e = 0;
#pragma unroll 1
        for (int q = 1; q < NEXP; ++q) e = (tp[q] <= mt) ? q : e;
        u.e = e; u.pm = mt - tp[e]; const int r = cn[e] - 256 * u.pm; u.rows = r < 256 ? r : 256; return true;
    }
};
struct SchedMoeUp : SchedMoeBase<4> {
    static constexpr bool GATHER = true;
    const char* A; const char* B; const int* list;
    __device__ __forceinline__ const char* a_base(const pg8::Unit&) const { return A; }
    __device__ __forceinline__ const char* b_base(const pg8::Unit& u) const { return B + ((size_t)u.e * 1024 + (size_t)u.pn * 256) * DM * 2; }
    __device__ __forceinline__ void a_off(const pg8::Unit& u, int tid, unsigned (&v0)[2], unsigned (&v1)[2]) const {
        int R[2], C[2];
#pragma unroll
        for (int i = 0; i < 2; ++i) pg8::stage_rc(tid * 16 + i * 8192, R[i], C[i]);
        const int* le = list + (size_t)u.e * NTOK + 256 * u.pm;
#pragma unroll
        for (int i = 0; i < 2; ++i) { int r0 = R[i], r1 = R[i] + 128; r0 = r0 < u.rows ? r0 : u.rows - 1; r1 = r1 < u.rows ? r1 : u.rows - 1;
            const int t0 = le[r0] >> 1, t1 = le[r1] >> 1;
            v0[i] = (unsigned)(t0 * DM + C[i]) * 2u; v1[i] = (unsigned)(t1 * DM + C[i]) * 2u; }
    }
};
struct EpiMoeUp {
    static constexpr bool PERM = true;
    bf16* HB; const LAS int* sb;
    __device__ __forceinline__ void operator()(const f32x4 (&acc)[2][2][4][2], const pg8::Unit& u, int wr, int wc, int fr, int fq) const {
        const int col0 = u.pn * 128 + wc * 32 + 8 * fq; const size_t slot0 = (size_t)sb[u.e] + 256 * u.pm;
#pragma unroll
        for (int ai = 0; ai < 2; ++ai)
#pragma unroll
            for (int m = 0; m < 4; ++m) { const int r = ai * 128 + wr * 64 + m * 16 + fr;
                if (r < u.rows) { const f32x4 g0 = acc[ai][0][m][0], g1 = acc[ai][0][m][1], u0 = acc[ai][1][m][0], u1 = acc[ai][1][m][1];
                    v4u w; w.x = cvt_pk_bf16(siluf_(g0[0]) * u0[0], siluf_(g0[1]) * u0[1]); w.y = cvt_pk_bf16(siluf_(g0[2]) * u0[2], siluf_(g0[3]) * u0[3]);
                    w.z = cvt_pk_bf16(siluf_(g1[0]) * u1[0], siluf_(g1[1]) * u1[1]); w.w = cvt_pk_bf16(siluf_(g1[2]) * u1[2], siluf_(g1[3]) * u1[3]);
                    *(v4u*)(HB + (slot0 + r) * DEXP + col0) = w; } }
    }
};
struct SchedMoeDown : SchedMoeBase<8> {
    static constexpr bool GATHER = false;
    const char* A; const char* B;
    __device__ __forceinline__ const char* a_base(const pg8::Unit& u) const { return A + ((size_t)sb[u.e] + 256 * u.pm) * DEXP * 2; }
    __device__ __forceinline__ const char* b_base(const pg8::Unit& u) const { return B + ((size_t)u.e * DM + (size_t)u.pn * 256) * DEXP * 2; }
    __device__ __forceinline__ void a_off(const pg8::Unit&, int tid, unsigned (&v0)[2], unsigned (&v1)[2]) const {
        int R[2], C[2];
#pragma unroll
        for (int i = 0; i < 2; ++i) pg8::stage_rc(tid * 16 + i * 8192, R[i], C[i]);
#pragma unroll
        for (int i = 0; i < 2; ++i) { v0[i] = (unsigned)(R[i] * DEXP + C[i]) * 2u; v1[i] = v0[i] + 128u * DEXP * 2u; } }
};
struct EpiMoeDown {
    static constexpr bool PERM = true;
    bf16* YB; const int* list; const int* tinfo;
    __device__ __forceinline__ void operator()(const f32x4 (&acc)[2][2][4][2], const pg8::Unit& u, int wr, int wc, int fr, int fq) const {
        const int col0 = u.pn * 256 + wc * 32 + 8 * fq; const int* le = list + (size_t)u.e * NTOK + 256 * u.pm;
#pragma unroll
        for (int ai = 0; ai < 2; ++ai)
#pragma unroll
            for (int m = 0; m < 4; ++m) { const int r = ai * 128 + wr * 64 + m * 16 + fr;
                if (r < u.rows) { const int ent = le[r]; const float w = __int_as_float(tinfo[(ent >> 1) * 8 + 4 * (ent & 1) + 2]);
#pragma unroll
                    for (int bj = 0; bj < 2; ++bj) { const f32x4 v0 = acc[ai][bj][m][0] * w, v1 = acc[ai][bj][m][1] * w;
                        v4u o; o.x = cvt_pk_bf16(v0[0], v0[1]); o.y = cvt_pk_bf16(v0[2], v0[3]); o.z = cvt_pk_bf16(v1[0], v1[1]); o.w = cvt_pk_bf16(v1[2], v1[3]);
                        *(v4u*)(YB + (size_t)ent * DM + col0 + bj * 128) = o; } } }
    }
};
#define KSWZ(row, colB) ((row) * 256 + ((colB) ^ (((row) & 7) << 4)))
#define SBAR() __builtin_amdgcn_sched_barrier(0)
__device__ __forceinline__ int crow(int r, int hi) { return (r & 3) + 8 * (r >> 2) + 4 * hi; }
__device__ __forceinline__ void qkt64(f32x16& p0, f32x16& p1, const LAS char* Ks, const bf16x8* qr, int r32, int hi) {
    p0 = f32x16{}; p1 = f32x16{};
#pragma unroll
    for (int d0 = 0; d0 < 8; ++d0) { const int cb = (d0 * 16 + hi * 8) * 2;
        const bf16x8 b0 = *(const LAS bf16x8*)(Ks + KSWZ(r32, cb));
        const bf16x8 b1 = *(const LAS bf16x8*)(Ks + KSWZ(32 + r32, cb));
        p0 = __builtin_amdgcn_mfma_f32_32x32x16_bf16(b0, qr[d0], p0, 0, 0, 0);
        p1 = __builtin_amdgcn_mfma_f32_32x32x16_bf16(b1, qr[d0], p1, 0, 0, 0); }
}
__device__ __forceinline__ void qkt32(f32x16& p0, const LAS char* Ks, const bf16x8* qr, int r32, int hi) {
    p0 = f32x16{};
#pragma unroll
    for (int d0 = 0; d0 < 8; ++d0) { const int cb = (d0 * 16 + hi * 8) * 2;
        const bf16x8 b0 = *(const LAS bf16x8*)(Ks + KSWZ(r32, cb));
        p0 = __builtin_amdgcn_mfma_f32_32x32x16_bf16(b0, qr[d0], p0, 0, 0, 0); }
}
__device__ __forceinline__ int v_st(int k, int c) { const int kk = (k & ~0xC) | ((k & 4) << 1) | ((k & 8) >> 1); return ((kk >> 3) * 4 + (c >> 5)) * 512 + ((kk & 7) * 32 + (c & 31)) * 2; }
__device__ __forceinline__ int v_rd_base(int lane) { return ((lane & 3) << 3) | (((lane >> 2) & 3) << 6) | (((lane >> 4) & 1) << 5) | (((lane >> 5) & 1) << 8); }
constexpr int v_rd_off(int d0, int ks, int half) { return d0 * 512 + ks * 4096 + half * 2048; }
template <int OFF> __device__ __forceinline__ s16x4 tr_read(int vb) {
    s16x4 r; asm volatile("ds_read_b64_tr_b16 %0, %1 offset:%2" : "=&v"(r) : "v"(vb), "i"(OFF) : "memory"); return r;
}
__device__ __forceinline__ s16x4 tr_read_dyn(unsigned addr) { s16x4 r; asm volatile("ds_read_b64_tr_b16 %0, %1" : "=&v"(r) : "v"(addr) : "memory"); return r; }
template <int D0> __device__ __forceinline__ void pv_one(f32x16& od, int vb, bf16x8 pa0, bf16x8 pa1, bf16x8 pa2, bf16x8 pa3) {
    const s16x4 l0 = tr_read<v_rd_off(D0, 0, 0)>(vb), h0 = tr_read<v_rd_off(D0, 0, 1)>(vb), l1 = tr_read<v_rd_off(D0, 1, 0)>(vb), h1 = tr_read<v_rd_off(D0, 1, 1)>(vb);
    const s16x4 l2 = tr_read<v_rd_off(D0, 2, 0)>(vb), h2 = tr_read<v_rd_off(D0, 2, 1)>(vb), l3 = tr_read<v_rd_off(D0, 3, 0)>(vb), h3 = tr_read<v_rd_off(D0, 3, 1)>(vb);
    asm volatile("s_waitcnt lgkmcnt(0)" ::: "memory"); SBAR();
#define PKV(L, H) (bf16x8){L[0], L[1], L[2], L[3], H[0], H[1], H[2], H[3]}
    od = __builtin_amdgcn_mfma_f32_32x32x16_bf16(pa0, PKV(l0, h0), od, 0, 0, 0);
    od = __builtin_amdgcn_mfma_f32_32x32x16_bf16(pa1, PKV(l1, h1), od, 0, 0, 0);
    od = __builtin_amdgcn_mfma_f32_32x32x16_bf16(pa2, PKV(l2, h2), od, 0, 0, 0);
    od = __builtin_amdgcn_mfma_f32_32x32x16_bf16(pa3, PKV(l3, h3), od, 0, 0, 0);
}
template <int D0> __device__ __forceinline__ void pv_one_lo(f32x16& od, int vb, bf16x8 pa0, bf16x8 pa1) {
    const s16x4 l0 = tr_read<v_rd_off(D0, 0, 0)>(vb), h0 = tr_read<v_rd_off(D0, 0, 1)>(vb), l1 = tr_read<v_rd_off(D0, 1, 0)>(vb), h1 = tr_read<v_rd_off(D0, 1, 1)>(vb);
    asm volatile("s_waitcnt lgkmcnt(0)" ::: "memory"); SBAR();
    od = __builtin_amdgcn_mfma_f32_32x32x16_bf16(pa0, PKV(l0, h0), od, 0, 0, 0);
    od = __builtin_amdgcn_mfma_f32_32x32x16_bf16(pa1, PKV(l1, h1), od, 0, 0, 0);
}
__device__ __forceinline__ void pv_all(f32x16* o, int vb, bf16x8 pa0, bf16x8 pa1, bf16x8 pa2, bf16x8 pa3) {
    pv_one<0>(o[0], vb, pa0, pa1, pa2, pa3); pv_one<1>(o[1], vb, pa0, pa1, pa2, pa3); pv_one<2>(o[2], vb, pa0, pa1, pa2, pa3); pv_one<3>(o[3], vb, pa0, pa1, pa2, pa3);
}
#define PK4(P, BASE, OUT) do { unsigned a0_ = cvt_pk_bf16(P[BASE + 0], P[BASE + 1]), a1_ = cvt_pk_bf16(P[BASE + 2], P[BASE + 3]);   \
    unsigned b0_ = cvt_pk_bf16(P[BASE + 4], P[BASE + 5]), b1_ = cvt_pk_bf16(P[BASE + 6], P[BASE + 7]);                              \
    auto r0_ = __builtin_amdgcn_permlane32_swap(a0_, b0_, false, false); auto r1_ = __builtin_amdgcn_permlane32_swap(a1_, b1_, false, false); \
    v4u w_ = {r0_[0], r1_[0], r0_[1], r1_[1]}; OUT = *reinterpret_cast<bf16x8*>(&w_); } while (0)
__device__ __forceinline__ float pair_sum(float v) { auto rr = __builtin_amdgcn_permlane32_swap(__float_as_uint(v), __float_as_uint(v), false, false); return __uint_as_float(rr[0]) + __uint_as_float(rr[1]); }
__device__ __forceinline__ float pair_max(float v) { auto rr = __builtin_amdgcn_permlane32_swap(__float_as_uint(v), __float_as_uint(v), false, false); return fmaxf(__uint_as_float(rr[0]), __uint_as_float(rr[1])); }
__device__ __forceinline__ unsigned off_b(unsigned row, unsigned ch) { return 256u * row + 16u * (ch ^ (((row & 3) << 2) | ((row >> 2) & 3))); }
__device__ __forceinline__ unsigned trb_addr(unsigned lane, unsigned c, unsigned ks, unsigned t) {
    const unsigned h = lane >> 5, blk = (lane >> 4) & 1, q = (lane & 15) >> 2, p = lane & 3;
    return off_b(16 * ks + 8 * h + 4 * t + q, 4 * c + 2 * blk + (p >> 1)) + 8 * (p & 1);
}

constexpr int ML_TAB_OFF = LDSCTL_OFF + 2048;
struct MTabs { LAS float* sum; LAS float* g; LAS float* b; LAS float* pm; LAS float* mprev; LAS float* mend; };
__device__ __forceinline__ MTabs mtabs(const Frame& F) { MTabs T; T.sum = (LAS float*)(F.lds + ML_TAB_OFF); T.g = T.sum + 64; T.b = T.g + 256; T.pm = T.b + 256; T.mprev = T.pm + 256; T.mend = T.mprev + 4; return T; }
__device__ __forceinline__ float* gif_ptr(const Frame& F) { return (float*)(F.ws + WS_MSN + 512 * 1024); }
__device__ __forceinline__ void mchain(const Frame& F, int l, int bh, int cr, const MTabs& T) {
    const int b = bh >> 3, h = bh & 7, lane = fresh_lane(), nchunk = 4 * cr + 4;
    const float bi = arg_in(4)[l * NH + h], bfv = arg_in(5)[l * NH + h];
    const float* gif = gif_ptr(F);
    __syncthreads();
    for (int j = F.wave; j < nchunk; j += NWAVES) {
        const size_t row = (size_t)b * SEQ + 64 * j + lane;
        const float it = gif[row * 16 + h] + bi, lf = logsigmoidf_(gif[row * 16 + 8 + h] + bfv);
        float bc = lf;
#pragma unroll
        for (int o = 1; o < 64; o <<= 1) { const float t = __shfl_up(bc, o); bc += (lane >= o) ? t : 0.f; }
        const float g = it - bc; float pm = g;
#pragma unroll
        for (int o = 1; o < 64; o <<= 1) { const float t = __shfl_up(pm, o); pm = (lane >= o) ? fmaxf(pm, t) : pm; }
        if (lane == 63) { T.sum[2 * j] = bc; T.sum[2 * j + 1] = pm; }
        if (j >= 4 * cr) { const int ci = j - 4 * cr; T.g[ci * 64 + lane] = g; T.b[ci * 64 + lane] = bc; T.pm[ci * 64 + lane] = pm; }
    }
    __syncthreads();
    if ((F.wave * 64 + fresh_lane()) == 0) { float m = 0.f;
        for (int j = 0; j < nchunk; ++j) { const float me = fmaxf(m, T.sum[2 * j + 1]);
            if (j >= 4 * cr) { T.mprev[j - 4 * cr] = m; T.mend[j - 4 * cr] = me; }
            m = T.sum[2 * j] + me; } }
    __syncthreads();
}
__device__ __forceinline__ void conv8(const bf16* P, const float* cw, size_t row, int t, int col0, int ch0, float sc, float (&o)[8]) {
#pragma unroll
    for (int e = 0; e < 8; ++e) o[e] = 0.f;
#pragma unroll
    for (int j = 0; j < 4; ++j) { const int tt = t - 3 + j;
        if (tt >= 0) { const v4u x = *(const v4u*)(P + (row - 3 + j) * PW + col0); const f32x4 w0 = *(const f32x4*)(cw + j * 2048 + ch0), w1 = *(const f32x4*)(cw + j * 2048 + ch0 + 4);
            o[0] += w0.x * bflo(x.x); o[1] += w0.y * bfhi(x.x); o[2] += w0.z * bflo(x.y); o[3] += w0.w * bfhi(x.y);
            o[4] += w1.x * bflo(x.z); o[5] += w1.y * bfhi(x.z); o[6] += w1.z * bflo(x.w); o[7] += w1.w * bfhi(x.w); } }
#pragma unroll
    for (int e = 0; e < 8; ++e) o[e] = siluf_(o[e]) * sc;
}
__device__ __forceinline__ void ml_delta(const Frame& F, int l) {
    const bf16* P = (const bf16*)(F.ws + WS_PROJ); const float* cw = arg_in(3) + (size_t)l * 4 * 2048;
    float* DEL = (float*)(F.ws + WS_MDEL); float* DN = (float*)(F.ws + WS_MDN); float* DEC = DN + 32 * 32 * 128;
    const int wave = F.wave;
    const MTabs T = mtabs(F);
    for (int blk = F.vcu; blk < 256; blk += F.G) {
        const int tid = F.wave * 64 + fresh_lane();
        const int lane = tid & 63;
        const int bh = blk >> 3, cr = blk & 7, b = bh >> 3, h = bh & 7;
        mchain(F, l, bh, cr, T);
#pragma unroll 1
        for (int it = tid; it < 4 * 64 * 16; it += NTHR) { const int ci = it >> 10, s = (it >> 4) & 63, ch = it & 15, t = 64 * (4 * cr + ci) + s; const size_t row = (size_t)b * SEQ + t;
            float kv[8]; conv8(P, cw, row, t, C_MK + h * HD + 8 * ch, 1024 + h * HD + 8 * ch, 1.f, kv);
            v4u o; o.x = pk2(kv[0], kv[1]); o.y = pk2(kv[2], kv[3]); o.z = pk2(kv[4], kv[5]); o.w = pk2(kv[6], kv[7]);
            *(LAS v4u*)(F.lds + ci * 32768 + off_b(s, ch)) = o;
            const float ws = __expf(T.g[ci * 64 + s] - T.mend[ci]);
            const v4u x = *(const v4u*)(P + row * PW + C_MV + h * HD + 8 * ch);
            o.x = pk2(ws * bflo(x.x), ws * bfhi(x.x)); o.y = pk2(ws * bflo(x.y), ws * bfhi(x.y)); o.z = pk2(ws * bflo(x.z), ws * bfhi(x.z)); o.w = pk2(ws * bflo(x.w), ws * bfhi(x.w));
            *(LAS v4u*)(F.lds + ci * 32768 + 16384 + off_b(s, ch)) = o; }
        __syncthreads();
        const int vb = wave >> 1, kh = wave & 1, r32 = lane & 31, hi = lane >> 5;
        const unsigned ldsb = (unsigned)(size_t)F.lds;
#pragma unroll 1
        for (int ci = 0; ci < 4; ++ci) { const int c = 4 * cr + ci; if (c == NCH - 1) break;
            f32x16 a0 = {}, a1 = {};
#pragma unroll
            for (int ks = 0; ks < 4; ++ks) {
                const s16x4 al = tr_read_dyn(ldsb + ci * 32768 + 16384 + trb_addr(lane, vb, ks, 0)), ah = tr_read_dyn(ldsb + ci * 32768 + 16384 + trb_addr(lane, vb, ks, 1));
                const s16x4 bl0 = tr_read_dyn(ldsb + ci * 32768 + trb_addr(lane, 2 * kh, ks, 0)), bh0 = tr_read_dyn(ldsb + ci * 32768 + trb_addr(lane, 2 * kh, ks, 1));
                const s16x4 bl1 = tr_read_dyn(ldsb + ci * 32768 + trb_addr(lane, 2 * kh + 1, ks, 0)), bh1 = tr_read_dyn(ldsb + ci * 32768 + trb_addr(lane, 2 * kh + 1, ks, 1));
                asm volatile("s_waitcnt lgkmcnt(0)" ::: "memory"); SBAR();
                a0 = __builtin_amdgcn_mfma_f32_32x32x16_bf16(PKV(al, ah), PKV(bl0, bh0), a0, 0, 0, 0);
                a1 = __builtin_amdgcn_mfma_f32_32x32x16_bf16(PKV(al, ah), PKV(bl1, bh1), a1, 0, 0, 0); }
            float* dp = DEL + ((size_t)(bh * 32 + c) * 128) * 128;
#pragma unroll
            for (int r = 0; r < 16; ++r) { const int v = 32 * vb + crow(r, hi); dp[(size_t)v * 128 + 64 * kh + r32] = a0[r]; dp[(size_t)v * 128 + 64 * kh + 32 + r32] = a1[r]; }
        }
        { const int ci = tid >> 7, k = tid & 127, c = 4 * cr + ci;
          if (c < NCH - 1) { float a = 0.f; const float me = T.mend[ci];
              for (int s = 0; s < 64; ++s) a += __expf(T.g[ci * 64 + s] - me) * bf2f(*(const LAS unsigned short*)(F.lds + ci * 32768 + off_b(s, k >> 3) + 2 * (k & 7)));
              DN[(size_t)(bh * 32 + c) * 128 + k] = a;
              if (k == 0) DEC[bh * 32 + c] = __expf(T.mprev[ci] - me); } }
        __syncthreads();
    }
}
__device__ __forceinline__ void ml_scan(const Frame& F) {
    const float* DEL = (const float*)(F.ws + WS_MDEL); const float* DN = (const float*)(F.ws + WS_MDN); const float* DEC = DN + 32 * 32 * 128;
    bf16* ST = (bf16*)(F.ws + WS_MST); float* SN = (float*)(F.ws + WS_MSN);
    const int gt = F.vcu * NTHR + (F.wave * 64 + fresh_lane()), NT = F.G * NTHR;
    for (int e4 = gt; e4 < 32 * 4096; e4 += NT) { const int bh = e4 >> 12, q = e4 & 4095;
        f32x4 acc = {0.f, 0.f, 0.f, 0.f};
#pragma unroll 4
        for (int c = 0; c < NCH - 1; ++c) { const float d = DEC[bh * 32 + c]; const f32x4 x = *(const f32x4*)(DEL + ((size_t)(bh * 32 + c) * 4096 + q) * 4);
            acc = acc * d + x; v2u o; o.x = pk2(acc.x, acc.y); o.y = pk2(acc.z, acc.w); *(v2u*)(ST + ((size_t)(bh * 32 + c + 1) * 4096 + q) * 4) = o; } }
    for (int e = gt; e < 32 * 128; e += NT) { const int bh = e >> 7, k = e & 127; float acc = 0.f;
        for (int c = 0; c < NCH - 1; ++c) { acc = acc * DEC[bh * 32 + c] + DN[(size_t)(bh * 32 + c) * 128 + k]; SN[(size_t)(bh * 32 + c + 1) * 128 + k] = acc; } }
}
__device__ __forceinline__ void ml_out(const Frame& F, int l) {
    const bf16* P = (const bf16*)(F.ws + WS_PROJ); const float* cw = arg_in(3) + (size_t)l * 4 * 2048; bf16* BR = (bf16*)(F.ws + WS_BR);
    const bf16* ST = (const bf16*)(F.ws + WS_MST); const float* SN = (const float*)(F.ws + WS_MSN); const float* gain = arg_in(6) + (size_t)l * BW;
    const int wave = F.wave;
    const MTabs T = mtabs(F);
    LAS float* rowL = (LAS float*)(F.lds + ML_TAB_OFF + 4096) + wave * 32;
    for (int blk = F.vcu; blk < 256; blk += F.G) {
        const int tid = F.wave * 64 + fresh_lane();
        const int lane = tid & 63, r32 = lane & 31, hi = lane >> 5;
        const int bh = blk >> 3, cr = blk & 7, b = bh >> 3, h = bh & 7;
        mchain(F, l, bh, cr, T);
#pragma unroll 1
        for (int it = tid; it < 4 * 64 * 16; it += NTHR) { const int ci = it >> 10, s = (it >> 4) & 63, ch = it & 15, t = 64 * (4 * cr + ci) + s; const size_t row = (size_t)b * SEQ + t;
            float kv[8]; conv8(P, cw, row, t, C_MK + h * HD + 8 * ch, 1024 + h * HD + 8 * ch, 1.f, kv);
            v4u o; o.x = pk2(kv[0], kv[1]); o.y = pk2(kv[2], kv[3]); o.z = pk2(kv[4], kv[5]); o.w = pk2(kv[6], kv[7]);
            *(LAS v4u*)(F.lds + ci * 32768 + KSWZ(s, ch * 16)) = o;
            *(LAS v4u*)(F.lds + ci * 32768 + 16384 + v_st(s, ch * 8)) = *(const v4u*)(P + row * PW + C_MV + h * HD + 8 * ch); }
        __syncthreads();
        const int ci = wave >> 1, rh = wave & 1, c = 4 * cr + ci, tau = 32 * rh + r32, t = 64 * c + tau; const size_t row = (size_t)b * SEQ + t;
        bf16x8 qr[8];
#pragma unroll
        for (int d0 = 0; d0 < 8; ++d0) { float qv[8]; conv8(P, cw, row, t, C_MQ + h * HD + 16 * d0 + 8 * hi, h * HD + 16 * d0 + 8 * hi, 0.08838834764831845f, qv);
            v4u o; o.x = pk2(qv[0], qv[1]); o.y = pk2(qv[2], qv[3]); o.z = pk2(qv[4], qv[5]); o.w = pk2(qv[6], qv[7]); qr[d0] = *reinterpret_cast<bf16x8*>(&o); asm volatile("" ::: "memory"); }
        const float mprev = T.mprev[ci], Mt = fmaxf(mprev, T.pm[ci * 64 + tau]), winter = __expf(mprev - Mt), flo = __expf(-T.b[ci * 64 + tau] - Mt);
        const LAS char* Kc = (const LAS char*)(F.lds + ci * 32768);
        const int vbase = (int)(size_t)(F.lds + ci * 32768 + 16384) + v_rd_base(lane);
        f32x16 o[4] = {}; f32x16 p0, p1; float ps = 0.f; bf16x8 pa0, pa1, pa2, pa3;
        const LAS f32x4* g4 = (const LAS f32x4*)(T.g + ci * 64);
        if (rh == 0) { qkt32(p0, Kc, qr, r32, hi);
#pragma unroll
            for (int q = 0; q < 4; ++q) { const f32x4 gg = g4[2 * q + hi];
#pragma unroll
                for (int e = 0; e < 4; ++e) { const int r = 4 * q + e, s = crow(r, hi); const float wgt = (s <= tau) ? __expf(gg[e] - Mt) : 0.f; p0[r] *= wgt; ps += p0[r]; } }
            PK4(p0, 0, pa0); PK4(p0, 8, pa1);
            pv_one_lo<0>(o[0], vbase, pa0, pa1); pv_one_lo<1>(o[1], vbase, pa0, pa1); pv_one_lo<2>(o[2], vbase, pa0, pa1); pv_one_lo<3>(o[3], vbase, pa0, pa1);
        } else { qkt64(p0, p1, Kc, qr, r32, hi);
#pragma unroll
            for (int q = 0; q < 4; ++q) { const f32x4 gg = g4[2 * q + hi], gh = g4[8 + 2 * q + hi];
#pragma unroll
                for (int e = 0; e < 4; ++e) { const int r = 4 * q + e, s = crow(r, hi); p0[r] *= __expf(gg[e] - Mt); ps += p0[r];
                    const float wgt = (32 + s <= tau) ? __expf(gh[e] - Mt) : 0.f; p1[r] *= wgt; ps += p1[r]; } }
            PK4(p0, 0, pa0); PK4(p0, 8, pa1); PK4(p1, 0, pa2); PK4(p1, 8, pa3);
            pv_all(o, vbase, pa0, pa1, pa2, pa3);
        }
        ps = pair_sum(ps);
        float nq = 0.f;
        if (c > 0) {
            const bf16* Sc = ST + (size_t)(bh * 32 + c) * 16384; const float* nc = SN + (size_t)(bh * 32 + c) * 128;
#pragma unroll
            for (int ks = 0; ks < 8; ++ks) { const v4u qq = *reinterpret_cast<const v4u*>(&qr[ks]);
                const f32x4 n0 = *(const f32x4*)(nc + 16 * ks + 8 * hi), n1 = *(const f32x4*)(nc + 16 * ks + 8 * hi + 4);
                nq += bflo(qq.x) * n0.x + bfhi(qq.x) * n0.y + bflo(qq.y) * n0.z + bfhi(qq.y) * n0.w + bflo(qq.z) * n1.x + bfhi(qq.z) * n1.y + bflo(qq.w) * n1.z + bfhi(qq.w) * n1.w;
                v4u sq; sq.x = pk2(bflo(qq.x) * winter, bfhi(qq.x) * winter); sq.y = pk2(bflo(qq.y) * winter, bfhi(qq.y) * winter); sq.z = pk2(bflo(qq.z) * winter, bfhi(qq.z) * winter); sq.w = pk2(bflo(qq.w) * winter, bfhi(qq.w) * winter);
                const bf16x8 qs = *reinterpret_cast<const bf16x8*>(&sq);
#pragma unroll
                for (int d0 = 0; d0 < 4; ++d0) { const bf16x8 cf = *(const bf16x8*)(Sc + (size_t)(32 * d0 + r32) * 128 + 16 * ks + 8 * hi);
                    o[d0] = __builtin_amdgcn_mfma_f32_32x32x16_bf16(qs, cf, o[d0], 0, 0, 0); }
                asm volatile("" ::: "memory"); }
            nq = pair_sum(nq);
        }
        const float den = winter * nq + ps, rinv = 1.0f / fmaxf(fabsf(den), flo);
        if (hi == 0) rowL[r32] = rinv;
        LDS_WAIT(); asm volatile("" ::: "memory");
        float ss[16];
#pragma unroll
        for (int r = 0; r < 16; ++r) { const float ri = rowL[crow(r, hi)]; float a = 0.f;
#pragma unroll
            for (int d0 = 0; d0 < 4; ++d0) { o[d0][r] *= ri; a += o[d0][r] * o[d0][r]; }
            ss[r] = a; }
#pragma unroll
        for (int r = 0; r < 16; ++r) {
#pragma unroll
            for (int of = 1; of < 32; of <<= 1) ss[r] += __shfl_xor(ss[r], of);
            ss[r] = 1.0f / sqrtf(ss[r] * (1.f / HD) + EPS); }
        const size_t row0 = (size_t)b * SEQ + 64 * c + 32 * rh;
#pragma unroll
        for (int d0 = 0; d0 < 4; ++d0) { const int col = h * HD + 32 * d0 + r32; const float gn = gain[col];
#pragma unroll
            for (int r = 0; r < 16; ++r) { const size_t rr = row0 + crow(r, hi);
                const float og = sigmoidf_(bf2f(P[rr * PW + C_MO + col]));
                BR[rr * 3072 + col] = (bf16)f2bf(o[d0][r] * ss[r] * gn * og); }
            asm volatile("" ::: "memory"); }
        __syncthreads();
    }
}
__device__ __forceinline__ void ph_norm2_mfma(const Frame& F, int l) {
    const float* g = arg_in(11) + (size_t)l * DM;
    const float* wrg = arg_in(12) + (size_t)l * DM * NGRP; const float* brg = arg_in(13) + l * NGRP;
    const float* wre = arg_in(14) + (size_t)l * DM * NEXP; const float* bre = arg_in(15) + l * NEXP;
    const float* X1 = (const float*)(F.ws + WS_X1); bf16* XN = (bf16*)(F.ws + WS_XN);
    int* list = (int*)(F.ws + WS_LIST); int* tinfo = tokinfo_ptr(F);
    unsigned* ecnt = F.ctl + CW_ECNT + l * NEXP * 64;
    LAS float* PL = (LAS float*)F.lds;
    LAS float* LG = PL + 8 * 2048;
    LAS float* RS = LG + 32 * 36;
    for (int blk = F.vcu; blk < NTOK / 32; blk += F.G) {
        const int lane = fresh_lane(), wave = F.wave, tid = wave * 64 + lane; const int m0 = blk * 32;
        __syncthreads();
#pragma unroll 1
        for (int q = 0; q < 4; ++q) { const int m = m0 + 4 * wave + q;
            f32x4 v[8]; float s = 0.f;
            const f32x4* xr = (const f32x4*)(X1 + (size_t)m * DM) + lane;
#pragma unroll
            for (int j = 0; j < 8; ++j) { v[j] = xr[64 * j]; s += (v[j].x * v[j].x + v[j].y * v[j].y) + (v[j].z * v[j].z + v[j].w * v[j].w); }
            const float rstd = 1.0f / sqrtf(wave_sum(s) * (1.f / DM) + EPS);
            v2u* o8 = (v2u*)(XN + (size_t)m * DM) + lane; const f32x4* gr = (const f32x4*)g + lane;
#pragma unroll
            for (int j = 0; j < 8; ++j) { const f32x4 gg = gr[64 * j]; v2u o; o.x = pk2(v[j].x * rstd * gg.x, v[j].y * rstd * gg.y); o.y = pk2(v[j].z * rstd * gg.z, v[j].w * rstd * gg.w); o8[64 * j] = o; }
            if (lane == 0) RS[4 * wave + q] = rstd; }
        { const int i = lane & 31, h = lane >> 5, kb = 256 * wave + 128 * h;
          f32x16 aE = {}, aG = {};
          const float* xp = X1 + (size_t)(m0 + i) * DM + kb; const float* gp = g + kb;
          const float* we = wre + (size_t)kb * NEXP + i; const float* wg = wrg + (size_t)kb * NGRP + (i & 3);
#pragma unroll 2
          for (int s4 = 0; s4 < 32; ++s4) { const f32x4 xv = *(const f32x4*)(xp + 4 * s4), gv = *(const f32x4*)(gp + 4 * s4);
#pragma unroll
              for (int c = 0; c < 4; ++c) { const int s = 4 * s4 + c; const float gk = gv[c];
                  const float be = we[(size_t)s * NEXP] * gk; const float bg = (i < 4) ? wg[(size_t)s * NGRP] * gk : 0.f;
                  aE = __builtin_amdgcn_mfma_f32_32x32x2f32(xv[c], be, aE, 0, 0, 0);
                  aG = __builtin_amdgcn_mfma_f32_32x32x2f32(xv[c], bg, aG, 0, 0, 0); } }
#pragma unroll
          for (int r = 0; r < 16; ++r) { const int t = crow(r, h); PL[(wave * 2 + 0) * 1024 + t * 32 + i] = aE[r]; PL[(wave * 2 + 1) * 1024 + t * 32 + i] = aG[r]; } }
        __syncthreads();
        for (int idx = tid; idx < 32 * 36; idx += NTHR) { const int t = idx / 36, j = idx % 36; float a = 0.f;
#pragma unroll
            for (int w = 0; w < 8; ++w) a += (j < 4) ? PL[(w * 2 + 1) * 1024 + t * 32 + j] : PL[(w * 2) * 1024 + t * 32 + (j - 4)];
            LG[idx] = a * RS[t]; }
        __syncthreads();
        if (tid < 32) { const int m = m0 + tid; const LAS float* lg = LG + tid * 36;
            int gs = 0; float best = lg[0] + brg[0];
#pragma unroll
            for (int q = 1; q < 4; ++q) { const float t = lg[q] + brg[q]; if (t > best) { best = t; gs = q; } }
            const float gm = fmaxf(fmaxf(lg[0], lg[1]), fmaxf(lg[2], lg[3])); float gsum = 0.f, gsel = 0.f;
#pragma unroll
            for (int q = 0; q < 4; ++q) { const float e = __expf(lg[q] - gm); gsum += e; gsel = (q == gs) ? e : gsel; }
            const float pg = gsel / gsum;
            float ein[8];
#pragma unroll
            for (int q = 0; q < 8; ++q) ein[q] = lg[4 + gs * 8 + q];
            int e0 = 0, e1 = -1; float b0 = -3.0e38f, b1 = -3.0e38f;
#pragma unroll
            for (int q = 0; q < 8; ++q) { const float t = ein[q] + bre[gs * 8 + q];
                if (t > b0) { b1 = b0; e1 = e0; b0 = t; e0 = q; } else if (t > b1) { b1 = t; e1 = q; } }
            float em = ein[0];
#pragma unroll
            for (int q = 1; q < 8; ++q) em = fmaxf(em, ein[q]);
            float p0 = 0.f, p1 = 0.f;
#pragma unroll
            for (int q = 0; q < 8; ++q) { const float e = __expf(ein[q] - em); p0 = (q == e0) ? e : p0; p1 = (q == e1) ? e : p1; }
            const float w0 = pg * p0 / (p0 + p1), w1 = pg * p1 / (p0 + p1);
            const int x0 = gs * 8 + e0, x1 = gs * 8 + e1;
            const int pos0 = (int)atomicAdd(ecnt + x0 * 64, 1u), pos1 = (int)atomicAdd(ecnt + x1 * 64, 1u);
            list[x0 * NTOK + pos0] = 2 * m; list[x1 * NTOK + pos1] = 2 * m + 1;
            tinfo[m * 8 + 0] = x0; tinfo[m * 8 + 1] = pos0; tinfo[m * 8 + 2] = __float_as_int(w0); tinfo[m * 8 + 3] = 0;
            tinfo[m * 8 + 4] = x1; tinfo[m * 8 + 5] = pos1; tinfo[m * 8 + 6] = __float_as_int(w1); tinfo[m * 8 + 7] = 0; }
    }
}
__device__ __forceinline__ void dsa_index(const Frame& F) {
    const bf16* P = (const bf16*)(F.ws + WS_PROJ); unsigned long long* MK = (unsigned long long*)(F.ws + WS_MASK);
    LAS float* SL = (LAS float*)(F.lds + F.wave * 16384);
    const int gw = GW_ID(F), NGW = GW_N(F);
    for (int wu = gw; wu < 2048; wu += NGW) {
        const int lane = fresh_lane();
        const int m = lane & 31, hi = lane >> 5, qa = (m >> 2) & 1, head = (m & 3) + 4 * (m >> 3);
        const int b = wu >> 9, jj = wu & 511;
#pragma unroll 1
        for (int half = 0; half < 2; ++half) {
            const int tp = half ? 1023 - jj : jj, t0 = 2 * tp; const size_t rb = (size_t)b * SEQ;
            bf16x8 afr[4];
#pragma unroll
            for (int ks = 0; ks < 4; ++ks) afr[ks] = *(const bf16x8*)(P + (rb + t0 + qa) * PW + C_IQ + head * 64 + 16 * ks + 8 * hi);
            float wr[16];
            { const v4u w0 = *(const v4u*)(P + (rb + t0 + hi) * PW + C_IW), w1 = *(const v4u*)(P + (rb + t0 + hi) * PW + C_IW + 8);
              wr[0] = bflo(w0.x); wr[1] = bfhi(w0.x); wr[2] = bflo(w0.y); wr[3] = bfhi(w0.y); wr[4] = bflo(w0.z); wr[5] = bfhi(w0.z); wr[6] = bflo(w0.w); wr[7] = bfhi(w0.w);
              wr[8] = bflo(w1.x); wr[9] = bfhi(w1.x); wr[10] = bflo(w1.y); wr[11] = bfhi(w1.y); wr[12] = bflo(w1.z); wr[13] = bfhi(w1.z); wr[14] = bflo(w1.w); wr[15] = bfhi(w1.w);
#pragma unroll
              for (int r = 0; r < 16; ++r) wr[r] *= 0.03125f; }
            const int nkb = (t0 + 1) / 32 + 1;
#pragma unroll 2
            for (int kb = 0; kb < nkb; ++kb) {
                const bf16* kp = P + (rb + 32 * kb + m) * PW + C_IK + 8 * hi;
                f32x16 acc = {};
#pragma unroll
                for (int ks = 0; ks < 4; ++ks) acc = __builtin_amdgcn_mfma_f32_32x32x16_bf16(afr[ks], *(const bf16x8*)(kp + 16 * ks), acc, 0, 0, 0);
                float sc = 0.f;
#pragma unroll
                for (int r = 0; r < 16; ++r) sc += wr[r] * fmaxf(acc[r], 0.f);
                SL[hi * 2048 + 32 * kb + m] = sc;
            }
            LDS_WAIT(); asm volatile("" ::: "memory");
#pragma unroll 1
            for (int q = 0; q < 2; ++q) { const int t = t0 + q; unsigned key[32];
#pragma unroll
                for (int j = 0; j < 32; ++j) { const int s = lane + 64 * j; key[j] = (s <= t) ? fkey(SL[q * 2048 + s]) : 0u; }
                select_row(key, t + 1, MK + (rb + t) * 32, lane); }
            LDS_WAIT(); asm volatile("" ::: "memory");
        }
    }
}

struct KVRegs { v4u k0, k1, v0, v1; };
__device__ __forceinline__ void kv_load(KVRegs& R, const bf16* Kp, const bf16* Vp, size_t row0, int sr, int sc) {
    R.k0 = *(const v4u*)(Kp + (row0 + sr) * PW + sc); R.k1 = *(const v4u*)(Kp + (row0 + 32 + sr) * PW + sc);
    R.v0 = *(const v4u*)(Vp + (row0 + sr) * PW + sc); R.v1 = *(const v4u*)(Vp + (row0 + 32 + sr) * PW + sc);
}
__device__ __forceinline__ v4u knorm8(v4u x, const float (&kg)[8]) {
    float f[8] = {bflo(x.x), bfhi(x.x), bflo(x.y), bfhi(x.y), bflo(x.z), bfhi(x.z), bflo(x.w), bfhi(x.w)};
    float s = 0.f;
#pragma unroll
    for (int e = 0; e < 8; ++e) s += f[e] * f[e];
    s += __shfl_xor(s, 1); s += __shfl_xor(s, 2); s += __shfl_xor(s, 4); s += __shfl_xor(s, 8);
    const float r = 1.0f / sqrtf(s * (1.f / HD) + EPS);
    v4u o; o.x = pk2(f[0] * r * kg[0], f[1] * r * kg[1]); o.y = pk2(f[2] * r * kg[2], f[3] * r * kg[3]); o.z = pk2(f[4] * r * kg[4], f[5] * r * kg[5]); o.w = pk2(f[6] * r * kg[6], f[7] * r * kg[7]);
    return o;
}
template <bool NORM> __device__ __forceinline__ void kv_write(const KVRegs& R, LAS unsigned char* buf, int sr, int sc, const float (&kg)[8]) {
    *(LAS v4u*)(buf + KSWZ(sr, sc * 2)) = NORM ? knorm8(R.k0, kg) : R.k0; *(LAS v4u*)(buf + KSWZ(32 + sr, sc * 2)) = NORM ? knorm8(R.k1, kg) : R.k1;
    *(LAS v4u*)(buf + 16384 + v_st(sr, sc)) = R.v0; *(LAS v4u*)(buf + 16384 + v_st(32 + sr, sc)) = R.v1;
}
constexpr int AT_TAB_OFF = LDSCTL_OFF + 8192;

__device__ __forceinline__ void dsa_attn(const Frame& F, int l) {
    const bf16* P = (const bf16*)(F.ws + WS_PROJ); const unsigned long long* MK = (const unsigned long long*)(F.ws + WS_MASK); bf16* BR = (bf16*)(F.ws + WS_BR);
    const float* qg = arg_in(7) + l * HD; const float* kgp = arg_in(8) + l * HD; const float* rbias = arg_in(19);
    LAS float* biasL = (LAS float*)(F.lds + AT_TAB_OFF); LAS float* rowL = biasL + 128 + F.wave * 32;
    constexpr float C = 0.08838834764831845f * 1.4426950408889634f;
    for (int u = F.vcu; u < 256; u += F.G) {
        const int tid = F.wave * 64 + fresh_lane();
        const int lane = tid & 63, wave = F.wave, r32 = lane & 31, hi = lane >> 5, sr = tid >> 4, sc = (tid & 15) * 8;
        const int b = u >> 6, h = (u >> 3) & 7, qb = 7 - (u & 7), q0 = qb * 256, NT = 4 * (qb + 1); const size_t rb = (size_t)b * SEQ;
        __syncthreads();
        if (tid < 128) biasL[tid] = rbias[t5_bucket(tid) * NH + h] * 1.4426950408889634f;
        float kg[8];
#pragma unroll
        for (int e = 0; e < 8; ++e) kg[e] = kgp[sc + e];
        const int tq = q0 + 32 * wave + r32; bf16x8 qr[8];
        { v4u xs[8]; float s = 0.f;
#pragma unroll
          for (int d0 = 0; d0 < 8; ++d0) { const v4u x = *(const v4u*)(P + (rb + tq) * PW + C_DQ + h * HD + 16 * d0 + 8 * hi); xs[d0] = x;
              s += bflo(x.x) * bflo(x.x) + bfhi(x.x) * bfhi(x.x) + bflo(x.y) * bflo(x.y) + bfhi(x.y) * bfhi(x.y) + bflo(x.z) * bflo(x.z) + bfhi(x.z) * bfhi(x.z) + bflo(x.w) * bflo(x.w) + bfhi(x.w) * bfhi(x.w); }
          const float r = 1.0f / sqrtf(pair_sum(s) * (1.f / HD) + EPS);
#pragma unroll
          for (int d0 = 0; d0 < 8; ++d0) { const f32x4 g0 = *(const f32x4*)(qg + 16 * d0 + 8 * hi), g1 = *(const f32x4*)(qg + 16 * d0 + 8 * hi + 4); const v4u x = xs[d0];
              v4u o; o.x = pk2(bflo(x.x) * r * g0.x, bfhi(x.x) * r * g0.y); o.y = pk2(bflo(x.y) * r * g0.z, bfhi(x.y) * r * g0.w);
              o.z = pk2(bflo(x.z) * r * g1.x, bfhi(x.z) * r * g1.y); o.w = pk2(bflo(x.w) * r * g1.z, bfhi(x.w) * r * g1.w); qr[d0] = *reinterpret_cast<bf16x8*>(&o); } }
        const bf16* Kp = P + C_DK + h * HD; const bf16* Vp = P + C_DV + h * HD;
        KVRegs R; kv_load(R, Kp, Vp, rb, sr, sc); kv_write<true>(R, F.lds, sr, sc, kg);
        __syncthreads();
        float m_reg = -1e30f, l_reg = 0.f; f32x16 o[4] = {};
        const float b31 = biasL[127];
        for (int j = 0; j < NT; ++j) {
            LAS unsigned char* buf = F.lds + (j & 1) * 32768;
            if (j + 1 < NT) kv_load(R, Kp, Vp, rb + 64 * (j + 1), sr, sc);
            if (64 * j <= q0 + 32 * wave + 31) {
                const unsigned long long mw = MK[(rb + tq) * 32 + j]; const unsigned mlo = (unsigned)mw, mhi = (unsigned)(mw >> 32);
                f32x16 p0, p1; qkt64(p0, p1, (const LAS char*)buf, qr, r32, hi);
                const int rel0 = tq - 64 * j;
                const bool nearb = (q0 + 32 * wave - (64 * j + 63)) < 113;
                float pmax = -1e30f;
#pragma unroll
                for (int r = 0; r < 16; ++r) { const int kk = crow(r, hi);
                    float b0 = b31, b1 = b31;
                    if (nearb) { int i0 = rel0 - kk, i1 = rel0 - kk - 32; i0 = i0 < 0 ? 0 : (i0 > 127 ? 127 : i0); i1 = i1 < 0 ? 0 : (i1 > 127 ? 127 : i1); b0 = biasL[i0]; b1 = biasL[i1]; }
                    p0[r] = ((mlo >> kk) & 1u) ? fmaf(p0[r], C, b0) : -1e30f; p1[r] = ((mhi >> kk) & 1u) ? fmaf(p1[r], C, b1) : -1e30f;
                    pmax = fmaxf(pmax, fmaxf(p0[r], p1[r])); }
                pmax = pair_max(pmax);
                const float mn = fmaxf(m_reg, pmax), alpha = __builtin_amdgcn_exp2f(m_reg - mn); m_reg = mn;
                float ps = 0.f;
#pragma unroll
                for (int r = 0; r < 16; ++r) { const int kk = crow(r, hi);
                    p0[r] = ((mlo >> kk) & 1u) ? __builtin_amdgcn_exp2f(p0[r] - mn) : 0.f; p1[r] = ((mhi >> kk) & 1u) ? __builtin_amdgcn_exp2f(p1[r] - mn) : 0.f; ps += p0[r] + p1[r]; }
                l_reg = l_reg * alpha + pair_sum(ps);
                if (__any(alpha < 1.f)) { if (hi == 0) rowL[r32] = alpha; LDS_WAIT(); asm volatile("" ::: "memory");
#pragma unroll
                    for (int r = 0; r < 16; ++r) { const float a = rowL[crow(r, hi)];
#pragma unroll
                        for (int d = 0; d < 4; ++d) o[d][r] *= a; }
                    LDS_WAIT(); asm volatile("" ::: "memory"); }
                bf16x8 pa0, pa1, pa2, pa3; PK4(p0, 0, pa0); PK4(p0, 8, pa1); PK4(p1, 0, pa2); PK4(p1, 8, pa3);
                pv_all(o, (int)(size_t)(buf + 16384) + v_rd_base(lane), pa0, pa1, pa2, pa3);
            }
            if (j + 1 < NT) kv_write<true>(R, F.lds + ((j + 1) & 1) * 32768, sr, sc, kg);
            __syncthreads();
        }
        if (hi == 0) rowL[r32] = 1.0f / l_reg;
        LDS_WAIT(); asm volatile("" ::: "memory");
        const size_t row0 = rb + q0 + 32 * wave;
#pragma unroll
        for (int r = 0; r < 16; ++r) { const float a = rowL[crow(r, hi)]; bf16* op = BR + (row0 + crow(r, hi)) * 3072 + 1024 + h * HD + r32;
#pragma unroll
            for (int d = 0; d < 4; ++d) op[32 * d] = (bf16)f2bf(o[d][r] * a); }
    }
}

__device__ __forceinline__ void sb_attn(const Frame& F) {
    const bf16* P = (const bf16*)(F.ws + WS_PROJ); bf16* BR = (bf16*)(F.ws + WS_BR);
    LAS unsigned* flagL = (LAS unsigned*)(F.lds + AT_TAB_OFF + 2048);
    for (int u = F.vcu; u < 256; u += F.G) {
        const int tid = F.wave * 64 + fresh_lane();
        const int lane = tid & 63, wave = F.wave, r32 = lane & 31, hi = lane >> 5, sr = tid >> 4, sc = (tid & 15) * 8;
        const int b = u >> 6, h = (u >> 3) & 7, qb = u & 7, q0 = qb * 256, NT = 4 * (qb + 1); const size_t rb = (size_t)b * SEQ;
        const float kgd[8] = {1.f, 1.f, 1.f, 1.f, 1.f, 1.f, 1.f, 1.f};
        const int tq = q0 + 32 * wave + r32; bf16x8 qr[8];
#pragma unroll
        for (int d0 = 0; d0 < 8; ++d0) { const v4u x = *(const v4u*)(P + (rb + tq) * PW + C_SQ + h * HD + 16 * d0 + 8 * hi); const float s = 0.08838834764831845f;
            v4u o; o.x = pk2(bflo(x.x) * s, bfhi(x.x) * s); o.y = pk2(bflo(x.y) * s, bfhi(x.y) * s); o.z = pk2(bflo(x.z) * s, bfhi(x.z) * s); o.w = pk2(bflo(x.w) * s, bfhi(x.w) * s); qr[d0] = *reinterpret_cast<bf16x8*>(&o); }
        const bf16* Kp = P + C_SK + h * HD; const bf16* Vp = P + C_SV + h * HD;
        __syncthreads();
        KVRegs R; kv_load(R, Kp, Vp, rb + 64 * (NT - 1), sr, sc); kv_write<false>(R, F.lds, sr, sc, kgd);
        __syncthreads();
        float carry = 1.f; f32x16 o[4] = {};
        int it = 0;
        for (int j = NT - 1; j >= 0; --j, ++it) {
            LAS unsigned char* buf = F.lds + (it & 1) * 32768;
            if (j > 0) kv_load(R, Kp, Vp, rb + 64 * (j - 1), sr, sc);
            if (64 * j < q0 + 32 * wave + 31) {
                f32x16 p0, p1; qkt64(p0, p1, (const LAS char*)buf, qr, r32, hi);
                const int rel0 = tq - 64 * j;
                float To[8];
#pragma unroll
                for (int a = 0; a < 8; ++a) {
                    float n[4], sg[4];
#pragma unroll
                    for (int e = 0; e < 4; ++e) { const int r = 4 * (a & 3) + e, kk = crow(r, hi) + (a >= 4 ? 32 : 0);
                        float z = (a >= 4) ? p1[r] : p0[r]; z = fminf(fmaxf(z, -60.f), 60.f);
                        const float ex = __builtin_amdgcn_exp2f(-z * 1.4426950408889634f), s1 = __builtin_amdgcn_rcpf(1.f + ex);
                        const bool ok = kk < rel0; sg[e] = ok ? s1 : 0.f; n[e] = ok ? ex * s1 : 1.f; }
                    const float e2 = n[3], e1 = e2 * n[2], e0 = e1 * n[1]; To[a] = e0 * n[0];
                    if (a >= 4) { p1[4 * (a & 3) + 3] = sg[3]; p1[4 * (a & 3) + 2] = sg[2] * e2; p1[4 * (a & 3) + 1] = sg[1] * e1; p1[4 * (a & 3)] = sg[0] * e0; }
                    else { p0[4 * a + 3] = sg[3]; p0[4 * a + 2] = sg[2] * e2; p0[4 * a + 1] = sg[1] * e1; p0[4 * a] = sg[0] * e0; }
                }
                float run = carry;
#pragma unroll
                for (int a = 7; a >= 0; --a) { const float Tp = __shfl_xor(To[a], 32);
                    const float E = hi ? run : run * Tp; run = run * To[a] * Tp;
#pragma unroll
                    for (int e = 0; e < 4; ++e) { if (a >= 4) p1[4 * (a & 3) + e] *= E; else p0[4 * a + e] *= E; } }
                carry = run;
                bf16x8 pa0, pa1, pa2, pa3; PK4(p0, 0, pa0); PK4(p0, 8, pa1); PK4(p1, 0, pa2); PK4(p1, 8, pa3);
                pv_all(o, (int)(size_t)(buf + 16384) + v_rd_base(lane), pa0, pa1, pa2, pa3);
            }
            if (lane == 0) flagL[(it & 1) * 8 + wave] = __all(carry < 1e-30f) ? 1u : 0u;
            if (j > 0) kv_write<false>(R, F.lds + ((it + 1) & 1) * 32768, sr, sc, kgd);
            __syncthreads();
            unsigned done = 1u;
#pragma unroll
            for (int w = 0; w < 8; ++w) done &= flagL[(it & 1) * 8 + w];
            if (done) break;
        }
        const size_t row0 = rb + q0 + 32 * wave;
#pragma unroll
        for (int r = 0; r < 16; ++r) { bf16* op = BR + (row0 + crow(r, hi)) * 3072 + 2048 + h * HD + r32;
#pragma unroll
            for (int d = 0; d < 4; ++d) op[32 * d] = (bf16)f2bf(o[d][r]); }
    }
}
template <int LDA, int LDB> struct SchedDense {
    static constexpr bool GATHER = false;
    pg8::TileOrder T; const char* A; const char* B;
    __device__ __forceinline__ bool next(int i, pg8::Unit& u) const { u.e = 0; u.rows = 256; return T.tile(i, u.pm, u.pn); }
    __device__ __forceinline__ const char* a_base(const pg8::Unit& u) const { return A + (size_t)u.pm * 256 * LDA * 2; }
    __device__ __forceinline__ const char* b_base(const pg8::Unit& u) const { return B + (size_t)u.pn * 256 * LDB * 2; }
    __device__ __forceinline__ void a_off(const pg8::Unit&, int tid, unsigned (&v0)[2], unsigned (&v1)[2]) const {
        int R[2], C[2];
#pragma unroll
        for (int i = 0; i < 2; ++i) pg8::stage_rc(tid * 16 + i * 8192, R[i], C[i]);
#pragma unroll
        for (int i = 0; i < 2; ++i) { v0[i] = (unsigned)(R[i] * LDA + C[i]) * 2u; v1[i] = v0[i] + 128u * LDA * 2u; } }
};
struct EpiProj {
    static constexpr bool PERM = true;
    bf16* O; float* GIF;
    __device__ __forceinline__ void operator()(const f32x4 (&acc)[2][2][4][2], const pg8::Unit& u, int wr, int wc, int fr, int fq) const {
        const int row0 = u.pm * 256 + wr * 64 + fr, col0 = u.pn * 256 + wc * 32 + 8 * fq;
#pragma unroll
        for (int ai = 0; ai < 2; ++ai)
#pragma unroll
            for (int m = 0; m < 4; ++m) { bf16* rowp = O + (size_t)(row0 + ai * 128 + m * 16) * PW + col0;
#pragma unroll
                for (int bj = 0; bj < 2; ++bj) { const f32x4 v0 = acc[ai][bj][m][0], v1 = acc[ai][bj][m][1];
                    v4u w; w.x = cvt_pk_bf16(v0[0], v0[1]); w.y = cvt_pk_bf16(v0[2], v0[3]); w.z = cvt_pk_bf16(v1[0], v1[1]); w.w = cvt_pk_bf16(v1[2], v1[3]);
                    *(v4u*)(rowp + bj * 128) = w;
                    if (u.pn == PW / 256 - 1 && bj == 0 && wc == 0 && fq < 2) { float* gp = GIF + (size_t)(row0 + ai * 128 + m * 16) * 16 + 8 * fq; *(f32x4*)gp = v0; *(f32x4*)(gp + 4) = v1; } } }
    }
};
struct SchedBranch {
    static constexpr bool GATHER = false;
    pg8::TileOrder T; const char* A; const char* B;
    __device__ __forceinline__ bool next(int i, pg8::Unit& u) const { u.e = i % 3; u.rows = 256; return T.tile(i / 3, u.pm, u.pn); }
    __device__ __forceinline__ const char* a_base(const pg8::Unit& u) const { return A + ((size_t)u.pm * 256 * 3072 + (size_t)u.e * 1024) * 2; }
    __device__ __forceinline__ const char* b_base(const pg8::Unit& u) const { return B + ((size_t)u.e * 2048 + (size_t)u.pn * 256) * 1024 * 2; }
    __device__ __forceinline__ void a_off(const pg8::Unit&, int tid, unsigned (&v0)[2], unsigned (&v1)[2]) const {
        int R[2], C[2];
#pragma unroll
        for (int i = 0; i < 2; ++i) pg8::stage_rc(tid * 16 + i * 8192, R[i], C[i]);
#pragma unroll
        for (int i = 0; i < 2; ++i) { v0[i] = (unsigned)(R[i] * 3072 + C[i]) * 2u; v1[i] = v0[i] + 128u * 3072u * 2u; } }
};
struct EpiBranch {
    static constexpr bool PERM = true;
    const bf16* P; float* scr; bf16* O;
    __device__ __forceinline__ void operator()(const f32x4 (&acc)[2][2][4][2], const pg8::Unit& u, int wr, int wc, int fr, int fq) const {
        const int row0 = u.pm * 256 + wr * 64 + fr, col0 = u.pn * 256 + wc * 32 + 8 * fq;
#pragma unroll
        for (int ai = 0; ai < 2; ++ai)
#pragma unroll
            for (int m = 0; m < 4; ++m) { const size_t row = (size_t)(row0 + ai * 128 + m * 16);
#pragma unroll
                for (int bj = 0; bj < 2; ++bj) { const int col = col0 + bj * 128;
                    const v4u gw = *(const v4u*)(P + row * PW + C_G + u.e * 2048 + col);
                    f32x4 v0 = acc[ai][bj][m][0], v1 = acc[ai][bj][m][1];
                    v0[0] *= sigmoidf_(bflo(gw.x)); v0[1] *= sigmoidf_(bfhi(gw.x)); v0[2] *= sigmoidf_(bflo(gw.y)); v0[3] *= sigmoidf_(bfhi(gw.y));
                    v1[0] *= sigmoidf_(bflo(gw.z)); v1[1] *= sigmoidf_(bfhi(gw.z)); v1[2] *= sigmoidf_(bflo(gw.w)); v1[3] *= sigmoidf_(bfhi(gw.w));
                    float* sp = scr + row * DM + col;
                    if (u.e > 0) { v0 += *(const f32x4*)sp; v1 += *(const f32x4*)(sp + 4); }
                    if (u.e < 2) { *(f32x4*)sp = v0; *(f32x4*)(sp + 4) = v1; }
                    else { v4u w; w.x = cvt_pk_bf16(v0[0], v0[1]); w.y = cvt_pk_bf16(v0[2], v0[3]); w.z = cvt_pk_bf16(v1[0], v1[1]); w.w = cvt_pk_bf16(v1[2], v1[3]);
                        *(v4u*)(O + row * DM + col) = w; } } }
    }
};
struct EpiOut {
    static constexpr bool PERM = false;
    const float* base; float* out;
    __device__ __forceinline__ void operator()(const f32x4 (&acc)[2][2][4][2], const pg8::Unit& u, int wr, int wc, int fr, int fq) const {
        const int row0 = u.pm * 256 + wr * 64 + fr, col0 = u.pn * 256 + wc * 32 + 4 * fq;
#pragma unroll
        for (int ai = 0; ai < 2; ++ai)
#pragma unroll
            for (int m = 0; m < 4; ++m) { const size_t off = (size_t)(row0 + ai * 128 + m * 16) * DM + col0;
#pragma unroll
                for (int bj = 0; bj < 2; ++bj)
#pragma unroll
                    for (int n = 0; n < 2; ++n) { const f32x4 bs = *(const f32x4*)(base + off + bj * 128 + n * 16); *(f32x4*)(out + off + bj * 128 + n * 16) = bs + acc[ai][bj][m][n]; } }
    }
};

#ifndef MK_NAIVE_MOE
#define MK_NAIVE_MOE 0
#endif
#ifndef PROBE_MASK
#define PROBE_MASK 0
#endif
#ifndef OFFMASK
#define OFFMASK 0
#endif
constexpr int PH_CONVW = 0, PH_NORM1 = 1, PH_INPROJ = 2, PH_NVCONV = 3, PH_NVMLSTM = 4, PH_NVMNORM = 5, PH_NVIDX = 6, PH_NVDSA = 7, PH_NVSB = 8,
              PH_BRANCH = 9, PH_OUT = 10, PH_NORM2 = 11, PH_MOE = 12, PH_MOED = 13, NPH_L = 14, PH_FINAL = DEPTH * NPH_L, NPH = PH_FINAL + 1;

__global__ void __launch_bounds__(NTHR, 2) fwd_kernel(Args args) {
    extern __shared__ __attribute__((aligned(16))) unsigned char lds_raw[];
    Frame F;
    F.lds = (LAS unsigned char*)lds_raw;
    F.wave = __builtin_amdgcn_readfirstlane((int)threadIdx.x >> 6);
    const int wave0 = F.wave;
    F.G = gridDim.x; { const int bx = blockIdx.x; F.vcu = (F.G % 8 == 0) ? (bx % 8) * (F.G / 8) + bx / 8 : bx; }
    F.ws = args.ws; F.ctl = (unsigned*)(args.ws + WS_CTL);
    volatile LAS unsigned* MISC = (volatile LAS unsigned*)(F.lds + LDSCTL_OFF);
    for (int u = threadIdx.x; u < (LDS_BYTES - LDSCTL_OFF) / 4; u += NTHR) ((LAS unsigned*)(F.lds + LDSCTL_OFF))[u] = 0u;
    __syncthreads();
    XcdBarrier bar; bar.bar = F.ctl + CW_BAR; bar.x = 0; bar.st = nullptr;
    if (args.use_bar) bar = xcd_barrier_post(F.ctl + CW_BAR, MISC + 8);
    const int lo = args.ph_lo, hi = args.ph_hi;
#define IN(k) (lo <= (k) && (k) < hi)
#define FRESH() do { F.wave = wave0; F.ws = arg_ws(); F.ctl = (unsigned*)(F.ws + WS_CTL); } while (0)
#define SEAM(k) do { if (args.use_bar && IN((k) + 1)) { FRESH(); xcd_barrier(bar, (F.wave * 64 + fresh_lane())); } } while (0)
    for (int l = 0; l < DEPTH; ++l) {
        const int p0 = l * NPH_L;
        if (IN(p0 + PH_CONVW)) { FRESH(); _Pragma("unroll 1") for (int rep_ = 0; rep_ < (int)((args.reps >> (2 * 0)) & 3u); ++rep_) { if (rep_) { __syncthreads(); } ph_convw(F, l); } SEAM(p0 + PH_CONVW); }
        if (IN(p0 + PH_NORM1)) { FRESH(); _Pragma("unroll 1") for (int rep_ = 0; rep_ < (int)((args.reps >> (2 * 1)) & 3u); ++rep_) { if (rep_) { __syncthreads(); } ph_norm1(F, l); } SEAM(p0 + PH_NORM1); }
        if (IN(p0 + PH_INPROJ)) {
            SchedDense<DM, DM> S; S.T.init(NTOK / 256, PW / 256, F.G, (int)blockIdx.x); S.A = (const char*)(F.ws + WS_XN); S.B = (const char*)(F.ws + WS_WIN);
            EpiProj E{(bf16*)(F.ws + WS_PROJ), gif_ptr(F)};
            _Pragma("unroll 1") for (int rep_ = 0; rep_ < (int)((args.reps >> (2 * 10)) & 3u); ++rep_) { if (rep_) { __syncthreads(); } pg8::gemm_phase<SchedDense<DM, DM>, EpiProj, DM, DM, DM, true>(F.lds, S, E, (F.wave * 64 + fresh_lane())); }
            SEAM(p0 + PH_INPROJ);
        }
        if (IN(p0 + PH_NVCONV)) { FRESH(); _Pragma("unroll 1") for (int rep_ = 0; rep_ < (int)((args.reps >> (2 * 2)) & 3u); ++rep_) { if (rep_) { __syncthreads(); } ml_delta(F, l); } SEAM(p0 + PH_NVCONV); }
        if (IN(p0 + PH_NVMLSTM)) { FRESH(); _Pragma("unroll 1") for (int rep_ = 0; rep_ < (int)((args.reps >> (2 * 3)) & 3u); ++rep_) { if (rep_) { __syncthreads(); } ml_scan(F); } SEAM(p0 + PH_NVMLSTM); }
        if (IN(p0 + PH_NVMNORM)) { FRESH(); _Pragma("unroll 1") for (int rep_ = 0; rep_ < (int)((args.reps >> (2 * 4)) & 3u); ++rep_) { if (rep_) { __syncthreads(); } ml_out(F, l); } SEAM(p0 + PH_NVMNORM); }
        if (IN(p0 + PH_NVIDX)) { FRESH(); _Pragma("unroll 1") for (int rep_ = 0; rep_ < (int)((args.reps >> (2 * 5)) & 3u); ++rep_) { if (rep_) { __syncthreads(); } dsa_index(F); } SEAM(p0 + PH_NVIDX); }
        if (IN(p0 + PH_NVDSA)) { FRESH(); _Pragma("unroll 1") for (int rep_ = 0; rep_ < (int)((args.reps >> (2 * 6)) & 3u); ++rep_) { if (rep_) { __syncthreads(); } dsa_attn(F, l); } SEAM(p0 + PH_NVDSA); }
        if (IN(p0 + PH_NVSB)) { FRESH(); _Pragma("unroll 1") for (int rep_ = 0; rep_ < (int)((args.reps >> (2 * 7)) & 3u); ++rep_) { if (rep_) { __syncthreads(); } sb_attn(F); } SEAM(p0 + PH_NVSB); }
        if (IN(p0 + PH_BRANCH)) {
            SchedBranch S; S.T.init(NTOK / 256, DM / 256, F.G, (int)blockIdx.x); S.A = (const char*)(F.ws + WS_BR); S.B = (const char*)(F.ws + WS_WBR);
            EpiBranch E{(const bf16*)(F.ws + WS_PROJ), (float*)(F.ws + WS_X1), (bf16*)(F.ws + WS_MRG)};
            _Pragma("unroll 1") for (int rep_ = 0; rep_ < (int)((args.reps >> (2 * 11)) & 3u); ++rep_) { if (rep_) { __syncthreads(); } pg8::gemm_phase<SchedBranch, EpiBranch, BW, 3072, BW, true>(F.lds, S, E, (F.wave * 64 + fresh_lane())); }
            SEAM(p0 + PH_BRANCH);
        }
        if (IN(p0 + PH_OUT)) {
            SchedDense<DM, DM> S; S.T.init(NTOK / 256, DM / 256, F.G, (int)blockIdx.x); S.A = (const char*)(F.ws + WS_MRG); S.B = (const char*)(F.ws + WS_WOUT);
            EpiOut E{l == 0 ? arg_in(0) : (const float*)(F.ws + WS_XA), (float*)(F.ws + WS_X1)};
            _Pragma("unroll 1") for (int rep_ = 0; rep_ < (int)((args.reps >> (2 * 12)) & 3u); ++rep_) { if (rep_) { __syncthreads(); } pg8::gemm_phase<SchedDense<DM, DM>, EpiOut, DM, DM, DM, true>(F.lds, S, E, (F.wave * 64 + fresh_lane())); }
            SEAM(p0 + PH_OUT);
        }
        if (IN(p0 + PH_NORM2)) { FRESH(); _Pragma("unroll 1") for (int rep_ = 0; rep_ < (int)((args.reps >> (2 * 8)) & 3u); ++rep_) { if (rep_) { __syncthreads(); } ph_norm2_mfma(F, l); } SEAM(p0 + PH_NORM2); }
        if (IN(p0 + PH_MOE)) { FRESH();
#if MK_NAIVE_MOE
            nv_moe(F);
#else
            moe_tables(F, l);
            SchedMoeUp S; S.tp = (const LAS int*)(F.lds + MOE_TAB_OFF); S.cn = S.tp + 40; S.sb = S.cn + 40; S.G = F.G; S.c = (int)blockIdx.x;
            S.A = (const char*)(F.ws + WS_XN); S.B = (const char*)(F.ws + WS_WGU); S.list = (const int*)(F.ws + WS_LIST);
            EpiMoeUp E{(bf16*)(F.ws + WS_HB), S.sb};
            _Pragma("unroll 1") for (int rep_ = 0; rep_ < (int)((args.reps >> (2 * 13)) & 3u); ++rep_) { if (rep_) { __syncthreads(); } pg8::gemm_phase<SchedMoeUp, EpiMoeUp, DM, DM, DM, true>(F.lds, S, E, (F.wave * 64 + fresh_lane())); }
#endif
            SEAM(p0 + PH_MOE); }
        if (IN(p0 + PH_MOED)) { FRESH();
#if !MK_NAIVE_MOE
            moe_tables(F, l);
            SchedMoeDown S; S.tp = (const LAS int*)(F.lds + MOE_TAB_OFF); S.cn = S.tp + 40; S.sb = S.cn + 40; S.G = F.G; S.c = (int)blockIdx.x;
            S.A = (const char*)(F.ws + WS_HB); S.B = (const char*)(F.ws + WS_WDN);
            EpiMoeDown E{(bf16*)(F.ws + WS_YB), (const int*)(F.ws + WS_LIST), (const int*)tokinfo_ptr(F)};
            _Pragma("unroll 1") for (int rep_ = 0; rep_ < (int)((args.reps >> (2 * 14)) & 3u); ++rep_) { if (rep_) { __syncthreads(); } pg8::gemm_phase<SchedMoeDown, EpiMoeDown, DEXP, DEXP, DEXP, true>(F.lds, S, E, (F.wave * 64 + fresh_lane())); }
#endif
            SEAM(p0 + PH_MOED); }
    }
    if (IN(PH_FINAL)) { FRESH(); } if (IN(PH_FINAL)) ph_final(F, args.out);
#undef IN
#undef SEAM
}

#ifndef MK_ONE_LAUNCH
#define MK_ONE_LAUNCH 1
#endif
extern "C" void kernel_launch(void* const* d_in, const int* in_sizes, int n_in, void* d_out, int out_size, void* d_ws, size_t ws_size, hipStream_t stream) {
    static int grid = 0;
    if (grid == 0) {
        if (n_in != 20 || in_sizes[0] != NTOK * DM || out_size != NTOK * DM || ws_size < WS_END) { fprintf(stderr, "kernel_launch: shape mismatch (n_in %d, ws %zu < %zu?)\n", n_in, ws_size, (size_t)WS_END); grid = -1; return; }
        int dev = 0, cus = 0, per_cu = 0;
        if (hipGetDevice(&dev) != hipSuccess || hipDeviceGetAttribute(&cus, hipDeviceAttributeMultiprocessorCount, dev) != hipSuccess) { grid = -1; return; }
        if (hipFuncSetAttribute((const void*)fwd_kernel, hipFuncAttributeMaxDynamicSharedMemorySize, LDS_BYTES) != hipSuccess) { fprintf(stderr, "kernel_launch: hipFuncSetAttribute failed\n"); grid = -1; return; }
        if (hipOccupancyMaxActiveBlocksPerMultiprocessor(&per_cu, (const void*)fwd_kernel, NTHR, LDS_BYTES) != hipSuccess || per_cu < 1) fprintf(stderr, "kernel_launch: occupancy query says %d\n", per_cu);
        (void)hipGetLastError();
        grid = cus;
    }
    if (grid < 0) return;
    if (hipMemsetAsync((char*)d_ws + WS_CTL, 0, CTL_ZERO_BYTES, stream) != hipSuccess) return;
    Args a{};
    for (int i = 0; i < 20; ++i) a.in[i] = (const float*)d_in[i];
    a.out = (float*)d_out; a.ws = (unsigned char*)d_ws;
    { unsigned r = 0; for (int k = 0; k < 15; ++k) r |= (1u + ((PROBE_MASK >> k) & 1u)) << (2 * k); a.reps = r; }
#if MK_ONE_LAUNCH
    a.ph_lo = 0; a.ph_hi = NPH; a.use_bar = 1;
    hipLaunchKernelGGL(fwd_kernel, dim3(grid), dim3(NTHR), LDS_BYTES, stream, a);
#else
    for (int ph = 0; ph < NPH; ++ph) { a.ph_lo = ph; a.ph_hi = ph + 1; a.use_bar = 0;
        hipLaunchKernelGGL(fwd_kernel, dim3(grid), dim3(NTHR), LDS_BYTES, stream, a); }
#endif
    const hipError_t le = hipPeekAtLastError();
    if (le != hipSuccess) fprintf(stderr, "kernel_launch: launch failed: %s\n", hipGetErrorName(le));
}
```

```cpp
#define PROBE_MASK 0x0
#include <hip/hip_runtime.h>
#include <cstdio>
#include <cstdint>

constexpr int BATCH = 4, SEQ = 2048, DM = 2048, NTOK = BATCH * SEQ, NH = 8, HD = 128, BW = 1024, DEPTH = 2;
constexpr int NIN = 17504, PW = 17664;
constexpr int IDXH = 16, IDXD = 64, TOPK = 256, NEXP = 32, NGRP = 4, EPG = 8, DEXP = 512, MCH = 64, NCH = SEQ / MCH;
constexpr float EPS = 1e-6f;
constexpr int C_MQ = 0, C_MK = 1024, C_MV = 2048, C_MO = 3072, C_DQ = 4096, C_DK = 5120, C_DV = 6144, C_IQ = 7168, C_SQ = 8192, C_SK = 9216, C_SV = 10240,
              C_G = 11264, C_MI = 17408, C_MF = 17416, C_IK = 17424, C_IW = 17488;
__host__ __device__ __forceinline__ int src_col(int c) {
    if (c < 4096) return c;
    if (c < 8192) return c + 16;
    if (c < 17408) return c + 96;
    if (c < 17424) return 4096 + (c - 17408);
    if (c < 17488) return 8208 + (c - 17424);
    if (c < 17504) return 8272 + (c - 17488);
    return -1;
}

constexpr size_t MiB = 1u << 20;
constexpr size_t WS_CTL = 0, CTL_ZERO_BYTES = 1 * MiB;
constexpr size_t WS_WIN = 1 * MiB;
constexpr size_t WS_WBR = WS_WIN + 69 * MiB;
constexpr size_t WS_WOUT = WS_WBR + 12 * MiB;
constexpr size_t WS_WGU = WS_WOUT + 8 * MiB;
constexpr size_t WS_WDN = WS_WGU + 128 * MiB;
constexpr size_t WS_XN = WS_WDN + 64 * MiB;
constexpr size_t WS_XA = WS_XN + 32 * MiB;
constexpr size_t WS_X1 = WS_XA + 64 * MiB;
constexpr size_t WS_PROJ = WS_X1 + 64 * MiB;
constexpr size_t WS_BR = WS_PROJ + 276 * MiB;
constexpr size_t WS_MRG = WS_BR + 48 * MiB;
constexpr size_t WS_MASK = WS_MRG + 32 * MiB;
constexpr size_t WS_MDEL = WS_MASK + 2 * MiB;
constexpr size_t WS_MDN = WS_MDEL + 64 * MiB;
constexpr size_t WS_MST = WS_MDN + 1 * MiB;
constexpr size_t WS_MSN = WS_MST + 32 * MiB;
constexpr size_t WS_HB = WS_MSN + 1 * MiB;
constexpr size_t WS_YB = WS_HB + 16 * MiB;
constexpr size_t WS_LIST = WS_YB + 64 * MiB;
constexpr size_t WS_TMP = WS_LIST + 2 * MiB;
constexpr size_t WS_END = WS_TMP + 96 * MiB;
static_assert(WS_END <= 1100 * MiB, "workspace map");

constexpr int CW_BAR = 4096;
constexpr int CW_ECNT = 16384;

#define GAS __attribute__((address_space(1)))
#define LAS __attribute__((address_space(3)))
typedef unsigned short bf16;
typedef unsigned v4u __attribute__((ext_vector_type(4)));
typedef unsigned v2u __attribute__((ext_vector_type(2)));
typedef float f32x4 __attribute__((ext_vector_type(4)));
typedef float f32x2 __attribute__((ext_vector_type(2)));
typedef float f32x16 __attribute__((ext_vector_type(16)));
typedef short bf16x8 __attribute__((ext_vector_type(8)));
typedef short s16x4 __attribute__((ext_vector_type(4)));
#define RLX_AGENT __ATOMIC_RELAXED, __HIP_MEMORY_SCOPE_AGENT
#define LDS_WAIT() asm volatile("s_waitcnt lgkmcnt(0)" ::: "memory")
#define VM_WAIT() asm volatile("s_waitcnt vmcnt(0)" ::: "memory")
constexpr int NWAVES = 8, NTHR = 512;
constexpr int RING_BYTES = 131072, LDSCTL_OFF = RING_BYTES, LDS_BYTES = 147456;

__device__ __forceinline__ unsigned f2bf(float f) { unsigned u = __builtin_bit_cast(unsigned, f); return (u + 0x7fffu + ((u >> 16) & 1u)) >> 16; }
__device__ __forceinline__ unsigned pk2(float lo, float hi) { return f2bf(lo) | (f2bf(hi) << 16); }
__device__ __forceinline__ float bf2f(unsigned short b) { return __builtin_bit_cast(float, ((unsigned)b) << 16); }
__device__ __forceinline__ float bflo(unsigned w) { return __builtin_bit_cast(float, w << 16); }
__device__ __forceinline__ float bfhi(unsigned w) { return __builtin_bit_cast(float, w & 0xffff0000u); }
__device__ __forceinline__ unsigned cvt_pk_bf16(float lo, float hi) { unsigned r; asm volatile("v_cvt_pk_bf16_f32 %0, %1, %2" : "=v"(r) : "v"(lo), "v"(hi)); return r; }
__device__ __forceinline__ float wave_sum(float v) {
#pragma unroll
    for (int o = 1; o < 64; o <<= 1) v += __shfl_xor(v, o);
    return v;
}
__device__ __forceinline__ float wave_max(float v) {
#pragma unroll
    for (int o = 1; o < 64; o <<= 1) v = fmaxf(v, __shfl_xor(v, o));
    return v;
}
__device__ __forceinline__ float sigmoidf_(float x) { return 1.0f / (1.0f + __expf(-x)); }
__device__ __forceinline__ float siluf_(float x) { return x / (1.0f + __expf(-x)); }
__device__ __forceinline__ float logsigmoidf_(float x) { return fminf(x, 0.f) - log1pf(__expf(-fabsf(x))); }
__device__ __forceinline__ int t5_bucket(int n) {
    if (n < 16) return n;
    return 16 + (n >= 19) + (n >= 21) + (n >= 24) + (n >= 27) + (n >= 31) + (n >= 35) + (n >= 40) + (n >= 46) + (n >= 52) + (n >= 59) + (n >= 67) + (n >= 77) + (n >= 87) + (n >= 99) + (n >= 113);
}
namespace pg8 {
constexpr int BM = 256, BK = 64, HALF = 128, HTB = HALF * BK * 2, STAGE_BYTES = 8 * HTB, NXCD = 8, WGM = 8;
__host__ __device__ __forceinline__ int lds_byte(int r, int c) { const int st = (r >> 4) * 2 + (c >> 5), rr = r & 15, cc = c & 31, ob = rr * 64 + cc * 2; return st * 1024 + (ob ^ (((ob >> 9) & 1) << 5)); }
__host__ __device__ __forceinline__ void stage_rc(int b, int& R, int& C) { const int st = b / 1024, sb = b % 1024, swz = sb ^ (((sb >> 9) & 1) << 5); R = (st >> 1) * 16 + swz / 64; C = (st & 1) * 32 + (swz % 64) / 2; }
__host__ __device__ __forceinline__ int perm32(int rho) { const int n = rho >> 4, i = rho & 15; return 8 * (i >> 2) + 4 * n + (i & 3); }

struct Unit { int pm, pn, e, rows; };

struct TileOrder {
    int nM, nN, nwg, G, c;
    __device__ void init(int nM_, int nN_, int G_, int c_) { nM = nM_; nN = nN_; nwg = nM * nN; G = G_; c = c_; }
    __device__ bool tile(int i, int& pm, int& pn) const {
        const long L = (long)i * G + c; if (L >= nwg) return false;
        int wgid = (int)L; { const int q = nwg / NXCD, r = nwg % NXCD, xcd = wgid % NXCD, off = wgid / NXCD; wgid = (xcd < r ? xcd * (q + 1) : r * (q + 1) + (xcd - r) * q) + off; }
        const int nig = WGM * nN, gid = wgid / nig, fm = gid * WGM, gsz = (nM - fm) < WGM ? (nM - fm) : WGM;
        pm = fm + ((wgid % nig) % gsz); pn = (wgid % nig) / gsz; return true;
    }
};

template <class Sched, class Epi, int K, int LDA, int LDB, bool ALIGN_EPI>
__device__ __forceinline__ void gemm_phase(LAS unsigned char* lds, const Sched& S, const Epi& E, int tid_in) {
    int tid_ = tid_in; asm volatile("" : "+v"(tid_));
    const int tid = tid_, wid = __builtin_amdgcn_readfirstlane(tid >> 6), lane = tid & 63, wr = wid >> 2, wc = wid & 3, fr = lane & 15, fq = lane >> 4;
    constexpr int nt = K / BK;
    static_assert(K % 128 == 0 && K >= 256, "K");
    unsigned voffB[2];
#pragma unroll
    for (int i = 0; i < 2; ++i) { int R, C; stage_rc(tid * 16 + i * 8192, R, C); const int Rb = Epi::PERM ? ((R & ~31) + perm32(R & 31)) : R;
        voffB[i] = (unsigned)(Rb * LDB + C) * 2u; }
    constexpr size_t kstep = (size_t)(BK * 2);
    constexpr size_t hstepB = (size_t)HALF * LDB * 2;
    constexpr size_t hstepA = Sched::GATHER ? 0 : (size_t)HALF * LDA * 2;
    const unsigned ldsw = (unsigned)wid * 1024u;
    const int aoff = lds_byte(wr * 64 + fr, fq * 8), boff = lds_byte(wc * 32 + fr, fq * 8);
#define PG8_SA(b, h) (((b) * 2 + (h)) * HTB)
#define PG8_SB(b, h) ((4 + (b) * 2 + (h)) * HTB)
#define PG8_STAGE(bufoff, gbase, voff) do { _Pragma("unroll") for (int _i = 0; _i < 2; ++_i) \
        __builtin_amdgcn_global_load_lds((const unsigned*)((const char*)(gbase) + (voff)[_i]), (LAS unsigned*)(lds + (bufoff) + ldsw + _i * 8192), 16, 0, 0); } while (0)
#define PG8_LDA(dst, b, h) do { _Pragma("unroll") for (int m = 0; m < 4; ++m) _Pragma("unroll") for (int k = 0; k < 2; ++k) dst[m][k] = *(const LAS bf16x8*)(lds + PG8_SA(b, h) + aoff + m * 2048 + k * 1024); } while (0)
#define PG8_LDB(dst, b, h) do { _Pragma("unroll") for (int n = 0; n < 2; ++n) _Pragma("unroll") for (int k = 0; k < 2; ++k) dst[n][k] = *(const LAS bf16x8*)(lds + PG8_SB(b, h) + boff + n * 2048 + k * 1024); } while (0)
#define PG8_MMA(ai, bj, At, Bt) do { __builtin_amdgcn_s_setprio(1); _Pragma("unroll") for (int m = 0; m < 4; ++m) _Pragma("unroll") for (int n = 0; n < 2; ++n) _Pragma("unroll") for (int k = 0; k < 2; ++k) \
        acc[ai][bj][m][n] = __builtin_amdgcn_mfma_f32_16x16x32_bf16(Bt[n][k], At[m][k], acc[ai][bj][m][n], 0, 0, 0); __builtin_amdgcn_s_setprio(0); } while (0)
#define VA1 (Sched::GATHER ? vA1 : vA0)
#define W0 vA0
#define W1 VA1
#define PG8_WAIT_V(n) asm volatile("s_waitcnt vmcnt(" #n ")" ::: "memory")
#define PG8_WAIT_L(n) asm volatile("s_waitcnt lgkmcnt(" #n ")" ::: "memory")
#define PG8_BAR __builtin_amdgcn_s_barrier()
#define PG8_SCHED __builtin_amdgcn_sched_barrier(0)
    Unit cur, nxt; int ui = 0;
    if (!S.next(0, cur)) return;
    f32x4 acc[2][2][4][2];
#pragma unroll
    for (int a = 0; a < 2; ++a)
#pragma unroll
        for (int b = 0; b < 2; ++b)
#pragma unroll
            for (int m = 0; m < 4; ++m)
#pragma unroll
                for (int n = 0; n < 2; ++n) acc[a][b][m][n] = (f32x4){0.f, 0.f, 0.f, 0.f};
    bf16x8 At[4][2], B0[2][2], B1[2][2];
    unsigned vA0[2], vA1[2];
    S.a_off(cur, tid, vA0, vA1);
    const char* cA = S.a_base(cur); const char* cB = S.b_base(cur);
    PG8_STAGE(PG8_SB(0, 0), cB, voffB); PG8_STAGE(PG8_SB(0, 1), cB + hstepB, voffB); PG8_STAGE(PG8_SA(0, 0), cA, vA0); PG8_STAGE(PG8_SA(0, 1), cA + hstepA, VA1);
    if (wr == 1) PG8_BAR;
    PG8_WAIT_V(2); PG8_BAR;
    PG8_STAGE(PG8_SB(1, 0), cB + kstep, voffB); PG8_STAGE(PG8_SA(1, 0), cA + kstep, vA0); PG8_STAGE(PG8_SB(1, 1), cB + hstepB + kstep, voffB);
    PG8_WAIT_V(6); PG8_BAR;
    for (;;) {
        const bool has_next = S.next(ui + 1, nxt);
        const char* nA = has_next ? S.a_base(nxt) : cA; const char* nB = has_next ? S.b_base(nxt) : cB;
        for (int t = 0; t < nt; t += 2) {
            const bool last = (t == nt - 2);
            const char* a1 = cA + (size_t)(t + 1) * kstep;
            const char* a2 = last ? nA : cA + (size_t)(t + 2) * kstep; const char* b2 = last ? nB : cB + (size_t)(t + 2) * kstep;
            const char* a3 = a2 + kstep; const char* b3 = b2 + kstep;
            PG8_LDB(B0, 0, 0); PG8_LDB(B1, 0, 1); PG8_SCHED; PG8_LDA(At, 0, 0); PG8_STAGE(PG8_SA(1, 1), a1 + hstepA, VA1);
            if constexpr (Sched::GATHER) { if (last && has_next) S.a_off(nxt, tid, vA0, vA1); }
            PG8_WAIT_V(8); PG8_WAIT_L(0); PG8_BAR; PG8_MMA(0, 0, At, B0); PG8_MMA(0, 1, At, B1); PG8_BAR; PG8_SCHED;
            PG8_LDA(At, 0, 1); PG8_STAGE(PG8_SB(0, 0), b2, voffB); PG8_STAGE(PG8_SB(0, 1), b2 + hstepB, voffB); PG8_STAGE(PG8_SA(0, 0), a2, W0);
            PG8_WAIT_V(8); PG8_WAIT_L(0); PG8_BAR; PG8_MMA(1, 0, At, B0); PG8_MMA(1, 1, At, B1); PG8_BAR; PG8_SCHED;
            PG8_LDB(B0, 1, 0); PG8_LDB(B1, 1, 1); PG8_SCHED; PG8_LDA(At, 1, 0); PG8_STAGE(PG8_SA(0, 1), a2 + hstepA, W1);
            PG8_WAIT_V(8); PG8_WAIT_L(0); PG8_BAR; PG8_MMA(0, 0, At, B0); PG8_MMA(0, 1, At, B1); PG8_BAR; PG8_SCHED;
            PG8_LDA(At, 1, 1); PG8_STAGE(PG8_SB(1, 0), b3, voffB); PG8_STAGE(PG8_SB(1, 1), b3 + hstepB, voffB); PG8_STAGE(PG8_SA(1, 0), a3, W0);
            PG8_WAIT_V(8); PG8_WAIT_L(0); PG8_BAR; PG8_MMA(1, 0, At, B0); PG8_MMA(1, 1, At, B1); PG8_BAR; PG8_SCHED;
        }
        if constexpr (ALIGN_EPI) { if (wr == 0) PG8_BAR; }
        { int fr_e = fr, fq_e = fq; asm volatile("" : "+v"(fr_e), "+v"(fq_e));
          E(acc, cur, wr, wc, fr_e, fq_e); }
        if (!has_next) break;
        if (E.zero_after(cur)) {
#pragma unroll
        for (int a = 0; a < 2; ++a)
#pragma unroll
            for (int b = 0; b < 2; ++b)
#pragma unroll
                for (int m = 0; m < 4; ++m)
#pragma unroll
                    for (int n = 0; n < 2; ++n) acc[a][b][m][n] = (f32x4){0.f, 0.f, 0.f, 0.f}; }
        cur = nxt; cA = nA; cB = nB; ++ui;
        if constexpr (ALIGN_EPI) { if (wr == 1) PG8_BAR; }
    }
    PG8_WAIT_V(0);
    if constexpr (!ALIGN_EPI) { if (wr == 0) PG8_BAR; }
    PG8_BAR;
#undef PG8_SA
#undef VA1
#undef W0
#undef W1
#undef PG8_SB
#undef PG8_STAGE
#undef PG8_LDA
#undef PG8_LDB
#undef PG8_MMA
#undef PG8_WAIT_V
#undef PG8_WAIT_L
#undef PG8_BAR
#undef PG8_SCHED
}
}
#define XB_TMO      128
#define XB_XCNT(j)  (256  + 64 * (j))
#define XB_XSUB(j)  (1280 + 64 * (j))
#define XB_XGEN(j)  (2304 + 64 * (j))
#define XB_TOP      3328
#define XB_TOPGEN   3392
#define XCD_BAR_WORDS 3456
#define XB_SPIN_CAP (1u << 18)
__device__ __forceinline__ unsigned xb_ld(unsigned* p)              { return __hip_atomic_load(p, __ATOMIC_RELAXED, __HIP_MEMORY_SCOPE_AGENT); }
__device__ __forceinline__ unsigned xb_add(unsigned* p, unsigned v) { return __hip_atomic_fetch_add(p, v, __ATOMIC_RELAXED, __HIP_MEMORY_SCOPE_AGENT); }
__device__ __forceinline__ unsigned xb_xcc_id() { return (unsigned)__builtin_amdgcn_s_getreg((3 << 11) | 20) & 0xFu; }
#define XB_SPIN(cond, bar) do { unsigned _sp = 0; while (cond) { __builtin_amdgcn_s_sleep(1); \
    if ((++_sp & 255u) == 0u) { if (xb_ld(&(bar)[XB_TMO])) break; if (_sp > XB_SPIN_CAP) { atomicAdd(&(bar)[XB_TMO], 1u); break; } } } } while (0)
struct XcdBarrier { unsigned* bar; unsigned x; volatile LAS unsigned* st; };
__device__ __forceinline__ XcdBarrier xcd_barrier_post(unsigned* bar, volatile LAS unsigned* st) {
    XcdBarrier b; b.bar = bar; b.x = xb_xcc_id(); b.st = st;
    if (threadIdx.x == 0) (void)xb_add(&bar[XB_XCNT(b.x)], 1u);
    return b;
}
__device__ __forceinline__ void xcd_barrier_complete(unsigned* bar, unsigned x, unsigned& nloc, unsigned& nx) {
    const unsigned G = gridDim.x * gridDim.y * gridDim.z;
    unsigned sum, cnt, mine, sp = 0u;
    for (;;) {
        sum = 0u; cnt = 0u; mine = 0u;
#pragma unroll
        for (unsigned j = 0; j < 16; ++j) { const unsigned c = xb_ld(&bar[XB_XCNT(j)]); sum += c; cnt += (c > 0u) ? 1u : 0u; mine = (j == x) ? c : mine; }
        if (sum == G) break;
        __builtin_amdgcn_s_sleep(1);
        if ((++sp & 255u) == 0u) { if (xb_ld(&bar[XB_TMO])) break; if (sp > XB_SPIN_CAP) { atomicAdd(&bar[XB_TMO], 1u); break; } }
    }
    nloc = mine > 0u ? mine : 1u; nx = cnt > 0u ? cnt : 1u;
}
__device__ __forceinline__ void xcd_barrier(const XcdBarrier& b, int tid) {
    asm volatile("s_waitcnt vmcnt(0)" ::: "memory");
    __syncthreads();
    if (tid == 0) {
        unsigned* bar = b.bar; asm volatile("" : "+s"(bar));
        __builtin_amdgcn_s_waitcnt(0);
        unsigned nloc = b.st[0], nx = b.st[1];
        if (nloc == 0u) { xcd_barrier_complete(bar, b.x, nloc, nx); b.st[0] = nloc; b.st[1] = nx; }
        const unsigned old = xb_add(&bar[XB_XSUB(b.x)], 1u);
        const unsigned gen = old / nloc;
        if (old + 1u == (gen + 1u) * nloc) {
            __builtin_amdgcn_fence(__ATOMIC_RELEASE, "agent");
            asm volatile("s_waitcnt vmcnt(0)" ::: "memory");
            const unsigned og = xb_add(&bar[XB_TOP], 1u);
            const unsigned tg = og / nx;
            if (og + 1u == (tg + 1u) * nx) xb_add(&bar[XB_TOPGEN], 1u);
            else XB_SPIN(xb_ld(&bar[XB_TOPGEN]) == tg, bar);
            __builtin_amdgcn_fence(__ATOMIC_ACQUIRE, "agent");
            xb_add(&bar[XB_XGEN(b.x)], 1u);
            asm volatile("s_waitcnt vmcnt(0)" ::: "memory");
        } else {
            XB_SPIN(xb_ld(&bar[XB_XGEN(b.x)]) == gen, bar);
            __builtin_amdgcn_fence(__ATOMIC_ACQUIRE, "agent");
            asm volatile("s_waitcnt vmcnt(0)" ::: "memory");
        }
    }
    __syncthreads();
}

struct Args { const float* in[20]; float* out; unsigned char* ws; int ph_lo, ph_hi, use_bar; unsigned reps; };
struct Frame {
    LAS unsigned char* lds;
    unsigned* ctl;
    int wave, vcu, G;
    unsigned char* ws;
};
__device__ __forceinline__ int fresh_lane() { int l_; asm volatile("v_mbcnt_lo_u32_b32 %0, -1, 0\n\tv_mbcnt_hi_u32_b32 %0, -1, %0" : "=v"(l_)); return l_; }
__device__ __forceinline__ const float* arg_in(int i) { asm volatile("" : "+s"(i)); return ((const float* const __attribute__((address_space(4)))*)__builtin_amdgcn_kernarg_segment_ptr())[i]; }
__device__ __forceinline__ unsigned char* arg_ws() { int i = 21; asm volatile("" : "+s"(i)); return ((unsigned char* const __attribute__((address_space(4)))*)__builtin_amdgcn_kernarg_segment_ptr())[i]; }
#define GW_ID(F) ((F).vcu * NWAVES + (F).wave)
#define GW_N(F) ((F).G * NWAVES)

__device__ __forceinline__ void cvt_item(const float* W, int ldw, int k0, int srcc, bf16* WT, size_t out_row0, int ldo, LAS float* scr, int lane) {
#pragma unroll 8
    for (int i = 0; i < 32; ++i) { const int kk = 2 * i + (lane >> 5); scr[kk * 33 + (lane & 31)] = srcc >= 0 ? W[(size_t)(k0 + kk) * ldw + srcc] : 0.f; }
    LDS_WAIT(); asm volatile("" ::: "memory");
    const int c = lane & 7;
#pragma unroll
    for (int j = 0; j < 4; ++j) { const int n = (lane >> 3) + 8 * j; const LAS float* s = scr + (8 * c) * 33 + n;
        v4u o; o.x = pk2(s[0 * 33], s[1 * 33]); o.y = pk2(s[2 * 33], s[3 * 33]); o.z = pk2(s[4 * 33], s[5 * 33]); o.w = pk2(s[6 * 33], s[7 * 33]);
        *(v4u*)(WT + (out_row0 + n) * (size_t)ldo + k0 + 8 * c) = o; }
    LDS_WAIT(); asm volatile("" ::: "memory");
}
__device__ __forceinline__ void ph_convw(const Frame& F, int l) {
    LAS float* scr = (LAS float*)(F.lds + F.wave * 16384);
    const int gw = GW_ID(F), NGW = GW_N(F), lane = fresh_lane(), ln = lane & 31;
    constexpr int I_IN = (PW / 32) * 32, I_BR = 3 * 64 * 16, I_OUT = 64 * 32, I_G = 32 * 16 * 32, I_D = 32 * 64 * 8;
    constexpr int NITEMS = I_IN + I_BR + I_OUT + 2 * I_G + I_D;
    for (int it = gw; it < NITEMS; it += NGW) {
        int r = it;
        if (r < I_IN) { const int kb = r / (PW / 32), nb = r % (PW / 32);
            cvt_item(arg_in(2) + (size_t)l * DM * NIN, NIN, 64 * kb, src_col(32 * nb + ln), (bf16*)(F.ws + WS_WIN), (size_t)32 * nb, DM, scr, lane); continue; }
        r -= I_IN;
        if (r < I_BR) { const int n = r / (64 * 16), q = r % (64 * 16), kb = q / 64, nb = q % 64;
            cvt_item(arg_in(9) + ((size_t)l * 3 + n) * BW * DM, DM, 64 * kb, 32 * nb + ln, (bf16*)(F.ws + WS_WBR) + (size_t)n * DM * BW, (size_t)32 * nb, BW, scr, lane); continue; }
        r -= I_BR;
        if (r < I_OUT) { const int kb = r / 64, nb = r % 64;
            cvt_item(arg_in(10) + (size_t)l * DM * DM, DM, 64 * kb, 32 * nb + ln, (bf16*)(F.ws + WS_WOUT), (size_t)32 * nb, DM, scr, lane); continue; }
        r -= I_OUT;
        if (r < 2 * I_G) { const int up = r >= I_G; if (up) r -= I_G; const int e = r / (16 * 32), q = r % (16 * 32), kb = q / 16, nb = q % 16, f0 = 32 * nb;
            cvt_item(arg_in(up ? 17 : 16) + ((size_t)l * NEXP + e) * DM * DEXP, DEXP, 64 * kb, f0 + ln, (bf16*)(F.ws + WS_WGU) + (size_t)e * 1024 * DM,
                     (size_t)((f0 >> 7) * 256 + (up ? 128 : 0) + (f0 & 127)), DM, scr, lane); continue; }
        r -= 2 * I_G;
        { const int e = r / (64 * 8), q = r % (64 * 8), kb = q / 64, nb = q % 64;
            cvt_item(arg_in(18) + ((size_t)l * NEXP + e) * DEXP * DM, DM, 64 * kb, 32 * nb + ln, (bf16*)(F.ws + WS_WDN) + (size_t)e * DM * DEXP, (size_t)32 * nb, DEXP, scr, lane); }
    }
}

__device__ __forceinline__ int* tokinfo_ptr(const Frame& F) { return (int*)(F.ws + WS_LIST + MiB); }

__device__ __forceinline__ void ph_norm1(const Frame& F, int l) {
    const int gw = GW_ID(F), NGW = GW_N(F), lane = fresh_lane();
    const float* g = arg_in(1) + (size_t)l * DM;
    bf16* XN = (bf16*)(F.ws + WS_XN);
    for (int m = gw; m < NTOK; m += NGW) {
        f32x4 v[8]; float s = 0.f;
        if (l == 0) {
            const f32x4* xr = (const f32x4*)(arg_in(0) + (size_t)m * DM) + lane;
#pragma unroll
            for (int j = 0; j < 8; ++j) v[j] = xr[64 * j];
        } else {
            const f32x4* xr = (const f32x4*)((const float*)(F.ws + WS_X1) + (size_t)m * DM) + lane;
            const v2u* y0 = (const v2u*)((const bf16*)(F.ws + WS_YB) + (size_t)(2 * m) * DM) + lane;
            const v2u* y1 = (const v2u*)((const bf16*)(F.ws + WS_YB) + (size_t)(2 * m + 1) * DM) + lane;
            f32x4* xo = (f32x4*)((float*)(F.ws + WS_XA) + (size_t)m * DM) + lane;
#pragma unroll
            for (int j = 0; j < 8; ++j) { f32x4 x = xr[64 * j]; const v2u a = y0[64 * j], b = y1[64 * j];
                x.x = (x.x + bflo(a.x)) + bflo(b.x); x.y = (x.y + bfhi(a.x)) + bfhi(b.x); x.z = (x.z + bflo(a.y)) + bflo(b.y); x.w = (x.w + bfhi(a.y)) + bfhi(b.y);
                v[j] = x; xo[64 * j] = x; }
        }
#pragma unroll
        for (int j = 0; j < 8; ++j) s += (v[j].x * v[j].x + v[j].y * v[j].y) + (v[j].z * v[j].z + v[j].w * v[j].w);
        const float rstd = 1.0f / sqrtf(wave_sum(s) * (1.f / DM) + EPS);
        v2u* o8 = (v2u*)(XN + (size_t)m * DM) + lane;
        const f32x4* gr = (const f32x4*)g + lane;
#pragma unroll
        for (int j = 0; j < 8; ++j) { const f32x4 gg = gr[64 * j]; v2u o; o.x = pk2(v[j].x * rstd * gg.x, v[j].y * rstd * gg.y); o.y = pk2(v[j].z * rstd * gg.z, v[j].w * rstd * gg.w); o8[64 * j] = o; }
    }
}

__device__ __forceinline__ void ph_final(const Frame& F, float* out) {
    const int gw = GW_ID(F), NGW = GW_N(F), lane = fresh_lane();
    for (int m = gw; m < NTOK; m += NGW) {
        const f32x4* xr = (const f32x4*)((const float*)(F.ws + WS_X1) + (size_t)m * DM) + lane;
        const v2u* y0 = (const v2u*)((const bf16*)(F.ws + WS_YB) + (size_t)(2 * m) * DM) + lane;
        const v2u* y1 = (const v2u*)((const bf16*)(F.ws + WS_YB) + (size_t)(2 * m + 1) * DM) + lane;
        f32x4* xo = (f32x4*)(out + (size_t)m * DM) + lane;
#pragma unroll
        for (int j = 0; j < 8; ++j) { f32x4 x = xr[64 * j]; const v2u a = y0[64 * j], b = y1[64 * j];
            x.x = (x.x + bflo(a.x)) + bflo(b.x); x.y = (x.y + bfhi(a.x)) + bfhi(b.x); x.z = (x.z + bflo(a.y)) + bflo(b.y); x.w = (x.w + bfhi(a.y)) + bfhi(b.y);
            xo[64 * j] = x; }
    }
}

__device__ __forceinline__ void ph_norm2(const Frame& F, int l) {
    const int gw = GW_ID(F), NGW = GW_N(F), lane = fresh_lane();
    const float* g = arg_in(11) + (size_t)l * DM;
    const float* wrg = arg_in(12) + (size_t)l * DM * NGRP; const float* brg = arg_in(13) + l * NGRP;
    const float* wre = arg_in(14) + (size_t)l * DM * NEXP; const float* bre = arg_in(15) + l * NEXP;
    bf16* XN = (bf16*)(F.ws + WS_XN);
    int* list = (int*)(F.ws + WS_LIST); int* tinfo = tokinfo_ptr(F);
    unsigned* ecnt = F.ctl + CW_ECNT + l * NEXP * 64;
    for (int m = gw; m < NTOK; m += NGW) {
        f32x4 v[8]; float s = 0.f;
        const f32x4* xr = (const f32x4*)((const float*)(F.ws + WS_X1) + (size_t)m * DM) + lane;
#pragma unroll
        for (int j = 0; j < 8; ++j) { v[j] = xr[64 * j]; s += (v[j].x * v[j].x + v[j].y * v[j].y) + (v[j].z * v[j].z + v[j].w * v[j].w); }
        const float rstd = 1.0f / sqrtf(wave_sum(s) * (1.f / DM) + EPS);
        v2u* o8 = (v2u*)(XN + (size_t)m * DM) + lane;
        const f32x4* gr = (const f32x4*)g + lane;
#pragma unroll
        for (int j = 0; j < 8; ++j) { const f32x4 gg = gr[64 * j]; v2u o; o.x = pk2(v[j].x * rstd * gg.x, v[j].y * rstd * gg.y); o.y = pk2(v[j].z * rstd * gg.z, v[j].w * rstd * gg.w); o8[64 * j] = o; }
        float lg[36];
#pragma unroll
        for (int q = 0; q < 36; ++q) lg[q] = 0.f;
#pragma unroll 1
        for (int j = 0; j < 8; ++j) { const f32x4 gg = gr[64 * j], xx = xr[64 * j]; f32x4 x; x.x = xx.x * rstd * gg.x; x.y = xx.y * rstd * gg.y; x.z = xx.z * rstd * gg.z; x.w = xx.w * rstd * gg.w;
            const int k0 = 4 * lane + 256 * j;
#pragma unroll
            for (int c = 0; c < 4; ++c) { const float xv = x[c];
                const f32x4 wg = *(const f32x4*)(wrg + (size_t)(k0 + c) * NGRP);
                lg[0] += xv * wg.x; lg[1] += xv * wg.y; lg[2] += xv * wg.z; lg[3] += xv * wg.w;
                const f32x4* we = (const f32x4*)(wre + (size_t)(k0 + c) * NEXP);
#pragma unroll
                for (int q = 0; q < 8; ++q) { const f32x4 w = we[q]; lg[4 + 4 * q] += xv * w.x; lg[5 + 4 * q] += xv * w.y; lg[6 + 4 * q] += xv * w.z; lg[7 + 4 * q] += xv * w.w; } } }
#pragma unroll
        for (int q = 0; q < 36; ++q) lg[q] = wave_sum(lg[q]);
        LAS float* lgL = (LAS float*)(F.lds + F.wave * 256);
        if (lane == 0) {
#pragma unroll
            for (int q = 0; q < 36; ++q) lgL[q] = lg[q];
            int gs = 0; float best = lg[0] + brg[0];
#pragma unroll
            for (int q = 1; q < 4; ++q) { const float t = lg[q] + brg[q]; if (t > best) { best = t; gs = q; } }
            float gm = fmaxf(fmaxf(lg[0], lg[1]), fmaxf(lg[2], lg[3])), gsum = 0.f, gsel = 0.f;
#pragma unroll
            for (int q = 0; q < 4; ++q) { const float e = __expf(lg[q] - gm); gsum += e; gsel = (q == gs) ? e : gsel; }
            const float pg = gsel / gsum;
            LDS_WAIT(); asm volatile("" ::: "memory");
            float ein[8];
#pragma unroll
            for (int q = 0; q < 8; ++q) ein[q] = lgL[4 + gs * 8 + q];
            int e0 = 0, e1 = -1; float b0 = -3.0e38f, b1 = -3.0e38f;
#pragma unroll
            for (int q = 0; q < 8; ++q) { const float t = ein[q] + bre[gs * 8 + q];
                if (t > b0) { b1 = b0; e1 = e0; b0 = t; e0 = q; } else if (t > b1) { b1 = t; e1 = q; } }
            float em = ein[0];
#pragma unroll
            for (int q = 1; q < 8; ++q) em = fmaxf(em, ein[q]);
            float p0 = 0.f, p1 = 0.f;
#pragma unroll
            for (int q = 0; q < 8; ++q) { const float e = __expf(ein[q] - em); p0 = (q == e0) ? e : p0; p1 = (q == e1) ? e : p1; }
            const float w0 = pg * p0 / (p0 + p1), w1 = pg * p1 / (p0 + p1);
            const int x0 = gs * 8 + e0, x1 = gs * 8 + e1;
            const int pos0 = (int)atomicAdd(ecnt + x0 * 64, 1u), pos1 = (int)atomicAdd(ecnt + x1 * 64, 1u);
            list[x0 * NTOK + pos0] = 2 * m; list[x1 * NTOK + pos1] = 2 * m + 1;
            tinfo[m * 8 + 0] = x0; tinfo[m * 8 + 1] = pos0; tinfo[m * 8 + 2] = __float_as_int(w0); tinfo[m * 8 + 3] = 0;
            tinfo[m * 8 + 4] = x1; tinfo[m * 8 + 5] = pos1; tinfo[m * 8 + 6] = __float_as_int(w1); tinfo[m * 8 + 7] = 0;
        }
    }
}

__device__ __forceinline__ void nv_conv(const Frame& F, int l) {
    const bf16* P = (const bf16*)(F.ws + WS_PROJ); float* QK = (float*)(F.ws + WS_TMP);
    const float* cw = arg_in(3) + (size_t)l * 4 * 2048;
    const size_t total = (size_t)NTOK * 2048, stride = (size_t)F.G * NTHR;
    for (size_t i = (size_t)F.vcu * NTHR + (F.wave * 64 + fresh_lane()); i < total; i += stride) {
        const int row = (int)(i >> 11), c = (int)(i & 2047), t = row & (SEQ - 1);
        float a = 0.f;
#pragma unroll
        for (int j = 0; j < 4; ++j) { const int tt = t - 3 + j; if (tt >= 0) a += cw[j * 2048 + c] * bf2f(P[(size_t)(row - 3 + j) * PW + c]); }
        QK[i] = siluf_(a);
    }
}
__device__ __forceinline__ void nv_mlstm(const Frame& F, int l) {
    const bf16* P = (const bf16*)(F.ws + WS_PROJ); const float* QK = (const float*)(F.ws + WS_TMP); float* HR = (float*)(F.ws + WS_TMP + 64 * MiB);
    const int tid = (F.wave * 64 + fresh_lane()), v = tid >> 2, kq = tid & 3;
    for (int bh = F.vcu; bh < BATCH * NH; bh += F.G) {
        const int b = bh >> 3, h = bh & 7;
        const float bi = arg_in(4)[l * NH + h], bfv = arg_in(5)[l * NH + h];
        float C[32], nn[32], m = 0.f;
#pragma unroll
        for (int j = 0; j < 32; ++j) { C[j] = 0.f; nn[j] = 0.f; }
        for (int t = 0; t < SEQ; ++t) {
            const size_t row = (size_t)b * SEQ + t;
            const float it = bf2f(P[row * PW + C_MI + h]) + bi, ft = bf2f(P[row * PW + C_MF + h]) + bfv;
            const float lf = logsigmoidf_(ft);
            const float mn = fmaxf(lf + m, it), ip = __expf(it - mn), fp = __expf(lf + m - mn); m = mn;
            const float vv = bf2f(P[row * PW + C_MV + h * HD + v]);
            const f32x4* qp = (const f32x4*)(QK + row * 2048 + h * HD + kq * 32);
            const f32x4* kp = (const f32x4*)(QK + row * 2048 + 1024 + h * HD + kq * 32);
            float num = 0.f, den = 0.f;
#pragma unroll
            for (int j4 = 0; j4 < 8; ++j4) { const f32x4 q = qp[j4], k = kp[j4];
#pragma unroll
                for (int c = 0; c < 4; ++c) { const int j = 4 * j4 + c; const float qq = q[c] * 0.08838834764831845f;
                    C[j] = fp * C[j] + ip * vv * k[c]; nn[j] = fp * nn[j] + ip * k[c]; num += C[j] * qq; den += nn[j] * qq; } }
            num += __shfl_xor(num, 1); num += __shfl_xor(num, 2); den += __shfl_xor(den, 1); den += __shfl_xor(den, 2);
            if (kq == 0) HR[row * 1024 + h * HD + v] = num / fmaxf(fabsf(den), __expf(-m));
        }
    }
}
__device__ __forceinline__ void nv_mnorm(const Frame& F, int l) {
    const bf16* P = (const bf16*)(F.ws + WS_PROJ); const float* HR = (const float*)(F.ws + WS_TMP + 64 * MiB); bf16* BR = (bf16*)(F.ws + WS_BR);
    const float* g = arg_in(6) + (size_t)l * BW;
    const int gw = GW_ID(F), NGW = GW_N(F), lane = fresh_lane();
    for (int it = gw; it < NTOK * NH; it += NGW) {
        const size_t row = it >> 3; const int h = it & 7, c = h * HD + 2 * lane;
        const float a = HR[row * 1024 + c], b = HR[row * 1024 + c + 1];
        const float r = 1.0f / sqrtf(wave_sum(a * a + b * b) * (1.f / HD) + EPS);
        const float o0 = a * r * g[c] * sigmoidf_(bf2f(P[row * PW + C_MO + c])), o1 = b * r * g[c + 1] * sigmoidf_(bf2f(P[row * PW + C_MO + c + 1]));
        *(unsigned*)(BR + row * 3072 + c) = pk2(o0, o1);
    }
}
__device__ __forceinline__ unsigned fkey(float f) { const unsigned u = __float_as_uint(f); return (u & 0x80000000u) ? ~u : (u | 0x80000000u); }
__device__ __forceinline__ void select_row(const unsigned (&key)[32], int nvalid, unsigned long long* mrow, int lane) {
    if (nvalid <= TOPK) {
#pragma unroll
        for (int j = 0; j < 32; ++j) { const unsigned long long b = __ballot(lane + 64 * j < nvalid); if (lane == 0) mrow[j] = b; }
        return;
    }
    unsigned T = 0u;
    for (int bit = 31; bit >= 0; --bit) {
        const unsigned cand = T | (1u << bit); int c = 0;
#pragma unroll
        for (int j = 0; j < 32; ++j) c += (key[j] >= cand) ? 1 : 0;
#pragma unroll
        for (int o = 1; o < 64; o <<= 1) c += __shfl_xor(c, o);
        if (c >= TOPK) T = cand;
    }
    int cgt = 0;
#pragma unroll
    for (int j = 0; j < 32; ++j) cgt += (key[j] > T) ? 1 : 0;
#pragma unroll
    for (int o = 1; o < 64; o <<= 1) cgt += __shfl_xor(cgt, o);
    const int need = TOPK - cgt; int run = 0;
    const unsigned long long below = (lane == 0) ? 0ull : (~0ull >> (64 - lane));
#pragma unroll
    for (int j = 0; j < 32; ++j) {
        const bool eq = key[j] == T; const unsigned long long be = __ballot(eq);
        const int rank = run + __popcll(be & below);
        const bool sel = (key[j] > T) || (eq && rank < need);
        run += __popcll(be);
        const unsigned long long b = __ballot(sel); if (lane == 0) mrow[j] = b;
    }
}
__device__ __forceinline__ void nv_index(const Frame& F) {
    const bf16* P = (const bf16*)(F.ws + WS_PROJ); unsigned long long* MK = (unsigned long long*)(F.ws + WS_MASK);
    LAS float* iqL = (LAS float*)(F.lds + F.wave * 12288); LAS float* scL = iqL + 1024;
    const int gw = GW_ID(F), NGW = GW_N(F), lane = fresh_lane();
    for (int row = gw; row < NTOK; row += NGW) {
        const int t = row & (SEQ - 1), r0 = row - t;
        for (int i = lane; i < 1024; i += 64) iqL[i] = bf2f(P[(size_t)row * PW + C_IQ + i]);
        float w[16];
#pragma unroll
        for (int hh = 0; hh < 16; ++hh) w[hh] = bf2f(P[(size_t)row * PW + C_IW + hh]) * 0.25f;
        LDS_WAIT(); asm volatile("" ::: "memory");
        for (int s = lane; s <= t; s += 64) {
            float d[16];
#pragma unroll
            for (int hh = 0; hh < 16; ++hh) d[hh] = 0.f;
            const v4u* kp = (const v4u*)(P + (size_t)(r0 + s) * PW + C_IK);
#pragma unroll 1
            for (int hf = 0; hf < 2; ++hf) {
                float kr[32];
#pragma unroll
                for (int q = 0; q < 4; ++q) { const v4u x = kp[4 * hf + q]; kr[8 * q] = bflo(x.x); kr[8 * q + 1] = bfhi(x.x); kr[8 * q + 2] = bflo(x.y); kr[8 * q + 3] = bfhi(x.y); kr[8 * q + 4] = bflo(x.z); kr[8 * q + 5] = bfhi(x.z); kr[8 * q + 6] = bflo(x.w); kr[8 * q + 7] = bfhi(x.w); }
#pragma unroll
                for (int hh = 0; hh < 16; ++hh) {
#pragma unroll
                    for (int e = 0; e < 32; ++e) d[hh] += iqL[hh * 64 + hf * 32 + e] * kr[e]; }
            }
            float sc = 0.f;
#pragma unroll
            for (int hh = 0; hh < 16; ++hh) sc += w[hh] * fmaxf(d[hh] * 0.125f, 0.f);
            scL[s] = sc;
        }
        LDS_WAIT(); asm volatile("" ::: "memory");
        unsigned key[32];
#pragma unroll
        for (int j = 0; j < 32; ++j) { const int s = lane + 64 * j; key[j] = (s <= t) ? fkey(scL[s]) : 0u; }
        select_row(key, t + 1, MK + (size_t)row * 32, lane);
        LDS_WAIT(); asm volatile("" ::: "memory");
    }
}
__device__ __forceinline__ void nv_dsa(const Frame& F, int l) {
    const bf16* P = (const bf16*)(F.ws + WS_PROJ); const unsigned long long* MK = (const unsigned long long*)(F.ws + WS_MASK); bf16* BR = (bf16*)(F.ws + WS_BR);
    const float* qg = arg_in(7) + l * HD; const float* kg = arg_in(8) + l * HD; const float* rb = arg_in(19);
    LAS float* lgL = (LAS float*)(F.lds + F.wave * 2048); LAS int* ixL = (LAS int*)(lgL + 256);
    const int gw = GW_ID(F), NGW = GW_N(F), lane = fresh_lane();
    for (int it = gw; it < NTOK * NH; it += NGW) {
        const int row = it >> 3, h = it & 7, t = row & (SEQ - 1), r0 = row - t, c = h * HD + 2 * lane;
        float q0 = bf2f(P[(size_t)row * PW + C_DQ + c]), q1 = bf2f(P[(size_t)row * PW + C_DQ + c + 1]);
        const float qr = 1.0f / sqrtf(wave_sum(q0 * q0 + q1 * q1) * (1.f / HD) + EPS);
        q0 *= qr * qg[2 * lane]; q1 *= qr * qg[2 * lane + 1];
        const float kg0 = kg[2 * lane], kg1 = kg[2 * lane + 1];
        int cnt = 0; float mx = -3.0e38f;
        for (int wi = 0; wi <= (t >> 6); ++wi) {
            unsigned long long w = MK[(size_t)row * 32 + wi];
            while (w) { const int s = wi * 64 + __builtin_ctzll(w); w &= w - 1;
                const unsigned kk = *(const unsigned*)(P + (size_t)(r0 + s) * PW + C_DK + c);
                const float k0 = bflo(kk), k1 = bfhi(kk);
                const float ss = wave_sum(k0 * k0 + k1 * k1), dd = wave_sum(q0 * k0 * kg0 + q1 * k1 * kg1);
                const float kr = 1.0f / sqrtf(ss * (1.f / HD) + EPS);
                const float lgt = dd * kr * 0.08838834764831845f + rb[t5_bucket(t - s) * NH + h];
                if (lane == 0) { lgL[cnt] = lgt; ixL[cnt] = s; }
                mx = fmaxf(mx, lgt); ++cnt; }
        }
        LDS_WAIT(); asm volatile("" ::: "memory");
        float o0 = 0.f, o1 = 0.f, den = 0.f;
        for (int j = 0; j < cnt; ++j) { const float p = __expf(lgL[j] - mx); const int s = ixL[j];
            const unsigned vv = *(const unsigned*)(P + (size_t)(r0 + s) * PW + C_DV + c);
            o0 += p * bflo(vv); o1 += p * bfhi(vv); den += p; }
        *(unsigned*)(BR + (size_t)row * 3072 + 1024 + c) = pk2(o0 / den, o1 / den);
        LDS_WAIT(); asm volatile("" ::: "memory");
    }
}
__device__ __forceinline__ void nv_sb(const Frame& F) {
    const bf16* P = (const bf16*)(F.ws + WS_PROJ); bf16* BR = (bf16*)(F.ws + WS_BR);
    const int gw = GW_ID(F), NGW = GW_N(F), lane = fresh_lane();
    for (int it = gw; it < NTOK * NH; it += NGW) {
        const int row = it >> 3, h = it & 7, t = row & (SEQ - 1), r0 = row - t, c = h * HD + 2 * lane;
        const unsigned qq = *(const unsigned*)(P + (size_t)row * PW + C_SQ + c);
        const float q0 = bflo(qq) * 0.08838834764831845f, q1 = bfhi(qq) * 0.08838834764831845f;
        float o0 = 0.f, o1 = 0.f, lp = 0.f;
        for (int s = t - 1; s >= 0; --s) {
            const unsigned kk = *(const unsigned*)(P + (size_t)(r0 + s) * PW + C_SK + c);
            const float z = wave_sum(q0 * bflo(kk) + q1 * bfhi(kk));
            const float a = __expf(logsigmoidf_(z) + lp);
            const unsigned vv = *(const unsigned*)(P + (size_t)(r0 + s) * PW + C_SV + c);
            o0 += a * bflo(vv); o1 += a * bfhi(vv);
            lp += logsigmoidf_(-z);
            if (lp < -80.f) break;
        }
        *(unsigned*)(BR + (size_t)row * 3072 + 2048 + c) = pk2(o0, o1);
    }
}
__device__ __forceinline__ void nv_moe(const Frame& F) {
    const bf16* XN = (const bf16*)(F.ws + WS_XN); bf16* YB = (bf16*)(F.ws + WS_YB); const int* tinfo = tokinfo_ptr(F);
    LAS float* xL = (LAS float*)F.lds; LAS float* hL = xL + 2048;
    const int tid = (F.wave * 64 + fresh_lane());
    for (int slot = F.vcu; slot < 2 * NTOK; slot += F.G) {
        const int m = slot >> 1, k = slot & 1; const int e = tinfo[m * 8 + 4 * k]; const float w = __int_as_float(tinfo[m * 8 + 4 * k + 2]);
        __syncthreads();
        for (int i = tid; i < 2048; i += NTHR) xL[i] = bf2f(XN[(size_t)m * DM + i]);
        __syncthreads();
        { const int f = tid; const bf16* wg = (const bf16*)(F.ws + WS_WGU) + ((size_t)e * 1024 + (f >> 7) * 256 + (f & 127)) * DM; const bf16* wu = wg + (size_t)128 * DM;
          float g = 0.f, u = 0.f;
          for (int k8 = 0; k8 < 256; ++k8) { const v4u a = ((const v4u*)wg)[k8], b = ((const v4u*)wu)[k8]; const LAS float* x = xL + 8 * k8;
              g += x[0] * bflo(a.x) + x[1] * bfhi(a.x) + x[2] * bflo(a.y) + x[3] * bfhi(a.y) + x[4] * bflo(a.z) + x[5] * bfhi(a.z) + x[6] * bflo(a.w) + x[7] * bfhi(a.w);
              u += x[0] * bflo(b.x) + x[1] * bfhi(b.x) + x[2] * bflo(b.y) + x[3] * bfhi(b.y) + x[4] * bflo(b.z) + x[5] * bfhi(b.z) + x[6] * bflo(b.w) + x[7] * bfhi(b.w); }
          hL[f] = bf2f((unsigned short)f2bf(siluf_(g) * u)); }
        __syncthreads();
        { float y[4];
#pragma unroll
          for (int c = 0; c < 4; ++c) { const int d = 4 * tid + c; const bf16* wd = (const bf16*)(F.ws + WS_WDN) + ((size_t)e * DM + d) * DEXP; float a = 0.f;
              for (int k8 = 0; k8 < 64; ++k8) { const v4u x = ((const v4u*)wd)[k8]; const LAS float* hh = hL + 8 * k8;
                  a += hh[0] * bflo(x.x) + hh[1] * bfhi(x.x) + hh[2] * bflo(x.y) + hh[3] * bfhi(x.y) + hh[4] * bflo(x.z) + hh[5] * bfhi(x.z) + hh[6] * bflo(x.w) + hh[7] * bfhi(x.w); }
              y[c] = a * w; }
          v2u o; o.x = pk2(y[0], y[1]); o.y = pk2(y[2], y[3]); *(v2u*)(YB + (size_t)slot * DM + 4 * tid) = o; }
    }
}
constexpr int MOE_TAB_OFF = LDSCTL_OFF + 1024;
__device__ __forceinline__ void moe_tables(const Frame& F, int l) {
    LAS int* tp = (LAS int*)(F.lds + MOE_TAB_OFF); LAS int* cn = tp + 40; LAS int* sb = cn + 40;
    __syncthreads();
    if ((F.wave * 64 + fresh_lane()) == 0) { int p = 0, s = 0;
        for (int e = 0; e < NEXP; ++e) { const int c = (int)__hip_atomic_load(F.ctl + CW_ECNT + (l * NEXP + e) * 64, RLX_AGENT); tp[e] = p; cn[e] = c; sb[e] = s; p += (c + 255) >> 8; s += c; }
        tp[NEXP] = p; sb[NEXP] = s; }
    __syncthreads();
}
template <int NT> struct SchedMoeBase {
    const LAS int* tp; const LAS int* cn; const LAS int* sb; int G, c;
    __device__ __forceinline__ bool next(int i, pg8::Unit& u) const {
        const int L = i * G + c, total = tp[NEXP] * NT; if (L >= total) return false;
        const int mt = L / NT; u.pn = L % NT; int e = 0;
#pragma unroll 1
        for (int q = 1; q < NEXP; ++q) e = (tp[q] <= mt) ? q : e;
        u.e = e; u.pm = mt - tp[e]; const int r = cn[e] - 256 * u.pm; u.rows = r < 256 ? r : 256; return true;
    }
};
struct SchedMoeUp : SchedMoeBase<4> {
    static constexpr bool GATHER = true;
    const char* A; const char* B; const int* list;
    __device__ __forceinline__ const char* a_base(const pg8::Unit&) const { return A; }
    __device__ __forceinline__ const char* b_base(const pg8::Unit& u) const { return B + ((size_t)u.e * 1024 + (size_t)u.pn * 256) * DM * 2; }
    __device__ __forceinline__ void a_off(const pg8::Unit& u, int tid, unsigned (&v0)[2], unsigned (&v1)[2]) const {
        int R[2], C[2];
#pragma unroll
        for (int i = 0; i < 2; ++i) pg8::stage_rc(tid * 16 + i * 8192, R[i], C[i]);
        const int* le = list + (size_t)u.e * NTOK + 256 * u.pm;
#pragma unroll
        for (int i = 0; i < 2; ++i) { int r0 = R[i], r1 = R[i] + 128; r0 = r0 < u.rows ? r0 : u.rows - 1; r1 = r1 < u.rows ? r1 : u.rows - 1;
            const int t0 = le[r0] >> 1, t1 = le[r1] >> 1;
            v0[i] = (unsigned)(t0 * DM + C[i]) * 2u; v1[i] = (unsigned)(t1 * DM + C[i]) * 2u; }
    }
};
struct EpiMoeUp {
    static constexpr bool PERM = true;
    __device__ __forceinline__ bool zero_after(const pg8::Unit&) const { return true; }
    bf16* HB; const LAS int* sb;
    __device__ __forceinline__ void operator()(const f32x4 (&acc)[2][2][4][2], const pg8::Unit& u, int wr, int wc, int fr, int fq) const {
        const int col0 = u.pn * 128 + wc * 32 + 8 * fq; const size_t slot0 = (size_t)sb[u.e] + 256 * u.pm;
#pragma unroll
        for (int ai = 0; ai < 2; ++ai)
#pragma unroll
            for (int m = 0; m < 4; ++m) { const int r = ai * 128 + wr * 64 + m * 16 + fr;
                if (r < u.rows) { const f32x4 g0 = acc[ai][0][m][0], g1 = acc[ai][0][m][1], u0 = acc[ai][1][m][0], u1 = acc[ai][1][m][1];
                    v4u w; w.x = cvt_pk_bf16(siluf_(g0[0]) * u0[0], siluf_(g0[1]) * u0[1]); w.y = cvt_pk_bf16(siluf_(g0[2]) * u0[2], siluf_(g0[3]) * u0[3]);
                    w.z = cvt_pk_bf16(siluf_(g1[0]) * u1[0], siluf_(g1[1]) * u1[1]); w.w = cvt_pk_bf16(siluf_(g1[2]) * u1[2], siluf_(g1[3]) * u1[3]);
                    *(v4u*)(HB + (slot0 + r) * DEXP + col0) = w; } }
    }
};
struct SchedMoeDown : SchedMoeBase<8> {
    static constexpr bool GATHER = false;
    const char* A; const char* B;
    __device__ __forceinline__ const char* a_base(const pg8::Unit& u) const { return A + ((size_t)sb[u.e] + 256 * u.pm) * DEXP * 2; }
    __device__ __forceinline__ const char* b_base(const pg8::Unit& u) const { return B + ((size_t)u.e * DM + (size_t)u.pn * 256) * DEXP * 2; }
    __device__ __forceinline__ void a_off(const pg8::Unit&, int tid, unsigned (&v0)[2], unsigned (&v1)[2]) const {
        int R[2], C[2];
#pragma unroll
        for (int i = 0; i < 2; ++i) pg8::stage_rc(tid * 16 + i * 8192, R[i], C[i]);
#pragma unroll
        for (int i = 0; i < 2; ++i) { v0[i] = (unsigned)(R[i] * DEXP + C[i]) * 2u; v1[i] = v0[i] + 128u * DEXP * 2u; } }
};
struct EpiMoeDown {
    static constexpr bool PERM = true;
    __device__ __forceinline__ bool zero_after(const pg8::Unit&) const { return true; }
    bf16* YB; const int* list; const int* tinfo;
    __device__ __forceinline__ void operator()(const f32x4 (&acc)[2][2][4][2], const pg8::Unit& u, int wr, int wc, int fr, int fq) const {
        const int col0 = u.pn * 256 + wc * 32 + 8 * fq; const int* le = list + (size_t)u.e * NTOK + 256 * u.pm;
#pragma unroll
        for (int ai = 0; ai < 2; ++ai)
#pragma unroll
            for (int m = 0; m < 4; ++m) { const int r = ai * 128 + wr * 64 + m * 16 + fr;
                if (r < u.rows) { const int ent = le[r]; const float w = __int_as_float(tinfo[(ent >> 1) * 8 + 4 * (ent & 1) + 2]);
#pragma unroll
                    for (int bj = 0; bj < 2; ++bj) { const f32x4 v0 = acc[ai][bj][m][0] * w, v1 = acc[ai][bj][m][1] * w;
                        v4u o; o.x = cvt_pk_bf16(v0[0], v0[1]); o.y = cvt_pk_bf16(v0[2], v0[3]); o.z = cvt_pk_bf16(v1[0], v1[1]); o.w = cvt_pk_bf16(v1[2], v1[3]);
                        *(v4u*)(YB + (size_t)ent * DM + col0 + bj * 128) = o; } } }
    }
};
#define KSWZ(row, colB) ((row) * 256 + ((colB) ^ (((row) & 7) << 4)))
#define SBAR() __builtin_amdgcn_sched_barrier(0)
__device__ __forceinline__ int crow(int r, int hi) { return (r & 3) + 8 * (r >> 2) + 4 * hi; }
__device__ __forceinline__ void qkt64(f32x16& p0, f32x16& p1, const LAS char* Ks, const bf16x8* qr, int r32, int hi) {
    p0 = f32x16{}; p1 = f32x16{};
#pragma unroll
    for (int d0 = 0; d0 < 8; ++d0) { const int cb = (d0 * 16 + hi * 8) * 2;
        const bf16x8 b0 = *(const LAS bf16x8*)(Ks + KSWZ(r32, cb));
        const bf16x8 b1 = *(const LAS bf16x8*)(Ks + KSWZ(32 + r32, cb));
        p0 = __builtin_amdgcn_mfma_f32_32x32x16_bf16(b0, qr[d0], p0, 0, 0, 0);
        p1 = __builtin_amdgcn_mfma_f32_32x32x16_bf16(b1, qr[d0], p1, 0, 0, 0); }
}
__device__ __forceinline__ void qkt32(f32x16& p0, const LAS char* Ks, const bf16x8* qr, int r32, int hi) {
    p0 = f32x16{};
#pragma unroll
    for (int d0 = 0; d0 < 8; ++d0) { const int cb = (d0 * 16 + hi * 8) * 2;
        const bf16x8 b0 = *(const LAS bf16x8*)(Ks + KSWZ(r32, cb));
        p0 = __builtin_amdgcn_mfma_f32_32x32x16_bf16(b0, qr[d0], p0, 0, 0, 0); }
}
__device__ __forceinline__ int v_st(int k, int c) { const int kk = (k & ~0xC) | ((k & 4) << 1) | ((k & 8) >> 1); return ((kk >> 3) * 4 + (c >> 5)) * 512 + ((kk & 7) * 32 + (c & 31)) * 2; }
__device__ __forceinline__ int v_rd_base(int lane) { return ((lane & 3) << 3) | (((lane >> 2) & 3) << 6) | (((lane >> 4) & 1) << 5) | (((lane >> 5) & 1) << 8); }
constexpr int v_rd_off(int d0, int ks, int half) { return d0 * 512 + ks * 4096 + half * 2048; }
template <int OFF> __device__ __forceinline__ s16x4 tr_read(int vb) {
    s16x4 r; asm volatile("ds_read_b64_tr_b16 %0, %1 offset:%2" : "=&v"(r) : "v"(vb), "i"(OFF) : "memory"); return r;
}
__device__ __forceinline__ s16x4 tr_read_dyn(unsigned addr) { s16x4 r; asm volatile("ds_read_b64_tr_b16 %0, %1" : "=&v"(r) : "v"(addr) : "memory"); return r; }
template <int D0> __device__ __forceinline__ void pv_one(f32x16& od, int vb, bf16x8 pa0, bf16x8 pa1, bf16x8 pa2, bf16x8 pa3) {
    const s16x4 l0 = tr_read<v_rd_off(D0, 0, 0)>(vb), h0 = tr_read<v_rd_off(D0, 0, 1)>(vb), l1 = tr_read<v_rd_off(D0, 1, 0)>(vb), h1 = tr_read<v_rd_off(D0, 1, 1)>(vb);
    const s16x4 l2 = tr_read<v_rd_off(D0, 2, 0)>(vb), h2 = tr_read<v_rd_off(D0, 2, 1)>(vb), l3 = tr_read<v_rd_off(D0, 3, 0)>(vb), h3 = tr_read<v_rd_off(D0, 3, 1)>(vb);
    asm volatile("s_waitcnt lgkmcnt(0)" ::: "memory"); SBAR();
#define PKV(L, H) (bf16x8){L[0], L[1], L[2], L[3], H[0], H[1], H[2], H[3]}
    od = __builtin_amdgcn_mfma_f32_32x32x16_bf16(pa0, PKV(l0, h0), od, 0, 0, 0);
    od = __builtin_amdgcn_mfma_f32_32x32x16_bf16(pa1, PKV(l1, h1), od, 0, 0, 0);
    od = __builtin_amdgcn_mfma_f32_32x32x16_bf16(pa2, PKV(l2, h2), od, 0, 0, 0);
    od = __builtin_amdgcn_mfma_f32_32x32x16_bf16(pa3, PKV(l3, h3), od, 0, 0, 0);
}
template <int D0> __device__ __forceinline__ void pv_one_lo(f32x16& od, int vb, bf16x8 pa0, bf16x8 pa1) {
    const s16x4 l0 = tr_read<v_rd_off(D0, 0, 0)>(vb), h0 = tr_read<v_rd_off(D0, 0, 1)>(vb), l1 = tr_read<v_rd_off(D0, 1, 0)>(vb), h1 = tr_read<v_rd_off(D0, 1, 1)>(vb);
    asm volatile("s_waitcnt lgkmcnt(0)" ::: "memory"); SBAR();
    od = __builtin_amdgcn_mfma_f32_32x32x16_bf16(pa0, PKV(l0, h0), od, 0, 0, 0);
    od = __builtin_amdgcn_mfma_f32_32x32x16_bf16(pa1, PKV(l1, h1), od, 0, 0, 0);
}
__device__ __forceinline__ void pv_all(f32x16* o, int vb, bf16x8 pa0, bf16x8 pa1, bf16x8 pa2, bf16x8 pa3) {
    pv_one<0>(o[0], vb, pa0, pa1, pa2, pa3); pv_one<1>(o[1], vb, pa0, pa1, pa2, pa3); pv_one<2>(o[2], vb, pa0, pa1, pa2, pa3); pv_one<3>(o[3], vb, pa0, pa1, pa2, pa3);
}
#define PK4(P, BASE, OUT) do { unsigned a0_ = cvt_pk_bf16(P[BASE + 0], P[BASE + 1]), a1_ = cvt_pk_bf16(P[BASE + 2], P[BASE + 3]);   \
    unsigned b0_ = cvt_pk_bf16(P[BASE + 4], P[BASE + 5]), b1_ = cvt_pk_bf16(P[BASE + 6], P[BASE + 7]);                              \
    auto r0_ = __builtin_amdgcn_permlane32_swap(a0_, b0_, false, false); auto r1_ = __builtin_amdgcn_permlane32_swap(a1_, b1_, false, false); \
    v4u w_ = {r0_[0], r1_[0], r0_[1], r1_[1]}; OUT = *reinterpret_cast<bf16x8*>(&w_); } while (0)
__device__ __forceinline__ float pair_sum(float v) { auto rr = __builtin_amdgcn_permlane32_swap(__float_as_uint(v), __float_as_uint(v), false, false); return __uint_as_float(rr[0]) + __uint_as_float(rr[1]); }
__device__ __forceinline__ float pair_max(float v) { auto rr = __builtin_amdgcn_permlane32_swap(__float_as_uint(v), __float_as_uint(v), false, false); return fmaxf(__uint_as_float(rr[0]), __uint_as_float(rr[1])); }
__device__ __forceinline__ unsigned off_b(unsigned row, unsigned ch) { return 256u * row + 16u * (ch ^ (((row & 3) << 2) | ((row >> 2) & 3))); }
__device__ __forceinline__ unsigned trb_addr(unsigned lane, unsigned c, unsigned ks, unsigned t) {
    const unsigned h = lane >> 5, blk = (lane >> 4) & 1, q = (lane & 15) >> 2, p = lane & 3;
    return off_b(16 * ks + 8 * h + 4 * t + q, 4 * c + 2 * blk + (p >> 1)) + 8 * (p & 1);
}

constexpr int ML_TAB_OFF = LDSCTL_OFF + 2048;
struct MTabs { LAS float* sum; LAS float* g; LAS float* b; LAS float* pm; LAS float* mprev; LAS float* mend; };
__device__ __forceinline__ MTabs mtabs(const Frame& F) { MTabs T; T.sum = (LAS float*)(F.lds + ML_TAB_OFF); T.g = T.sum + 64; T.b = T.g + 256; T.pm = T.b + 256; T.mprev = T.pm + 256; T.mend = T.mprev + 4; return T; }
__device__ __forceinline__ float* gif_ptr(const Frame& F) { return (float*)(F.ws + WS_MSN + 512 * 1024); }
__device__ __forceinline__ void mchain(const Frame& F, int l, int bh, int cr, const MTabs& T) {
    const int b = bh >> 3, h = bh & 7, lane = fresh_lane(), nchunk = 4 * cr + 4;
    const float bi = arg_in(4)[l * NH + h], bfv = arg_in(5)[l * NH + h];
    const float* gif = gif_ptr(F);
    __syncthreads();
    for (int j = F.wave; j < nchunk; j += NWAVES) {
        const size_t row = (size_t)b * SEQ + 64 * j + lane;
        const float it = gif[row * 16 + h] + bi, lf = logsigmoidf_(gif[row * 16 + 8 + h] + bfv);
        float bc = lf;
#pragma unroll
        for (int o = 1; o < 64; o <<= 1) { const float t = __shfl_up(bc, o); bc += (lane >= o) ? t : 0.f; }
        const float g = it - bc; float pm = g;
#pragma unroll
        for (int o = 1; o < 64; o <<= 1) { const float t = __shfl_up(pm, o); pm = (lane >= o) ? fmaxf(pm, t) : pm; }
        if (lane == 63) { T.sum[2 * j] = bc; T.sum[2 * j + 1] = pm; }
        if (j >= 4 * cr) { const int ci = j - 4 * cr; T.g[ci * 64 + lane] = g; T.b[ci * 64 + lane] = bc; T.pm[ci * 64 + lane] = pm; }
    }
    __syncthreads();
    if ((F.wave * 64 + fresh_lane()) == 0) { float m = 0.f;
        for (int j = 0; j < nchunk; ++j) { const float me = fmaxf(m, T.sum[2 * j + 1]);
            if (j >= 4 * cr) { T.mprev[j - 4 * cr] = m; T.mend[j - 4 * cr] = me; }
            m = T.sum[2 * j] + me; } }
    __syncthreads();
}
__device__ __forceinline__ void conv8(const bf16* P, const float* cw, size_t row, int t, int col0, int ch0, float sc, float (&o)[8]) {
#pragma unroll
    for (int e = 0; e < 8; ++e) o[e] = 0.f;
#pragma unroll
    for (int j = 0; j < 4; ++j) { const int tt = t - 3 + j;
        if (tt >= 0) { const v4u x = *(const v4u*)(P + (row - 3 + j) * PW + col0); const f32x4 w0 = *(const f32x4*)(cw + j * 2048 + ch0), w1 = *(const f32x4*)(cw + j * 2048 + ch0 + 4);
            o[0] += w0.x * bflo(x.x); o[1] += w0.y * bfhi(x.x); o[2] += w0.z * bflo(x.y); o[3] += w0.w * bfhi(x.y);
            o[4] += w1.x * bflo(x.z); o[5] += w1.y * bfhi(x.z); o[6] += w1.z * bflo(x.w); o[7] += w1.w * bfhi(x.w); } }
#pragma unroll
    for (int e = 0; e < 8; ++e) o[e] = siluf_(o[e]) * sc;
}
__device__ __forceinline__ void ml_delta(const Frame& F, int l) {
    const bf16* P = (const bf16*)(F.ws + WS_PROJ); const float* cw = arg_in(3) + (size_t)l * 4 * 2048;
    float* DEL = (float*)(F.ws + WS_MDEL); float* DN = (float*)(F.ws + WS_MDN); float* DEC = DN + 32 * 32 * 128;
    const int wave = F.wave;
    const MTabs T = mtabs(F);
    for (int blk = F.vcu; blk < 256; blk += F.G) {
        const int tid = F.wave * 64 + fresh_lane();
        const int lane = tid & 63;
        const int bh = blk >> 3, cr = blk & 7, b = bh >> 3, h = bh & 7;
        mchain(F, l, bh, cr, T);
#pragma unroll 1
        for (int it = tid; it < 4 * 64 * 16; it += NTHR) { const int ci = it >> 10, s = (it >> 4) & 63, ch = it & 15, t = 64 * (4 * cr + ci) + s; const size_t row = (size_t)b * SEQ + t;
            float kv[8]; conv8(P, cw, row, t, C_MK + h * HD + 8 * ch, 1024 + h * HD + 8 * ch, 1.f, kv);
            v4u o; o.x = pk2(kv[0], kv[1]); o.y = pk2(kv[2], kv[3]); o.z = pk2(kv[4], kv[5]); o.w = pk2(kv[6], kv[7]);
            *(LAS v4u*)(F.lds + ci * 32768 + off_b(s, ch)) = o;
            const float ws = __expf(T.g[ci * 64 + s] - T.mend[ci]);
            const v4u x = *(const v4u*)(P + row * PW + C_MV + h * HD + 8 * ch);
            o.x = pk2(ws * bflo(x.x), ws * bfhi(x.x)); o.y = pk2(ws * bflo(x.y), ws * bfhi(x.y)); o.z = pk2(ws * bflo(x.z), ws * bfhi(x.z)); o.w = pk2(ws * bflo(x.w), ws * bfhi(x.w));
            *(LAS v4u*)(F.lds + ci * 32768 + 16384 + off_b(s, ch)) = o; }
        __syncthreads();
        const int vb = wave >> 1, kh = wave & 1, r32 = lane & 31, hi = lane >> 5;
        const unsigned ldsb = (unsigned)(size_t)F.lds;
#pragma unroll 1
        for (int ci = 0; ci < 4; ++ci) { const int c = 4 * cr + ci; if (c == NCH - 1) break;
            f32x16 a0 = {}, a1 = {};
#pragma unroll
            for (int ks = 0; ks < 4; ++ks) {
                const s16x4 al = tr_read_dyn(ldsb + ci * 32768 + 16384 + trb_addr(lane, vb, ks, 0)), ah = tr_read_dyn(ldsb + ci * 32768 + 16384 + trb_addr(lane, vb, ks, 1));
                const s16x4 bl0 = tr_read_dyn(ldsb + ci * 32768 + trb_addr(lane, 2 * kh, ks, 0)), bh0 = tr_read_dyn(ldsb + ci * 32768 + trb_addr(lane, 2 * kh, ks, 1));
                const s16x4 bl1 = tr_read_dyn(ldsb + ci * 32768 + trb_addr(lane, 2 * kh + 1, ks, 0)), bh1 = tr_read_dyn(ldsb + ci * 32768 + trb_addr(lane, 2 * kh + 1, ks, 1));
                asm volatile("s_waitcnt lgkmcnt(0)" ::: "memory"); SBAR();
                a0 = __builtin_amdgcn_mfma_f32_32x32x16_bf16(PKV(al, ah), PKV(bl0, bh0), a0, 0, 0, 0);
                a1 = __builtin_amdgcn_mfma_f32_32x32x16_bf16(PKV(al, ah), PKV(bl1, bh1), a1, 0, 0, 0); }
            float* dp = DEL + ((size_t)(bh * 32 + c) * 128) * 128;
#pragma unroll
            for (int r = 0; r < 16; ++r) { const int v = 32 * vb + crow(r, hi); dp[(size_t)v * 128 + 64 * kh + r32] = a0[r]; dp[(size_t)v * 128 + 64 * kh + 32 + r32] = a1[r]; }
        }
        { const int ci = tid >> 7, k = tid & 127, c = 4 * cr + ci;
          if (c < NCH - 1) { float a = 0.f; const float me = T.mend[ci];
              for (int s = 0; s < 64; ++s) a += __expf(T.g[ci * 64 + s] - me) * bf2f(*(const LAS unsigned short*)(F.lds + ci * 32768 + off_b(s, k >> 3) + 2 * (k & 7)));
              DN[(size_t)(bh * 32 + c) * 128 + k] = a;
              if (k == 0) DEC[bh * 32 + c] = __expf(T.mprev[ci] - me); } }
        __syncthreads();
    }
}
__device__ __forceinline__ void ml_scan(const Frame& F) {
    const float* DEL = (const float*)(F.ws + WS_MDEL); const float* DN = (const float*)(F.ws + WS_MDN); const float* DEC = DN + 32 * 32 * 128;
    bf16* ST = (bf16*)(F.ws + WS_MST); float* SN = (float*)(F.ws + WS_MSN);
    const int gt = F.vcu * NTHR + (F.wave * 64 + fresh_lane()), NT = F.G * NTHR;
    for (int e4 = gt; e4 < 32 * 4096; e4 += NT) { const int bh = e4 >> 12, q = e4 & 4095;
        f32x4 acc = {0.f, 0.f, 0.f, 0.f};
#pragma unroll 4
        for (int c = 0; c < NCH - 1; ++c) { const float d = DEC[bh * 32 + c]; const f32x4 x = *(const f32x4*)(DEL + ((size_t)(bh * 32 + c) * 4096 + q) * 4);
            acc = acc * d + x; v2u o; o.x = pk2(acc.x, acc.y); o.y = pk2(acc.z, acc.w); *(v2u*)(ST + ((size_t)(bh * 32 + c + 1) * 4096 + q) * 4) = o; } }
    for (int e = gt; e < 32 * 128; e += NT) { const int bh = e >> 7, k = e & 127; float acc = 0.f;
        for (int c = 0; c < NCH - 1; ++c) { acc = acc * DEC[bh * 32 + c] + DN[(size_t)(bh * 32 + c) * 128 + k]; SN[(size_t)(bh * 32 + c + 1) * 128 + k] = acc; } }
}
__device__ __forceinline__ void ml_out(const Frame& F, int l) {
    const bf16* P = (const bf16*)(F.ws + WS_PROJ); const float* cw = arg_in(3) + (size_t)l * 4 * 2048; bf16* BR = (bf16*)(F.ws + WS_BR);
    const bf16* ST = (const bf16*)(F.ws + WS_MST); const float* SN = (const float*)(F.ws + WS_MSN); const float* gain = arg_in(6) + (size_t)l * BW;
    const int wave = F.wave;
    const MTabs T = mtabs(F);
    LAS float* rowL = (LAS float*)(F.lds + ML_TAB_OFF + 4096) + wave * 32;
    for (int blk = F.vcu; blk < 256; blk += F.G) {
        const int tid = F.wave * 64 + fresh_lane();
        const int lane = tid & 63, r32 = lane & 31, hi = lane >> 5;
        const int bh = blk >> 3, cr = blk & 7, b = bh >> 3, h = bh & 7;
        mchain(F, l, bh, cr, T);
#pragma unroll 1
        for (int it = tid; it < 4 * 64 * 16; it += NTHR) { const int ci = it >> 10, s = (it >> 4) & 63, ch = it & 15, t = 64 * (4 * cr + ci) + s; const size_t row = (size_t)b * SEQ + t;
            float kv[8]; conv8(P, cw, row, t, C_MK + h * HD + 8 * ch, 1024 + h * HD + 8 * ch, 1.f, kv);
            v4u o; o.x = pk2(kv[0], kv[1]); o.y = pk2(kv[2], kv[3]); o.z = pk2(kv[4], kv[5]); o.w = pk2(kv[6], kv[7]);
            *(LAS v4u*)(F.lds + ci * 32768 + KSWZ(s, ch * 16)) = o;
            *(LAS v4u*)(F.lds + ci * 32768 + 16384 + v_st(s, ch * 8)) = *(const v4u*)(P + row * PW + C_MV + h * HD + 8 * ch); }
        __syncthreads();
        const int ci = wave >> 1, rh = wave & 1, c = 4 * cr + ci, tau = 32 * rh + r32, t = 64 * c + tau; const size_t row = (size_t)b * SEQ + t;
        bf16x8 qr[8];
#pragma unroll
        for (int d0 = 0; d0 < 8; ++d0) { float qv[8]; conv8(P, cw, row, t, C_MQ + h * HD + 16 * d0 + 8 * hi, h * HD + 16 * d0 + 8 * hi, 0.08838834764831845f, qv);
            v4u o; o.x = pk2(qv[0], qv[1]); o.y = pk2(qv[2], qv[3]); o.z = pk2(qv[4], qv[5]); o.w = pk2(qv[6], qv[7]); qr[d0] = *reinterpret_cast<bf16x8*>(&o); asm volatile("" ::: "memory"); }
        const float mprev = T.mprev[ci], Mt = fmaxf(mprev, T.pm[ci * 64 + tau]), winter = __expf(mprev - Mt), flo = __expf(-T.b[ci * 64 + tau] - Mt);
        const LAS char* Kc = (const LAS char*)(F.lds + ci * 32768);
        const int vbase = (int)(size_t)(F.lds + ci * 32768 + 16384) + v_rd_base(lane);
        f32x16 o[4] = {}; f32x16 p0, p1; float ps = 0.f; bf16x8 pa0, pa1, pa2, pa3;
        const LAS f32x4* g4 = (const LAS f32x4*)(T.g + ci * 64);
        if (rh == 0) { qkt32(p0, Kc, qr, r32, hi);
#pragma unroll
            for (int q = 0; q < 4; ++q) { const f32x4 gg = g4[2 * q + hi];
#pragma unroll
                for (int e = 0; e < 4; ++e) { const int r = 4 * q + e, s = crow(r, hi); const float wgt = (s <= tau) ? __expf(gg[e] - Mt) : 0.f; p0[r] *= wgt; ps += p0[r]; } }
            PK4(p0, 0, pa0); PK4(p0, 8, pa1);
            pv_one_lo<0>(o[0], vbase, pa0, pa1); pv_one_lo<1>(o[1], vbase, pa0, pa1); pv_one_lo<2>(o[2], vbase, pa0, pa1); pv_one_lo<3>(o[3], vbase, pa0, pa1);
        } else { qkt64(p0, p1, Kc, qr, r32, hi);
#pragma unroll
            for (int q = 0; q < 4; ++q) { const f32x4 gg = g4[2 * q + hi], gh = g4[8 + 2 * q + hi];
#pragma unroll
                for (int e = 0; e < 4; ++e) { const int r = 4 * q + e, s = crow(r, hi); p0[r] *= __expf(gg[e] - Mt); ps += p0[r];
                    const float wgt = (32 + s <= tau) ? __expf(gh[e] - Mt) : 0.f; p1[r] *= wgt; ps += p1[r]; } }
            PK4(p0, 0, pa0); PK4(p0, 8, pa1); PK4(p1, 0, pa2); PK4(p1, 8, pa3);
            pv_all(o, vbase, pa0, pa1, pa2, pa3);
        }
        ps = pair_sum(ps);
        float nq = 0.f;
        if (c > 0) {
            const bf16* Sc = ST + (size_t)(bh * 32 + c) * 16384; const float* nc = SN + (size_t)(bh * 32 + c) * 128;
#pragma unroll
            for (int ks = 0; ks < 8; ++ks) { const v4u qq = *reinterpret_cast<const v4u*>(&qr[ks]);
                const f32x4 n0 = *(const f32x4*)(nc + 16 * ks + 8 * hi), n1 = *(const f32x4*)(nc + 16 * ks + 8 * hi + 4);
                nq += bflo(qq.x) * n0.x + bfhi(qq.x) * n0.y + bflo(qq.y) * n0.z + bfhi(qq.y) * n0.w + bflo(qq.z) * n1.x + bfhi(qq.z) * n1.y + bflo(qq.w) * n1.z + bfhi(qq.w) * n1.w;
                v4u sq; sq.x = pk2(bflo(qq.x) * winter, bfhi(qq.x) * winter); sq.y = pk2(bflo(qq.y) * winter, bfhi(qq.y) * winter); sq.z = pk2(bflo(qq.z) * winter, bfhi(qq.z) * winter); sq.w = pk2(bflo(qq.w) * winter, bfhi(qq.w) * winter);
                const bf16x8 qs = *reinterpret_cast<const bf16x8*>(&sq);
#pragma unroll
                for (int d0 = 0; d0 < 4; ++d0) { const bf16x8 cf = *(const bf16x8*)(Sc + (size_t)(32 * d0 + r32) * 128 + 16 * ks + 8 * hi);
                    o[d0] = __builtin_amdgcn_mfma_f32_32x32x16_bf16(qs, cf, o[d0], 0, 0, 0); }
                asm volatile("" ::: "memory"); }
            nq = pair_sum(nq);
        }
        const float den = winter * nq + ps, rinv = 1.0f / fmaxf(fabsf(den), flo);
        if (hi == 0) rowL[r32] = rinv;
        LDS_WAIT(); asm volatile("" ::: "memory");
        float ss[16];
#pragma unroll
        for (int r = 0; r < 16; ++r) { const float ri = rowL[crow(r, hi)]; float a = 0.f;
#pragma unroll
            for (int d0 = 0; d0 < 4; ++d0) { o[d0][r] *= ri; a += o[d0][r] * o[d0][r]; }
            ss[r] = a; }
#pragma unroll
        for (int r = 0; r < 16; ++r) {
#pragma unroll
            for (int of = 1; of < 32; of <<= 1) ss[r] += __shfl_xor(ss[r], of);
            ss[r] = 1.0f / sqrtf(ss[r] * (1.f / HD) + EPS); }
        const size_t row0 = (size_t)b * SEQ + 64 * c + 32 * rh;
#pragma unroll
        for (int d0 = 0; d0 < 4; ++d0) { const int col = h * HD + 32 * d0 + r32; const float gn = gain[col];
#pragma unroll
            for (int r = 0; r < 16; ++r) { const size_t rr = row0 + crow(r, hi);
                const float og = sigmoidf_(bf2f(P[rr * PW + C_MO + col]));
                BR[rr * 3072 + col] = (bf16)f2bf(o[d0][r] * ss[r] * gn * og); }
            asm volatile("" ::: "memory"); }
        __syncthreads();
    }
}
__device__ __forceinline__ void ph_norm2_mfma(const Frame& F, int l) {
    const float* g = arg_in(11) + (size_t)l * DM;
    const float* wrg = arg_in(12) + (size_t)l * DM * NGRP; const float* brg = arg_in(13) + l * NGRP;
    const float* wre = arg_in(14) + (size_t)l * DM * NEXP; const float* bre = arg_in(15) + l * NEXP;
    const float* X1 = (const float*)(F.ws + WS_X1); bf16* XN = (bf16*)(F.ws + WS_XN);
    int* list = (int*)(F.ws + WS_LIST); int* tinfo = tokinfo_ptr(F);
    unsigned* ecnt = F.ctl + CW_ECNT + l * NEXP * 64;
    LAS float* PL = (LAS float*)F.lds;
    LAS float* LG = PL + 8 * 2048;
    LAS float* RS = LG + 32 * 36;
    for (int blk = F.vcu; blk < NTOK / 32; blk += F.G) {
        const int lane = fresh_lane(), wave = F.wave, tid = wave * 64 + lane; const int m0 = blk * 32;
        __syncthreads();
#pragma unroll 1
        for (int q = 0; q < 4; ++q) { const int m = m0 + 4 * wave + q;
            f32x4 v[8]; float s = 0.f;
            const f32x4* xr = (const f32x4*)(X1 + (size_t)m * DM) + lane;
#pragma unroll
            for (int j = 0; j < 8; ++j) { v[j] = xr[64 * j]; s += (v[j].x * v[j].x + v[j].y * v[j].y) + (v[j].z * v[j].z + v[j].w * v[j].w); }
            const float rstd = 1.0f / sqrtf(wave_sum(s) * (1.f / DM) + EPS);
            v2u* o8 = (v2u*)(XN + (size_t)m * DM) + lane; const f32x4* gr = (const f32x4*)g + lane;
#pragma unroll
            for (int j = 0; j < 8; ++j) { const f32x4 gg = gr[64 * j]; v2u o; o.x = pk2(v[j].x * rstd * gg.x, v[j].y * rstd * gg.y); o.y = pk2(v[j].z * rstd * gg.z, v[j].w * rstd * gg.w); o8[64 * j] = o; }
            if (lane == 0) RS[4 * wave + q] = rstd; }
        { const int i = lane & 31, h = lane >> 5, kb = 256 * wave + 128 * h;
          f32x16 aE = {}, aG = {};
          const float* xp = X1 + (size_t)(m0 + i) * DM + kb; const float* gp = g + kb;
          const float* we = wre + (size_t)kb * NEXP + i; const float* wg = wrg + (size_t)kb * NGRP + (i & 3);
#pragma unroll 2
          for (int s4 = 0; s4 < 32; ++s4) { const f32x4 xv = *(const f32x4*)(xp + 4 * s4), gv = *(const f32x4*)(gp + 4 * s4);
#pragma unroll
              for (int c = 0; c < 4; ++c) { const int s = 4 * s4 + c; const float gk = gv[c];
                  const float be = we[(size_t)s * NEXP] * gk; const float bg = (i < 4) ? wg[(size_t)s * NGRP] * gk : 0.f;
                  aE = __builtin_amdgcn_mfma_f32_32x32x2f32(xv[c], be, aE, 0, 0, 0);
                  aG = __builtin_amdgcn_mfma_f32_32x32x2f32(xv[c], bg, aG, 0, 0, 0); } }
#pragma unroll
          for (int r = 0; r < 16; ++r) { const int t = crow(r, h); PL[(wave * 2 + 0) * 1024 + t * 32 + i] = aE[r]; PL[(wave * 2 + 1) * 1024 + t * 32 + i] = aG[r]; } }
        __syncthreads();
        for (int idx = tid; idx < 32 * 36; idx += NTHR) { const int t = idx / 36, j = idx % 36; float a = 0.f;
#pragma unroll
            for (int w = 0; w < 8; ++w) a += (j < 4) ? PL[(w * 2 + 1) * 1024 + t * 32 + j] : PL[(w * 2) * 1024 + t * 32 + (j - 4)];
            LG[idx] = a * RS[t]; }
        __syncthreads();
        if (tid < 32) { const int m = m0 + tid; const LAS float* lg = LG + tid * 36;
            int gs = 0; float best = lg[0] + brg[0];
#pragma unroll
            for (int q = 1; q < 4; ++q) { const float t = lg[q] + brg[q]; if (t > best) { best = t; gs = q; } }
            const float gm = fmaxf(fmaxf(lg[0], lg[1]), fmaxf(lg[2], lg[3])); float gsum = 0.f, gsel = 0.f;
#pragma unroll
            for (int q = 0; q < 4; ++q) { const float e = __expf(lg[q] - gm); gsum += e; gsel = (q == gs) ? e : gsel; }
            const float pg = gsel / gsum;
            float ein[8];
#pragma unroll
            for (int q = 0; q < 8; ++q) ein[q] = lg[4 + gs * 8 + q];
            int e0 = 0, e1 = -1; float b0 = -3.0e38f, b1 = -3.0e38f;
#pragma unroll
            for (int q = 0; q < 8; ++q) { const float t = ein[q] + bre[gs * 8 + q];
                if (t > b0) { b1 = b0; e1 = e0; b0 = t; e0 = q; } else if (t > b1) { b1 = t; e1 = q; } }
            float em = ein[0];
#pragma unroll
            for (int q = 1; q < 8; ++q) em = fmaxf(em, ein[q]);
            float p0 = 0.f, p1 = 0.f;
#pragma unroll
            for (int q = 0; q < 8; ++q) { const float e = __expf(ein[q] - em); p0 = (q == e0) ? e : p0; p1 = (q == e1) ? e : p1; }
            const float w0 = pg * p0 / (p0 + p1), w1 = pg * p1 / (p0 + p1);
            const int x0 = gs * 8 + e0, x1 = gs * 8 + e1;
            const int pos0 = (int)atomicAdd(ecnt + x0 * 64, 1u), pos1 = (int)atomicAdd(ecnt + x1 * 64, 1u);
            list[x0 * NTOK + pos0] = 2 * m; list[x1 * NTOK + pos1] = 2 * m + 1;
            tinfo[m * 8 + 0] = x0; tinfo[m * 8 + 1] = pos0; tinfo[m * 8 + 2] = __float_as_int(w0); tinfo[m * 8 + 3] = 0;
            tinfo[m * 8 + 4] = x1; tinfo[m * 8 + 5] = pos1; tinfo[m * 8 + 6] = __float_as_int(w1); tinfo[m * 8 + 7] = 0; }
    }
}
__device__ __forceinline__ void dsa_index(const Frame& F) {
    const bf16* P = (const bf16*)(F.ws + WS_PROJ); unsigned long long* MK = (unsigned long long*)(F.ws + WS_MASK);
    LAS float* SL = (LAS float*)(F.lds + F.wave * 16384);
    const int gw = GW_ID(F), NGW = GW_N(F);
    for (int wu = gw; wu < 2048; wu += NGW) {
        const int lane = fresh_lane();
        const int m = lane & 31, hi = lane >> 5, qa = (m >> 2) & 1, head = (m & 3) + 4 * (m >> 3);
        const int b = wu >> 9, jj = wu & 511;
#pragma unroll 1
        for (int half = 0; half < 2; ++half) {
            const int tp = half ? 1023 - jj : jj, t0 = 2 * tp; const size_t rb = (size_t)b * SEQ;
            bf16x8 afr[4];
#pragma unroll
            for (int ks = 0; ks < 4; ++ks) afr[ks] = *(const bf16x8*)(P + (rb + t0 + qa) * PW + C_IQ + head * 64 + 16 * ks + 8 * hi);
            float wr[16];
            { const v4u w0 = *(const v4u*)(P + (rb + t0 + hi) * PW + C_IW), w1 = *(const v4u*)(P + (rb + t0 + hi) * PW + C_IW + 8);
              wr[0] = bflo(w0.x); wr[1] = bfhi(w0.x); wr[2] = bflo(w0.y); wr[3] = bfhi(w0.y); wr[4] = bflo(w0.z); wr[5] = bfhi(w0.z); wr[6] = bflo(w0.w); wr[7] = bfhi(w0.w);
              wr[8] = bflo(w1.x); wr[9] = bfhi(w1.x); wr[10] = bflo(w1.y); wr[11] = bfhi(w1.y); wr[12] = bflo(w1.z); wr[13] = bfhi(w1.z); wr[14] = bflo(w1.w); wr[15] = bfhi(w1.w);
#pragma unroll
              for (int r = 0; r < 16; ++r) wr[r] *= 0.03125f; }
            const int nkb = (t0 + 1) / 32 + 1;
#pragma unroll 2
            for (int kb = 0; kb < nkb; ++kb) {
                const bf16* kp = P + (rb + 32 * kb + m) * PW + C_IK + 8 * hi;
                f32x16 acc = {};
#pragma unroll
                for (int ks = 0; ks < 4; ++ks) acc = __builtin_amdgcn_mfma_f32_32x32x16_bf16(afr[ks], *(const bf16x8*)(kp + 16 * ks), acc, 0, 0, 0);
                float sc = 0.f;
#pragma unroll
                for (int r = 0; r < 16; ++r) sc += wr[r] * fmaxf(acc[r], 0.f);
                SL[hi * 2048 + 32 * kb + m] = sc;
            }
            LDS_WAIT(); asm volatile("" ::: "memory");
#pragma unroll 1
            for (int q = 0; q < 2; ++q) { const int t = t0 + q; unsigned key[32];
#pragma unroll
                for (int j = 0; j < 32; ++j) { const int s = lane + 64 * j; key[j] = (s <= t) ? fkey(SL[q * 2048 + s]) : 0u; }
                select_row(key, t + 1, MK + (rb + t) * 32, lane); }
            LDS_WAIT(); asm volatile("" ::: "memory");
        }
    }
}

struct KVRegs { v4u k0, k1, v0, v1; };
__device__ __forceinline__ void kv_load(KVRegs& R, const bf16* Kp, const bf16* Vp, size_t row0, int sr, int sc) {
    R.k0 = *(const v4u*)(Kp + (row0 + sr) * PW + sc); R.k1 = *(const v4u*)(Kp + (row0 + 32 + sr) * PW + sc);
    R.v0 = *(const v4u*)(Vp + (row0 + sr) * PW + sc); R.v1 = *(const v4u*)(Vp + (row0 + 32 + sr) * PW + sc);
}
__device__ __forceinline__ v4u knorm8(v4u x, const float (&kg)[8]) {
    float f[8] = {bflo(x.x), bfhi(x.x), bflo(x.y), bfhi(x.y), bflo(x.z), bfhi(x.z), bflo(x.w), bfhi(x.w)};
    float s = 0.f;
#pragma unroll
    for (int e = 0; e < 8; ++e) s += f[e] * f[e];
    s += __shfl_xor(s, 1); s += __shfl_xor(s, 2); s += __shfl_xor(s, 4); s += __shfl_xor(s, 8);
    const float r = 1.0f / sqrtf(s * (1.f / HD) + EPS);
    v4u o; o.x = pk2(f[0] * r * kg[0], f[1] * r * kg[1]); o.y = pk2(f[2] * r * kg[2], f[3] * r * kg[3]); o.z = pk2(f[4] * r * kg[4], f[5] * r * kg[5]); o.w = pk2(f[6] * r * kg[6], f[7] * r * kg[7]);
    return o;
}
template <bool NORM> __device__ __forceinline__ void kv_write(const KVRegs& R, LAS unsigned char* buf, int sr, int sc, const float (&kg)[8]) {
    *(LAS v4u*)(buf + KSWZ(sr, sc * 2)) = NORM ? knorm8(R.k0, kg) : R.k0; *(LAS v4u*)(buf + KSWZ(32 + sr, sc * 2)) = NORM ? knorm8(R.k1, kg) : R.k1;
    *(LAS v4u*)(buf + 16384 + v_st(sr, sc)) = R.v0; *(LAS v4u*)(buf + 16384 + v_st(32 + sr, sc)) = R.v1;
}
constexpr int AT_TAB_OFF = LDSCTL_OFF + 8192;

__device__ __forceinline__ void dsa_attn(const Frame& F, int l) {
    const bf16* P = (const bf16*)(F.ws + WS_PROJ); const unsigned long long* MK = (const unsigned long long*)(F.ws + WS_MASK); bf16* BR = (bf16*)(F.ws + WS_BR);
    const float* qg = arg_in(7) + l * HD; const float* kgp = arg_in(8) + l * HD; const float* rbias = arg_in(19);
    LAS float* biasL = (LAS float*)(F.lds + AT_TAB_OFF); LAS float* rowL = biasL + 128 + F.wave * 32;
    constexpr float C = 0.08838834764831845f * 1.4426950408889634f;
    for (int u = F.vcu; u < 256; u += F.G) {
        const int tid = F.wave * 64 + fresh_lane();
        const int lane = tid & 63, wave = F.wave, r32 = lane & 31, hi = lane >> 5, sr = tid >> 4, sc = (tid & 15) * 8;
        const int b = u >> 6, h = (u >> 3) & 7, qb = 7 - (u & 7), q0 = qb * 256, NT = 4 * (qb + 1); const size_t rb = (size_t)b * SEQ;
        __syncthreads();
        if (tid < 128) biasL[tid] = rbias[t5_bucket(tid) * NH + h] * 1.4426950408889634f;
        float kg[8];
#pragma unroll
        for (int e = 0; e < 8; ++e) kg[e] = kgp[sc + e];
        const int tq = q0 + 32 * wave + r32; bf16x8 qr[8];
        { v4u xs[8]; float s = 0.f;
#pragma unroll
          for (int d0 = 0; d0 < 8; ++d0) { const v4u x = *(const v4u*)(P + (rb + tq) * PW + C_DQ + h * HD + 16 * d0 + 8 * hi); xs[d0] = x;
              s += bflo(x.x) * bflo(x.x) + bfhi(x.x) * bfhi(x.x) + bflo(x.y) * bflo(x.y) + bfhi(x.y) * bfhi(x.y) + bflo(x.z) * bflo(x.z) + bfhi(x.z) * bfhi(x.z) + bflo(x.w) * bflo(x.w) + bfhi(x.w) * bfhi(x.w); }
          const float r = 1.0f / sqrtf(pair_sum(s) * (1.f / HD) + EPS);
#pragma unroll
          for (int d0 = 0; d0 < 8; ++d0) { const f32x4 g0 = *(const f32x4*)(qg + 16 * d0 + 8 * hi), g1 = *(const f32x4*)(qg + 16 * d0 + 8 * hi + 4); const v4u x = xs[d0];
              v4u o; o.x = pk2(bflo(x.x) * r * g0.x, bfhi(x.x) * r * g0.y); o.y = pk2(bflo(x.y) * r * g0.z, bfhi(x.y) * r * g0.w);
              o.z = pk2(bflo(x.z) * r * g1.x, bfhi(x.z) * r * g1.y); o.w = pk2(bflo(x.w) * r * g1.z, bfhi(x.w) * r * g1.w); qr[d0] = *reinterpret_cast<bf16x8*>(&o); } }
        const bf16* Kp = P + C_DK + h * HD; const bf16* Vp = P + C_DV + h * HD;
        KVRegs R; kv_load(R, Kp, Vp, rb, sr, sc); kv_write<true>(R, F.lds, sr, sc, kg);
        __syncthreads();
        float m_reg = -1e30f, l_reg = 0.f; f32x16 o[4] = {};
        const float b31 = biasL[127];
        for (int j = 0; j < NT; ++j) {
            LAS unsigned char* buf = F.lds + (j & 1) * 32768;
            if (j + 1 < NT) kv_load(R, Kp, Vp, rb + 64 * (j + 1), sr, sc);
            if (64 * j <= q0 + 32 * wave + 31) {
                const unsigned long long mw = MK[(rb + tq) * 32 + j]; const unsigned mlo = (unsigned)mw, mhi = (unsigned)(mw >> 32);
                f32x16 p0, p1; qkt64(p0, p1, (const LAS char*)buf, qr, r32, hi);
                const int rel0 = tq - 64 * j;
                const bool nearb = (q0 + 32 * wave - (64 * j + 63)) < 113;
                float pmax = -1e30f;
#pragma unroll
                for (int r = 0; r < 16; ++r) { const int kk = crow(r, hi);
                    float b0 = b31, b1 = b31;
                    if (nearb) { int i0 = rel0 - kk, i1 = rel0 - kk - 32; i0 = i0 < 0 ? 0 : (i0 > 127 ? 127 : i0); i1 = i1 < 0 ? 0 : (i1 > 127 ? 127 : i1); b0 = biasL[i0]; b1 = biasL[i1]; }
                    p0[r] = ((mlo >> kk) & 1u) ? fmaf(p0[r], C, b0) : -1e30f; p1[r] = ((mhi >> kk) & 1u) ? fmaf(p1[r], C, b1) : -1e30f;
                    pmax = fmaxf(pmax, fmaxf(p0[r], p1[r])); }
                pmax = pair_max(pmax);
                const float mn = fmaxf(m_reg, pmax), alpha = __builtin_amdgcn_exp2f(m_reg - mn); m_reg = mn;
                float ps = 0.f;
#pragma unroll
                for (int r = 0; r < 16; ++r) { const int kk = crow(r, hi);
                    p0[r] = ((mlo >> kk) & 1u) ? __builtin_amdgcn_exp2f(p0[r] - mn) : 0.f; p1[r] = ((mhi >> kk) & 1u) ? __builtin_amdgcn_exp2f(p1[r] - mn) : 0.f; ps += p0[r] + p1[r]; }
                l_reg = l_reg * alpha + pair_sum(ps);
                if (__any(alpha < 1.f)) { if (hi == 0) rowL[r32] = alpha; LDS_WAIT(); asm volatile("" ::: "memory");
#pragma unroll
                    for (int r = 0; r < 16; ++r) { const float a = rowL[crow(r, hi)];
#pragma unroll
                        for (int d = 0; d < 4; ++d) o[d][r] *= a; }
                    LDS_WAIT(); asm volatile("" ::: "memory"); }
                bf16x8 pa0, pa1, pa2, pa3; PK4(p0, 0, pa0); PK4(p0, 8, pa1); PK4(p1, 0, pa2); PK4(p1, 8, pa3);
                pv_all(o, (int)(size_t)(buf + 16384) + v_rd_base(lane), pa0, pa1, pa2, pa3);
            }
            if (j + 1 < NT) kv_write<true>(R, F.lds + ((j + 1) & 1) * 32768, sr, sc, kg);
            __syncthreads();
        }
        if (hi == 0) rowL[r32] = 1.0f / l_reg;
        LDS_WAIT(); asm volatile("" ::: "memory");
        const size_t row0 = rb + q0 + 32 * wave;
#pragma unroll
        for (int r = 0; r < 16; ++r) { const float a = rowL[crow(r, hi)]; bf16* op = BR + (row0 + crow(r, hi)) * 3072 + 1024 + h * HD + r32;
#pragma unroll
            for (int d = 0; d < 4; ++d) op[32 * d] = (bf16)f2bf(o[d][r] * a); }
    }
}

__device__ __forceinline__ void sb_attn(const Frame& F) {
    const bf16* P = (const bf16*)(F.ws + WS_PROJ); bf16* BR = (bf16*)(F.ws + WS_BR);
    LAS unsigned* flagL = (LAS unsigned*)(F.lds + AT_TAB_OFF + 2048);
    for (int u = F.vcu; u < 256; u += F.G) {
        const int tid = F.wave * 64 + fresh_lane();
        const int lane = tid & 63, wave = F.wave, r32 = lane & 31, hi = lane >> 5, sr = tid >> 4, sc = (tid & 15) * 8;
        const int b = u >> 6, h = (u >> 3) & 7, qb = u & 7, q0 = qb * 256, NT = 4 * (qb + 1); const size_t rb = (size_t)b * SEQ;
        const float kgd[8] = {1.f, 1.f, 1.f, 1.f, 1.f, 1.f, 1.f, 1.f};
        const int tq = q0 + 32 * wave + r32; bf16x8 qr[8];
#pragma unroll
        for (int d0 = 0; d0 < 8; ++d0) { const v4u x = *(const v4u*)(P + (rb + tq) * PW + C_SQ + h * HD + 16 * d0 + 8 * hi); const float s = 0.08838834764831845f;
            v4u o; o.x = pk2(bflo(x.x) * s, bfhi(x.x) * s); o.y = pk2(bflo(x.y) * s, bfhi(x.y) * s); o.z = pk2(bflo(x.z) * s, bfhi(x.z) * s); o.w = pk2(bflo(x.w) * s, bfhi(x.w) * s); qr[d0] = *reinterpret_cast<bf16x8*>(&o); }
        const bf16* Kp = P + C_SK + h * HD; const bf16* Vp = P + C_SV + h * HD;
        __syncthreads();
        KVRegs R; kv_load(R, Kp, Vp, rb + 64 * (NT - 1), sr, sc); kv_write<false>(R, F.lds, sr, sc, kgd);
        __syncthreads();
        float carry = 1.f; f32x16 o[4] = {};
        int it = 0;
        for (int j = NT - 1; j >= 0; --j, ++it) {
            LAS unsigned char* buf = F.lds + (it & 1) * 32768;
            if (j > 0) kv_load(R, Kp, Vp, rb + 64 * (j - 1), sr, sc);
            if (64 * j < q0 + 32 * wave + 31) {
                f32x16 p0, p1; qkt64(p0, p1, (const LAS char*)buf, qr, r32, hi);
                const int rel0 = tq - 64 * j;
                float To[8];
#pragma unroll
                for (int a = 0; a < 8; ++a) {
                    float n[4], sg[4];
#pragma unroll
                    for (int e = 0; e < 4; ++e) { const int r = 4 * (a & 3) + e, kk = crow(r, hi) + (a >= 4 ? 32 : 0);
                        float z = (a >= 4) ? p1[r] : p0[r]; z = fminf(fmaxf(z, -60.f), 60.f);
                        const float ex = __builtin_amdgcn_exp2f(-z * 1.4426950408889634f), s1 = __builtin_amdgcn_rcpf(1.f + ex);
                        const bool ok = kk < rel0; sg[e] = ok ? s1 : 0.f; n[e] = ok ? ex * s1 : 1.f; }
                    const float e2 = n[3], e1 = e2 * n[2], e0 = e1 * n[1]; To[a] = e0 * n[0];
                    if (a >= 4) { p1[4 * (a & 3) + 3] = sg[3]; p1[4 * (a & 3) + 2] = sg[2] * e2; p1[4 * (a & 3) + 1] = sg[1] * e1; p1[4 * (a & 3)] = sg[0] * e0; }
                    else { p0[4 * a + 3] = sg[3]; p0[4 * a + 2] = sg[2] * e2; p0[4 * a + 1] = sg[1] * e1; p0[4 * a] = sg[0] * e0; }
                }
                float run = carry;
#pragma unroll
                for (int a = 7; a >= 0; --a) { const float Tp = __shfl_xor(To[a], 32);
                    const float E = hi ? run : run * Tp; run = run * To[a] * Tp;
#pragma unroll
                    for (int e = 0; e < 4; ++e) { if (a >= 4) p1[4 * (a & 3) + e] *= E; else p0[4 * a + e] *= E; } }
                carry = run;
                bf16x8 pa0, pa1, pa2, pa3; PK4(p0, 0, pa0); PK4(p0, 8, pa1); PK4(p1, 0, pa2); PK4(p1, 8, pa3);
                pv_all(o, (int)(size_t)(buf + 16384) + v_rd_base(lane), pa0, pa1, pa2, pa3);
            }
            if (lane == 0) flagL[(it & 1) * 8 + wave] = __all(carry < 1e-30f) ? 1u : 0u;
            if (j > 0) kv_write<false>(R, F.lds + ((it + 1) & 1) * 32768, sr, sc, kgd);
            __syncthreads();
            unsigned done = 1u;
#pragma unroll
            for (int w = 0; w < 8; ++w) done &= flagL[(it & 1) * 8 + w];
            if (done) break;
        }
        const size_t row0 = rb + q0 + 32 * wave;
#pragma unroll
        for (int r = 0; r < 16; ++r) { bf16* op = BR + (row0 + crow(r, hi)) * 3072 + 2048 + h * HD + r32;
#pragma unroll
            for (int d = 0; d < 4; ++d) op[32 * d] = (bf16)f2bf(o[d][r]); }
    }
}
template <int LDA, int LDB> struct SchedDense {
    static constexpr bool GATHER = false;
    pg8::TileOrder T; const char* A; const char* B;
    __device__ __forceinline__ bool next(int i, pg8::Unit& u) const { u.e = 0; u.rows = 256; return T.tile(i, u.pm, u.pn); }
    __device__ __forceinline__ const char* a_base(const pg8::Unit& u) const { return A + (size_t)u.pm * 256 * LDA * 2; }
    __device__ __forceinline__ const char* b_base(const pg8::Unit& u) const { return B + (size_t)u.pn * 256 * LDB * 2; }
    __device__ __forceinline__ void a_off(const pg8::Unit&, int tid, unsigned (&v0)[2], unsigned (&v1)[2]) const {
        int R[2], C[2];
#pragma unroll
        for (int i = 0; i < 2; ++i) pg8::stage_rc(tid * 16 + i * 8192, R[i], C[i]);
#pragma unroll
        for (int i = 0; i < 2; ++i) { v0[i] = (unsigned)(R[i] * LDA + C[i]) * 2u; v1[i] = v0[i] + 128u * LDA * 2u; } }
};
struct EpiProj {
    static constexpr bool PERM = true;
    __device__ __forceinline__ bool zero_after(const pg8::Unit&) const { return true; }
    bf16* O; float* GIF;
    __device__ __forceinline__ void operator()(const f32x4 (&acc)[2][2][4][2], const pg8::Unit& u, int wr, int wc, int fr, int fq) const {
        const int row0 = u.pm * 256 + wr * 64 + fr, col0 = u.pn * 256 + wc * 32 + 8 * fq;
#pragma unroll
        for (int ai = 0; ai < 2; ++ai)
#pragma unroll
            for (int m = 0; m < 4; ++m) { bf16* rowp = O + (size_t)(row0 + ai * 128 + m * 16) * PW + col0;
#pragma unroll
                for (int bj = 0; bj < 2; ++bj) { const f32x4 v0 = acc[ai][bj][m][0], v1 = acc[ai][bj][m][1];
                    v4u w; w.x = cvt_pk_bf16(v0[0], v0[1]); w.y = cvt_pk_bf16(v0[2], v0[3]); w.z = cvt_pk_bf16(v1[0], v1[1]); w.w = cvt_pk_bf16(v1[2], v1[3]);
                    *(v4u*)(rowp + bj * 128) = w;
                    if (u.pn == PW / 256 - 1 && bj == 0 && wc == 0 && fq < 2) { float* gp = GIF + (size_t)(row0 + ai * 128 + m * 16) * 16 + 8 * fq; *(f32x4*)gp = v0; *(f32x4*)(gp + 4) = v1; } } }
    }
};
struct SchedBranch {
    static constexpr bool GATHER = false;
    pg8::TileOrder T; const char* A; const char* B;
    __device__ __forceinline__ bool next(int i, pg8::Unit& u) const { u.e = i % 3; u.rows = 256; return T.tile(i / 3, u.pm, u.pn); }
    __device__ __forceinline__ const char* a_base(const pg8::Unit& u) const { return A + ((size_t)u.pm * 256 * 3072 + (size_t)u.e * 1024) * 2; }
    __device__ __forceinline__ const char* b_base(const pg8::Unit& u) const { return B + ((size_t)u.e * 2048 + (size_t)u.pn * 256) * 1024 * 2; }
    __device__ __forceinline__ void a_off(const pg8::Unit&, int tid, unsigned (&v0)[2], unsigned (&v1)[2]) const {
        int R[2], C[2];
#pragma unroll
        for (int i = 0; i < 2; ++i) pg8::stage_rc(tid * 16 + i * 8192, R[i], C[i]);
#pragma unroll
        for (int i = 0; i < 2; ++i) { v0[i] = (unsigned)(R[i] * 3072 + C[i]) * 2u; v1[i] = v0[i] + 128u * 3072u * 2u; } }
};
struct EpiBranch {
    static constexpr bool PERM = true;
    __device__ __forceinline__ bool zero_after(const pg8::Unit& u) const { return u.e == 2; }
    const bf16* P; bf16* O;
    __device__ __forceinline__ void operator()(f32x4 (&acc)[2][2][4][2], const pg8::Unit& u, int wr, int wc, int fr, int fq) const {
        const int row0 = u.pm * 256 + wr * 64 + fr, col0 = u.pn * 256 + wc * 32 + 8 * fq;
#pragma unroll
        for (int ai = 0; ai < 2; ++ai)
#pragma unroll
            for (int m = 0; m < 4; ++m) { const size_t row = (size_t)(row0 + ai * 128 + m * 16);
#pragma unroll
                for (int bj = 0; bj < 2; ++bj) { const int col = col0 + bj * 128;
                    const v4u ga = *(const v4u*)(P + row * PW + C_G + u.e * 2048 + col);
                    float f[8];
                    { const float a[8] = {bflo(ga.x), bfhi(ga.x), bflo(ga.y), bfhi(ga.y), bflo(ga.z), bfhi(ga.z), bflo(ga.w), bfhi(ga.w)};
#pragma unroll
                      for (int e = 0; e < 8; ++e) f[e] = 1.0f / (1.0f + __expf(-fminf(fmaxf(a[e], -30.f), 30.f))); }
                    if (u.e < 2) { const v4u gb = *(const v4u*)(P + row * PW + C_G + (u.e + 1) * 2048 + col);
                        const float b[8] = {bflo(gb.x), bfhi(gb.x), bflo(gb.y), bfhi(gb.y), bflo(gb.z), bfhi(gb.z), bflo(gb.w), bfhi(gb.w)};
#pragma unroll
                        for (int e = 0; e < 8; ++e) f[e] *= 1.0f + __expf(-fminf(fmaxf(b[e], -30.f), 30.f)); }
                    f32x4 v0 = acc[ai][bj][m][0], v1 = acc[ai][bj][m][1];
                    v0[0] *= f[0]; v0[1] *= f[1]; v0[2] *= f[2]; v0[3] *= f[3]; v1[0] *= f[4]; v1[1] *= f[5]; v1[2] *= f[6]; v1[3] *= f[7];
                    if (u.e < 2) { acc[ai][bj][m][0] = v0; acc[ai][bj][m][1] = v1; }
                    else { v4u w; w.x = cvt_pk_bf16(v0[0], v0[1]); w.y = cvt_pk_bf16(v0[2], v0[3]); w.z = cvt_pk_bf16(v1[0], v1[1]); w.w = cvt_pk_bf16(v1[2], v1[3]);
                        *(v4u*)(O + row * DM + col) = w; } } }
    }
};
struct EpiOut {
    static constexpr bool PERM = false;
    __device__ __forceinline__ bool zero_after(const pg8::Unit&) const { return true; }
    const float* base; float* out;
    __device__ __forceinline__ void operator()(const f32x4 (&acc)[2][2][4][2], const pg8::Unit& u, int wr, int wc, int fr, int fq) const {
        const int row0 = u.pm * 256 + wr * 64 + fr, col0 = u.pn * 256 + wc * 32 + 4 * fq;
#pragma unroll
        for (int ai = 0; ai < 2; ++ai)
#pragma unroll
            for (int m = 0; m < 4; ++m) { const size_t off = (size_t)(row0 + ai * 128 + m * 16) * DM + col0;
#pragma unroll
                for (int bj = 0; bj < 2; ++bj)
#pragma unroll
                    for (int n = 0; n < 2; ++n) { const f32x4 bs = *(const f32x4*)(base + off + bj * 128 + n * 16); *(f32x4*)(out + off + bj * 128 + n * 16) = bs + acc[ai][bj][m][n]; } }
    }
};

#ifndef MK_NAIVE_MOE
#define MK_NAIVE_MOE 0
#endif
#ifndef PROBE_MASK
#define PROBE_MASK 0
#endif
#ifndef OFFMASK
#define OFFMASK 0
#endif
constexpr int PH_PRE = 0, PH_INPROJ = 1, PH_MIXA = 2, PH_MIXB = 3, PH_MIXC = 4, PH_BRANCH = 5, PH_OUT = 6, PH_NORM2 = 7, PH_MOE = 8, PH_MOED = 9, NPH_L = 10,
              PH_FINAL = DEPTH * NPH_L, NPH = PH_FINAL + 1;

__global__ void __launch_bounds__(NTHR, 2) fwd_kernel(Args args) {
    extern __shared__ __attribute__((aligned(16))) unsigned char lds_raw[];
    Frame F;
    F.lds = (LAS unsigned char*)lds_raw;
    F.wave = __builtin_amdgcn_readfirstlane((int)threadIdx.x >> 6);
    const int wave0 = F.wave;
    F.G = gridDim.x; { const int bx = blockIdx.x; F.vcu = (F.G % 8 == 0) ? (bx % 8) * (F.G / 8) + bx / 8 : bx; }
    F.ws = args.ws; F.ctl = (unsigned*)(args.ws + WS_CTL);
    volatile LAS unsigned* MISC = (volatile LAS unsigned*)(F.lds + LDSCTL_OFF);
    for (int u = threadIdx.x; u < (LDS_BYTES - LDSCTL_OFF) / 4; u += NTHR) ((LAS unsigned*)(F.lds + LDSCTL_OFF))[u] = 0u;
    __syncthreads();
    XcdBarrier bar; bar.bar = F.ctl + CW_BAR; bar.x = 0; bar.st = nullptr;
    if (args.use_bar) bar = xcd_barrier_post(F.ctl + CW_BAR, MISC + 8);
    const int lo = args.ph_lo, hi = args.ph_hi;
#define IN(k) (lo <= (k) && (k) < hi)
#define FRESH() do { F.wave = wave0; F.ws = arg_ws(); F.ctl = (unsigned*)(F.ws + WS_CTL); } while (0)
#define SEAM(k) do { if (args.use_bar && IN((k) + 1)) { FRESH(); xcd_barrier(bar, (F.wave * 64 + fresh_lane())); } } while (0)
    for (int l = 0; l < DEPTH; ++l) {
        const int p0 = l * NPH_L;
#define REPS(k) for (int rep_ = 0; rep_ < (int)((args.reps >> (2 * (k))) & 3u); ++rep_)
#define RSYNC() do { if (rep_) __syncthreads(); } while (0)
        if (IN(p0 + PH_PRE)) { FRESH();
            _Pragma("unroll 1") REPS(0) { RSYNC(); ph_convw(F, l); }
            _Pragma("unroll 1") REPS(1) { RSYNC(); ph_norm1(F, l); }
            SEAM(p0 + PH_PRE); }
        if (IN(p0 + PH_INPROJ)) { FRESH();
            SchedDense<DM, DM> S; S.T.init(NTOK / 256, PW / 256, F.G, (int)blockIdx.x); S.A = (const char*)(F.ws + WS_XN); S.B = (const char*)(F.ws + WS_WIN);
            EpiProj E{(bf16*)(F.ws + WS_PROJ), gif_ptr(F)};
            _Pragma("unroll 1") REPS(10) { RSYNC(); pg8::gemm_phase<SchedDense<DM, DM>, EpiProj, DM, DM, DM, true>(F.lds, S, E, (F.wave * 64 + fresh_lane())); }
            SEAM(p0 + PH_INPROJ); }
        if (IN(p0 + PH_MIXA)) { FRESH();
            _Pragma("unroll 1") REPS(2) { RSYNC(); ml_delta(F, l); }
            __syncthreads();
            _Pragma("unroll 1") REPS(5) { RSYNC(); dsa_index(F); }
            SEAM(p0 + PH_MIXA); }
        if (IN(p0 + PH_MIXB)) { FRESH();
            _Pragma("unroll 1") REPS(3) { RSYNC(); ml_scan(F); }
            __syncthreads();
            _Pragma("unroll 1") REPS(7) { RSYNC(); sb_attn(F); }
            SEAM(p0 + PH_MIXB); }
        if (IN(p0 + PH_MIXC)) { FRESH();
            _Pragma("unroll 1") REPS(6) { RSYNC(); dsa_attn(F, l); }
            __syncthreads();
            _Pragma("unroll 1") REPS(4) { RSYNC(); ml_out(F, l); }
            SEAM(p0 + PH_MIXC); }
        if (IN(p0 + PH_BRANCH)) { FRESH();
            SchedBranch S; S.T.init(NTOK / 256, DM / 256, F.G, (int)blockIdx.x); S.A = (const char*)(F.ws + WS_BR); S.B = (const char*)(F.ws + WS_WBR);
            EpiBranch E{(const bf16*)(F.ws + WS_PROJ), (bf16*)(F.ws + WS_MRG)};
            _Pragma("unroll 1") REPS(11) { RSYNC(); pg8::gemm_phase<SchedBranch, EpiBranch, BW, 3072, BW, true>(F.lds, S, E, (F.wave * 64 + fresh_lane())); }
            SEAM(p0 + PH_BRANCH); }
        if (IN(p0 + PH_OUT)) { FRESH();
            SchedDense<DM, DM> S; S.T.init(NTOK / 256, DM / 256, F.G, (int)blockIdx.x); S.A = (const char*)(F.ws + WS_MRG); S.B = (const char*)(F.ws + WS_WOUT);
            EpiOut E{l == 0 ? arg_in(0) : (const float*)(F.ws + WS_XA), (float*)(F.ws + WS_X1)};
            _Pragma("unroll 1") REPS(12) { RSYNC(); pg8::gemm_phase<SchedDense<DM, DM>, EpiOut, DM, DM, DM, true>(F.lds, S, E, (F.wave * 64 + fresh_lane())); }
            SEAM(p0 + PH_OUT); }
        if (IN(p0 + PH_NORM2)) { FRESH(); _Pragma("unroll 1") REPS(8) { RSYNC(); ph_norm2_mfma(F, l); } SEAM(p0 + PH_NORM2); }
        if (IN(p0 + PH_MOE)) { FRESH();
            moe_tables(F, l);
            SchedMoeUp S; S.tp = (const LAS int*)(F.lds + MOE_TAB_OFF); S.cn = S.tp + 40; S.sb = S.cn + 40; S.G = F.G; S.c = (int)blockIdx.x;
            S.A = (const char*)(F.ws + WS_XN); S.B = (const char*)(F.ws + WS_WGU); S.list = (const int*)(F.ws + WS_LIST);
            EpiMoeUp E{(bf16*)(F.ws + WS_HB), S.sb};
            _Pragma("unroll 1") REPS(13) { RSYNC(); pg8::gemm_phase<SchedMoeUp, EpiMoeUp, DM, DM, DM, true>(F.lds, S, E, (F.wave * 64 + fresh_lane())); }
            SEAM(p0 + PH_MOE); }
        if (IN(p0 + PH_MOED)) { FRESH();
            moe_tables(F, l);
            SchedMoeDown S; S.tp = (const LAS int*)(F.lds + MOE_TAB_OFF); S.cn = S.tp + 40; S.sb = S.cn + 40; S.G = F.G; S.c = (int)blockIdx.x;
            S.A = (const char*)(F.ws + WS_HB); S.B = (const char*)(F.ws + WS_WDN);
            EpiMoeDown E{(bf16*)(F.ws + WS_YB), (const int*)(F.ws + WS_LIST), (const int*)tokinfo_ptr(F)};
            _Pragma("unroll 1") REPS(14) { RSYNC(); pg8::gemm_phase<SchedMoeDown, EpiMoeDown, DEXP, DEXP, DEXP, true>(F.lds, S, E, (F.wave * 64 + fresh_lane())); }
            SEAM(p0 + PH_MOED); }
    }
    if (IN(PH_FINAL)) { FRESH(); } if (IN(PH_FINAL)) ph_final(F, args.out);
#undef IN
#undef SEAM
}

#ifndef MK_ONE_LAUNCH
#define MK_ONE_LAUNCH 1
#endif
extern "C" void kernel_launch(void* const* d_in, const int* in_sizes, int n_in, void* d_out, int out_size, void* d_ws, size_t ws_size, hipStream_t stream) {
    static int grid = 0;
    if (grid == 0) {
        if (n_in != 20 || in_sizes[0] != NTOK * DM || out_size != NTOK * DM || ws_size < WS_END) { fprintf(stderr, "kernel_launch: shape mismatch (n_in %d, ws %zu < %zu?)\n", n_in, ws_size, (size_t)WS_END); grid = -1; return; }
        int dev = 0, cus = 0, per_cu = 0;
        if (hipGetDevice(&dev) != hipSuccess || hipDeviceGetAttribute(&cus, hipDeviceAttributeMultiprocessorCount, dev) != hipSuccess) { grid = -1; return; }
        if (hipFuncSetAttribute((const void*)fwd_kernel, hipFuncAttributeMaxDynamicSharedMemorySize, LDS_BYTES) != hipSuccess) { fprintf(stderr, "kernel_launch: hipFuncSetAttribute failed\n"); grid = -1; return; }
        if (hipOccupancyMaxActiveBlocksPerMultiprocessor(&per_cu, (const void*)fwd_kernel, NTHR, LDS_BYTES) != hipSuccess || per_cu < 1) fprintf(stderr, "kernel_launch: occupancy query says %d\n", per_cu);
        (void)hipGetLastError();
        grid = cus;
    }
    if (grid < 0) return;
    if (hipMemsetAsync((char*)d_ws + WS_CTL, 0, CTL_ZERO_BYTES, stream) != hipSuccess) return;
    Args a{};
    for (int i = 0; i < 20; ++i) a.in[i] = (const float*)d_in[i];
    a.out = (float*)d_out; a.ws = (unsigned char*)d_ws;
    { unsigned r = 0; for (int k = 0; k < 15; ++k) r |= (1u + ((PROBE_MASK >> k) & 1u)) << (2 * k); a.reps = r; }
#if MK_ONE_LAUNCH
    a.ph_lo = 0; a.ph_hi = NPH; a.use_bar = 1;
    hipLaunchKernelGGL(fwd_kernel, dim3(grid), dim3(NTHR), LDS_BYTES, stream, a);
#else
    for (int ph = 0; ph < NPH; ++ph) { a.ph_lo = ph; a.ph_hi = ph + 1; a.use_bar = 0;
        hipLaunchKernelGGL(fwd_kernel, dim3(grid), dim3(NTHR), LDS_BYTES, stream, a); }
#endif
    const hipError_t le = hipPeekAtLastError();
    if (le != hipSuccess) fprintf(stderr, "kernel_launch: launch failed: %s\n", hipGetErrorName(le));
}
```

```cpp
#define PROBE_MASK 0x0
#include <hip/hip_runtime.h>
#include <cstdio>
#include <cstdint>

constexpr int BATCH = 4, SEQ = 2048, DM = 2048, NTOK = BATCH * SEQ, NH = 8, HD = 128, BW = 1024, DEPTH = 2;
constexpr int NIN = 17504, PW = 17664;
constexpr int IDXH = 16, IDXD = 64, TOPK = 256, NEXP = 32, NGRP = 4, EPG = 8, DEXP = 512, MCH = 64, NCH = SEQ / MCH;
constexpr float EPS = 1e-6f;
constexpr int C_MQ = 0, C_MK = 1024, C_MV = 2048, C_MO = 3072, C_DQ = 4096, C_DK = 5120, C_DV = 6144, C_IQ = 7168, C_SQ = 8192, C_SK = 9216, C_SV = 10240,
              C_G = 11264, C_MI = 17408, C_MF = 17416, C_IK = 17424, C_IW = 17488;
__host__ __device__ __forceinline__ int src_col(int c) {
    if (c < 4096) return c;
    if (c < 8192) return c + 16;
    if (c < 17408) return c + 96;
    if (c < 17424) return 4096 + (c - 17408);
    if (c < 17488) return 8208 + (c - 17424);
    if (c < 17504) return 8272 + (c - 17488);
    return -1;
}

constexpr size_t MiB = 1u << 20;
constexpr size_t WS_CTL = 0, CTL_ZERO_BYTES = 1 * MiB;
constexpr size_t WS_WIN = 1 * MiB;
constexpr size_t WS_WBR = WS_WIN + 69 * MiB;
constexpr size_t WS_WOUT = WS_WBR + 12 * MiB;
constexpr size_t WS_WGU = WS_WOUT + 8 * MiB;
constexpr size_t WS_WDN = WS_WGU + 128 * MiB;
constexpr size_t WS_XN = WS_WDN + 64 * MiB;
constexpr size_t WS_XA = WS_XN + 32 * MiB;
constexpr size_t WS_X1 = WS_XA + 64 * MiB;
constexpr size_t WS_PROJ = WS_X1 + 64 * MiB;
constexpr size_t WS_BR = WS_PROJ + 276 * MiB;
constexpr size_t WS_MRG = WS_BR + 48 * MiB;
constexpr size_t WS_MASK = WS_MRG + 32 * MiB;
constexpr size_t WS_MDEL = WS_MASK + 2 * MiB;
constexpr size_t WS_MDN = WS_MDEL + 64 * MiB;
constexpr size_t WS_MST = WS_MDN + 1 * MiB;
constexpr size_t WS_MSN = WS_MST + 32 * MiB;
constexpr size_t WS_HB = WS_MSN + 1 * MiB;
constexpr size_t WS_YB = WS_HB + 16 * MiB;
constexpr size_t WS_LIST = WS_YB + 64 * MiB;
constexpr size_t WS_TMP = WS_LIST + 2 * MiB;
constexpr size_t WS_WIN2 = WS_TMP;
constexpr size_t WS_END = WS_WIN2 + 69 * MiB;
static_assert(WS_END <= 1100 * MiB, "workspace map");

constexpr int CW_BAR = 4096;
constexpr int CW_CVT = 12288;
constexpr int CW_ECNT = 16384;

#define GAS __attribute__((address_space(1)))
#define LAS __attribute__((address_space(3)))
typedef unsigned short bf16;
typedef unsigned v4u __attribute__((ext_vector_type(4)));
typedef unsigned v2u __attribute__((ext_vector_type(2)));
typedef float f32x4 __attribute__((ext_vector_type(4)));
typedef float f32x2 __attribute__((ext_vector_type(2)));
typedef float f32x16 __attribute__((ext_vector_type(16)));
typedef short bf16x8 __attribute__((ext_vector_type(8)));
typedef short s16x4 __attribute__((ext_vector_type(4)));
#define RLX_AGENT __ATOMIC_RELAXED, __HIP_MEMORY_SCOPE_AGENT
#define LDS_WAIT() asm volatile("s_waitcnt lgkmcnt(0)" ::: "memory")
#define VM_WAIT() asm volatile("s_waitcnt vmcnt(0)" ::: "memory")
constexpr int NWAVES = 8, NTHR = 512;
constexpr int RING_BYTES = 131072, LDSCTL_OFF = RING_BYTES, LDS_BYTES = 147456;

__device__ __forceinline__ unsigned f2bf(float f) { unsigned u = __builtin_bit_cast(unsigned, f); return (u + 0x7fffu + ((u >> 16) & 1u)) >> 16; }
__device__ __forceinline__ unsigned pk2(float lo, float hi) { return f2bf(lo) | (f2bf(hi) << 16); }
__device__ __forceinline__ float bf2f(unsigned short b) { return __builtin_bit_cast(float, ((unsigned)b) << 16); }
__device__ __forceinline__ float bflo(unsigned w) { return __builtin_bit_cast(float, w << 16); }
__device__ __forceinline__ float bfhi(unsigned w) { return __builtin_bit_cast(float, w & 0xffff0000u); }
__device__ __forceinline__ unsigned cvt_pk_bf16(float lo, float hi) { unsigned r; asm volatile("v_cvt_pk_bf16_f32 %0, %1, %2" : "=v"(r) : "v"(lo), "v"(hi)); return r; }
__device__ __forceinline__ float wave_sum(float v) {
#pragma unroll
    for (int o = 1; o < 64; o <<= 1) v += __shfl_xor(v, o);
    return v;
}
__device__ __forceinline__ float wave_max(float v) {
#pragma unroll
    for (int o = 1; o < 64; o <<= 1) v = fmaxf(v, __shfl_xor(v, o));
    return v;
}
__device__ __forceinline__ float sigmoidf_(float x) { return 1.0f / (1.0f + __expf(-x)); }
__device__ __forceinline__ float siluf_(float x) { return x / (1.0f + __expf(-x)); }
__device__ __forceinline__ float logsigmoidf_(float x) { return fminf(x, 0.f) - log1pf(__expf(-fabsf(x))); }
__device__ __forceinline__ int t5_bucket(int n) {
    if (n < 16) return n;
    return 16 + (n >= 19) + (n >= 21) + (n >= 24) + (n >= 27) + (n >= 31) + (n >= 35) + (n >= 40) + (n >= 46) + (n >= 52) + (n >= 59) + (n >= 67) + (n >= 77) + (n >= 87) + (n >= 99) + (n >= 113);
}
namespace pg8 {
constexpr int BM = 256, BK = 64, HALF = 128, HTB = HALF * BK * 2, STAGE_BYTES = 8 * HTB, NXCD = 8, WGM = 8;
__host__ __device__ __forceinline__ int lds_byte(int r, int c) { const int st = (r >> 4) * 2 + (c >> 5), rr = r & 15, cc = c & 31, ob = rr * 64 + cc * 2; return st * 1024 + (ob ^ (((ob >> 9) & 1) << 5)); }
__host__ __device__ __forceinline__ void stage_rc(int b, int& R, int& C) { const int st = b / 1024, sb = b % 1024, swz = sb ^ (((sb >> 9) & 1) << 5); R = (st >> 1) * 16 + swz / 64; C = (st & 1) * 32 + (swz % 64) / 2; }
__host__ __device__ __forceinline__ int perm32(int rho) { const int n = rho >> 4, i = rho & 15; return 8 * (i >> 2) + 4 * n + (i & 3); }

struct Unit { int pm, pn, e, rows; };

struct TileOrder {
    int nM, nN, nwg, G, c;
    __device__ void init(int nM_, int nN_, int G_, int c_) { nM = nM_; nN = nN_; nwg = nM * nN; G = G_; c = c_; }
    __device__ bool tile(int i, int& pm, int& pn) const {
        const long L = (long)i * G + c; if (L >= nwg) return false;
        int wgid = (int)L; { const int q = nwg / NXCD, r = nwg % NXCD, xcd = wgid % NXCD, off = wgid / NXCD; wgid = (xcd < r ? xcd * (q + 1) : r * (q + 1) + (xcd - r) * q) + off; }
        const int nig = WGM * nN, gid = wgid / nig, fm = gid * WGM, gsz = (nM - fm) < WGM ? (nM - fm) : WGM;
        pm = fm + ((wgid % nig) % gsz); pn = (wgid % nig) / gsz; return true;
    }
};

template <class Sched, class Epi, int K, int LDA, int LDB, bool ALIGN_EPI>
__device__ __forceinline__ void gemm_phase(LAS unsigned char* lds, const Sched& S, const Epi& E, int tid_in) {
    int tid_ = tid_in; asm volatile("" : "+v"(tid_));
    const int tid = tid_, wid = __builtin_amdgcn_readfirstlane(tid >> 6), lane = tid & 63, wr = wid >> 2, wc = wid & 3, fr = lane & 15, fq = lane >> 4;
    constexpr int nt = K / BK;
    static_assert(K % 128 == 0 && K >= 256, "K");
    unsigned voffB[2];
#pragma unroll
    for (int i = 0; i < 2; ++i) { int R, C; stage_rc(tid * 16 + i * 8192, R, C); const int Rb = Epi::PERM ? ((R & ~31) + perm32(R & 31)) : R;
        voffB[i] = (unsigned)(Rb * LDB + C) * 2u; }
    constexpr size_t kstep = (size_t)(BK * 2);
    constexpr size_t hstepB = (size_t)HALF * LDB * 2;
    constexpr size_t hstepA = Sched::GATHER ? 0 : (size_t)HALF * LDA * 2;
    const unsigned ldsw = (unsigned)wid * 1024u;
    const int aoff = lds_byte(wr * 64 + fr, fq * 8), boff = lds_byte(wc * 32 + fr, fq * 8);
#define PG8_SA(b, h) (((b) * 2 + (h)) * HTB)
#define PG8_SB(b, h) ((4 + (b) * 2 + (h)) * HTB)
#define PG8_STAGE(bufoff, gbase, voff) do { _Pragma("unroll") for (int _i = 0; _i < 2; ++_i) \
        __builtin_amdgcn_global_load_lds((const unsigned*)((const char*)(gbase) + (voff)[_i]), (LAS unsigned*)(lds + (bufoff) + ldsw + _i * 8192), 16, 0, 0); } while (0)
#define PG8_LDA(dst, b, h) do { _Pragma("unroll") for (int m = 0; m < 4; ++m) _Pragma("unroll") for (int k = 0; k < 2; ++k) dst[m][k] = *(const LAS bf16x8*)(lds + PG8_SA(b, h) + aoff + m * 2048 + k * 1024); } while (0)
#define PG8_LDB(dst, b, h) do { _Pragma("unroll") for (int n = 0; n < 2; ++n) _Pragma("unroll") for (int k = 0; k < 2; ++k) dst[n][k] = *(const LAS bf16x8*)(lds + PG8_SB(b, h) + boff + n * 2048 + k * 1024); } while (0)
#define PG8_MMA(ai, bj, At, Bt) do { __builtin_amdgcn_s_setprio(1); _Pragma("unroll") for (int m = 0; m < 4; ++m) _Pragma("unroll") for (int n = 0; n < 2; ++n) _Pragma("unroll") for (int k = 0; k < 2; ++k) \
        acc[ai][bj][m][n] = __builtin_amdgcn_mfma_f32_16x16x32_bf16(Bt[n][k], At[m][k], acc[ai][bj][m][n], 0, 0, 0); __builtin_amdgcn_s_setprio(0); } while (0)
#define VA1 (Sched::GATHER ? vA1 : vA0)
#define W0 vA0
#define W1 VA1
#define PG8_WAIT_V(n) asm volatile("s_waitcnt vmcnt(" #n ")" ::: "memory")
#define PG8_WAIT_L(n) asm volatile("s_waitcnt lgkmcnt(" #n ")" ::: "memory")
#define PG8_BAR __builtin_amdgcn_s_barrier()
#define PG8_SCHED __builtin_amdgcn_sched_barrier(0)
    Unit cur, nxt; int ui = 0;
    if (!S.next(0, cur)) return;
    f32x4 acc[2][2][4][2];
#pragma unroll
    for (int a = 0; a < 2; ++a)
#pragma unroll
        for (int b = 0; b < 2; ++b)
#pragma unroll
            for (int m = 0; m < 4; ++m)
#pragma unroll
                for (int n = 0; n < 2; ++n) acc[a][b][m][n] = (f32x4){0.f, 0.f, 0.f, 0.f};
    bf16x8 At[4][2], B0[2][2], B1[2][2];
    unsigned vA0[2], vA1[2];
    S.a_off(cur, tid, vA0, vA1);
    const char* cA = S.a_base(cur); const char* cB = S.b_base(cur);
    PG8_STAGE(PG8_SB(0, 0), cB, voffB); PG8_STAGE(PG8_SB(0, 1), cB + hstepB, voffB); PG8_STAGE(PG8_SA(0, 0), cA, vA0); PG8_STAGE(PG8_SA(0, 1), cA + hstepA, VA1);
    if (wr == 1) PG8_BAR;
    PG8_WAIT_V(2); PG8_BAR;
    PG8_STAGE(PG8_SB(1, 0), cB + kstep, voffB); PG8_STAGE(PG8_SA(1, 0), cA + kstep, vA0); PG8_STAGE(PG8_SB(1, 1), cB + hstepB + kstep, voffB);
    PG8_WAIT_V(6); PG8_BAR;
    for (;;) {
        const bool has_next = S.next(ui + 1, nxt);
        const char* nA = has_next ? S.a_base(nxt) : cA; const char* nB = has_next ? S.b_base(nxt) : cB;
        for (int t = 0; t < nt; t += 2) {
            const bool last = (t == nt - 2);
            const char* a1 = cA + (size_t)(t + 1) * kstep;
            const char* a2 = last ? nA : cA + (size_t)(t + 2) * kstep; const char* b2 = last ? nB : cB + (size_t)(t + 2) * kstep;
            const char* a3 = a2 + kstep; const char* b3 = b2 + kstep;
            PG8_LDB(B0, 0, 0); PG8_LDB(B1, 0, 1); PG8_SCHED; PG8_LDA(At, 0, 0); PG8_STAGE(PG8_SA(1, 1), a1 + hstepA, VA1);
            if constexpr (Sched::GATHER) { if (last && has_next) S.a_off(nxt, tid, vA0, vA1); }
            PG8_WAIT_V(8); PG8_WAIT_L(0); PG8_BAR; PG8_MMA(0, 0, At, B0); PG8_MMA(0, 1, At, B1); PG8_BAR; PG8_SCHED;
            PG8_LDA(At, 0, 1); PG8_STAGE(PG8_SB(0, 0), b2, voffB); PG8_STAGE(PG8_SB(0, 1), b2 + hstepB, voffB); PG8_STAGE(PG8_SA(0, 0), a2, W0);
            PG8_WAIT_V(8); PG8_WAIT_L(0); PG8_BAR; PG8_MMA(1, 0, At, B0); PG8_MMA(1, 1, At, B1); PG8_BAR; PG8_SCHED;
            PG8_LDB(B0, 1, 0); PG8_LDB(B1, 1, 1); PG8_SCHED; PG8_LDA(At, 1, 0); PG8_STAGE(PG8_SA(0, 1), a2 + hstepA, W1);
            PG8_WAIT_V(8); PG8_WAIT_L(0); PG8_BAR; PG8_MMA(0, 0, At, B0); PG8_MMA(0, 1, At, B1); PG8_BAR; PG8_SCHED;
            PG8_LDA(At, 1, 1); PG8_STAGE(PG8_SB(1, 0), b3, voffB); PG8_STAGE(PG8_SB(1, 1), b3 + hstepB, voffB); PG8_STAGE(PG8_SA(1, 0), a3, W0);
            PG8_WAIT_V(8); PG8_WAIT_L(0); PG8_BAR; PG8_MMA(1, 0, At, B0); PG8_MMA(1, 1, At, B1); PG8_BAR; PG8_SCHED;
        }
        if constexpr (ALIGN_EPI) { if (wr == 0) PG8_BAR; }
        { int fr_e = fr, fq_e = fq; asm volatile("" : "+v"(fr_e), "+v"(fq_e));
          E(acc, cur, wr, wc, fr_e, fq_e);
#ifdef PROBE_EPI2
          if constexpr (Epi::PROBE2) E(acc, cur, wr, wc, fr_e, fq_e);
#endif
        }
        if (!has_next) break;
        if (E.zero_after(cur)) {
#pragma unroll
        for (int a = 0; a < 2; ++a)
#pragma unroll
            for (int b = 0; b < 2; ++b)
#pragma unroll
                for (int m = 0; m < 4; ++m)
#pragma unroll
                    for (int n = 0; n < 2; ++n) acc[a][b][m][n] = (f32x4){0.f, 0.f, 0.f, 0.f}; }
        cur = nxt; cA = nA; cB = nB; ++ui;
        if constexpr (ALIGN_EPI) { if (wr == 1) PG8_BAR; }
    }
    PG8_WAIT_V(0);
    if constexpr (!ALIGN_EPI) { if (wr == 0) PG8_BAR; }
    PG8_BAR;
#undef PG8_SA
#undef VA1
#undef W0
#undef W1
#undef PG8_SB
#undef PG8_STAGE
#undef PG8_LDA
#undef PG8_LDB
#undef PG8_MMA
#undef PG8_WAIT_V
#undef PG8_WAIT_L
#undef PG8_BAR
#undef PG8_SCHED
}
}
#define XB_TMO      128
#define XB_XCNT(j)  (256  + 64 * (j))
#define XB_XSUB(j)  (1280 + 64 * (j))
#define XB_XGEN(j)  (2304 + 64 * (j))
#define XB_TOP      3328
#define XB_TOPGEN   3392
#define XCD_BAR_WORDS 3456
#define XB_SPIN_CAP (1u << 18)
__device__ __forceinline__ unsigned xb_ld(unsigned* p)              { return __hip_atomic_load(p, __ATOMIC_RELAXED, __HIP_MEMORY_SCOPE_AGENT); }
__device__ __forceinline__ unsigned xb_add(unsigned* p, unsigned v) { return __hip_atomic_fetch_add(p, v, __ATOMIC_RELAXED, __HIP_MEMORY_SCOPE_AGENT); }
__device__ __forceinline__ unsigned xb_xcc_id() { return (unsigned)__builtin_amdgcn_s_getreg((3 << 11) | 20) & 0xFu; }
#define XB_SPIN(cond, bar) do { unsigned _sp = 0; while (cond) { __builtin_amdgcn_s_sleep(1); \
    if ((++_sp & 255u) == 0u) { if (xb_ld(&(bar)[XB_TMO])) break; if (_sp > XB_SPIN_CAP) { atomicAdd(&(bar)[XB_TMO], 1u); break; } } } } while (0)
struct XcdBarrier { unsigned* bar; unsigned x; volatile LAS unsigned* st; };
__device__ __forceinline__ XcdBarrier xcd_barrier_post(unsigned* bar, volatile LAS unsigned* st) {
    XcdBarrier b; b.bar = bar; b.x = xb_xcc_id(); b.st = st;
    if (threadIdx.x == 0) (void)xb_add(&bar[XB_XCNT(b.x)], 1u);
    return b;
}
__device__ __forceinline__ void xcd_barrier_complete(unsigned* bar, unsigned x, unsigned& nloc, unsigned& nx) {
    const unsigned G = gridDim.x * gridDim.y * gridDim.z;
    unsigned sum, cnt, mine, sp = 0u;
    for (;;) {
        sum = 0u; cnt = 0u; mine = 0u;
#pragma unroll
        for (unsigned j = 0; j < 16; ++j) { const unsigned c = xb_ld(&bar[XB_XCNT(j)]); sum += c; cnt += (c > 0u) ? 1u : 0u; mine = (j == x) ? c : mine; }
        if (sum == G) break;
        __builtin_amdgcn_s_sleep(1);
        if ((++sp & 255u) == 0u) { if (xb_ld(&bar[XB_TMO])) break; if (sp > XB_SPIN_CAP) { atomicAdd(&bar[XB_TMO], 1u); break; } }
    }
    nloc = mine > 0u ? mine : 1u; nx = cnt > 0u ? cnt : 1u;
}
__device__ __forceinline__ void xcd_barrier(const XcdBarrier& b, int tid) {
    asm volatile("s_waitcnt vmcnt(0)" ::: "memory");
    __syncthreads();
    if (tid == 0) {
        unsigned* bar = b.bar; asm volatile("" : "+s"(bar));
        __builtin_amdgcn_s_waitcnt(0);
        unsigned nloc = b.st[0], nx = b.st[1];
        if (nloc == 0u) { xcd_barrier_complete(bar, b.x, nloc, nx); b.st[0] = nloc; b.st[1] = nx; }
        const unsigned old = xb_add(&bar[XB_XSUB(b.x)], 1u);
        const unsigned gen = old / nloc;
        if (old + 1u == (gen + 1u) * nloc) {
            __builtin_amdgcn_fence(__ATOMIC_RELEASE, "agent");
            asm volatile("s_waitcnt vmcnt(0)" ::: "memory");
            const unsigned og = xb_add(&bar[XB_TOP], 1u);
            const unsigned tg = og / nx;
            if (og + 1u == (tg + 1u) * nx) xb_add(&bar[XB_TOPGEN], 1u);
            else XB_SPIN(xb_ld(&bar[XB_TOPGEN]) == tg, bar);
            __builtin_amdgcn_fence(__ATOMIC_ACQUIRE, "agent");
            xb_add(&bar[XB_XGEN(b.x)], 1u);
            asm volatile("s_waitcnt vmcnt(0)" ::: "memory");
        } else {
            XB_SPIN(xb_ld(&bar[XB_XGEN(b.x)]) == gen, bar);
            __builtin_amdgcn_fence(__ATOMIC_ACQUIRE, "agent");
            asm volatile("s_waitcnt vmcnt(0)" ::: "memory");
        }
    }
    __syncthreads();
}

struct Args { const float* in[20]; float* out; unsigned char* ws; int ph_lo, ph_hi, use_bar; unsigned reps; };
struct Frame {
    LAS unsigned char* lds;
    unsigned* ctl;
    int wave, vcu, G;
    unsigned char* ws;
};
__device__ __forceinline__ int fresh_lane() { int l_; asm volatile("v_mbcnt_lo_u32_b32 %0, -1, 0\n\tv_mbcnt_hi_u32_b32 %0, -1, %0" : "=v"(l_)); return l_; }
__device__ __forceinline__ const float* arg_in(int i) { asm volatile("" : "+s"(i)); return ((const float* const __attribute__((address_space(4)))*)__builtin_amdgcn_kernarg_segment_ptr())[i]; }
__device__ __forceinline__ unsigned char* arg_ws() { int i = 21; asm volatile("" : "+s"(i)); return ((unsigned char* const __attribute__((address_space(4)))*)__builtin_amdgcn_kernarg_segment_ptr())[i]; }
#define GW_ID(F) ((F).vcu * NWAVES + (F).wave)
#define GW_N(F) ((F).G * NWAVES)

__device__ __forceinline__ void cvt_item(const float* W, int ldw, int k0, int srcc, bf16* WT, size_t out_row0, int ldo, LAS float* scr, int lane) {
    float t[32];
#pragma unroll
    for (int i = 0; i < 32; ++i) { const int kk = 2 * i + (lane >> 5); t[i] = srcc >= 0 ? W[(size_t)(k0 + kk) * ldw + srcc] : 0.f; }
#pragma unroll
    for (int i = 0; i < 32; ++i) { const int kk = 2 * i + (lane >> 5); scr[kk * 33 + (lane & 31)] = t[i]; }
    LDS_WAIT(); asm volatile("" ::: "memory");
    const int c = lane & 7;
#pragma unroll
    for (int j = 0; j < 4; ++j) { const int n = (lane >> 3) + 8 * j; const LAS float* s = scr + (8 * c) * 33 + n;
        v4u o; o.x = pk2(s[0 * 33], s[1 * 33]); o.y = pk2(s[2 * 33], s[3 * 33]); o.z = pk2(s[4 * 33], s[5 * 33]); o.w = pk2(s[6 * 33], s[7 * 33]);
        *(v4u*)(WT + (out_row0 + n) * (size_t)ldo + k0 + 8 * c) = o; }
    LDS_WAIT(); asm volatile("" ::: "memory");
}
__device__ __forceinline__ void ph_convw(const Frame& F, int l) {
    LAS float* scr = (LAS float*)(F.lds + F.wave * 16384);
    const int gw = GW_ID(F), NGW = GW_N(F), lane = fresh_lane(), ln = lane & 31;
    constexpr int I_IN = (PW / 32) * 32, I_BR = 3 * 64 * 16, I_OUT = 64 * 32, I_G = 32 * 16 * 32, I_D = 32 * 64 * 8;
    constexpr int NITEMS = I_IN + I_BR + I_OUT + 2 * I_G + I_D;
    for (int it = gw; it < NITEMS; it += NGW) {
        int r = it;
        if (r < I_IN) { const int kb = r / (PW / 32), nb = r % (PW / 32);
            cvt_item(arg_in(2) + (size_t)l * DM * NIN, NIN, 64 * kb, src_col(32 * nb + ln), (bf16*)(F.ws + WS_WIN), (size_t)32 * nb, DM, scr, lane); continue; }
        r -= I_IN;
        if (r < I_BR) { const int n = r / (64 * 16), q = r % (64 * 16), kb = q / 64, nb = q % 64;
            cvt_item(arg_in(9) + ((size_t)l * 3 + n) * BW * DM, DM, 64 * kb, 32 * nb + ln, (bf16*)(F.ws + WS_WBR) + (size_t)n * DM * BW, (size_t)32 * nb, BW, scr, lane); continue; }
        r -= I_BR;
        if (r < I_OUT) { const int kb = r / 64, nb = r % 64;
            cvt_item(arg_in(10) + (size_t)l * DM * DM, DM, 64 * kb, 32 * nb + ln, (bf16*)(F.ws + WS_WOUT), (size_t)32 * nb, DM, scr, lane); continue; }
        r -= I_OUT;
        if (r < 2 * I_G) { const int up = r >= I_G; if (up) r -= I_G; const int e = r / (16 * 32), q = r % (16 * 32), kb = q / 16, nb = q % 16, f0 = 32 * nb;
            cvt_item(arg_in(up ? 17 : 16) + ((size_t)l * NEXP + e) * DM * DEXP, DEXP, 64 * kb, f0 + ln, (bf16*)(F.ws + WS_WGU) + (size_t)e * 1024 * DM,
                     (size_t)((f0 >> 7) * 256 + (up ? 128 : 0) + (f0 & 127)), DM, scr, lane); continue; }
        r -= 2 * I_G;
        { const int e = r / (64 * 8), q = r % (64 * 8), kb = q / 64, nb = q % 64;
            cvt_item(arg_in(18) + ((size_t)l * NEXP + e) * DEXP * DM, DM, 64 * kb, 32 * nb + ln, (bf16*)(F.ws + WS_WDN) + (size_t)e * DM * DEXP, (size_t)32 * nb, DEXP, scr, lane); }
    }
}

__device__ __forceinline__ int* tokinfo_ptr(const Frame& F) { return (int*)(F.ws + WS_LIST + MiB); }

__device__ __forceinline__ void ph_norm1(const Frame& F, int l) {
    const int gw = GW_ID(F), NGW = GW_N(F), lane = fresh_lane();
    const float* g = arg_in(1) + (size_t)l * DM;
    bf16* XN = (bf16*)(F.ws + WS_XN);
    for (int m = gw; m < NTOK; m += NGW) {
        f32x4 v[8]; float s = 0.f;
        if (l == 0) {
            const f32x4* xr = (const f32x4*)(arg_in(0) + (size_t)m * DM) + lane;
#pragma unroll
            for (int j = 0; j < 8; ++j) v[j] = xr[64 * j];
        } else {
            const f32x4* xr = (const f32x4*)((const float*)(F.ws + WS_X1) + (size_t)m * DM) + lane;
            const v2u* y0 = (const v2u*)((const bf16*)(F.ws + WS_YB) + (size_t)(2 * m) * DM) + lane;
            const v2u* y1 = (const v2u*)((const bf16*)(F.ws + WS_YB) + (size_t)(2 * m + 1) * DM) + lane;
            f32x4* xo = (f32x4*)((float*)(F.ws + WS_XA) + (size_t)m * DM) + lane;
#pragma unroll
            for (int j = 0; j < 8; ++j) { f32x4 x = xr[64 * j]; const v2u a = y0[64 * j], b = y1[64 * j];
                x.x = (x.x + bflo(a.x)) + bflo(b.x); x.y = (x.y + bfhi(a.x)) + bfhi(b.x); x.z = (x.z + bflo(a.y)) + bflo(b.y); x.w = (x.w + bfhi(a.y)) + bfhi(b.y);
                v[j] = x; xo[64 * j] = x; }
        }
#pragma unroll
        for (int j = 0; j < 8; ++j) s += (v[j].x * v[j].x + v[j].y * v[j].y) + (v[j].z * v[j].z + v[j].w * v[j].w);
        const float rstd = 1.0f / sqrtf(wave_sum(s) * (1.f / DM) + EPS);
        v2u* o8 = (v2u*)(XN + (size_t)m * DM) + lane;
        const f32x4* gr = (const f32x4*)g + lane;
#pragma unroll
        for (int j = 0; j < 8; ++j) { const f32x4 gg = gr[64 * j]; v2u o; o.x = pk2(v[j].x * rstd * gg.x, v[j].y * rstd * gg.y); o.y = pk2(v[j].z * rstd * gg.z, v[j].w * rstd * gg.w); o8[64 * j] = o; }
    }
}

__device__ __forceinline__ void ph_final(const Frame& F, float* out) {
    const int gw = GW_ID(F), NGW = GW_N(F), lane = fresh_lane();
    for (int m = gw; m < NTOK; m += NGW) {
        const f32x4* xr = (const f32x4*)((const float*)(F.ws + WS_X1) + (size_t)m * DM) + lane;
        const v2u* y0 = (const v2u*)((const bf16*)(F.ws + WS_YB) + (size_t)(2 * m) * DM) + lane;
        const v2u* y1 = (const v2u*)((const bf16*)(F.ws + WS_YB) + (size_t)(2 * m + 1) * DM) + lane;
        f32x4* xo = (f32x4*)(out + (size_t)m * DM) + lane;
#pragma unroll
        for (int j = 0; j < 8; ++j) { f32x4 x = xr[64 * j]; const v2u a = y0[64 * j], b = y1[64 * j];
            x.x = (x.x + bflo(a.x)) + bflo(b.x); x.y = (x.y + bfhi(a.x)) + bfhi(b.x); x.z = (x.z + bflo(a.y)) + bflo(b.y); x.w = (x.w + bfhi(a.y)) + bfhi(b.y);
            xo[64 * j] = x; }
    }
}

__device__ __forceinline__ void ph_norm2(const Frame& F, int l) {
    const int gw = GW_ID(F), NGW = GW_N(F), lane = fresh_lane();
    const float* g = arg_in(11) + (size_t)l * DM;
    const float* wrg = arg_in(12) + (size_t)l * DM * NGRP; const float* brg = arg_in(13) + l * NGRP;
    const float* wre = arg_in(14) + (size_t)l * DM * NEXP; const float* bre = arg_in(15) + l * NEXP;
    bf16* XN = (bf16*)(F.ws + WS_XN);
    int* list = (int*)(F.ws + WS_LIST); int* tinfo = tokinfo_ptr(F);
    unsigned* ecnt = F.ctl + CW_ECNT + l * NEXP * 64;
    for (int m = gw; m < NTOK; m += NGW) {
        f32x4 v[8]; float s = 0.f;
        const f32x4* xr = (const f32x4*)((const float*)(F.ws + WS_X1) + (size_t)m * DM) + lane;
#pragma unroll
        for (int j = 0; j < 8; ++j) { v[j] = xr[64 * j]; s += (v[j].x * v[j].x + v[j].y * v[j].y) + (v[j].z * v[j].z + v[j].w * v[j].w); }
        const float rstd = 1.0f / sqrtf(wave_sum(s) * (1.f / DM) + EPS);
        v2u* o8 = (v2u*)(XN + (size_t)m * DM) + lane;
        const f32x4* gr = (const f32x4*)g + lane;
#pragma unroll
        for (int j = 0; j < 8; ++j) { const f32x4 gg = gr[64 * j]; v2u o; o.x = pk2(v[j].x * rstd * gg.x, v[j].y * rstd * gg.y); o.y = pk2(v[j].z * rstd * gg.z, v[j].w * rstd * gg.w); o8[64 * j] = o; }
        float lg[36];
#pragma unroll
        for (int q = 0; q < 36; ++q) lg[q] = 0.f;
#pragma unroll 1
        for (int j = 0; j < 8; ++j) { const f32x4 gg = gr[64 * j], xx = xr[64 * j]; f32x4 x; x.x = xx.x * rstd * gg.x; x.y = xx.y * rstd * gg.y; x.z = xx.z * rstd * gg.z; x.w = xx.w * rstd * gg.w;
            const int k0 = 4 * lane + 256 * j;
#pragma unroll
            for (int c = 0; c < 4; ++c) { const float xv = x[c];
                const f32x4 wg = *(const f32x4*)(wrg + (size_t)(k0 + c) * NGRP);
                lg[0] += xv * wg.x; lg[1] += xv * wg.y; lg[2] += xv * wg.z; lg[3] += xv * wg.w;
                const f32x4* we = (const f32x4*)(wre + (size_t)(k0 + c) * NEXP);
#pragma unroll
                for (int q = 0; q < 8; ++q) { const f32x4 w = we[q]; lg[4 + 4 * q] += xv * w.x; lg[5 + 4 * q] += xv * w.y; lg[6 + 4 * q] += xv * w.z; lg[7 + 4 * q] += xv * w.w; } } }
#pragma unroll
        for (int q = 0; q < 36; ++q) lg[q] = wave_sum(lg[q]);
        LAS float* lgL = (LAS float*)(F.lds + F.wave * 256);
        if (lane == 0) {
#pragma unroll
            for (int q = 0; q < 36; ++q) lgL[q] = lg[q];
            int gs = 0; float best = lg[0] + brg[0];
#pragma unroll
            for (int q = 1; q < 4; ++q) { const float t = lg[q] + brg[q]; if (t > best) { best = t; gs = q; } }
            float gm = fmaxf(fmaxf(lg[0], lg[1]), fmaxf(lg[2], lg[3])), gsum = 0.f, gsel = 0.f;
#pragma unroll
            for (int q = 0; q < 4; ++q) { const float e = __expf(lg[q] - gm); gsum += e; gsel = (q == gs) ? e : gsel; }
            const float pg = gsel / gsum;
            LDS_WAIT(); asm volatile("" ::: "memory");
            float ein[8];
#pragma unroll
            for (int q = 0; q < 8; ++q) ein[q] = lgL[4 + gs * 8 + q];
            int e0 = 0, e1 = -1; float b0 = -3.0e38f, b1 = -3.0e38f;
#pragma unroll
            for (int q = 0; q < 8; ++q) { const float t = ein[q] + bre[gs * 8 + q];
                if (t > b0) { b1 = b0; e1 = e0; b0 = t; e0 = q; } else if (t > b1) { b1 = t; e1 = q; } }
            float em = ein[0];
#pragma unroll
            for (int q = 1; q < 8; ++q) em = fmaxf(em, ein[q]);
            float p0 = 0.f, p1 = 0.f;
#pragma unroll
            for (int q = 0; q < 8; ++q) { const float e = __expf(ein[q] - em); p0 = (q == e0) ? e : p0; p1 = (q == e1) ? e : p1; }
            const float w0 = pg * p0 / (p0 + p1), w1 = pg * p1 / (p0 + p1);
            const int x0 = gs * 8 + e0, x1 = gs * 8 + e1;
            const int pos0 = (int)atomicAdd(ecnt + x0 * 64, 1u), pos1 = (int)atomicAdd(ecnt + x1 * 64, 1u);
            list[x0 * NTOK + pos0] = 2 * m; list[x1 * NTOK + pos1] = 2 * m + 1;
            tinfo[m * 8 + 0] = x0; tinfo[m * 8 + 1] = pos0; tinfo[m * 8 + 2] = __float_as_int(w0); tinfo[m * 8 + 3] = 0;
            tinfo[m * 8 + 4] = x1; tinfo[m * 8 + 5] = pos1; tinfo[m * 8 + 6] = __float_as_int(w1); tinfo[m * 8 + 7] = 0;
        }
    }
}

__device__ __forceinline__ void nv_conv(const Frame& F, int l) {
    const bf16* P = (const bf16*)(F.ws + WS_PROJ); float* QK = (float*)(F.ws + WS_TMP);
    const float* cw = arg_in(3) + (size_t)l * 4 * 2048;
    const size_t total = (size_t)NTOK * 2048, stride = (size_t)F.G * NTHR;
    for (size_t i = (size_t)F.vcu * NTHR + (F.wave * 64 + fresh_lane()); i < total; i += stride) {
        const int row = (int)(i >> 11), c = (int)(i & 2047), t = row & (SEQ - 1);
        float a = 0.f;
#pragma unroll
        for (int j = 0; j < 4; ++j) { const int tt = t - 3 + j; if (tt >= 0) a += cw[j * 2048 + c] * bf2f(P[(size_t)(row - 3 + j) * PW + c]); }
        QK[i] = siluf_(a);
    }
}
__device__ __forceinline__ void nv_mlstm(const Frame& F, int l) {
    const bf16* P = (const bf16*)(F.ws + WS_PROJ); const float* QK = (const float*)(F.ws + WS_TMP); float* HR = (float*)(F.ws + WS_TMP + 64 * MiB);
    const int tid = (F.wave * 64 + fresh_lane()), v = tid >> 2, kq = tid & 3;
    for (int bh = F.vcu; bh < BATCH * NH; bh += F.G) {
        const int b = bh >> 3, h = bh & 7;
        const float bi = arg_in(4)[l * NH + h], bfv = arg_in(5)[l * NH + h];
        float C[32], nn[32], m = 0.f;
#pragma unroll
        for (int j = 0; j < 32; ++j) { C[j] = 0.f; nn[j] = 0.f; }
        for (int t = 0; t < SEQ; ++t) {
            const size_t row = (size_t)b * SEQ + t;
            const float it = bf2f(P[row * PW + C_MI + h]) + bi, ft = bf2f(P[row * PW + C_MF + h]) + bfv;
            const float lf = logsigmoidf_(ft);
            const float mn = fmaxf(lf + m, it), ip = __expf(it - mn), fp = __expf(lf + m - mn); m = mn;
            const float vv = bf2f(P[row * PW + C_MV + h * HD + v]);
            const f32x4* qp = (const f32x4*)(QK + row * 2048 + h * HD + kq * 32);
            const f32x4* kp = (const f32x4*)(QK + row * 2048 + 1024 + h * HD + kq * 32);
            float num = 0.f, den = 0.f;
#pragma unroll
            for (int j4 = 0; j4 < 8; ++j4) { const f32x4 q = qp[j4], k = kp[j4];
#pragma unroll
                for (int c = 0; c < 4; ++c) { const int j = 4 * j4 + c; const float qq = q[c] * 0.08838834764831845f;
                    C[j] = fp * C[j] + ip * vv * k[c]; nn[j] = fp * nn[j] + ip * k[c]; num += C[j] * qq; den += nn[j] * qq; } }
            num += __shfl_xor(num, 1); num += __shfl_xor(num, 2); den += __shfl_xor(den, 1); den += __shfl_xor(den, 2);
            if (kq == 0) HR[row * 1024 + h * HD + v] = num / fmaxf(fabsf(den), __expf(-m));
        }
    }
}
__device__ __forceinline__ void nv_mnorm(const Frame& F, int l) {
    const bf16* P = (const bf16*)(F.ws + WS_PROJ); const float* HR = (const float*)(F.ws + WS_TMP + 64 * MiB); bf16* BR = (bf16*)(F.ws + WS_BR);
    const float* g = arg_in(6) + (size_t)l * BW;
    const int gw = GW_ID(F), NGW = GW_N(F), lane = fresh_lane();
    for (int it = gw; it < NTOK * NH; it += NGW) {
        const size_t row = it >> 3; const int h = it & 7, c = h * HD + 2 * lane;
        const float a = HR[row * 1024 + c], b = HR[row * 1024 + c + 1];
        const float r = 1.0f / sqrtf(wave_sum(a * a + b * b) * (1.f / HD) + EPS);
        const float o0 = a * r * g[c] * sigmoidf_(bf2f(P[row * PW + C_MO + c])), o1 = b * r * g[c + 1] * sigmoidf_(bf2f(P[row * PW + C_MO + c + 1]));
        *(unsigned*)(BR + row * 3072 + c) = pk2(o0, o1);
    }
}
__device__ __forceinline__ unsigned fkey(float f) { const unsigned u = __float_as_uint(f); return (u & 0x80000000u) ? ~u : (u | 0x80000000u); }
__device__ __forceinline__ void select_row(const unsigned (&key)[32], int nvalid, unsigned long long* mrow, int lane, LAS unsigned* cand) {
    if (nvalid <= TOPK) {
#pragma unroll
        for (int j = 0; j < 32; ++j) { const unsigned long long b = __ballot(lane + 64 * j < nvalid); if (lane == 0) mrow[j] = b; }
        return;
    }
    unsigned T = 0u; int cT = 2048, cU = 0, bit = 31;
    for (; bit >= 0; --bit) {
        const unsigned cnd = T | (1u << bit); int c = 0;
#pragma unroll
        for (int j = 0; j < 32; ++j) c += __popcll(__ballot(key[j] >= cnd));
        if (c >= TOPK) { T = cnd; cT = c; } else cU = c;
        if (cT - cU <= 64) break;
    }
    if (bit > 0) {
        const unsigned span = 1u << bit; int base = 0;
#pragma unroll
        for (int j = 0; j < 32; ++j) { const bool pr = (key[j] - T) < span; const unsigned long long m = __ballot(pr);
            if (m) { const int pos = base + (int)__builtin_amdgcn_mbcnt_hi((unsigned)(m >> 32), __builtin_amdgcn_mbcnt_lo((unsigned)m, 0u)); if (pr) cand[pos] = key[j]; base += __popcll(m); } }
        LDS_WAIT(); asm volatile("" ::: "memory");
        const int u = cT - cU, kq = TOPK - cU;
        const unsigned my = (lane < u) ? cand[lane] : 0u; int cnt = 0;
        for (int m = 0; m < u; ++m) cnt += (cand[m] > my) ? 1 : 0;
        unsigned best = (lane < u && cnt < kq) ? my : 0xFFFFFFFFu;
#pragma unroll
        for (int o = 1; o < 64; o <<= 1) { const unsigned t = (unsigned)__shfl_xor((int)best, o); best = t < best ? t : best; }
        T = best;
        LDS_WAIT(); asm volatile("" ::: "memory");
    }
    int cgt = 0;
#pragma unroll
    for (int j = 0; j < 32; ++j) cgt += __popcll(__ballot(key[j] > T));
    const int need = TOPK - cgt; int run = 0;
    const unsigned long long below = (lane == 0) ? 0ull : (~0ull >> (64 - lane));
#pragma unroll
    for (int j = 0; j < 32; ++j) {
        const bool eq = key[j] == T; const unsigned long long be = __ballot(eq);
        const int rank = run + __popcll(be & below);
        const bool sel = (key[j] > T) || (eq && rank < need);
        run += __popcll(be);
        const unsigned long long b = __ballot(sel); if (lane == 0) mrow[j] = b;
    }
}
__device__ __forceinline__ void nv_index(const Frame& F) {
    const bf16* P = (const bf16*)(F.ws + WS_PROJ); unsigned long long* MK = (unsigned long long*)(F.ws + WS_MASK);
    LAS float* iqL = (LAS float*)(F.lds + F.wave * 12288); LAS float* scL = iqL + 1024;
    const int gw = GW_ID(F), NGW = GW_N(F), lane = fresh_lane();
    for (int row = gw; row < NTOK; row += NGW) {
        const int t = row & (SEQ - 1), r0 = row - t;
        for (int i = lane; i < 1024; i += 64) iqL[i] = bf2f(P[(size_t)row * PW + C_IQ + i]);
        float w[16];
#pragma unroll
        for (int hh = 0; hh < 16; ++hh) w[hh] = bf2f(P[(size_t)row * PW + C_IW + hh]) * 0.25f;
        LDS_WAIT(); asm volatile("" ::: "memory");
        for (int s = lane; s <= t; s += 64) {
            float d[16];
#pragma unroll
            for (int hh = 0; hh < 16; ++hh) d[hh] = 0.f;
            const v4u* kp = (const v4u*)(P + (size_t)(r0 + s) * PW + C_IK);
#pragma unroll 1
            for (int hf = 0; hf < 2; ++hf) {
                float kr[32];
#pragma unroll
                for (int q = 0; q < 4; ++q) { const v4u x = kp[4 * hf + q]; kr[8 * q] = bflo(x.x); kr[8 * q + 1] = bfhi(x.x); kr[8 * q + 2] = bflo(x.y); kr[8 * q + 3] = bfhi(x.y); kr[8 * q + 4] = bflo(x.z); kr[8 * q + 5] = bfhi(x.z); kr[8 * q + 6] = bflo(x.w); kr[8 * q + 7] = bfhi(x.w); }
#pragma unroll
                for (int hh = 0; hh < 16; ++hh) {
#pragma unroll
                    for (int e = 0; e < 32; ++e) d[hh] += iqL[hh * 64 + hf * 32 + e] * kr[e]; }
            }
            float sc = 0.f;
#pragma unroll
            for (int hh = 0; hh < 16; ++hh) sc += w[hh] * fmaxf(d[hh] * 0.125f, 0.f);
            scL[s] = sc;
        }
        LDS_WAIT(); asm volatile("" ::: "memory");
        unsigned key[32];
#pragma unroll
        for (int j = 0; j < 32; ++j) { const int s = lane + 64 * j; key[j] = (s <= t) ? fkey(scL[s]) : 0u; }
        select_row(key, t + 1, MK + (size_t)row * 32, lane, (LAS unsigned*)scL);
        LDS_WAIT(); asm volatile("" ::: "memory");
    }
}
__device__ __forceinline__ void nv_dsa(const Frame& F, int l) {
    const bf16* P = (const bf16*)(F.ws + WS_PROJ); const unsigned long long* MK = (const unsigned long long*)(F.ws + WS_MASK); bf16* BR = (bf16*)(F.ws + WS_BR);
    const float* qg = arg_in(7) + l * HD; const float* kg = arg_in(8) + l * HD; const float* rb = arg_in(19);
    LAS float* lgL = (LAS float*)(F.lds + F.wave * 2048); LAS int* ixL = (LAS int*)(lgL + 256);
    const int gw = GW_ID(F), NGW = GW_N(F), lane = fresh_lane();
    for (int it = gw; it < NTOK * NH; it += NGW) {
        const int row = it >> 3, h = it & 7, t = row & (SEQ - 1), r0 = row - t, c = h * HD + 2 * lane;
        float q0 = bf2f(P[(size_t)row * PW + C_DQ + c]), q1 = bf2f(P[(size_t)row * PW + C_DQ + c + 1]);
        const float qr = 1.0f / sqrtf(wave_sum(q0 * q0 + q1 * q1) * (1.f / HD) + EPS);
        q0 *= qr * qg[2 * lane]; q1 *= qr * qg[2 * lane + 1];
        const float kg0 = kg[2 * lane], kg1 = kg[2 * lane + 1];
        int cnt = 0; float mx = -3.0e38f;
        for (int wi = 0; wi <= (t >> 6); ++wi) {
            unsigned long long w = MK[(size_t)row * 32 + wi];
            while (w) { const int s = wi * 64 + __builtin_ctzll(w); w &= w - 1;
                const unsigned kk = *(const unsigned*)(P + (size_t)(r0 + s) * PW + C_DK + c);
                const float k0 = bflo(kk), k1 = bfhi(kk);
                const float ss = wave_sum(k0 * k0 + k1 * k1), dd = wave_sum(q0 * k0 * kg0 + q1 * k1 * kg1);
                const float kr = 1.0f / sqrtf(ss * (1.f / HD) + EPS);
                const float lgt = dd * kr * 0.08838834764831845f + rb[t5_bucket(t - s) * NH + h];
                if (lane == 0) { lgL[cnt] = lgt; ixL[cnt] = s; }
                mx = fmaxf(mx, lgt); ++cnt; }
        }
        LDS_WAIT(); asm volatile("" ::: "memory");
        float o0 = 0.f, o1 = 0.f, den = 0.f;
        for (int j = 0; j < cnt; ++j) { const float p = __expf(lgL[j] - mx); const int s = ixL[j];
            const unsigned vv = *(const unsigned*)(P + (size_t)(r0 + s) * PW + C_DV + c);
            o0 += p * bflo(vv); o1 += p * bfhi(vv); den += p; }
        *(unsigned*)(BR + (size_t)row * 3072 + 1024 + c) = pk2(o0 / den, o1 / den);
        LDS_WAIT(); asm volatile("" ::: "memory");
    }
}
__device__ __forceinline__ void nv_sb(const Frame& F) {
    const bf16* P = (const bf16*)(F.ws + WS_PROJ); bf16* BR = (bf16*)(F.ws + WS_BR);
    const int gw = GW_ID(F), NGW = GW_N(F), lane = fresh_lane();
    for (int it = gw; it < NTOK * NH; it += NGW) {
        const int row = it >> 3, h = it & 7, t = row & (SEQ - 1), r0 = row - t, c = h * HD + 2 * lane;
        const unsigned qq = *(const unsigned*)(P + (size_t)row * PW + C_SQ + c);
        const float q0 = bflo(qq) * 0.08838834764831845f, q1 = bfhi(qq) * 0.08838834764831845f;
        float o0 = 0.f, o1 = 0.f, lp = 0.f;
        for (int s = t - 1; s >= 0; --s) {
            const unsigned kk = *(const unsigned*)(P + (size_t)(r0 + s) * PW + C_SK + c);
            const float z = wave_sum(q0 * bflo(kk) + q1 * bfhi(kk));
            const float a = __expf(logsigmoidf_(z) + lp);
            const unsigned vv = *(const unsigned*)(P + (size_t)(r0 + s) * PW + C_SV + c);
            o0 += a * bflo(vv); o1 += a * bfhi(vv);
            lp += logsigmoidf_(-z);
            if (lp < -80.f) break;
        }
        *(unsigned*)(BR + (size_t)row * 3072 + 2048 + c) = pk2(o0, o1);
    }
}
__device__ __forceinline__ void nv_moe(const Frame& F) {
    const bf16* XN = (const bf16*)(F.ws + WS_XN); bf16* YB = (bf16*)(F.ws + WS_YB); const int* tinfo = tokinfo_ptr(F);
    LAS float* xL = (LAS float*)F.lds; LAS float* hL = xL + 2048;
    const int tid = (F.wave * 64 + fresh_lane());
    for (int slot = F.vcu; slot < 2 * NTOK; slot += F.G) {
        const int m = slot >> 1, k = slot & 1; const int e = tinfo[m * 8 + 4 * k]; const float w = __int_as_float(tinfo[m * 8 + 4 * k + 2]);
        __syncthreads();
        for (int i = tid; i < 2048; i += NTHR) xL[i] = bf2f(XN[(size_t)m * DM + i]);
        __syncthreads();
        { const int f = tid; const bf16* wg = (const bf16*)(F.ws + WS_WGU) + ((size_t)e * 1024 + (f >> 7) * 256 + (f & 127)) * DM; const bf16* wu = wg + (size_t)128 * DM;
          float g = 0.f, u = 0.f;
          for (int k8 = 0; k8 < 256; ++k8) { const v4u a = ((const v4u*)wg)[k8], b = ((const v4u*)wu)[k8]; const LAS float* x = xL + 8 * k8;
              g += x[0] * bflo(a.x) + x[1] * bfhi(a.x) + x[2] * bflo(a.y) + x[3] * bfhi(a.y) + x[4] * bflo(a.z) + x[5] * bfhi(a.z) + x[6] * bflo(a.w) + x[7] * bfhi(a.w);
              u += x[0] * bflo(b.x) + x[1] * bfhi(b.x) + x[2] * bflo(b.y) + x[3] * bfhi(b.y) + x[4] * bflo(b.z) + x[5] * bfhi(b.z) + x[6] * bflo(b.w) + x[7] * bfhi(b.w); }
          hL[f] = bf2f((unsigned short)f2bf(siluf_(g) * u)); }
        __syncthreads();
        { float y[4];
#pragma unroll
          for (int c = 0; c < 4; ++c) { const int d = 4 * tid + c; const bf16* wd = (const bf16*)(F.ws + WS_WDN) + ((size_t)e * DM + d) * DEXP; float a = 0.f;
              for (int k8 = 0; k8 < 64; ++k8) { const v4u x = ((const v4u*)wd)[k8]; const LAS float* hh = hL + 8 * k8;
                  a += hh[0] * bflo(x.x) + hh[1] * bfhi(x.x) + hh[2] * bflo(x.y) + hh[3] * bfhi(x.y) + hh[4] * bflo(x.z) + hh[5] * bfhi(x.z) + hh[6] * bflo(x.w) + hh[7] * bfhi(x.w); }
              y[c] = a * w; }
          v2u o; o.x = pk2(y[0], y[1]); o.y = pk2(y[2], y[3]); *(v2u*)(YB + (size_t)slot * DM + 4 * tid) = o; }
    }
}
constexpr int MOE_TAB_OFF = LDSCTL_OFF + 1024;
__device__ __forceinline__ void moe_tables(const Frame& F, int l) {
    LAS int* tp = (LAS int*)(F.lds + MOE_TAB_OFF); LAS int* cn = tp + 40; LAS int* sb = cn + 40;
    __syncthreads();
    if ((F.wave * 64 + fresh_lane()) == 0) { int p = 0, s = 0;
        for (int e = 0; e < NEXP; ++e) { const int c = (int)__hip_atomic_load(F.ctl + CW_ECNT + (l * NEXP + e) * 64, RLX_AGENT); tp[e] = p; cn[e] = c; sb[e] = s; p += (c + 255) >> 8; s += c; }
        tp[NEXP] = p; sb[NEXP] = s; }
    __syncthreads();
}
template <int NT> struct SchedMoeBase {
    const LAS int* tp; const LAS int* cn; const LAS int* sb; int G, c;
    __device__ __forceinline__ bool next(int i, pg8::Unit& u) const {
        const int L = i * G + c, total = tp[NEXP] * NT; if (L >= total) return false;
        const int mt = L / NT; u.pn = L % NT; int e = 0;
#pragma unroll 1
        for (int q = 1; q < NEXP; ++q) e = (tp[q] <= mt) ? q : e;
        u.e = e; u.pm = mt - tp[e]; const int r = cn[e] - 256 * u.pm; u.rows = r < 256 ? r : 256; return true;
    }
};
struct SchedMoeUp : SchedMoeBase<4> {
    static constexpr bool GATHER = true;
    const char* A; const char* B; const int* list;
    __device__ __forceinline__ const char* a_base(const pg8::Unit&) const { return A; }
    __device__ __forceinline__ const char* b_base(const pg8::Unit& u) const { return B + ((size_t)u.e * 1024 + (size_t)u.pn * 256) * DM * 2; }
    __device__ __forceinline__ void a_off(const pg8::Unit& u, int tid, unsigned (&v0)[2], unsigned (&v1)[2]) const {
        int R[2], C[2];
#pragma unroll
        for (int i = 0; i < 2; ++i) pg8::stage_rc(tid * 16 + i * 8192, R[i], C[i]);
        const int* le = list + (size_t)u.e * NTOK + 256 * u.pm;
#pragma unroll
        for (int i = 0; i < 2; ++i) { int r0 = R[i], r1 = R[i] + 128; r0 = r0 < u.rows ? r0 : u.rows - 1; r1 = r1 < u.rows ? r1 : u.rows - 1;
            const int t0 = le[r0] >> 1, t1 = le[r1] >> 1;
            v0[i] = (unsigned)(t0 * DM + C[i]) * 2u; v1[i] = (unsigned)(t1 * DM + C[i]) * 2u; }
    }
};
struct EpiMoeUp {
    static constexpr bool PERM = true;
    static constexpr bool PROBE2 = false;
    __device__ __forceinline__ bool zero_after(const pg8::Unit&) const { return true; }
    bf16* HB; const LAS int* sb;
    __device__ __forceinline__ void operator()(const f32x4 (&acc)[2][2][4][2], const pg8::Unit& u, int wr, int wc, int fr, int fq) const {
        const int col0 = u.pn * 128 + wc * 32 + 8 * fq; const size_t slot0 = (size_t)sb[u.e] + 256 * u.pm;
#pragma unroll
        for (int ai = 0; ai < 2; ++ai)
#pragma unroll
            for (int m = 0; m < 4; ++m) { const int r = ai * 128 + wr * 64 + m * 16 + fr;
                if (r < u.rows) { const f32x4 g0 = acc[ai][0][m][0], g1 = acc[ai][0][m][1], u0 = acc[ai][1][m][0], u1 = acc[ai][1][m][1];
                    v4u w; w.x = cvt_pk_bf16(siluf_(g0[0]) * u0[0], siluf_(g0[1]) * u0[1]); w.y = cvt_pk_bf16(siluf_(g0[2]) * u0[2], siluf_(g0[3]) * u0[3]);
                    w.z = cvt_pk_bf16(siluf_(g1[0]) * u1[0], siluf_(g1[1]) * u1[1]); w.w = cvt_pk_bf16(siluf_(g1[2]) * u1[2], siluf_(g1[3]) * u1[3]);
                    *(v4u*)(HB + (slot0 + r) * DEXP + col0) = w; } }
    }
};
struct SchedMoeDown : SchedMoeBase<8> {
    static constexpr bool GATHER = false;
    const char* A; const char* B;
    __device__ __forceinline__ const char* a_base(const pg8::Unit& u) const { return A + ((size_t)sb[u.e] + 256 * u.pm) * DEXP * 2; }
    __device__ __forceinline__ const char* b_base(const pg8::Unit& u) const { return B + ((size_t)u.e * DM + (size_t)u.pn * 256) * DEXP * 2; }
    __device__ __forceinline__ void a_off(const pg8::Unit&, int tid, unsigned (&v0)[2], unsigned (&v1)[2]) const {
        int R[2], C[2];
#pragma unroll
        for (int i = 0; i < 2; ++i) pg8::stage_rc(tid * 16 + i * 8192, R[i], C[i]);
#pragma unroll
        for (int i = 0; i < 2; ++i) { v0[i] = (unsigned)(R[i] * DEXP + C[i]) * 2u; v1[i] = v0[i] + 128u * DEXP * 2u; } }
};
struct EpiMoeDown {
    static constexpr bool PERM = true;
    static constexpr bool PROBE2 = false;
    __device__ __forceinline__ bool zero_after(const pg8::Unit&) const { return true; }
    bf16* YB; const int* list; const int* tinfo;
    __device__ __forceinline__ void operator()(const f32x4 (&acc)[2][2][4][2], const pg8::Unit& u, int wr, int wc, int fr, int fq) const {
        const int col0 = u.pn * 256 + wc * 32 + 8 * fq; const int* le = list + (size_t)u.e * NTOK + 256 * u.pm;
#pragma unroll
        for (int ai = 0; ai < 2; ++ai)
#pragma unroll
            for (int m = 0; m < 4; ++m) { const int r = ai * 128 + wr * 64 + m * 16 + fr;
                if (r < u.rows) { const int ent = le[r]; const float w = __int_as_float(tinfo[(ent >> 1) * 8 + 4 * (ent & 1) + 2]);
#pragma unroll
                    for (int bj = 0; bj < 2; ++bj) { const f32x4 v0 = acc[ai][bj][m][0] * w, v1 = acc[ai][bj][m][1] * w;
                        v4u o; o.x = cvt_pk_bf16(v0[0], v0[1]); o.y = cvt_pk_bf16(v0[2], v0[3]); o.z = cvt_pk_bf16(v1[0], v1[1]); o.w = cvt_pk_bf16(v1[2], v1[3]);
                        *(v4u*)(YB + (size_t)ent * DM + col0 + bj * 128) = o; } } }
    }
};
#define KSWZ(row, colB) ((row) * 256 + ((colB) ^ (((row) & 7) << 4)))
#define SBAR() __builtin_amdgcn_sched_barrier(0)
__device__ __forceinline__ int crow(int r, int hi) { return (r & 3) + 8 * (r >> 2) + 4 * hi; }
__device__ __forceinline__ void qkt64(f32x16& p0, f32x16& p1, const LAS char* Ks, const bf16x8* qr, int r32, int hi) {
    p0 = f32x16{}; p1 = f32x16{};
#pragma unroll
    for (int d0 = 0; d0 < 8; ++d0) { const int cb = (d0 * 16 + hi * 8) * 2;
        const bf16x8 b0 = *(const LAS bf16x8*)(Ks + KSWZ(r32, cb));
        const bf16x8 b1 = *(const LAS bf16x8*)(Ks + KSWZ(32 + r32, cb));
        p0 = __builtin_amdgcn_mfma_f32_32x32x16_bf16(b0, qr[d0], p0, 0, 0, 0);
        p1 = __builtin_amdgcn_mfma_f32_32x32x16_bf16(b1, qr[d0], p1, 0, 0, 0); }
}
__device__ __forceinline__ void qkt32(f32x16& p0, const LAS char* Ks, const bf16x8* qr, int r32, int hi) {
    p0 = f32x16{};
#pragma unroll
    for (int d0 = 0; d0 < 8; ++d0) { const int cb = (d0 * 16 + hi * 8) * 2;
        const bf16x8 b0 = *(const LAS bf16x8*)(Ks + KSWZ(r32, cb));
        p0 = __builtin_amdgcn_mfma_f32_32x32x16_bf16(b0, qr[d0], p0, 0, 0, 0); }
}
__device__ __forceinline__ int v_st(int k, int c) { const int kk = (k & ~0xC) | ((k & 4) << 1) | ((k & 8) >> 1); return ((kk >> 3) * 4 + (c >> 5)) * 512 + ((kk & 7) * 32 + (c & 31)) * 2; }
__device__ __forceinline__ int v_rd_base(int lane) { return ((lane & 3) << 3) | (((lane >> 2) & 3) << 6) | (((lane >> 4) & 1) << 5) | (((lane >> 5) & 1) << 8); }
constexpr int v_rd_off(int d0, int ks, int half) { return d0 * 512 + ks * 4096 + half * 2048; }
template <int OFF> __device__ __forceinline__ s16x4 tr_read(int vb) {
    s16x4 r; asm volatile("ds_read_b64_tr_b16 %0, %1 offset:%2" : "=&v"(r) : "v"(vb), "i"(OFF) : "memory"); return r;
}
__device__ __forceinline__ s16x4 tr_read_dyn(unsigned addr) { s16x4 r; asm volatile("ds_read_b64_tr_b16 %0, %1" : "=&v"(r) : "v"(addr) : "memory"); return r; }
template <int D0> __device__ __forceinline__ void pv_one(f32x16& od, int vb, bf16x8 pa0, bf16x8 pa1, bf16x8 pa2, bf16x8 pa3) {
    const s16x4 l0 = tr_read<v_rd_off(D0, 0, 0)>(vb), h0 = tr_read<v_rd_off(D0, 0, 1)>(vb), l1 = tr_read<v_rd_off(D0, 1, 0)>(vb), h1 = tr_read<v_rd_off(D0, 1, 1)>(vb);
    const s16x4 l2 = tr_read<v_rd_off(D0, 2, 0)>(vb), h2 = tr_read<v_rd_off(D0, 2, 1)>(vb), l3 = tr_read<v_rd_off(D0, 3, 0)>(vb), h3 = tr_read<v_rd_off(D0, 3, 1)>(vb);
    asm volatile("s_waitcnt lgkmcnt(0)" ::: "memory"); SBAR();
#define PKV(L, H) (bf16x8){L[0], L[1], L[2], L[3], H[0], H[1], H[2], H[3]}
    od = __builtin_amdgcn_mfma_f32_32x32x16_bf16(pa0, PKV(l0, h0), od, 0, 0, 0);
    od = __builtin_amdgcn_mfma_f32_32x32x16_bf16(pa1, PKV(l1, h1), od, 0, 0, 0);
    od = __builtin_amdgcn_mfma_f32_32x32x16_bf16(pa2, PKV(l2, h2), od, 0, 0, 0);
    od = __builtin_amdgcn_mfma_f32_32x32x16_bf16(pa3, PKV(l3, h3), od, 0, 0, 0);
}
template <int D0> __device__ __forceinline__ void pv_one_lo(f32x16& od, int vb, bf16x8 pa0, bf16x8 pa1) {
    const s16x4 l0 = tr_read<v_rd_off(D0, 0, 0)>(vb), h0 = tr_read<v_rd_off(D0, 0, 1)>(vb), l1 = tr_read<v_rd_off(D0, 1, 0)>(vb), h1 = tr_read<v_rd_off(D0, 1, 1)>(vb);
    asm volatile("s_waitcnt lgkmcnt(0)" ::: "memory"); SBAR();
    od = __builtin_amdgcn_mfma_f32_32x32x16_bf16(pa0, PKV(l0, h0), od, 0, 0, 0);
    od = __builtin_amdgcn_mfma_f32_32x32x16_bf16(pa1, PKV(l1, h1), od, 0, 0, 0);
}
__device__ __forceinline__ void pv_all(f32x16* o, int vb, bf16x8 pa0, bf16x8 pa1, bf16x8 pa2, bf16x8 pa3) {
    pv_one<0>(o[0], vb, pa0, pa1, pa2, pa3); pv_one<1>(o[1], vb, pa0, pa1, pa2, pa3); pv_one<2>(o[2], vb, pa0, pa1, pa2, pa3); pv_one<3>(o[3], vb, pa0, pa1, pa2, pa3);
}
#define PK4(P, BASE, OUT) do { unsigned a0_ = cvt_pk_bf16(P[BASE + 0], P[BASE + 1]), a1_ = cvt_pk_bf16(P[BASE + 2], P[BASE + 3]);   \
    unsigned b0_ = cvt_pk_bf16(P[BASE + 4], P[BASE + 5]), b1_ = cvt_pk_bf16(P[BASE + 6], P[BASE + 7]);                              \
    auto r0_ = __builtin_amdgcn_permlane32_swap(a0_, b0_, false, false); auto r1_ = __builtin_amdgcn_permlane32_swap(a1_, b1_, false, false); \
    v4u w_ = {r0_[0], r1_[0], r0_[1], r1_[1]}; OUT = *reinterpret_cast<bf16x8*>(&w_); } while (0)
__device__ __forceinline__ float pair_sum(float v) { auto rr = __builtin_amdgcn_permlane32_swap(__float_as_uint(v), __float_as_uint(v), false, false); return __uint_as_float(rr[0]) + __uint_as_float(rr[1]); }
__device__ __forceinline__ float pair_max(float v) { auto rr = __builtin_amdgcn_permlane32_swap(__float_as_uint(v), __float_as_uint(v), false, false); return fmaxf(__uint_as_float(rr[0]), __uint_as_float(rr[1])); }
__device__ __forceinline__ unsigned off_b(unsigned row, unsigned ch) { return 256u * row + 16u * (ch ^ (((row & 3) << 2) | ((row >> 2) & 3))); }
__device__ __forceinline__ unsigned trb_addr(unsigned lane, unsigned c, unsigned ks, unsigned t) {
    const unsigned h = lane >> 5, blk = (lane >> 4) & 1, q = (lane & 15) >> 2, p = lane & 3;
    return off_b(16 * ks + 8 * h + 4 * t + q, 4 * c + 2 * blk + (p >> 1)) + 8 * (p & 1);
}

constexpr int ML_TAB_OFF = LDSCTL_OFF + 2048;
struct MTabs { LAS float* sum; LAS float* g; LAS float* b; LAS float* pm; LAS float* mprev; LAS float* mend; };
__device__ __forceinline__ MTabs mtabs(const Frame& F) { MTabs T; T.sum = (LAS float*)(F.lds + ML_TAB_OFF); T.g = T.sum + 64; T.b = T.g + 256; T.pm = T.b + 256; T.mprev = T.pm + 256; T.mend = T.mprev + 4; return T; }
__device__ __forceinline__ float* gif_ptr(const Frame& F) { return (float*)(F.ws + WS_MSN + 512 * 1024); }
__device__ __forceinline__ void mchain(const Frame& F, int l, int bh, int cr, const MTabs& T) {
    const int b = bh >> 3, h = bh & 7, lane = fresh_lane(), nchunk = 4 * cr + 4;
    const float bi = arg_in(4)[l * NH + h], bfv = arg_in(5)[l * NH + h];
    const float* gif = gif_ptr(F);
    __syncthreads();
    for (int j = F.wave; j < nchunk; j += NWAVES) {
        const size_t row = (size_t)b * SEQ + 64 * j + lane;
        const float it = gif[row * 16 + h] + bi, lf = logsigmoidf_(gif[row * 16 + 8 + h] + bfv);
        float bc = lf;
#pragma unroll
        for (int o = 1; o < 64; o <<= 1) { const float t = __shfl_up(bc, o); bc += (lane >= o) ? t : 0.f; }
        const float g = it - bc; float pm = g;
#pragma unroll
        for (int o = 1; o < 64; o <<= 1) { const float t = __shfl_up(pm, o); pm = (lane >= o) ? fmaxf(pm, t) : pm; }
        if (lane == 63) { T.sum[2 * j] = bc; T.sum[2 * j + 1] = pm; }
        if (j >= 4 * cr) { const int ci = j - 4 * cr; T.g[ci * 64 + lane] = g; T.b[ci * 64 + lane] = bc; T.pm[ci * 64 + lane] = pm; }
    }
    __syncthreads();
    if ((F.wave * 64 + fresh_lane()) == 0) { float m = 0.f;
        for (int j = 0; j < nchunk; ++j) { const float me = fmaxf(m, T.sum[2 * j + 1]);
            if (j >= 4 * cr) { T.mprev[j - 4 * cr] = m; T.mend[j - 4 * cr] = me; }
            m = T.sum[2 * j] + me; } }
    __syncthreads();
}
__device__ __forceinline__ void conv8(const bf16* P, const float* cw, size_t row, int t, int col0, int ch0, float sc, float (&o)[8]) {
#pragma unroll
    for (int e = 0; e < 8; ++e) o[e] = 0.f;
#pragma unroll
    for (int j = 0; j < 4; ++j) { const int tt = t - 3 + j;
        if (tt >= 0) { const v4u x = *(const v4u*)(P + (row - 3 + j) * PW + col0); const f32x4 w0 = *(const f32x4*)(cw + j * 2048 + ch0), w1 = *(const f32x4*)(cw + j * 2048 + ch0 + 4);
            o[0] += w0.x * bflo(x.x); o[1] += w0.y * bfhi(x.x); o[2] += w0.z * bflo(x.y); o[3] += w0.w * bfhi(x.y);
            o[4] += w1.x * bflo(x.z); o[5] += w1.y * bfhi(x.z); o[6] += w1.z * bflo(x.w); o[7] += w1.w * bfhi(x.w); } }
#pragma unroll
    for (int e = 0; e < 8; ++e) o[e] = siluf_(o[e]) * sc;
}
__device__ __forceinline__ void ml_delta(const Frame& F, int l) {
    const bf16* P = (const bf16*)(F.ws + WS_PROJ); const float* cw = arg_in(3) + (size_t)l * 4 * 2048;
    float* DEL = (float*)(F.ws + WS_MDEL); float* DN = (float*)(F.ws + WS_MDN); float* DEC = DN + 32 * 32 * 128;
    const int wave = F.wave;
    const MTabs T = mtabs(F);
    for (int blk = F.vcu; blk < 256; blk += F.G) {
        const int tid = F.wave * 64 + fresh_lane();
        const int lane = tid & 63;
        const int bh = blk >> 3, cr = blk & 7, b = bh >> 3, h = bh & 7;
        mchain(F, l, bh, cr, T);
#pragma unroll 1
        for (int it = tid; it < 4 * 64 * 16; it += NTHR) { const int ci = it >> 10, s = (it >> 4) & 63, ch = it & 15, t = 64 * (4 * cr + ci) + s; const size_t row = (size_t)b * SEQ + t;
            float kv[8]; conv8(P, cw, row, t, C_MK + h * HD + 8 * ch, 1024 + h * HD + 8 * ch, 1.f, kv);
            v4u o; o.x = pk2(kv[0], kv[1]); o.y = pk2(kv[2], kv[3]); o.z = pk2(kv[4], kv[5]); o.w = pk2(kv[6], kv[7]);
            *(LAS v4u*)(F.lds + ci * 32768 + off_b(s, ch)) = o;
            const float ws = __expf(T.g[ci * 64 + s] - T.mend[ci]);
            const v4u x = *(const v4u*)(P + row * PW + C_MV + h * HD + 8 * ch);
            o.x = pk2(ws * bflo(x.x), ws * bfhi(x.x)); o.y = pk2(ws * bflo(x.y), ws * bfhi(x.y)); o.z = pk2(ws * bflo(x.z), ws * bfhi(x.z)); o.w = pk2(ws * bflo(x.w), ws * bfhi(x.w));
            *(LAS v4u*)(F.lds + ci * 32768 + 16384 + off_b(s, ch)) = o; }
        __syncthreads();
        const int vb = wave >> 1, kh = wave & 1, r32 = lane & 31, hi = lane >> 5;
        const unsigned ldsb = (unsigned)(size_t)F.lds;
#pragma unroll 1
        for (int ci = 0; ci < 4; ++ci) { const int c = 4 * cr + ci; if (c == NCH - 1) break;
            f32x16 a0 = {}, a1 = {};
#pragma unroll
            for (int ks = 0; ks < 4; ++ks) {
                const s16x4 al = tr_read_dyn(ldsb + ci * 32768 + 16384 + trb_addr(lane, vb, ks, 0)), ah = tr_read_dyn(ldsb + ci * 32768 + 16384 + trb_addr(lane, vb, ks, 1));
                const s16x4 bl0 = tr_read_dyn(ldsb + ci * 32768 + trb_addr(lane, 2 * kh, ks, 0)), bh0 = tr_read_dyn(ldsb + ci * 32768 + trb_addr(lane, 2 * kh, ks, 1));
                const s16x4 bl1 = tr_read_dyn(ldsb + ci * 32768 + trb_addr(lane, 2 * kh + 1, ks, 0)), bh1 = tr_read_dyn(ldsb + ci * 32768 + trb_addr(lane, 2 * kh + 1, ks, 1));
                asm volatile("s_waitcnt lgkmcnt(0)" ::: "memory"); SBAR();
                a0 = __builtin_amdgcn_mfma_f32_32x32x16_bf16(PKV(al, ah), PKV(bl0, bh0), a0, 0, 0, 0);
                a1 = __builtin_amdgcn_mfma_f32_32x32x16_bf16(PKV(al, ah), PKV(bl1, bh1), a1, 0, 0, 0); }
            float* dp = DEL + ((size_t)(bh * 32 + c) * 128) * 128;
#pragma unroll
            for (int r = 0; r < 16; ++r) { const int v = 32 * vb + crow(r, hi); dp[(size_t)v * 128 + 64 * kh + r32] = a0[r]; dp[(size_t)v * 128 + 64 * kh + 32 + r32] = a1[r]; }
        }
        { const int ci = tid >> 7, k = tid & 127, c = 4 * cr + ci;
          if (c < NCH - 1) { float a = 0.f; const float me = T.mend[ci];
              for (int s = 0; s < 64; ++s) a += __expf(T.g[ci * 64 + s] - me) * bf2f(*(const LAS unsigned short*)(F.lds + ci * 32768 + off_b(s, k >> 3) + 2 * (k & 7)));
              DN[(size_t)(bh * 32 + c) * 128 + k] = a;
              if (k == 0) DEC[bh * 32 + c] = __expf(T.mprev[ci] - me); } }
        __syncthreads();
    }
}
__device__ __forceinline__ void ml_scan(const Frame& F) {
    const float* DEL = (const float*)(F.ws + WS_MDEL); const float* DN = (const float*)(F.ws + WS_MDN); const float* DEC = DN + 32 * 32 * 128;
    bf16* ST = (bf16*)(F.ws + WS_MST); float* SN = (float*)(F.ws + WS_MSN);
    const int gt = F.vcu * NTHR + (F.wave * 64 + fresh_lane()), NT = F.G * NTHR;
    for (int e4 = gt; e4 < 32 * 4096; e4 += NT) { const int bh = e4 >> 12, q = e4 & 4095;
        f32x4 acc = {0.f, 0.f, 0.f, 0.f};
#pragma unroll 4
        for (int c = 0; c < NCH - 1; ++c) { const float d = DEC[bh * 32 + c]; const f32x4 x = *(const f32x4*)(DEL + ((size_t)(bh * 32 + c) * 4096 + q) * 4);
            acc = acc * d + x; v2u o; o.x = pk2(acc.x, acc.y); o.y = pk2(acc.z, acc.w); *(v2u*)(ST + ((size_t)(bh * 32 + c + 1) * 4096 + q) * 4) = o; } }
    for (int e = gt; e < 32 * 128; e += NT) { const int bh = e >> 7, k = e & 127; float acc = 0.f;
        for (int c = 0; c < NCH - 1; ++c) { acc = acc * DEC[bh * 32 + c] + DN[(size_t)(bh * 32 + c) * 128 + k]; SN[(size_t)(bh * 32 + c + 1) * 128 + k] = acc; } }
}
__device__ __forceinline__ void ml_out(const Frame& F, int l) {
    const bf16* P = (const bf16*)(F.ws + WS_PROJ); const float* cw = arg_in(3) + (size_t)l * 4 * 2048; bf16* BR = (bf16*)(F.ws + WS_BR);
    const bf16* ST = (const bf16*)(F.ws + WS_MST); const float* SN = (const float*)(F.ws + WS_MSN); const float* gain = arg_in(6) + (size_t)l * BW;
    const int wave = F.wave;
    const MTabs T = mtabs(F);
    LAS float* rowL = (LAS float*)(F.lds + ML_TAB_OFF + 4096) + wave * 32;
    for (int blk = F.vcu; blk < 256; blk += F.G) {
        const int tid = F.wave * 64 + fresh_lane();
        const int lane = tid & 63, r32 = lane & 31, hi = lane >> 5;
        const int bh = blk >> 3, cr = blk & 7, b = bh >> 3, h = bh & 7;
        mchain(F, l, bh, cr, T);
#pragma unroll 1
        for (int it = tid; it < 4 * 64 * 16; it += NTHR) { const int ci = it >> 10, s = (it >> 4) & 63, ch = it & 15, t = 64 * (4 * cr + ci) + s; const size_t row = (size_t)b * SEQ + t;
            float kv[8]; conv8(P, cw, row, t, C_MK + h * HD + 8 * ch, 1024 + h * HD + 8 * ch, 1.f, kv);
            v4u o; o.x = pk2(kv[0], kv[1]); o.y = pk2(kv[2], kv[3]); o.z = pk2(kv[4], kv[5]); o.w = pk2(kv[6], kv[7]);
            *(LAS v4u*)(F.lds + ci * 32768 + KSWZ(s, ch * 16)) = o;
            *(LAS v4u*)(F.lds + ci * 32768 + 16384 + v_st(s, ch * 8)) = *(const v4u*)(P + row * PW + C_MV + h * HD + 8 * ch); }
        __syncthreads();
        const int ci = wave >> 1, rh = wave & 1, c = 4 * cr + ci, tau = 32 * rh + r32, t = 64 * c + tau; const size_t row = (size_t)b * SEQ + t;
        bf16x8 qr[8];
#pragma unroll
        for (int d0 = 0; d0 < 8; ++d0) { float qv[8]; conv8(P, cw, row, t, C_MQ + h * HD + 16 * d0 + 8 * hi, h * HD + 16 * d0 + 8 * hi, 0.08838834764831845f, qv);
            v4u o; o.x = pk2(qv[0], qv[1]); o.y = pk2(qv[2], qv[3]); o.z = pk2(qv[4], qv[5]); o.w = pk2(qv[6], qv[7]); qr[d0] = *reinterpret_cast<bf16x8*>(&o); asm volatile("" ::: "memory"); }
        const float mprev = T.mprev[ci], Mt = fmaxf(mprev, T.pm[ci * 64 + tau]), winter = __expf(mprev - Mt), flo = __expf(-T.b[ci * 64 + tau] - Mt);
        const LAS char* Kc = (const LAS char*)(F.lds + ci * 32768);
        const int vbase = (int)(size_t)(F.lds + ci * 32768 + 16384) + v_rd_base(lane);
        f32x16 o[4] = {}; f32x16 p0, p1; float ps = 0.f; bf16x8 pa0, pa1, pa2, pa3;
        const LAS f32x4* g4 = (const LAS f32x4*)(T.g + ci * 64);
        if (rh == 0) { qkt32(p0, Kc, qr, r32, hi);
#pragma unroll
            for (int q = 0; q < 4; ++q) { const f32x4 gg = g4[2 * q + hi];
#pragma unroll
                for (int e = 0; e < 4; ++e) { const int r = 4 * q + e, s = crow(r, hi); const float wgt = (s <= tau) ? __expf(gg[e] - Mt) : 0.f; p0[r] *= wgt; ps += p0[r]; } }
            PK4(p0, 0, pa0); PK4(p0, 8, pa1);
            pv_one_lo<0>(o[0], vbase, pa0, pa1); pv_one_lo<1>(o[1], vbase, pa0, pa1); pv_one_lo<2>(o[2], vbase, pa0, pa1); pv_one_lo<3>(o[3], vbase, pa0, pa1);
        } else { qkt64(p0, p1, Kc, qr, r32, hi);
#pragma unroll
            for (int q = 0; q < 4; ++q) { const f32x4 gg = g4[2 * q + hi], gh = g4[8 + 2 * q + hi];
#pragma unroll
                for (int e = 0; e < 4; ++e) { const int r = 4 * q + e, s = crow(r, hi); p0[r] *= __expf(gg[e] - Mt); ps += p0[r];
                    const float wgt = (32 + s <= tau) ? __expf(gh[e] - Mt) : 0.f; p1[r] *= wgt; ps += p1[r]; } }
            PK4(p0, 0, pa0); PK4(p0, 8, pa1); PK4(p1, 0, pa2); PK4(p1, 8, pa3);
            pv_all(o, vbase, pa0, pa1, pa2, pa3);
        }
        ps = pair_sum(ps);
        float nq = 0.f;
        if (c > 0) {
            const bf16* Sc = ST + (size_t)(bh * 32 + c) * 16384; const float* nc = SN + (size_t)(bh * 32 + c) * 128;
#pragma unroll
            for (int ks = 0; ks < 8; ++ks) { const v4u qq = *reinterpret_cast<const v4u*>(&qr[ks]);
                const f32x4 n0 = *(const f32x4*)(nc + 16 * ks + 8 * hi), n1 = *(const f32x4*)(nc + 16 * ks + 8 * hi + 4);
                nq += bflo(qq.x) * n0.x + bfhi(qq.x) * n0.y + bflo(qq.y) * n0.z + bfhi(qq.y) * n0.w + bflo(qq.z) * n1.x + bfhi(qq.z) * n1.y + bflo(qq.w) * n1.z + bfhi(qq.w) * n1.w;
                v4u sq; sq.x = pk2(bflo(qq.x) * winter, bfhi(qq.x) * winter); sq.y = pk2(bflo(qq.y) * winter, bfhi(qq.y) * winter); sq.z = pk2(bflo(qq.z) * winter, bfhi(qq.z) * winter); sq.w = pk2(bflo(qq.w) * winter, bfhi(qq.w) * winter);
                const bf16x8 qs = *reinterpret_cast<const bf16x8*>(&sq);
#pragma unroll
                for (int d0 = 0; d0 < 4; ++d0) { const bf16x8 cf = *(const bf16x8*)(Sc + (size_t)(32 * d0 + r32) * 128 + 16 * ks + 8 * hi);
                    o[d0] = __builtin_amdgcn_mfma_f32_32x32x16_bf16(qs, cf, o[d0], 0, 0, 0); }
                asm volatile("" ::: "memory"); }
            nq = pair_sum(nq);
        }
        const float den = winter * nq + ps, rinv = 1.0f / fmaxf(fabsf(den), flo);
        if (hi == 0) rowL[r32] = rinv;
        LDS_WAIT(); asm volatile("" ::: "memory");
        float ss[16];
#pragma unroll
        for (int r = 0; r < 16; ++r) { const float ri = rowL[crow(r, hi)]; float a = 0.f;
#pragma unroll
            for (int d0 = 0; d0 < 4; ++d0) { o[d0][r] *= ri; a += o[d0][r] * o[d0][r]; }
            ss[r] = a; }
#pragma unroll
        for (int r = 0; r < 16; ++r) {
#pragma unroll
            for (int of = 1; of < 32; of <<= 1) ss[r] += __shfl_xor(ss[r], of);
            ss[r] = 1.0f / sqrtf(ss[r] * (1.f / HD) + EPS); }
        const size_t row0 = (size_t)b * SEQ + 64 * c + 32 * rh;
#pragma unroll
        for (int d0 = 0; d0 < 4; ++d0) { const int col = h * HD + 32 * d0 + r32; const float gn = gain[col];
#pragma unroll
            for (int r = 0; r < 16; ++r) { const size_t rr = row0 + crow(r, hi);
                const float og = sigmoidf_(bf2f(P[rr * PW + C_MO + col]));
                BR[rr * 3072 + col] = (bf16)f2bf(o[d0][r] * ss[r] * gn * og); }
            asm volatile("" ::: "memory"); }
        __syncthreads();
    }
}
__device__ __forceinline__ void ph_norm2_mfma(const Frame& F, int l) {
    const float* g = arg_in(11) + (size_t)l * DM;
    const float* wrg = arg_in(12) + (size_t)l * DM * NGRP; const float* brg = arg_in(13) + l * NGRP;
    const float* wre = arg_in(14) + (size_t)l * DM * NEXP; const float* bre = arg_in(15) + l * NEXP;
    const float* X1 = (const float*)(F.ws + WS_X1); bf16* XN = (bf16*)(F.ws + WS_XN);
    int* list = (int*)(F.ws + WS_LIST); int* tinfo = tokinfo_ptr(F);
    unsigned* ecnt = F.ctl + CW_ECNT + l * NEXP * 64;
    LAS float* PL = (LAS float*)F.lds;
    LAS float* LG = PL + 8 * 2048;
    LAS float* RS = LG + 32 * 36;
    for (int blk = F.vcu; blk < NTOK / 32; blk += F.G) {
        const int lane = fresh_lane(), wave = F.wave, tid = wave * 64 + lane; const int m0 = blk * 32;
        __syncthreads();
#pragma unroll 1
        for (int q = 0; q < 4; ++q) { const int m = m0 + 4 * wave + q;
            f32x4 v[8]; float s = 0.f;
            const f32x4* xr = (const f32x4*)(X1 + (size_t)m * DM) + lane;
#pragma unroll
            for (int j = 0; j < 8; ++j) { v[j] = xr[64 * j]; s += (v[j].x * v[j].x + v[j].y * v[j].y) + (v[j].z * v[j].z + v[j].w * v[j].w); }
            const float rstd = 1.0f / sqrtf(wave_sum(s) * (1.f / DM) + EPS);
            v2u* o8 = (v2u*)(XN + (size_t)m * DM) + lane; const f32x4* gr = (const f32x4*)g + lane;
#pragma unroll
            for (int j = 0; j < 8; ++j) { const f32x4 gg = gr[64 * j]; v2u o; o.x = pk2(v[j].x * rstd * gg.x, v[j].y * rstd * gg.y); o.y = pk2(v[j].z * rstd * gg.z, v[j].w * rstd * gg.w); o8[64 * j] = o; }
            if (lane == 0) RS[4 * wave + q] = rstd; }
        { const int i = lane & 31, h = lane >> 5, kb = 256 * wave + 128 * h;
          f32x16 aE = {}, aG = {};
          const float* xp = X1 + (size_t)(m0 + i) * DM + kb; const float* gp = g + kb;
          const float* we = wre + (size_t)kb * NEXP + i; const float* wg = wrg + (size_t)kb * NGRP + (i & 3);
#pragma unroll 2
          for (int s4 = 0; s4 < 32; ++s4) { const f32x4 xv = *(const f32x4*)(xp + 4 * s4), gv = *(const f32x4*)(gp + 4 * s4);
#pragma unroll
              for (int c = 0; c < 4; ++c) { const int s = 4 * s4 + c; const float gk = gv[c];
                  const float be = we[(size_t)s * NEXP] * gk; const float bg = (i < 4) ? wg[(size_t)s * NGRP] * gk : 0.f;
                  aE = __builtin_amdgcn_mfma_f32_32x32x2f32(xv[c], be, aE, 0, 0, 0);
                  aG = __builtin_amdgcn_mfma_f32_32x32x2f32(xv[c], bg, aG, 0, 0, 0); } }
#pragma unroll
          for (int r = 0; r < 16; ++r) { const int t = crow(r, h); PL[(wave * 2 + 0) * 1024 + t * 32 + i] = aE[r]; PL[(wave * 2 + 1) * 1024 + t * 32 + i] = aG[r]; } }
        __syncthreads();
        for (int idx = tid; idx < 32 * 36; idx += NTHR) { const int t = idx / 36, j = idx % 36; float a = 0.f;
#pragma unroll
            for (int w = 0; w < 8; ++w) a += (j < 4) ? PL[(w * 2 + 1) * 1024 + t * 32 + j] : PL[(w * 2) * 1024 + t * 32 + (j - 4)];
            LG[idx] = a * RS[t]; }
        __syncthreads();
        if (tid < 32) { const int m = m0 + tid; const LAS float* lg = LG + tid * 36;
            int gs = 0; float best = lg[0] + brg[0];
#pragma unroll
            for (int q = 1; q < 4; ++q) { const float t = lg[q] + brg[q]; if (t > best) { best = t; gs = q; } }
            const float gm = fmaxf(fmaxf(lg[0], lg[1]), fmaxf(lg[2], lg[3])); float gsum = 0.f, gsel = 0.f;
#pragma unroll
            for (int q = 0; q < 4; ++q) { const float e = __expf(lg[q] - gm); gsum += e; gsel = (q == gs) ? e : gsel; }
            const float pg = gsel / gsum;
            float ein[8];
#pragma unroll
            for (int q = 0; q < 8; ++q) ein[q] = lg[4 + gs * 8 + q];
            int e0 = 0, e1 = -1; float b0 = -3.0e38f, b1 = -3.0e38f;
#pragma unroll
            for (int q = 0; q < 8; ++q) { const float t = ein[q] + bre[gs * 8 + q];
                if (t > b0) { b1 = b0; e1 = e0; b0 = t; e0 = q; } else if (t > b1) { b1 = t; e1 = q; } }
            float em = ein[0];
#pragma unroll
            for (int q = 1; q < 8; ++q) em = fmaxf(em, ein[q]);
            float p0 = 0.f, p1 = 0.f;
#pragma unroll
            for (int q = 0; q < 8; ++q) { const float e = __expf(ein[q] - em); p0 = (q == e0) ? e : p0; p1 = (q == e1) ? e : p1; }
            const float w0 = pg * p0 / (p0 + p1), w1 = pg * p1 / (p0 + p1);
            const int x0 = gs * 8 + e0, x1 = gs * 8 + e1;
            const int pos0 = (int)atomicAdd(ecnt + x0 * 64, 1u), pos1 = (int)atomicAdd(ecnt + x1 * 64, 1u);
            list[x0 * NTOK + pos0] = 2 * m; list[x1 * NTOK + pos1] = 2 * m + 1;
            tinfo[m * 8 + 0] = x0; tinfo[m * 8 + 1] = pos0; tinfo[m * 8 + 2] = __float_as_int(w0); tinfo[m * 8 + 3] = 0;
            tinfo[m * 8 + 4] = x1; tinfo[m * 8 + 5] = pos1; tinfo[m * 8 + 6] = __float_as_int(w1); tinfo[m * 8 + 7] = 0; }
    }
}
constexpr int AT_TAB_OFF = LDSCTL_OFF + 8192;
__device__ __forceinline__ void dsa_index(const Frame& F) {
    const bf16* P = (const bf16*)(F.ws + WS_PROJ); unsigned long long* MK = (unsigned long long*)(F.ws + WS_MASK);
    LAS float* SL = (LAS float*)(F.lds + F.wave * 16384);
    const int gw = GW_ID(F), NGW = GW_N(F);
    for (int wu = gw; wu < 2048; wu += NGW) {
        const int lane = fresh_lane();
        const int m = lane & 31, hi = lane >> 5, qa = (m >> 2) & 1, head = (m & 3) + 4 * (m >> 3);
        const int b = wu >> 9, jj = wu & 511;
#pragma unroll 1
        for (int half = 0; half < 2; ++half) {
            const int tp = half ? 1023 - jj : jj, t0 = 2 * tp; const size_t rb = (size_t)b * SEQ;
            bf16x8 afr[4];
#pragma unroll
            for (int ks = 0; ks < 4; ++ks) afr[ks] = *(const bf16x8*)(P + (rb + t0 + qa) * PW + C_IQ + head * 64 + 16 * ks + 8 * hi);
            float wr[16];
            { const v4u w0 = *(const v4u*)(P + (rb + t0 + hi) * PW + C_IW), w1 = *(const v4u*)(P + (rb + t0 + hi) * PW + C_IW + 8);
              wr[0] = bflo(w0.x); wr[1] = bfhi(w0.x); wr[2] = bflo(w0.y); wr[3] = bfhi(w0.y); wr[4] = bflo(w0.z); wr[5] = bfhi(w0.z); wr[6] = bflo(w0.w); wr[7] = bfhi(w0.w);
              wr[8] = bflo(w1.x); wr[9] = bfhi(w1.x); wr[10] = bflo(w1.y); wr[11] = bfhi(w1.y); wr[12] = bflo(w1.z); wr[13] = bfhi(w1.z); wr[14] = bflo(w1.w); wr[15] = bfhi(w1.w);
#pragma unroll
              for (int r = 0; r < 16; ++r) wr[r] *= 0.03125f; }
            const int nkb = (t0 + 1) / 32 + 1;
#define IDX_LOAD(B_, kb0_) do { _Pragma("unroll") for (int i = 0; i < 4; ++i) { const int kb = ((kb0_) + i < nkb) ? (kb0_) + i : nkb - 1; const bf16* kp = P + (rb + 32 * kb + m) * PW + C_IK + 8 * hi; \
                _Pragma("unroll") for (int ks = 0; ks < 4; ++ks) B_[i][ks] = *(const bf16x8*)(kp + 16 * ks); } } while (0)
#define IDX_SCORE(B_, kb0_) do { _Pragma("unroll") for (int i = 0; i < 4; ++i) { f32x16 acc = {}; \
                _Pragma("unroll") for (int ks = 0; ks < 4; ++ks) acc = __builtin_amdgcn_mfma_f32_32x32x16_bf16(afr[ks], B_[i][ks], acc, 0, 0, 0); \
                float sc = 0.f; _Pragma("unroll") for (int r = 0; r < 16; ++r) sc += wr[r] * fmaxf(acc[r], 0.f); \
                if ((kb0_) + i < nkb) SL[hi * 2048 + 32 * ((kb0_) + i) + m] = sc; } } while (0)
            { bf16x8 bA[4][4], bB[4][4];
              IDX_LOAD(bA, 0);
#pragma unroll 1
              for (int kb0 = 0; kb0 < nkb; kb0 += 8) {
                  if (kb0 + 4 < nkb) IDX_LOAD(bB, kb0 + 4);
                  asm volatile("" ::: "memory");
                  IDX_SCORE(bA, kb0);
                  if (kb0 + 8 < nkb) IDX_LOAD(bA, kb0 + 8);
                  asm volatile("" ::: "memory");
                  if (kb0 + 4 < nkb) IDX_SCORE(bB, kb0 + 4);
              } }
#undef IDX_LOAD
#undef IDX_SCORE
            LDS_WAIT(); asm volatile("" ::: "memory");
#pragma unroll 1
            for (int q = 0; q < 2; ++q) { const int t = t0 + q; unsigned key[32];
#pragma unroll
                for (int j = 0; j < 32; ++j) { const int s = lane + 64 * j; key[j] = (s <= t) ? fkey(SL[q * 2048 + s]) : 0u; }
#ifndef IDX_SEL_REP
#define IDX_SEL_REP 1
#endif
#pragma unroll 1
                for (int rp = 0; rp < IDX_SEL_REP; ++rp) select_row(key, t + 1, MK + (rb + t) * 32, lane, (LAS unsigned*)(F.lds + AT_TAB_OFF + F.wave * 256)); }
            LDS_WAIT(); asm volatile("" ::: "memory");
        }
    }
}

struct KVRegs { v4u k0, k1, v0, v1; };
__device__ __forceinline__ void kv_load(KVRegs& R, const bf16* Kp, const bf16* Vp, size_t row0, int sr, int sc) {
    R.k0 = *(const v4u*)(Kp + (row0 + sr) * PW + sc); R.k1 = *(const v4u*)(Kp + (row0 + 32 + sr) * PW + sc);
    R.v0 = *(const v4u*)(Vp + (row0 + sr) * PW + sc); R.v1 = *(const v4u*)(Vp + (row0 + 32 + sr) * PW + sc);
}
__device__ __forceinline__ v4u knorm8(v4u x, const float (&kg)[8]) {
    float f[8] = {bflo(x.x), bfhi(x.x), bflo(x.y), bfhi(x.y), bflo(x.z), bfhi(x.z), bflo(x.w), bfhi(x.w)};
    float s = 0.f;
#pragma unroll
    for (int e = 0; e < 8; ++e) s += f[e] * f[e];
    s += __shfl_xor(s, 1); s += __shfl_xor(s, 2); s += __shfl_xor(s, 4); s += __shfl_xor(s, 8);
    const float r = 1.0f / sqrtf(s * (1.f / HD) + EPS);
    v4u o; o.x = pk2(f[0] * r * kg[0], f[1] * r * kg[1]); o.y = pk2(f[2] * r * kg[2], f[3] * r * kg[3]); o.z = pk2(f[4] * r * kg[4], f[5] * r * kg[5]); o.w = pk2(f[6] * r * kg[6], f[7] * r * kg[7]);
    return o;
}
template <bool NORM> __device__ __forceinline__ void kv_write(const KVRegs& R, LAS unsigned char* buf, int sr, int sc, const float (&kg)[8]) {
    *(LAS v4u*)(buf + KSWZ(sr, sc * 2)) = NORM ? knorm8(R.k0, kg) : R.k0; *(LAS v4u*)(buf + KSWZ(32 + sr, sc * 2)) = NORM ? knorm8(R.k1, kg) : R.k1;
    *(LAS v4u*)(buf + 16384 + v_st(sr, sc)) = R.v0; *(LAS v4u*)(buf + 16384 + v_st(32 + sr, sc)) = R.v1;
}

__device__ __forceinline__ void dsa_attn(const Frame& F, int l) {
    const bf16* P = (const bf16*)(F.ws + WS_PROJ); const unsigned long long* MK = (const unsigned long long*)(F.ws + WS_MASK); bf16* BR = (bf16*)(F.ws + WS_BR);
    const float* qg = arg_in(7) + l * HD; const float* kgp = arg_in(8) + l * HD; const float* rbias = arg_in(19);
    LAS float* biasL = (LAS float*)(F.lds + AT_TAB_OFF); LAS float* rowL = biasL + 128 + F.wave * 32;
    constexpr float C = 0.08838834764831845f * 1.4426950408889634f;
    for (int u = F.vcu; u < 256; u += F.G) {
        const int tid = F.wave * 64 + fresh_lane();
        const int lane = tid & 63, wave = F.wave, r32 = lane & 31, hi = lane >> 5, sr = tid >> 4, sc = (tid & 15) * 8;
        const int b = u >> 6, h = (u >> 3) & 7, qb = 7 - (u & 7), q0 = qb * 256, NT = 4 * (qb + 1); const size_t rb = (size_t)b * SEQ;
        __syncthreads();
        if (tid < 128) biasL[tid] = rbias[t5_bucket(tid) * NH + h] * 1.4426950408889634f;
        float kg[8];
#pragma unroll
        for (int e = 0; e < 8; ++e) kg[e] = kgp[sc + e];
        const int tq = q0 + 32 * wave + r32; bf16x8 qr[8];
        { v4u xs[8]; float s = 0.f;
#pragma unroll
          for (int d0 = 0; d0 < 8; ++d0) { const v4u x = *(const v4u*)(P + (rb + tq) * PW + C_DQ + h * HD + 16 * d0 + 8 * hi); xs[d0] = x;
              s += bflo(x.x) * bflo(x.x) + bfhi(x.x) * bfhi(x.x) + bflo(x.y) * bflo(x.y) + bfhi(x.y) * bfhi(x.y) + bflo(x.z) * bflo(x.z) + bfhi(x.z) * bfhi(x.z) + bflo(x.w) * bflo(x.w) + bfhi(x.w) * bfhi(x.w); }
          const float r = 1.0f / sqrtf(pair_sum(s) * (1.f / HD) + EPS);
#pragma unroll
          for (int d0 = 0; d0 < 8; ++d0) { const f32x4 g0 = *(const f32x4*)(qg + 16 * d0 + 8 * hi), g1 = *(const f32x4*)(qg + 16 * d0 + 8 * hi + 4); const v4u x = xs[d0];
              v4u o; o.x = pk2(bflo(x.x) * r * g0.x, bfhi(x.x) * r * g0.y); o.y = pk2(bflo(x.y) * r * g0.z, bfhi(x.y) * r * g0.w);
              o.z = pk2(bflo(x.z) * r * g1.x, bfhi(x.z) * r * g1.y); o.w = pk2(bflo(x.w) * r * g1.z, bfhi(x.w) * r * g1.w); qr[d0] = *reinterpret_cast<bf16x8*>(&o); } }
        const bf16* Kp = P + C_DK + h * HD; const bf16* Vp = P + C_DV + h * HD;
        KVRegs R; kv_load(R, Kp, Vp, rb, sr, sc); kv_write<true>(R, F.lds, sr, sc, kg);
        __syncthreads();
        float m_reg = -1e30f, l_reg = 0.f; f32x16 o[4] = {};
        const float b31 = biasL[127];
        for (int j = 0; j < NT; ++j) {
            LAS unsigned char* buf = F.lds + (j & 1) * 32768;
            if (j + 1 < NT) kv_load(R, Kp, Vp, rb + 64 * (j + 1), sr, sc);
            if (64 * j <= q0 + 32 * wave + 31) {
                const unsigned long long mw = MK[(rb + tq) * 32 + j]; const unsigned mlo = (unsigned)mw, mhi = (unsigned)(mw >> 32);
                f32x16 p0, p1; qkt64(p0, p1, (const LAS char*)buf, qr, r32, hi);
                const int rel0 = tq - 64 * j;
                const bool nearb = (q0 + 32 * wave - (64 * j + 63)) < 113;
                float pmax = -1e30f;
#pragma unroll
                for (int r = 0; r < 16; ++r) { const int kk = crow(r, hi);
                    float b0 = b31, b1 = b31;
                    if (nearb) { int i0 = rel0 - kk, i1 = rel0 - kk - 32; i0 = i0 < 0 ? 0 : (i0 > 127 ? 127 : i0); i1 = i1 < 0 ? 0 : (i1 > 127 ? 127 : i1); b0 = biasL[i0]; b1 = biasL[i1]; }
                    p0[r] = ((mlo >> kk) & 1u) ? fmaf(p0[r], C, b0) : -1e30f; p1[r] = ((mhi >> kk) & 1u) ? fmaf(p1[r], C, b1) : -1e30f;
                    pmax = fmaxf(pmax, fmaxf(p0[r], p1[r])); }
                pmax = pair_max(pmax);
                const float mn = fmaxf(m_reg, pmax), alpha = __builtin_amdgcn_exp2f(m_reg - mn); m_reg = mn;
                float ps = 0.f;
#pragma unroll
                for (int r = 0; r < 16; ++r) { const int kk = crow(r, hi);
                    p0[r] = ((mlo >> kk) & 1u) ? __builtin_amdgcn_exp2f(p0[r] - mn) : 0.f; p1[r] = ((mhi >> kk) & 1u) ? __builtin_amdgcn_exp2f(p1[r] - mn) : 0.f; ps += p0[r] + p1[r]; }
                l_reg = l_reg * alpha + pair_sum(ps);
                if (__any(alpha < 1.f)) { if (hi == 0) rowL[r32] = alpha; LDS_WAIT(); asm volatile("" ::: "memory");
#pragma unroll
                    for (int r = 0; r < 16; ++r) { const float a = rowL[crow(r, hi)];
#pragma unroll
                        for (int d = 0; d < 4; ++d) o[d][r] *= a; }
                    LDS_WAIT(); asm volatile("" ::: "memory"); }
                bf16x8 pa0, pa1, pa2, pa3; PK4(p0, 0, pa0); PK4(p0, 8, pa1); PK4(p1, 0, pa2); PK4(p1, 8, pa3);
                pv_all(o, (int)(size_t)(buf + 16384) + v_rd_base(lane), pa0, pa1, pa2, pa3);
            }
            if (j + 1 < NT) kv_write<true>(R, F.lds + ((j + 1) & 1) * 32768, sr, sc, kg);
            __syncthreads();
        }
        if (hi == 0) rowL[r32] = 1.0f / l_reg;
        LDS_WAIT(); asm volatile("" ::: "memory");
        const size_t row0 = rb + q0 + 32 * wave;
#pragma unroll
        for (int r = 0; r < 16; ++r) { const float a = rowL[crow(r, hi)]; bf16* op = BR + (row0 + crow(r, hi)) * 3072 + 1024 + h * HD + r32;
#pragma unroll
            for (int d = 0; d < 4; ++d) op[32 * d] = (bf16)f2bf(o[d][r] * a); }
    }
}

__device__ __forceinline__ void sb_attn(const Frame& F) {
    const bf16* P = (const bf16*)(F.ws + WS_PROJ); bf16* BR = (bf16*)(F.ws + WS_BR);
    LAS unsigned* flagL = (LAS unsigned*)(F.lds + AT_TAB_OFF + 2048);
    for (int u = F.vcu; u < 256; u += F.G) {
        const int tid = F.wave * 64 + fresh_lane();
        const int lane = tid & 63, wave = F.wave, r32 = lane & 31, hi = lane >> 5, sr = tid >> 4, sc = (tid & 15) * 8;
        const int b = u >> 6, h = (u >> 3) & 7, qb = u & 7, q0 = qb * 256, NT = 4 * (qb + 1); const size_t rb = (size_t)b * SEQ;
        const float kgd[8] = {1.f, 1.f, 1.f, 1.f, 1.f, 1.f, 1.f, 1.f};
        const int tq = q0 + 32 * wave + r32; bf16x8 qr[8];
#pragma unroll
        for (int d0 = 0; d0 < 8; ++d0) { const v4u x = *(const v4u*)(P + (rb + tq) * PW + C_SQ + h * HD + 16 * d0 + 8 * hi); const float s = 0.08838834764831845f;
            v4u o; o.x = pk2(bflo(x.x) * s, bfhi(x.x) * s); o.y = pk2(bflo(x.y) * s, bfhi(x.y) * s); o.z = pk2(bflo(x.z) * s, bfhi(x.z) * s); o.w = pk2(bflo(x.w) * s, bfhi(x.w) * s); qr[d0] = *reinterpret_cast<bf16x8*>(&o); }
        const bf16* Kp = P + C_SK + h * HD; const bf16* Vp = P + C_SV + h * HD;
        __syncthreads();
        KVRegs R; kv_load(R, Kp, Vp, rb + 64 * (NT - 1), sr, sc); kv_write<false>(R, F.lds, sr, sc, kgd);
        __syncthreads();
        float carry = 1.f; f32x16 o[4] = {};
        int it = 0;
        for (int j = NT - 1; j >= 0; --j, ++it) {
            LAS unsigned char* buf = F.lds + (it & 1) * 32768;
            if (j > 0) kv_load(R, Kp, Vp, rb + 64 * (j - 1), sr, sc);
            if (64 * j < q0 + 32 * wave + 31) {
                f32x16 p0, p1; qkt64(p0, p1, (const LAS char*)buf, qr, r32, hi);
                const int rel0 = tq - 64 * j;
                float To[8];
#pragma unroll
                for (int a = 0; a < 8; ++a) {
                    float n[4], sg[4];
#pragma unroll
                    for (int e = 0; e < 4; ++e) { const int r = 4 * (a & 3) + e, kk = crow(r, hi) + (a >= 4 ? 32 : 0);
                        float z = (a >= 4) ? p1[r] : p0[r]; z = fminf(fmaxf(z, -60.f), 60.f);
                        const float ex = __builtin_amdgcn_exp2f(-z * 1.4426950408889634f), s1 = __builtin_amdgcn_rcpf(1.f + ex);
                        const bool ok = kk < rel0; sg[e] = ok ? s1 : 0.f; n[e] = ok ? ex * s1 : 1.f; }
                    const float e2 = n[3], e1 = e2 * n[2], e0 = e1 * n[1]; To[a] = e0 * n[0];
                    if (a >= 4) { p1[4 * (a & 3) + 3] = sg[3]; p1[4 * (a & 3) + 2] = sg[2] * e2; p1[4 * (a & 3) + 1] = sg[1] * e1; p1[4 * (a & 3)] = sg[0] * e0; }
                    else { p0[4 * a + 3] = sg[3]; p0[4 * a + 2] = sg[2] * e2; p0[4 * a + 1] = sg[1] * e1; p0[4 * a] = sg[0] * e0; }
                }
                float run = carry;
#pragma unroll
                for (int a = 7; a >= 0; --a) { const float Tp = __shfl_xor(To[a], 32);
                    const float E = hi ? run : run * Tp; run = run * To[a] * Tp;
#pragma unroll
                    for (int e = 0; e < 4; ++e) { if (a >= 4) p1[4 * (a & 3) + e] *= E; else p0[4 * a + e] *= E; } }
                carry = run;
                bf16x8 pa0, pa1, pa2, pa3; PK4(p0, 0, pa0); PK4(p0, 8, pa1); PK4(p1, 0, pa2); PK4(p1, 8, pa3);
                pv_all(o, (int)(size_t)(buf + 16384) + v_rd_base(lane), pa0, pa1, pa2, pa3);
            }
            if (lane == 0) flagL[(it & 1) * 8 + wave] = __all(carry < 1e-30f) ? 1u : 0u;
            if (j > 0) kv_write<false>(R, F.lds + ((it + 1) & 1) * 32768, sr, sc, kgd);
            __syncthreads();
            unsigned done = 1u;
#pragma unroll
            for (int w = 0; w < 8; ++w) done &= flagL[(it & 1) * 8 + w];
            if (done) break;
        }
        const size_t row0 = rb + q0 + 32 * wave;
#pragma unroll
        for (int r = 0; r < 16; ++r) { bf16* op = BR + (row0 + crow(r, hi)) * 3072 + 2048 + h * HD + r32;
#pragma unroll
            for (int d = 0; d < 4; ++d) op[32 * d] = (bf16)f2bf(o[d][r]); }
    }
}
template <int LDA, int LDB> struct SchedDense {
    static constexpr bool GATHER = false;
    pg8::TileOrder T; const char* A; const char* B;
    __device__ __forceinline__ bool next(int i, pg8::Unit& u) const { u.e = 0; u.rows = 256; return T.tile(i, u.pm, u.pn); }
    __device__ __forceinline__ const char* a_base(const pg8::Unit& u) const { return A + (size_t)u.pm * 256 * LDA * 2; }
    __device__ __forceinline__ const char* b_base(const pg8::Unit& u) const { return B + (size_t)u.pn * 256 * LDB * 2; }
    __device__ __forceinline__ void a_off(const pg8::Unit&, int tid, unsigned (&v0)[2], unsigned (&v1)[2]) const {
        int R[2], C[2];
#pragma unroll
        for (int i = 0; i < 2; ++i) pg8::stage_rc(tid * 16 + i * 8192, R[i], C[i]);
#pragma unroll
        for (int i = 0; i < 2; ++i) { v0[i] = (unsigned)(R[i] * LDA + C[i]) * 2u; v1[i] = v0[i] + 128u * LDA * 2u; } }
};
struct EpiProj {
    static constexpr bool PERM = true;
    static constexpr bool PROBE2 = true;
    __device__ __forceinline__ bool zero_after(const pg8::Unit&) const { return true; }
    bf16* O; float* GIF;
    __device__ __forceinline__ void operator()(const f32x4 (&acc)[2][2][4][2], const pg8::Unit& u, int wr, int wc, int fr, int fq) const {
        const int row0 = u.pm * 256 + wr * 64 + fr, col0 = u.pn * 256 + wc * 32 + 8 * fq;
#pragma unroll
        for (int ai = 0; ai < 2; ++ai)
#pragma unroll
            for (int m = 0; m < 4; ++m) { bf16* rowp = O + (size_t)(row0 + ai * 128 + m * 16) * PW + col0;
#pragma unroll
                for (int bj = 0; bj < 2; ++bj) { const f32x4 v0 = acc[ai][bj][m][0], v1 = acc[ai][bj][m][1];
                    v4u w; w.x = cvt_pk_bf16(v0[0], v0[1]); w.y = cvt_pk_bf16(v0[2], v0[3]); w.z = cvt_pk_bf16(v1[0], v1[1]); w.w = cvt_pk_bf16(v1[2], v1[3]);
                    *(v4u*)(rowp + bj * 128) = w;
                    if (u.pn == PW / 256 - 1 && bj == 0 && wc == 0 && fq < 2) { float* gp = GIF + (size_t)(row0 + ai * 128 + m * 16) * 16 + 8 * fq; *(f32x4*)gp = v0; *(f32x4*)(gp + 4) = v1; } } }
    }
};
#ifdef PROBE_GEMM
template <int MODE> struct SchedProbe {
    static constexpr bool GATHER = false;
    pg8::TileOrder T; const char* A; const char* B;
    __device__ __forceinline__ bool next(int i, pg8::Unit& u) const { u.e = 0; u.rows = 256; return T.tile(i, u.pm, u.pn); }
    __device__ __forceinline__ const char* a_base(const pg8::Unit& u) const { return A + (size_t)((MODE & 2) ? 0 : u.pm) * 256 * DM * 2; }
    __device__ __forceinline__ const char* b_base(const pg8::Unit& u) const { return B + (size_t)((MODE & 1) ? 0 : u.pn) * 256 * DM * 2; }
    __device__ __forceinline__ void a_off(const pg8::Unit&, int tid, unsigned (&v0)[2], unsigned (&v1)[2]) const {
        int R[2], C[2];
#pragma unroll
        for (int i = 0; i < 2; ++i) pg8::stage_rc(tid * 16 + i * 8192, R[i], C[i]);
#pragma unroll
        for (int i = 0; i < 2; ++i) { v0[i] = (unsigned)(R[i] * DM + C[i]) * 2u; v1[i] = v0[i] + 128u * DM * 2u; } }
};
struct EpiProbe {
    static constexpr bool PERM = true;
    static constexpr bool PROBE2 = false;
    __device__ __forceinline__ bool zero_after(const pg8::Unit&) const { return true; }
    bf16* O;
    __device__ __forceinline__ void operator()(const f32x4 (&acc)[2][2][4][2], const pg8::Unit& u, int wr, int wc, int fr, int fq) const {
        const int row0 = ((u.pm * 256) & 1023) + wr * 64 + fr, col0 = u.pn * 256 + wc * 32 + 8 * fq;
#pragma unroll
        for (int ai = 0; ai < 2; ++ai)
#pragma unroll
            for (int m = 0; m < 4; ++m) { bf16* rowp = O + (size_t)(row0 + ai * 128 + m * 16) * PW + col0;
#pragma unroll
                for (int bj = 0; bj < 2; ++bj) { const f32x4 v0 = acc[ai][bj][m][0], v1 = acc[ai][bj][m][1];
                    v4u w; w.x = cvt_pk_bf16(v0[0], v0[1]); w.y = cvt_pk_bf16(v0[2], v0[3]); w.z = cvt_pk_bf16(v1[0], v1[1]); w.w = cvt_pk_bf16(v1[2], v1[3]);
                    *(v4u*)(rowp + bj * 128) = w; } }
    }
};
#endif
struct SchedBranch {
    static constexpr bool GATHER = false;
    pg8::TileOrder T; const char* A; const char* B;
    __device__ __forceinline__ bool next(int i, pg8::Unit& u) const { u.e = i % 3; u.rows = 256; return T.tile(i / 3, u.pm, u.pn); }
    __device__ __forceinline__ const char* a_base(const pg8::Unit& u) const { return A + ((size_t)u.pm * 256 * 3072 + (size_t)u.e * 1024) * 2; }
    __device__ __forceinline__ const char* b_base(const pg8::Unit& u) const { return B + ((size_t)u.e * 2048 + (size_t)u.pn * 256) * 1024 * 2; }
    __device__ __forceinline__ void a_off(const pg8::Unit&, int tid, unsigned (&v0)[2], unsigned (&v1)[2]) const {
        int R[2], C[2];
#pragma unroll
        for (int i = 0; i < 2; ++i) pg8::stage_rc(tid * 16 + i * 8192, R[i], C[i]);
#pragma unroll
        for (int i = 0; i < 2; ++i) { v0[i] = (unsigned)(R[i] * 3072 + C[i]) * 2u; v1[i] = v0[i] + 128u * 3072u * 2u; } }
};
struct EpiBranch {
    static constexpr bool PERM = true;
    static constexpr bool PROBE2 = false;
    __device__ __forceinline__ bool zero_after(const pg8::Unit& u) const { return u.e == 2; }
    const bf16* P; bf16* O;
    __device__ __forceinline__ void operator()(f32x4 (&acc)[2][2][4][2], const pg8::Unit& u, int wr, int wc, int fr, int fq) const {
        const int row0 = u.pm * 256 + wr * 64 + fr, col0 = u.pn * 256 + wc * 32 + 8 * fq;
#pragma unroll
        for (int ai = 0; ai < 2; ++ai)
#pragma unroll
            for (int m = 0; m < 4; ++m) { const size_t row = (size_t)(row0 + ai * 128 + m * 16);
#pragma unroll
                for (int bj = 0; bj < 2; ++bj) { const int col = col0 + bj * 128;
                    const v4u ga = *(const v4u*)(P + row * PW + C_G + u.e * 2048 + col);
                    float f[8];
                    { const float a[8] = {bflo(ga.x), bfhi(ga.x), bflo(ga.y), bfhi(ga.y), bflo(ga.z), bfhi(ga.z), bflo(ga.w), bfhi(ga.w)};
#pragma unroll
                      for (int e = 0; e < 8; ++e) f[e] = 1.0f / (1.0f + __expf(-fminf(fmaxf(a[e], -30.f), 30.f))); }
                    if (u.e < 2) { const v4u gb = *(const v4u*)(P + row * PW + C_G + (u.e + 1) * 2048 + col);
                        const float b[8] = {bflo(gb.x), bfhi(gb.x), bflo(gb.y), bfhi(gb.y), bflo(gb.z), bfhi(gb.z), bflo(gb.w), bfhi(gb.w)};
#pragma unroll
                        for (int e = 0; e < 8; ++e) f[e] *= 1.0f + __expf(-fminf(fmaxf(b[e], -30.f), 30.f)); }
                    f32x4 v0 = acc[ai][bj][m][0], v1 = acc[ai][bj][m][1];
                    v0[0] *= f[0]; v0[1] *= f[1]; v0[2] *= f[2]; v0[3] *= f[3]; v1[0] *= f[4]; v1[1] *= f[5]; v1[2] *= f[6]; v1[3] *= f[7];
                    if (u.e < 2) { acc[ai][bj][m][0] = v0; acc[ai][bj][m][1] = v1; }
                    else { v4u w; w.x = cvt_pk_bf16(v0[0], v0[1]); w.y = cvt_pk_bf16(v0[2], v0[3]); w.z = cvt_pk_bf16(v1[0], v1[1]); w.w = cvt_pk_bf16(v1[2], v1[3]);
                        *(v4u*)(O + row * DM + col) = w; } } }
    }
};
struct EpiOut {
    static constexpr bool PERM = false;
    static constexpr bool PROBE2 = false;
    __device__ __forceinline__ bool zero_after(const pg8::Unit&) const { return true; }
    const float* base; float* out;
    __device__ __forceinline__ void operator()(const f32x4 (&acc)[2][2][4][2], const pg8::Unit& u, int wr, int wc, int fr, int fq) const {
        const int row0 = u.pm * 256 + wr * 64 + fr, col0 = u.pn * 256 + wc * 32 + 4 * fq;
#pragma unroll
        for (int ai = 0; ai < 2; ++ai)
#pragma unroll
            for (int m = 0; m < 4; ++m) { const size_t off = (size_t)(row0 + ai * 128 + m * 16) * DM + col0;
#pragma unroll
                for (int bj = 0; bj < 2; ++bj)
#pragma unroll
                    for (int n = 0; n < 2; ++n) { const f32x4 bs = *(const f32x4*)(base + off + bj * 128 + n * 16); *(f32x4*)(out + off + bj * 128 + n * 16) = bs + acc[ai][bj][m][n]; } }
    }
};

#ifndef MK_NAIVE_MOE
#define MK_NAIVE_MOE 0
#endif
#ifndef PROBE_MASK
#define PROBE_MASK 0
#endif
#ifndef OFFMASK
#define OFFMASK 0
#endif
#ifndef CVT_FIRST
#define CVT_FIRST 4
#endif
constexpr int PH_PRE = 0, PH_INPROJ = 1, PH_MIXA = 2, PH_MIXB = 3, PH_MIXC = 4, PH_BRANCH = 5, PH_OUT = 6, PH_NORM2 = 7, PH_MOE = 8, PH_MOED = 9, NPH_L = 10,
              PH_FINAL = DEPTH * NPH_L, NPH = PH_FINAL + 1;

__global__ void __launch_bounds__(NTHR, 2) fwd_kernel(Args args) {
    extern __shared__ __attribute__((aligned(16))) unsigned char lds_raw[];
    Frame F;
    F.lds = (LAS unsigned char*)lds_raw;
    F.wave = __builtin_amdgcn_readfirstlane((int)threadIdx.x >> 6);
    const int wave0 = F.wave;
    F.G = gridDim.x; { const int bx = blockIdx.x; F.vcu = (F.G % 8 == 0) ? (bx % 8) * (F.G / 8) + bx / 8 : bx; }
    F.ws = args.ws; F.ctl = (unsigned*)(args.ws + WS_CTL);
    volatile LAS unsigned* MISC = (volatile LAS unsigned*)(F.lds + LDSCTL_OFF);
    for (int u = threadIdx.x; u < (LDS_BYTES - LDSCTL_OFF) / 4; u += NTHR) ((LAS unsigned*)(F.lds + LDSCTL_OFF))[u] = 0u;
    __syncthreads();
    XcdBarrier bar; bar.bar = F.ctl + CW_BAR; bar.x = 0; bar.st = nullptr;
    if (args.use_bar) bar = xcd_barrier_post(F.ctl + CW_BAR, MISC + 8);
    const int lo = args.ph_lo, hi = args.ph_hi;
#define IN(k) (lo <= (k) && (k) < hi)
#define FRESH() do { F.wave = wave0; F.ws = arg_ws(); F.ctl = (unsigned*)(F.ws + WS_CTL); } while (0)
#define SEAM(k) do { if (args.use_bar && IN((k) + 1)) { FRESH(); xcd_barrier(bar, (F.wave * 64 + fresh_lane())); } } while (0)
#define REPS(k) for (int rep_ = 0; rep_ < (int)((args.reps >> (2 * (k))) & 3u); ++rep_)
#define RSYNC() do { if (rep_) __syncthreads(); } while (0)
    { constexpr int l = 0; constexpr int p0 = 0;
        if (IN(p0 + PH_PRE)) { FRESH();
            _Pragma("unroll 1") REPS(0) { RSYNC(); ph_convw(F, l); }
            _Pragma("unroll 1") REPS(1) { RSYNC(); ph_norm1(F, l); }
            SEAM(p0 + PH_PRE); }
        if (IN(p0 + PH_INPROJ)) { FRESH();
            { SchedDense<DM, DM> S; S.T.init(NTOK / 256, PW / 256, F.G, (int)blockIdx.x); S.A = (const char*)(F.ws + WS_XN); S.B = (const char*)(F.ws + WS_WIN);
              EpiProj E{(bf16*)(F.ws + WS_PROJ), gif_ptr(F)};
              _Pragma("unroll 1") REPS(10) { RSYNC(); pg8::gemm_phase<SchedDense<DM, DM>, EpiProj, DM, DM, DM, true>(F.lds, S, E, (F.wave * 64 + fresh_lane())); } }
#ifdef PROBE_GEMM
            { __syncthreads(); SchedProbe<PROBE_GEMM> S; S.T.init(NTOK / 256, PW / 256, F.G, (int)blockIdx.x); S.A = (const char*)(F.ws + WS_XN); S.B = (const char*)(F.ws + WS_WIN);
              EpiProbe E{(bf16*)(F.ws + WS_TMP)};
              pg8::gemm_phase<SchedProbe<PROBE_GEMM>, EpiProbe, DM, DM, DM, true>(F.lds, S, E, (F.wave * 64 + fresh_lane())); }
#endif
            SEAM(p0 + PH_INPROJ); }
        if (IN(p0 + PH_MIXA)) { FRESH();
            _Pragma("unroll 1") REPS(2) { RSYNC(); ml_delta(F, l); }
            __syncthreads();
            _Pragma("unroll 1") REPS(5) { RSYNC(); dsa_index(F); }
            SEAM(p0 + PH_MIXA); }
        if (IN(p0 + PH_MIXB)) { FRESH();
            _Pragma("unroll 1") REPS(3) { RSYNC(); ml_scan(F); }
            __syncthreads();
            _Pragma("unroll 1") REPS(7) { RSYNC(); sb_attn(F); }
            SEAM(p0 + PH_MIXB); }
        if (IN(p0 + PH_MIXC)) { FRESH();
            _Pragma("unroll 1") REPS(6) { RSYNC(); dsa_attn(F, l); }
            __syncthreads();
            _Pragma("unroll 1") REPS(4) { RSYNC(); ml_out(F, l); }
            SEAM(p0 + PH_MIXC); }
        if (IN(p0 + PH_BRANCH)) { FRESH();
            SchedBranch S; S.T.init(NTOK / 256, DM / 256, F.G, (int)blockIdx.x); S.A = (const char*)(F.ws + WS_BR); S.B = (const char*)(F.ws + WS_WBR);
            EpiBranch E{(const bf16*)(F.ws + WS_PROJ), (bf16*)(F.ws + WS_MRG)};
            _Pragma("unroll 1") REPS(11) { RSYNC(); pg8::gemm_phase<SchedBranch, EpiBranch, BW, 3072, BW, true>(F.lds, S, E, (F.wave * 64 + fresh_lane())); }
            SEAM(p0 + PH_BRANCH); }
        if (IN(p0 + PH_OUT)) { FRESH();
            SchedDense<DM, DM> S; S.T.init(NTOK / 256, DM / 256, F.G, (int)blockIdx.x); S.A = (const char*)(F.ws + WS_MRG); S.B = (const char*)(F.ws + WS_WOUT);
            EpiOut E{l == 0 ? arg_in(0) : (const float*)(F.ws + WS_XA), (float*)(F.ws + WS_X1)};
            _Pragma("unroll 1") REPS(12) { RSYNC(); pg8::gemm_phase<SchedDense<DM, DM>, EpiOut, DM, DM, DM, true>(F.lds, S, E, (F.wave * 64 + fresh_lane())); }
            SEAM(p0 + PH_OUT); }
        if (IN(p0 + PH_NORM2)) { FRESH(); _Pragma("unroll 1") REPS(8) { RSYNC(); ph_norm2_mfma(F, l); } SEAM(p0 + PH_NORM2); }
        if (IN(p0 + PH_MOE)) { FRESH();
            moe_tables(F, l);
            SchedMoeUp S; S.tp = (const LAS int*)(F.lds + MOE_TAB_OFF); S.cn = S.tp + 40; S.sb = S.cn + 40; S.G = F.G; S.c = (int)blockIdx.x;
            S.A = (const char*)(F.ws + WS_XN); S.B = (const char*)(F.ws + WS_WGU); S.list = (const int*)(F.ws + WS_LIST);
            EpiMoeUp E{(bf16*)(F.ws + WS_HB), S.sb};
            _Pragma("unroll 1") REPS(13) { RSYNC(); pg8::gemm_phase<SchedMoeUp, EpiMoeUp, DM, DM, DM, true>(F.lds, S, E, (F.wave * 64 + fresh_lane())); }
            SEAM(p0 + PH_MOE); }
        if (IN(p0 + PH_MOED)) { FRESH();
            moe_tables(F, l);
            SchedMoeDown S; S.tp = (const LAS int*)(F.lds + MOE_TAB_OFF); S.cn = S.tp + 40; S.sb = S.cn + 40; S.G = F.G; S.c = (int)blockIdx.x;
            S.A = (const char*)(F.ws + WS_HB); S.B = (const char*)(F.ws + WS_WDN);
            EpiMoeDown E{(bf16*)(F.ws + WS_YB), (const int*)(F.ws + WS_LIST), (const int*)tokinfo_ptr(F)};
            _Pragma("unroll 1") REPS(14) { RSYNC(); pg8::gemm_phase<SchedMoeDown, EpiMoeDown, DEXP, DEXP, DEXP, true>(F.lds, S, E, (F.wave * 64 + fresh_lane())); }
            SEAM(p0 + PH_MOED); }
    }
    { constexpr int l = 1; constexpr int p0 = NPH_L;
        if (IN(p0 + PH_PRE)) { FRESH();
            _Pragma("unroll 1") REPS(0) { RSYNC(); ph_convw(F, l); }
            _Pragma("unroll 1") REPS(1) { RSYNC(); ph_norm1(F, l); }
            SEAM(p0 + PH_PRE); }
        if (IN(p0 + PH_INPROJ)) { FRESH();
            { SchedDense<DM, DM> S; S.T.init(NTOK / 256, PW / 256, F.G, (int)blockIdx.x); S.A = (const char*)(F.ws + WS_XN); S.B = (const char*)(F.ws + WS_WIN);
              EpiProj E{(bf16*)(F.ws + WS_PROJ), gif_ptr(F)};
              _Pragma("unroll 1") REPS(10) { RSYNC(); pg8::gemm_phase<SchedDense<DM, DM>, EpiProj, DM, DM, DM, true>(F.lds, S, E, (F.wave * 64 + fresh_lane())); } }
#ifdef PROBE_GEMM
            { __syncthreads(); SchedProbe<PROBE_GEMM> S; S.T.init(NTOK / 256, PW / 256, F.G, (int)blockIdx.x); S.A = (const char*)(F.ws + WS_XN); S.B = (const char*)(F.ws + WS_WIN);
              EpiProbe E{(bf16*)(F.ws + WS_TMP)};
              pg8::gemm_phase<SchedProbe<PROBE_GEMM>, EpiProbe, DM, DM, DM, true>(F.lds, S, E, (F.wave * 64 + fresh_lane())); }
#endif
            SEAM(p0 + PH_INPROJ); }
        if (IN(p0 + PH_MIXA)) { FRESH();
            _Pragma("unroll 1") REPS(2) { RSYNC(); ml_delta(F, l); }
            __syncthreads();
            _Pragma("unroll 1") REPS(5) { RSYNC(); dsa_index(F); }
            SEAM(p0 + PH_MIXA); }
        if (IN(p0 + PH_MIXB)) { FRESH();
            _Pragma("unroll 1") REPS(3) { RSYNC(); ml_scan(F); }
            __syncthreads();
            _Pragma("unroll 1") REPS(7) { RSYNC(); sb_attn(F); }
            SEAM(p0 + PH_MIXB); }
        if (IN(p0 + PH_MIXC)) { FRESH();
            _Pragma("unroll 1") REPS(6) { RSYNC(); dsa_attn(F, l); }
            __syncthreads();
            _Pragma("unroll 1") REPS(4) { RSYNC(); ml_out(F, l); }
            SEAM(p0 + PH_MIXC); }
        if (IN(p0 + PH_BRANCH)) { FRESH();
            SchedBranch S; S.T.init(NTOK / 256, DM / 256, F.G, (int)blockIdx.x); S.A = (const char*)(F.ws + WS_BR); S.B = (const char*)(F.ws + WS_WBR);
            EpiBranch E{(const bf16*)(F.ws + WS_PROJ), (bf16*)(F.ws + WS_MRG)};
            _Pragma("unroll 1") REPS(11) { RSYNC(); pg8::gemm_phase<SchedBranch, EpiBranch, BW, 3072, BW, true>(F.lds, S, E, (F.wave * 64 + fresh_lane())); }
            SEAM(p0 + PH_BRANCH); }
        if (IN(p0 + PH_OUT)) { FRESH();
            SchedDense<DM, DM> S; S.T.init(NTOK / 256, DM / 256, F.G, (int)blockIdx.x); S.A = (const char*)(F.ws + WS_MRG); S.B = (const char*)(F.ws + WS_WOUT);
            EpiOut E{l == 0 ? arg_in(0) : (const float*)(F.ws + WS_XA), (float*)(F.ws + WS_X1)};
            _Pragma("unroll 1") REPS(12) { RSYNC(); pg8::gemm_phase<SchedDense<DM, DM>, EpiOut, DM, DM, DM, true>(F.lds, S, E, (F.wave * 64 + fresh_lane())); }
            SEAM(p0 + PH_OUT); }
        if (IN(p0 + PH_NORM2)) { FRESH(); _Pragma("unroll 1") REPS(8) { RSYNC(); ph_norm2_mfma(F, l); } SEAM(p0 + PH_NORM2); }
        if (IN(p0 + PH_MOE)) { FRESH();
            moe_tables(F, l);
            SchedMoeUp S; S.tp = (const LAS int*)(F.lds + MOE_TAB_OFF); S.cn = S.tp + 40; S.sb = S.cn + 40; S.G = F.G; S.c = (int)blockIdx.x;
            S.A = (const char*)(F.ws + WS_XN); S.B = (const char*)(F.ws + WS_WGU); S.list = (const int*)(F.ws + WS_LIST);
            EpiMoeUp E{(bf16*)(F.ws + WS_HB), S.sb};
            _Pragma("unroll 1") REPS(13) { RSYNC(); pg8::gemm_phase<SchedMoeUp, EpiMoeUp, DM, DM, DM, true>(F.lds, S, E, (F.wave * 64 + fresh_lane())); }
            SEAM(p0 + PH_MOE); }
        if (IN(p0 + PH_MOED)) { FRESH();
            moe_tables(F, l);
            SchedMoeDown S; S.tp = (const LAS int*)(F.lds + MOE_TAB_OFF); S.cn = S.tp + 40; S.sb = S.cn + 40; S.G = F.G; S.c = (int)blockIdx.x;
            S.A = (const char*)(F.ws + WS_HB); S.B = (const char*)(F.ws + WS_WDN);
            EpiMoeDown E{(bf16*)(F.ws + WS_YB), (const int*)(F.ws + WS_LIST), (const int*)tokinfo_ptr(F)};
            _Pragma("unroll 1") REPS(14) { RSYNC(); pg8::gemm_phase<SchedMoeDown, EpiMoeDown, DEXP, DEXP, DEXP, true>(F.lds, S, E, (F.wave * 64 + fresh_lane())); }
            SEAM(p0 + PH_MOED); }
    }
    if (IN(PH_FINAL)) { FRESH(); } if (IN(PH_FINAL)) ph_final(F, args.out);
#undef IN
#undef SEAM
}

#ifndef MK_ONE_LAUNCH
#define MK_ONE_LAUNCH 1
#endif
extern "C" void kernel_launch(void* const* d_in, const int* in_sizes, int n_in, void* d_out, int out_size, void* d_ws, size_t ws_size, hipStream_t stream) {
    static int grid = 0;
    if (grid == 0) {
        if (n_in != 20 || in_sizes[0] != NTOK * DM || out_size != NTOK * DM || ws_size < WS_END) { fprintf(stderr, "kernel_launch: shape mismatch (n_in %d, ws %zu < %zu?)\n", n_in, ws_size, (size_t)WS_END); grid = -1; return; }
        int dev = 0, cus = 0, per_cu = 0;
        if (hipGetDevice(&dev) != hipSuccess || hipDeviceGetAttribute(&cus, hipDeviceAttributeMultiprocessorCount, dev) != hipSuccess) { grid = -1; return; }
        if (hipFuncSetAttribute((const void*)fwd_kernel, hipFuncAttributeMaxDynamicSharedMemorySize, LDS_BYTES) != hipSuccess) { fprintf(stderr, "kernel_launch: hipFuncSetAttribute failed\n"); grid = -1; return; }
        if (hipOccupancyMaxActiveBlocksPerMultiprocessor(&per_cu, (const void*)fwd_kernel, NTHR, LDS_BYTES) != hipSuccess || per_cu < 1) fprintf(stderr, "kernel_launch: occupancy query says %d\n", per_cu);
        (void)hipGetLastError();
        grid = cus;
    }
    if (grid < 0) return;
    if (hipMemsetAsync((char*)d_ws + WS_CTL, 0, CTL_ZERO_BYTES, stream) != hipSuccess) return;
    Args a{};
    for (int i = 0; i < 20; ++i) a.in[i] = (const float*)d_in[i];
    a.out = (float*)d_out; a.ws = (unsigned char*)d_ws;
    { unsigned r = 0; for (int k = 0; k < 15; ++k) r |= (1u + ((PROBE_MASK >> k) & 1u)) << (2 * k); a.reps = r; }
#if MK_ONE_LAUNCH
    a.ph_lo = 0; a.ph_hi = NPH; a.use_bar = 1;
    hipLaunchKernelGGL(fwd_kernel, dim3(grid), dim3(NTHR), LDS_BYTES, stream, a);
#else
    for (int ph = 0; ph < NPH; ++ph) { a.ph_lo = ph; a.ph_hi = ph + 1; a.use_bar = 0;
        hipLaunchKernelGGL(fwd_kernel, dim3(grid), dim3(NTHR), LDS_BYTES, stream, a); }
#endif
    const hipError_t le = hipPeekAtLastError();
    if (le != hipSuccess) fprintf(stderr, "kernel_launch: launch failed: %s\n", hipGetErrorName(le));
}
```

```cpp
#define PROBE_MASK 0x0
#include <hip/hip_runtime.h>
#include <cstdio>
#include <cstdint>

constexpr int BATCH = 4, SEQ = 2048, DM = 2048, NTOK = BATCH * SEQ, NH = 8, HD = 128, BW = 1024, DEPTH = 2;
constexpr int NIN = 17504, PW = 17664;
constexpr int IDXH = 16, IDXD = 64, TOPK = 256, NEXP = 32, NGRP = 4, EPG = 8, DEXP = 512, MCH = 64, NCH = SEQ / MCH;
constexpr float EPS = 1e-6f;
constexpr int C_MQ = 0, C_MK = 1024, C_MV = 2048, C_MO = 3072, C_DQ = 4096, C_DK = 5120, C_DV = 6144, C_IQ = 7168, C_SQ = 8192, C_SK = 9216, C_SV = 10240,
              C_G = 11264, C_MI = 17408, C_MF = 17416, C_IK = 17424, C_IW = 17488;
__host__ __device__ __forceinline__ int src_col(int c) {
    if (c < 4096) return c;
    if (c < 8192) return c + 16;
    if (c < 17408) return c + 96;
    if (c < 17424) return 4096 + (c - 17408);
    if (c < 17488) return 8208 + (c - 17424);
    if (c < 17504) return 8272 + (c - 17488);
    return -1;
}

constexpr size_t MiB = 1u << 20;
constexpr size_t WS_CTL = 0, CTL_ZERO_BYTES = 1 * MiB;
constexpr size_t WS_WIN = 1 * MiB;
constexpr size_t WS_WBR = WS_WIN + 69 * MiB;
constexpr size_t WS_WOUT = WS_WBR + 12 * MiB;
constexpr size_t WS_WGU = WS_WOUT + 8 * MiB;
constexpr size_t WS_WDN = WS_WGU + 128 * MiB;
constexpr size_t WS_XN = WS_WDN + 64 * MiB;
constexpr size_t WS_XA = WS_XN + 32 * MiB;
constexpr size_t WS_X1 = WS_XA + 64 * MiB;
constexpr size_t WS_PROJ = WS_X1 + 64 * MiB;
constexpr size_t WS_BR = WS_PROJ + 276 * MiB;
constexpr size_t WS_MRG = WS_BR + 48 * MiB;
constexpr size_t WS_MASK = WS_MRG + 32 * MiB;
constexpr size_t WS_MDEL = WS_MASK + 2 * MiB;
constexpr size_t WS_MDN = WS_MDEL + 64 * MiB;
constexpr size_t WS_MST = WS_MDN + 1 * MiB;
constexpr size_t WS_MSN = WS_MST + 32 * MiB;
constexpr size_t WS_HB = WS_MSN + 1 * MiB;
constexpr size_t WS_YB = WS_HB + 16 * MiB;
constexpr size_t WS_LIST = WS_YB + 64 * MiB;
constexpr size_t WS_TMP = WS_LIST + 2 * MiB;
constexpr size_t WS_WIN2 = WS_TMP;
constexpr size_t WS_END = WS_WIN2 + 69 * MiB;
static_assert(WS_END <= 1100 * MiB, "workspace map");

constexpr int CW_BAR = 4096;
constexpr int CW_CVT = 12288;
constexpr int CW_ECNT = 16384;

#define GAS __attribute__((address_space(1)))
#define LAS __attribute__((address_space(3)))
typedef unsigned short bf16;
typedef unsigned v4u __attribute__((ext_vector_type(4)));
typedef unsigned v2u __attribute__((ext_vector_type(2)));
typedef float f32x4 __attribute__((ext_vector_type(4)));
typedef float f32x2 __attribute__((ext_vector_type(2)));
typedef float f32x16 __attribute__((ext_vector_type(16)));
typedef short bf16x8 __attribute__((ext_vector_type(8)));
typedef short s16x4 __attribute__((ext_vector_type(4)));
#define RLX_AGENT __ATOMIC_RELAXED, __HIP_MEMORY_SCOPE_AGENT
#define LDS_WAIT() asm volatile("s_waitcnt lgkmcnt(0)" ::: "memory")
#define VM_WAIT() asm volatile("s_waitcnt vmcnt(0)" ::: "memory")
constexpr int NWAVES = 8, NTHR = 512;
constexpr int RING_BYTES = 131072, LDSCTL_OFF = RING_BYTES, LDS_BYTES = 147456;

__device__ __forceinline__ unsigned f2bf(float f) { unsigned u = __builtin_bit_cast(unsigned, f); return (u + 0x7fffu + ((u >> 16) & 1u)) >> 16; }
__device__ __forceinline__ unsigned pk2(float lo, float hi) { return f2bf(lo) | (f2bf(hi) << 16); }
__device__ __forceinline__ float bf2f(unsigned short b) { return __builtin_bit_cast(float, ((unsigned)b) << 16); }
__device__ __forceinline__ float bflo(unsigned w) { return __builtin_bit_cast(float, w << 16); }
__device__ __forceinline__ float bfhi(unsigned w) { return __builtin_bit_cast(float, w & 0xffff0000u); }
__device__ __forceinline__ unsigned cvt_pk_bf16(float lo, float hi) { unsigned r; asm volatile("v_cvt_pk_bf16_f32 %0, %1, %2" : "=v"(r) : "v"(lo), "v"(hi)); return r; }
__device__ __forceinline__ float wave_sum(float v) {
#pragma unroll
    for (int o = 1; o < 64; o <<= 1) v += __shfl_xor(v, o);
    return v;
}
__device__ __forceinline__ float wave_max(float v) {
#pragma unroll
    for (int o = 1; o < 64; o <<= 1) v = fmaxf(v, __shfl_xor(v, o));
    return v;
}
__device__ __forceinline__ float sigmoidf_(float x) { return 1.0f / (1.0f + __expf(-x)); }
__device__ __forceinline__ float siluf_(float x) { return x / (1.0f + __expf(-x)); }
__device__ __forceinline__ float logsigmoidf_(float x) { return fminf(x, 0.f) - log1pf(__expf(-fabsf(x))); }
__device__ __forceinline__ int t5_bucket(int n) {
    if (n < 16) return n;
    return 16 + (n >= 19) + (n >= 21) + (n >= 24) + (n >= 27) + (n >= 31) + (n >= 35) + (n >= 40) + (n >= 46) + (n >= 52) + (n >= 59) + (n >= 67) + (n >= 77) + (n >= 87) + (n >= 99) + (n >= 113);
}
namespace pg8 {
constexpr int BM = 256, BK = 64, HALF = 128, HTB = HALF * BK * 2, STAGE_BYTES = 8 * HTB, NXCD = 8, WGM = 8;
__host__ __device__ __forceinline__ int lds_byte(int r, int c) { const int st = (r >> 4) * 2 + (c >> 5), rr = r & 15, cc = c & 31, ob = rr * 64 + cc * 2; return st * 1024 + (ob ^ (((ob >> 9) & 1) << 5)); }
__host__ __device__ __forceinline__ void stage_rc(int b, int& R, int& C) { const int st = b / 1024, sb = b % 1024, swz = sb ^ (((sb >> 9) & 1) << 5); R = (st >> 1) * 16 + swz / 64; C = (st & 1) * 32 + (swz % 64) / 2; }
__host__ __device__ __forceinline__ int perm32(int rho) { const int n = rho >> 4, i = rho & 15; return 8 * (i >> 2) + 4 * n + (i & 3); }

struct Unit { int pm, pn, e, rows; };

struct TileOrder {
    int nM, nN, nwg, G, c;
    __device__ void init(int nM_, int nN_, int G_, int c_) { nM = nM_; nN = nN_; nwg = nM * nN; G = G_; c = c_; }
    __device__ bool tile(int i, int& pm, int& pn) const {
        const long L = (long)i * G + c; if (L >= nwg) return false;
        int wgid = (int)L; { const int q = nwg / NXCD, r = nwg % NXCD, xcd = wgid % NXCD, off = wgid / NXCD; wgid = (xcd < r ? xcd * (q + 1) : r * (q + 1) + (xcd - r) * q) + off; }
        const int nig = WGM * nN, gid = wgid / nig, fm = gid * WGM, gsz = (nM - fm) < WGM ? (nM - fm) : WGM;
        pm = fm + ((wgid % nig) % gsz); pn = (wgid % nig) / gsz; return true;
    }
};

template <class Sched, class Epi, int K, int LDA, int LDB, bool ALIGN_EPI>
__device__ __forceinline__ void gemm_phase(LAS unsigned char* lds, const Sched& S, const Epi& E, int tid_in) {
    int tid_ = tid_in; asm volatile("" : "+v"(tid_));
    const int tid = tid_, wid = __builtin_amdgcn_readfirstlane(tid >> 6), lane = tid & 63, wr = wid >> 2, wc = wid & 3, fr = lane & 15, fq = lane >> 4;
    constexpr int nt = K / BK;
    static_assert(K % 128 == 0 && K >= 256, "K");
    unsigned voffB[2];
#pragma unroll
    for (int i = 0; i < 2; ++i) { int R, C; stage_rc(tid * 16 + i * 8192, R, C); const int Rb = Epi::PERM ? ((R & ~31) + perm32(R & 31)) : R;
        voffB[i] = (unsigned)(Rb * LDB + C) * 2u; }
    constexpr size_t kstep = (size_t)(BK * 2);
    constexpr size_t hstepB = (size_t)HALF * LDB * 2;
    constexpr size_t hstepA = Sched::GATHER ? 0 : (size_t)HALF * LDA * 2;
    const unsigned ldsw = (unsigned)wid * 1024u;
    const int aoff = lds_byte(wr * 64 + fr, fq * 8), boff = lds_byte(wc * 32 + fr, fq * 8);
#define PG8_SA(b, h) (((b) * 2 + (h)) * HTB)
#define PG8_SB(b, h) ((4 + (b) * 2 + (h)) * HTB)
#define PG8_STAGE(bufoff, gbase, voff) do { _Pragma("unroll") for (int _i = 0; _i < 2; ++_i) \
        __builtin_amdgcn_global_load_lds((const unsigned*)((const char*)(gbase) + (voff)[_i]), (LAS unsigned*)(lds + (bufoff) + ldsw + _i * 8192), 16, 0, 0); } while (0)
#define PG8_LDA(dst, b, h) do { _Pragma("unroll") for (int m = 0; m < 4; ++m) _Pragma("unroll") for (int k = 0; k < 2; ++k) dst[m][k] = *(const LAS bf16x8*)(lds + PG8_SA(b, h) + aoff + m * 2048 + k * 1024); } while (0)
#define PG8_LDB(dst, b, h) do { _Pragma("unroll") for (int n = 0; n < 2; ++n) _Pragma("unroll") for (int k = 0; k < 2; ++k) dst[n][k] = *(const LAS bf16x8*)(lds + PG8_SB(b, h) + boff + n * 2048 + k * 1024); } while (0)
#define PG8_MMA(ai, bj, At, Bt) do { __builtin_amdgcn_s_setprio(1); _Pragma("unroll") for (int m = 0; m < 4; ++m) _Pragma("unroll") for (int n = 0; n < 2; ++n) _Pragma("unroll") for (int k = 0; k < 2; ++k) \
        acc[ai][bj][m][n] = __builtin_amdgcn_mfma_f32_16x16x32_bf16(Bt[n][k], At[m][k], acc[ai][bj][m][n], 0, 0, 0); __builtin_amdgcn_s_setprio(0); } while (0)
#define VA1 (Sched::GATHER ? vA1 : vA0)
#define W0 vA0
#define W1 VA1
#define PG8_WAIT_V(n) asm volatile("s_waitcnt vmcnt(" #n ")" ::: "memory")
#define PG8_WAIT_L(n) asm volatile("s_waitcnt lgkmcnt(" #n ")" ::: "memory")
#define PG8_BAR __builtin_amdgcn_s_barrier()
#define PG8_SCHED __builtin_amdgcn_sched_barrier(0)
    Unit cur, nxt; int ui = 0;
    if (!S.next(0, cur)) return;
    f32x4 acc[2][2][4][2];
#pragma unroll
    for (int a = 0; a < 2; ++a)
#pragma unroll
        for (int b = 0; b < 2; ++b)
#pragma unroll
            for (int m = 0; m < 4; ++m)
#pragma unroll
                for (int n = 0; n < 2; ++n) acc[a][b][m][n] = (f32x4){0.f, 0.f, 0.f, 0.f};
    bf16x8 At[4][2], B0[2][2], B1[2][2];
    unsigned vA0[2], vA1[2];
    S.a_off(cur, tid, vA0, vA1);
    const char* cA = S.a_base(cur); const char* cB = S.b_base(cur);
    PG8_STAGE(PG8_SB(0, 0), cB, voffB); PG8_STAGE(PG8_SB(0, 1), cB + hstepB, voffB); PG8_STAGE(PG8_SA(0, 0), cA, vA0); PG8_STAGE(PG8_SA(0, 1), cA + hstepA, VA1);
    if (wr == 1) PG8_BAR;
    PG8_WAIT_V(2); PG8_BAR;
    PG8_STAGE(PG8_SB(1, 0), cB + kstep, voffB); PG8_STAGE(PG8_SA(1, 0), cA + kstep, vA0); PG8_STAGE(PG8_SB(1, 1), cB + hstepB + kstep, voffB);
    PG8_WAIT_V(6); PG8_BAR;
    for (;;) {
        const bool has_next = S.next(ui + 1, nxt);
        const char* nA = has_next ? S.a_base(nxt) : cA; const char* nB = has_next ? S.b_base(nxt) : cB;
        for (int t = 0; t < nt; t += 2) {
            const bool last = (t == nt - 2);
            const char* a1 = cA + (size_t)(t + 1) * kstep;
            const char* a2 = last ? nA : cA + (size_t)(t + 2) * kstep; const char* b2 = last ? nB : cB + (size_t)(t + 2) * kstep;
            const char* a3 = a2 + kstep; const char* b3 = b2 + kstep;
            PG8_LDB(B0, 0, 0); PG8_LDB(B1, 0, 1); PG8_SCHED; PG8_LDA(At, 0, 0); PG8_STAGE(PG8_SA(1, 1), a1 + hstepA, VA1);
            if constexpr (Sched::GATHER) { if (last && has_next) S.a_off(nxt, tid, vA0, vA1); }
            PG8_WAIT_V(8); PG8_WAIT_L(0); PG8_BAR; PG8_MMA(0, 0, At, B0); PG8_MMA(0, 1, At, B1); PG8_BAR; PG8_SCHED;
            PG8_LDA(At, 0, 1); PG8_STAGE(PG8_SB(0, 0), b2, voffB); PG8_STAGE(PG8_SB(0, 1), b2 + hstepB, voffB); PG8_STAGE(PG8_SA(0, 0), a2, W0);
            PG8_WAIT_V(8); PG8_WAIT_L(0); PG8_BAR; PG8_MMA(1, 0, At, B0); PG8_MMA(1, 1, At, B1); PG8_BAR; PG8_SCHED;
            PG8_LDB(B0, 1, 0); PG8_LDB(B1, 1, 1); PG8_SCHED; PG8_LDA(At, 1, 0); PG8_STAGE(PG8_SA(0, 1), a2 + hstepA, W1);
            PG8_WAIT_V(8); PG8_WAIT_L(0); PG8_BAR; PG8_MMA(0, 0, At, B0); PG8_MMA(0, 1, At, B1); PG8_BAR; PG8_SCHED;
            PG8_LDA(At, 1, 1); PG8_STAGE(PG8_SB(1, 0), b3, voffB); PG8_STAGE(PG8_SB(1, 1), b3 + hstepB, voffB); PG8_STAGE(PG8_SA(1, 0), a3, W0);
            PG8_WAIT_V(8); PG8_WAIT_L(0); PG8_BAR; PG8_MMA(1, 0, At, B0); PG8_MMA(1, 1, At, B1); PG8_BAR; PG8_SCHED;
        }
        if constexpr (ALIGN_EPI) { if (wr == 0) PG8_BAR; }
        { int fr_e = fr, fq_e = fq; asm volatile("" : "+v"(fr_e), "+v"(fq_e));
          E(acc, cur, wr, wc, fr_e, fq_e);
#ifdef PROBE_EPI2
          if constexpr (Epi::PROBE2) E(acc, cur, wr, wc, fr_e, fq_e);
#endif
        }
        if (!has_next) break;
        if (E.zero_after(cur)) {
#pragma unroll
        for (int a = 0; a < 2; ++a)
#pragma unroll
            for (int b = 0; b < 2; ++b)
#pragma unroll
                for (int m = 0; m < 4; ++m)
#pragma unroll
                    for (int n = 0; n < 2; ++n) acc[a][b][m][n] = (f32x4){0.f, 0.f, 0.f, 0.f}; }
        cur = nxt; cA = nA; cB = nB; ++ui;
        if constexpr (ALIGN_EPI) { if (wr == 1) PG8_BAR; }
    }
    PG8_WAIT_V(0);
    if constexpr (!ALIGN_EPI) { if (wr == 0) PG8_BAR; }
    PG8_BAR;
#undef PG8_SA
#undef VA1
#undef W0
#undef W1
#undef PG8_SB
#undef PG8_STAGE
#undef PG8_LDA
#undef PG8_LDB
#undef PG8_MMA
#undef PG8_WAIT_V
#undef PG8_WAIT_L
#undef PG8_BAR
#undef PG8_SCHED
}
}
#define XB_TMO      128
#define XB_XCNT(j)  (256  + 64 * (j))
#define XB_XSUB(j)  (1280 + 64 * (j))
#define XB_XGEN(j)  (2304 + 64 * (j))
#define XB_TOP      3328
#define XB_TOPGEN   3392
#define XCD_BAR_WORDS 3456
#define XB_SPIN_CAP (1u << 18)
__device__ __forceinline__ unsigned xb_ld(unsigned* p)              { return __hip_atomic_load(p, __ATOMIC_RELAXED, __HIP_MEMORY_SCOPE_AGENT); }
__device__ __forceinline__ unsigned xb_add(unsigned* p, unsigned v) { return __hip_atomic_fetch_add(p, v, __ATOMIC_RELAXED, __HIP_MEMORY_SCOPE_AGENT); }
__device__ __forceinline__ unsigned xb_xcc_id() { return (unsigned)__builtin_amdgcn_s_getreg((3 << 11) | 20) & 0xFu; }
#define XB_SPIN(cond, bar) do { unsigned _sp = 0; while (cond) { __builtin_amdgcn_s_sleep(1); \
    if ((++_sp & 255u) == 0u) { if (xb_ld(&(bar)[XB_TMO])) break; if (_sp > XB_SPIN_CAP) { atomicAdd(&(bar)[XB_TMO], 1u); break; } } } } while (0)
struct XcdBarrier { unsigned* bar; unsigned x; volatile LAS unsigned* st; };
__device__ __forceinline__ XcdBarrier xcd_barrier_post(unsigned* bar, volatile LAS unsigned* st) {
    XcdBarrier b; b.bar = bar; b.x = xb_xcc_id(); b.st = st;
    if (threadIdx.x == 0) (void)xb_add(&bar[XB_XCNT(b.x)], 1u);
    return b;
}
__device__ __forceinline__ void xcd_barrier_complete(unsigned* bar, unsigned x, unsigned& nloc, unsigned& nx) {
    const unsigned G = gridDim.x * gridDim.y * gridDim.z;
    unsigned sum, cnt, mine, sp = 0u;
    for (;;) {
        sum = 0u; cnt = 0u; mine = 0u;
#pragma unroll
        for (unsigned j = 0; j < 16; ++j) { const unsigned c = xb_ld(&bar[XB_XCNT(j)]); sum += c; cnt += (c > 0u) ? 1u : 0u; mine = (j == x) ? c : mine; }
        if (sum == G) break;
        __builtin_amdgcn_s_sleep(1);
        if ((++sp & 255u) == 0u) { if (xb_ld(&bar[XB_TMO])) break; if (sp > XB_SPIN_CAP) { atomicAdd(&bar[XB_TMO], 1u); break; } }
    }
    nloc = mine > 0u ? mine : 1u; nx = cnt > 0u ? cnt : 1u;
}
__device__ __forceinline__ void xcd_barrier(const XcdBarrier& b, int tid) {
    asm volatile("s_waitcnt vmcnt(0)" ::: "memory");
    __syncthreads();
    if (tid == 0) {
        unsigned* bar = b.bar; asm volatile("" : "+s"(bar));
        __builtin_amdgcn_s_waitcnt(0);
        unsigned nloc = b.st[0], nx = b.st[1];
        if (nloc == 0u) { xcd_barrier_complete(bar, b.x, nloc, nx); b.st[0] = nloc; b.st[1] = nx; }
        const unsigned old = xb_add(&bar[XB_XSUB(b.x)], 1u);
        const unsigned gen = old / nloc;
        if (old + 1u == (gen + 1u) * nloc) {
            __builtin_amdgcn_fence(__ATOMIC_RELEASE, "agent");
            asm volatile("s_waitcnt vmcnt(0)" ::: "memory");
            const unsigned og = xb_add(&bar[XB_TOP], 1u);
            const unsigned tg = og / nx;
            if (og + 1u == (tg + 1u) * nx) xb_add(&bar[XB_TOPGEN], 1u);
            else XB_SPIN(xb_ld(&bar[XB_TOPGEN]) == tg, bar);
            __builtin_amdgcn_fence(__ATOMIC_ACQUIRE, "agent");
            xb_add(&bar[XB_XGEN(b.x)], 1u);
            asm volatile("s_waitcnt vmcnt(0)" ::: "memory");
        } else {
            XB_SPIN(xb_ld(&bar[XB_XGEN(b.x)]) == gen, bar);
            __builtin_amdgcn_fence(__ATOMIC_ACQUIRE, "agent");
            asm volatile("s_waitcnt vmcnt(0)" ::: "memory");
        }
    }
    __syncthreads();
}

struct Args { const float* in[20]; float* out; unsigned char* ws; int ph_lo, ph_hi, use_bar; unsigned reps; };
struct Frame {
    LAS unsigned char* lds;
    unsigned* ctl;
    int wave, vcu, G;
    unsigned char* ws;
};
__device__ __forceinline__ int fresh_lane() { int l_; asm volatile("v_mbcnt_lo_u32_b32 %0, -1, 0\n\tv_mbcnt_hi_u32_b32 %0, -1, %0" : "=v"(l_)); return l_; }
__device__ __forceinline__ const float* arg_in(int i) { asm volatile("" : "+s"(i)); return ((const float* const __attribute__((address_space(4)))*)__builtin_amdgcn_kernarg_segment_ptr())[i]; }
__device__ __forceinline__ unsigned char* arg_ws() { int i = 21; asm volatile("" : "+s"(i)); return ((unsigned char* const __attribute__((address_space(4)))*)__builtin_amdgcn_kernarg_segment_ptr())[i]; }
#define GW_ID(F) ((F).vcu * NWAVES + (F).wave)
#define GW_N(F) ((F).G * NWAVES)

__device__ __forceinline__ void cvt_item(const float* W, int ldw, int k0, int srcc, bf16* WT, size_t out_row0, int ldo, LAS float* scr, int lane) {
    float t[32];
#pragma unroll
    for (int i = 0; i < 32; ++i) { const int kk = 2 * i + (lane >> 5); t[i] = srcc >= 0 ? W[(size_t)(k0 + kk) * ldw + srcc] : 0.f; }
#pragma unroll
    for (int i = 0; i < 32; ++i) { const int kk = 2 * i + (lane >> 5); scr[kk * 33 + (lane & 31)] = t[i]; }
    LDS_WAIT(); asm volatile("" ::: "memory");
    const int c = lane & 7;
#pragma unroll
    for (int j = 0; j < 4; ++j) { const int n = (lane >> 3) + 8 * j; const LAS float* s = scr + (8 * c) * 33 + n;
        v4u o; o.x = pk2(s[0 * 33], s[1 * 33]); o.y = pk2(s[2 * 33], s[3 * 33]); o.z = pk2(s[4 * 33], s[5 * 33]); o.w = pk2(s[6 * 33], s[7 * 33]);
        *(v4u*)(WT + (out_row0 + n) * (size_t)ldo + k0 + 8 * c) = o; }
    LDS_WAIT(); asm volatile("" ::: "memory");
}
__device__ __forceinline__ void ph_convw(const Frame& F, int l) {
    LAS float* scr = (LAS float*)(F.lds + F.wave * 16384);
    const int gw = GW_ID(F), NGW = GW_N(F), lane = fresh_lane(), ln = lane & 31;
    constexpr int I_IN = (PW / 32) * 32, I_BR = 3 * 64 * 16, I_OUT = 64 * 32, I_G = 32 * 16 * 32, I_D = 32 * 64 * 8;
    constexpr int NITEMS = I_IN + I_BR + I_OUT + 2 * I_G + I_D;
    for (int it = gw; it < NITEMS; it += NGW) {
        int r = it;
        if (r < I_IN) { const int kb = r / (PW / 32), nb = r % (PW / 32);
            cvt_item(arg_in(2) + (size_t)l * DM * NIN, NIN, 64 * kb, src_col(32 * nb + ln), (bf16*)(F.ws + WS_WIN), (size_t)32 * nb, DM, scr, lane); continue; }
        r -= I_IN;
        if (r < I_BR) { const int n = r / (64 * 16), q = r % (64 * 16), kb = q / 64, nb = q % 64;
            cvt_item(arg_in(9) + ((size_t)l * 3 + n) * BW * DM, DM, 64 * kb, 32 * nb + ln, (bf16*)(F.ws + WS_WBR) + (size_t)n * DM * BW, (size_t)32 * nb, BW, scr, lane); continue; }
        r -= I_BR;
        if (r < I_OUT) { const int kb = r / 64, nb = r % 64;
            cvt_item(arg_in(10) + (size_t)l * DM * DM, DM, 64 * kb, 32 * nb + ln, (bf16*)(F.ws + WS_WOUT), (size_t)32 * nb, DM, scr, lane); continue; }
        r -= I_OUT;
        if (r < 2 * I_G) { const int up = r >= I_G; if (up) r -= I_G; const int e = r / (16 * 32), q = r % (16 * 32), kb = q / 16, nb = q % 16, f0 = 32 * nb;
            cvt_item(arg_in(up ? 17 : 16) + ((size_t)l * NEXP + e) * DM * DEXP, DEXP, 64 * kb, f0 + ln, (bf16*)(F.ws + WS_WGU) + (size_t)e * 1024 * DM,
                     (size_t)((f0 >> 7) * 256 + (up ? 128 : 0) + (f0 & 127)), DM, scr, lane); continue; }
        r -= 2 * I_G;
        { const int e = r / (64 * 8), q = r % (64 * 8), kb = q / 64, nb = q % 64;
            cvt_item(arg_in(18) + ((size_t)l * NEXP + e) * DEXP * DM, DM, 64 * kb, 32 * nb + ln, (bf16*)(F.ws + WS_WDN) + (size_t)e * DM * DEXP, (size_t)32 * nb, DEXP, scr, lane); }
    }
}

__device__ __forceinline__ int* tokinfo_ptr(const Frame& F) { return (int*)(F.ws + WS_LIST + MiB); }

__device__ __forceinline__ void ph_norm1(const Frame& F, int l) {
    const int gw = GW_ID(F), NGW = GW_N(F), lane = fresh_lane();
    const float* g = arg_in(1) + (size_t)l * DM;
    bf16* XN = (bf16*)(F.ws + WS_XN);
    for (int m = gw; m < NTOK; m += NGW) {
        f32x4 v[8]; float s = 0.f;
        if (l == 0) {
            const f32x4* xr = (const f32x4*)(arg_in(0) + (size_t)m * DM) + lane;
#pragma unroll
            for (int j = 0; j < 8; ++j) v[j] = xr[64 * j];
        } else {
            const f32x4* xr = (const f32x4*)((const float*)(F.ws + WS_X1) + (size_t)m * DM) + lane;
            const v2u* y0 = (const v2u*)((const bf16*)(F.ws + WS_YB) + (size_t)(2 * m) * DM) + lane;
            const v2u* y1 = (const v2u*)((const bf16*)(F.ws + WS_YB) + (size_t)(2 * m + 1) * DM) + lane;
            f32x4* xo = (f32x4*)((float*)(F.ws + WS_XA) + (size_t)m * DM) + lane;
#pragma unroll
            for (int j = 0; j < 8; ++j) { f32x4 x = xr[64 * j]; const v2u a = y0[64 * j], b = y1[64 * j];
                x.x = (x.x + bflo(a.x)) + bflo(b.x); x.y = (x.y + bfhi(a.x)) + bfhi(b.x); x.z = (x.z + bflo(a.y)) + bflo(b.y); x.w = (x.w + bfhi(a.y)) + bfhi(b.y);
                v[j] = x; xo[64 * j] = x; }
        }
#pragma unroll
        for (int j = 0; j < 8; ++j) s += (v[j].x * v[j].x + v[j].y * v[j].y) + (v[j].z * v[j].z + v[j].w * v[j].w);
        const float rstd = 1.0f / sqrtf(wave_sum(s) * (1.f / DM) + EPS);
        v2u* o8 = (v2u*)(XN + (size_t)m * DM) + lane;
        const f32x4* gr = (const f32x4*)g + lane;
#pragma unroll
        for (int j = 0; j < 8; ++j) { const f32x4 gg = gr[64 * j]; v2u o; o.x = pk2(v[j].x * rstd * gg.x, v[j].y * rstd * gg.y); o.y = pk2(v[j].z * rstd * gg.z, v[j].w * rstd * gg.w); o8[64 * j] = o; }
    }
}

__device__ __forceinline__ void ph_final(const Frame& F, float* out) {
    const int gw = GW_ID(F), NGW = GW_N(F), lane = fresh_lane();
    for (int m = gw; m < NTOK; m += NGW) {
        const f32x4* xr = (const f32x4*)((const float*)(F.ws + WS_X1) + (size_t)m * DM) + lane;
        const v2u* y0 = (const v2u*)((const bf16*)(F.ws + WS_YB) + (size_t)(2 * m) * DM) + lane;
        const v2u* y1 = (const v2u*)((const bf16*)(F.ws + WS_YB) + (size_t)(2 * m + 1) * DM) + lane;
        f32x4* xo = (f32x4*)(out + (size_t)m * DM) + lane;
#pragma unroll
        for (int j = 0; j < 8; ++j) { f32x4 x = xr[64 * j]; const v2u a = y0[64 * j], b = y1[64 * j];
            x.x = (x.x + bflo(a.x)) + bflo(b.x); x.y = (x.y + bfhi(a.x)) + bfhi(b.x); x.z = (x.z + bflo(a.y)) + bflo(b.y); x.w = (x.w + bfhi(a.y)) + bfhi(b.y);
            xo[64 * j] = x; }
    }
}

__device__ __forceinline__ void ph_norm2(const Frame& F, int l) {
    const int gw = GW_ID(F), NGW = GW_N(F), lane = fresh_lane();
    const float* g = arg_in(11) + (size_t)l * DM;
    const float* wrg = arg_in(12) + (size_t)l * DM * NGRP; const float* brg = arg_in(13) + l * NGRP;
    const float* wre = arg_in(14) + (size_t)l * DM * NEXP; const float* bre = arg_in(15) + l * NEXP;
    bf16* XN = (bf16*)(F.ws + WS_XN);
    int* list = (int*)(F.ws + WS_LIST); int* tinfo = tokinfo_ptr(F);
    unsigned* ecnt = F.ctl + CW_ECNT + l * NEXP * 64;
    for (int m = gw; m < NTOK; m += NGW) {
        f32x4 v[8]; float s = 0.f;
        const f32x4* xr = (const f32x4*)((const float*)(F.ws + WS_X1) + (size_t)m * DM) + lane;
#pragma unroll
        for (int j = 0; j < 8; ++j) { v[j] = xr[64 * j]; s += (v[j].x * v[j].x + v[j].y * v[j].y) + (v[j].z * v[j].z + v[j].w * v[j].w); }
        const float rstd = 1.0f / sqrtf(wave_sum(s) * (1.f / DM) + EPS);
        v2u* o8 = (v2u*)(XN + (size_t)m * DM) + lane;
        const f32x4* gr = (const f32x4*)g + lane;
#pragma unroll
        for (int j = 0; j < 8; ++j) { const f32x4 gg = gr[64 * j]; v2u o; o.x = pk2(v[j].x * rstd * gg.x, v[j].y * rstd * gg.y); o.y = pk2(v[j].z * rstd * gg.z, v[j].w * rstd * gg.w); o8[64 * j] = o; }
        float lg[36];
#pragma unroll
        for (int q = 0; q < 36; ++q) lg[q] = 0.f;
#pragma unroll 1
        for (int j = 0; j < 8; ++j) { const f32x4 gg = gr[64 * j], xx = xr[64 * j]; f32x4 x; x.x = xx.x * rstd * gg.x; x.y = xx.y * rstd * gg.y; x.z = xx.z * rstd * gg.z; x.w = xx.w * rstd * gg.w;
            const int k0 = 4 * lane + 256 * j;
#pragma unroll
            for (int c = 0; c < 4; ++c) { const float xv = x[c];
                const f32x4 wg = *(const f32x4*)(wrg + (size_t)(k0 + c) * NGRP);
                lg[0] += xv * wg.x; lg[1] += xv * wg.y; lg[2] += xv * wg.z; lg[3] += xv * wg.w;
                const f32x4* we = (const f32x4*)(wre + (size_t)(k0 + c) * NEXP);
#pragma unroll
                for (int q = 0; q < 8; ++q) { const f32x4 w = we[q]; lg[4 + 4 * q] += xv * w.x; lg[5 + 4 * q] += xv * w.y; lg[6 + 4 * q] += xv * w.z; lg[7 + 4 * q] += xv * w.w; } } }
#pragma unroll
        for (int q = 0; q < 36; ++q) lg[q] = wave_sum(lg[q]);
        LAS float* lgL = (LAS float*)(F.lds + F.wave * 256);
        if (lane == 0) {
#pragma unroll
            for (int q = 0; q < 36; ++q) lgL[q] = lg[q];
            int gs = 0; float best = lg[0] + brg[0];
#pragma unroll
            for (int q = 1; q < 4; ++q) { const float t = lg[q] + brg[q]; if (t > best) { best = t; gs = q; } }
            float gm = fmaxf(fmaxf(lg[0], lg[1]), fmaxf(lg[2], lg[3])), gsum = 0.f, gsel = 0.f;
#pragma unroll
            for (int q = 0; q < 4; ++q) { const float e = __expf(lg[q] - gm); gsum += e; gsel = (q == gs) ? e : gsel; }
            const float pg = gsel / gsum;
            LDS_WAIT(); asm volatile("" ::: "memory");
            float ein[8];
#pragma unroll
            for (int q = 0; q < 8; ++q) ein[q] = lgL[4 + gs * 8 + q];
            int e0 = 0, e1 = -1; float b0 = -3.0e38f, b1 = -3.0e38f;
#pragma unroll
            for (int q = 0; q < 8; ++q) { const float t = ein[q] + bre[gs * 8 + q];
                if (t > b0) { b1 = b0; e1 = e0; b0 = t; e0 = q; } else if (t > b1) { b1 = t; e1 = q; } }
            float em = ein[0];
#pragma unroll
            for (int q = 1; q < 8; ++q) em = fmaxf(em, ein[q]);
            float p0 = 0.f, p1 = 0.f;
#pragma unroll
            for (int q = 0; q < 8; ++q) { const float e = __expf(ein[q] - em); p0 = (q == e0) ? e : p0; p1 = (q == e1) ? e : p1; }
            const float w0 = pg * p0 / (p0 + p1), w1 = pg * p1 / (p0 + p1);
            const int x0 = gs * 8 + e0, x1 = gs * 8 + e1;
            const int pos0 = (int)atomicAdd(ecnt + x0 * 64, 1u), pos1 = (int)atomicAdd(ecnt + x1 * 64, 1u);
            list[x0 * NTOK + pos0] = 2 * m; list[x1 * NTOK + pos1] = 2 * m + 1;
            tinfo[m * 8 + 0] = x0; tinfo[m * 8 + 1] = pos0; tinfo[m * 8 + 2] = __float_as_int(w0); tinfo[m * 8 + 3] = 0;
            tinfo[m * 8 + 4] = x1; tinfo[m * 8 + 5] = pos1; tinfo[m * 8 + 6] = __float_as_int(w1); tinfo[m * 8 + 7] = 0;
        }
    }
}

__device__ __forceinline__ void nv_conv(const Frame& F, int l) {
    const bf16* P = (const bf16*)(F.ws + WS_PROJ); float* QK = (float*)(F.ws + WS_TMP);
    const float* cw = arg_in(3) + (size_t)l * 4 * 2048;
    const size_t total = (size_t)NTOK * 2048, stride = (size_t)F.G * NTHR;
    for (size_t i = (size_t)F.vcu * NTHR + (F.wave * 64 + fresh_lane()); i < total; i += stride) {
        const int row = (int)(i >> 11), c = (int)(i & 2047), t = row & (SEQ - 1);
        float a = 0.f;
#pragma unroll
        for (int j = 0; j < 4; ++j) { const int tt = t - 3 + j; if (tt >= 0) a += cw[j * 2048 + c] * bf2f(P[(size_t)(row - 3 + j) * PW + c]); }
        QK[i] = siluf_(a);
    }
}
__device__ __forceinline__ void nv_mlstm(const Frame& F, int l) {
    const bf16* P = (const bf16*)(F.ws + WS_PROJ); const float* QK = (const float*)(F.ws + WS_TMP); float* HR = (float*)(F.ws + WS_TMP + 64 * MiB);
    const int tid = (F.wave * 64 + fresh_lane()), v = tid >> 2, kq = tid & 3;
    for (int bh = F.vcu; bh < BATCH * NH; bh += F.G) {
        const int b = bh >> 3, h = bh & 7;
        const float bi = arg_in(4)[l * NH + h], bfv = arg_in(5)[l * NH + h];
        float C[32], nn[32], m = 0.f;
#pragma unroll
        for (int j = 0; j < 32; ++j) { C[j] = 0.f; nn[j] = 0.f; }
        for (int t = 0; t < SEQ; ++t) {
            const size_t row = (size_t)b * SEQ + t;
            const float it = bf2f(P[row * PW + C_MI + h]) + bi, ft = bf2f(P[row * PW + C_MF + h]) + bfv;
            const float lf = logsigmoidf_(ft);
            const float mn = fmaxf(lf + m, it), ip = __expf(it - mn), fp = __expf(lf + m - mn); m = mn;
            const float vv = bf2f(P[row * PW + C_MV + h * HD + v]);
            const f32x4* qp = (const f32x4*)(QK + row * 2048 + h * HD + kq * 32);
            const f32x4* kp = (const f32x4*)(QK + row * 2048 + 1024 + h * HD + kq * 32);
            float num = 0.f, den = 0.f;
#pragma unroll
            for (int j4 = 0; j4 < 8; ++j4) { const f32x4 q = qp[j4], k = kp[j4];
#pragma unroll
                for (int c = 0; c < 4; ++c) { const int j = 4 * j4 + c; const float qq = q[c] * 0.08838834764831845f;
                    C[j] = fp * C[j] + ip * vv * k[c]; nn[j] = fp * nn[j] + ip * k[c]; num += C[j] * qq; den += nn[j] * qq; } }
            num += __shfl_xor(num, 1); num += __shfl_xor(num, 2); den += __shfl_xor(den, 1); den += __shfl_xor(den, 2);
            if (kq == 0) HR[row * 1024 + h * HD + v] = num / fmaxf(fabsf(den), __expf(-m));
        }
    }
}
__device__ __forceinline__ void nv_mnorm(const Frame& F, int l) {
    const bf16* P = (const bf16*)(F.ws + WS_PROJ); const float* HR = (const float*)(F.ws + WS_TMP + 64 * MiB); bf16* BR = (bf16*)(F.ws + WS_BR);
    const float* g = arg_in(6) + (size_t)l * BW;
    const int gw = GW_ID(F), NGW = GW_N(F), lane = fresh_lane();
    for (int it = gw; it < NTOK * NH; it += NGW) {
        const size_t row = it >> 3; const int h = it & 7, c = h * HD + 2 * lane;
        const float a = HR[row * 1024 + c], b = HR[row * 1024 + c + 1];
        const float r = 1.0f / sqrtf(wave_sum(a * a + b * b) * (1.f / HD) + EPS);
        const float o0 = a * r * g[c] * sigmoidf_(bf2f(P[row * PW + C_MO + c])), o1 = b * r * g[c + 1] * sigmoidf_(bf2f(P[row * PW + C_MO + c + 1]));
        *(unsigned*)(BR + row * 3072 + c) = pk2(o0, o1);
    }
}
__device__ __forceinline__ unsigned fkey(float f) { const unsigned u = __float_as_uint(f); return (u & 0x80000000u) ? ~u : (u | 0x80000000u); }
__device__ __forceinline__ void select_row(const unsigned (&key)[32], int nvalid, unsigned long long* mrow, int lane, LAS unsigned* cand) {
    if (nvalid <= TOPK) {
#pragma unroll
        for (int j = 0; j < 32; ++j) { const unsigned long long b = __ballot(lane + 64 * j < nvalid); if (lane == 0) mrow[j] = b; }
        return;
    }
    unsigned T = 0u; int cT = 2048, cU = 0, bit = 31;
    for (; bit >= 0; --bit) {
        const unsigned cnd = T | (1u << bit); int c = 0;
#pragma unroll
        for (int j = 0; j < 32; ++j) c += __popcll(__ballot(key[j] >= cnd));
        if (c >= TOPK) { T = cnd; cT = c; } else cU = c;
        if (cT - cU <= 64) break;
    }
    if (bit > 0) {
        const unsigned span = 1u << bit; int base = 0;
#pragma unroll
        for (int j = 0; j < 32; ++j) { const bool pr = (key[j] - T) < span; const unsigned long long m = __ballot(pr);
            if (m) { const int pos = base + (int)__builtin_amdgcn_mbcnt_hi((unsigned)(m >> 32), __builtin_amdgcn_mbcnt_lo((unsigned)m, 0u)); if (pr) cand[pos] = key[j]; base += __popcll(m); } }
        LDS_WAIT(); asm volatile("" ::: "memory");
        const int u = cT - cU, kq = TOPK - cU;
        const unsigned my = (lane < u) ? cand[lane] : 0u; int cnt = 0;
        for (int m = 0; m < u; ++m) cnt += (cand[m] > my) ? 1 : 0;
        unsigned best = (lane < u && cnt < kq) ? my : 0xFFFFFFFFu;
#pragma unroll
        for (int o = 1; o < 64; o <<= 1) { const unsigned t = (unsigned)__shfl_xor((int)best, o); best = t < best ? t : best; }
        T = best;
        LDS_WAIT(); asm volatile("" ::: "memory");
    }
    int cgt = 0;
#pragma unroll
    for (int j = 0; j < 32; ++j) cgt += __popcll(__ballot(key[j] > T));
    const int need = TOPK - cgt; int run = 0;
    const unsigned long long below = (lane == 0) ? 0ull : (~0ull >> (64 - lane));
#pragma unroll
    for (int j = 0; j < 32; ++j) {
        const bool eq = key[j] == T; const unsigned long long be = __ballot(eq);
        const int rank = run + __popcll(be & below);
        const bool sel = (key[j] > T) || (eq && rank < need);
        run += __popcll(be);
        const unsigned long long b = __ballot(sel); if (lane == 0) mrow[j] = b;
    }
}
__device__ __forceinline__ void nv_index(const Frame& F) {
    const bf16* P = (const bf16*)(F.ws + WS_PROJ); unsigned long long* MK = (unsigned long long*)(F.ws + WS_MASK);
    LAS float* iqL = (LAS float*)(F.lds + F.wave * 12288); LAS float* scL = iqL + 1024;
    const int gw = GW_ID(F), NGW = GW_N(F), lane = fresh_lane();
    for (int row = gw; row < NTOK; row += NGW) {
        const int t = row & (SEQ - 1), r0 = row - t;
        for (int i = lane; i < 1024; i += 64) iqL[i] = bf2f(P[(size_t)row * PW + C_IQ + i]);
        float w[16];
#pragma unroll
        for (int hh = 0; hh < 16; ++hh) w[hh] = bf2f(P[(size_t)row * PW + C_IW + hh]) * 0.25f;
        LDS_WAIT(); asm volatile("" ::: "memory");
        for (int s = lane; s <= t; s += 64) {
            float d[16];
#pragma unroll
            for (int hh = 0; hh < 16; ++hh) d[hh] = 0.f;
            const v4u* kp = (const v4u*)(P + (size_t)(r0 + s) * PW + C_IK);
#pragma unroll 1
            for (int hf = 0; hf < 2; ++hf) {
                float kr[32];
#pragma unroll
                for (int q = 0; q < 4; ++q) { const v4u x = kp[4 * hf + q]; kr[8 * q] = bflo(x.x); kr[8 * q + 1] = bfhi(x.x); kr[8 * q + 2] = bflo(x.y); kr[8 * q + 3] = bfhi(x.y); kr[8 * q + 4] = bflo(x.z); kr[8 * q + 5] = bfhi(x.z); kr[8 * q + 6] = bflo(x.w); kr[8 * q + 7] = bfhi(x.w); }
#pragma unroll
                for (int hh = 0; hh < 16; ++hh) {
#pragma unroll
                    for (int e = 0; e < 32; ++e) d[hh] += iqL[hh * 64 + hf * 32 + e] * kr[e]; }
            }
            float sc = 0.f;
#pragma unroll
            for (int hh = 0; hh < 16; ++hh) sc += w[hh] * fmaxf(d[hh] * 0.125f, 0.f);
            scL[s] = sc;
        }
        LDS_WAIT(); asm volatile("" ::: "memory");
        unsigned key[32];
#pragma unroll
        for (int j = 0; j < 32; ++j) { const int s = lane + 64 * j; key[j] = (s <= t) ? fkey(scL[s]) : 0u; }
        select_row(key, t + 1, MK + (size_t)row * 32, lane, (LAS unsigned*)scL);
        LDS_WAIT(); asm volatile("" ::: "memory");
    }
}
__device__ __forceinline__ void nv_dsa(const Frame& F, int l) {
    const bf16* P = (const bf16*)(F.ws + WS_PROJ); const unsigned long long* MK = (const unsigned long long*)(F.ws + WS_MASK); bf16* BR = (bf16*)(F.ws + WS_BR);
    const float* qg = arg_in(7) + l * HD; const float* kg = arg_in(8) + l * HD; const float* rb = arg_in(19);
    LAS float* lgL = (LAS float*)(F.lds + F.wave * 2048); LAS int* ixL = (LAS int*)(lgL + 256);
    const int gw = GW_ID(F), NGW = GW_N(F), lane = fresh_lane();
    for (int it = gw; it < NTOK * NH; it += NGW) {
        const int row = it >> 3, h = it & 7, t = row & (SEQ - 1), r0 = row - t, c = h * HD + 2 * lane;
        float q0 = bf2f(P[(size_t)row * PW + C_DQ + c]), q1 = bf2f(P[(size_t)row * PW + C_DQ + c + 1]);
        const float qr = 1.0f / sqrtf(wave_sum(q0 * q0 + q1 * q1) * (1.f / HD) + EPS);
        q0 *= qr * qg[2 * lane]; q1 *= qr * qg[2 * lane + 1];
        const float kg0 = kg[2 * lane], kg1 = kg[2 * lane + 1];
        int cnt = 0; float mx = -3.0e38f;
        for (int wi = 0; wi <= (t >> 6); ++wi) {
            unsigned long long w = MK[(size_t)row * 32 + wi];
            while (w) { const int s = wi * 64 + __builtin_ctzll(w); w &= w - 1;
                const unsigned kk = *(const unsigned*)(P + (size_t)(r0 + s) * PW + C_DK + c);
                const float k0 = bflo(kk), k1 = bfhi(kk);
                const float ss = wave_sum(k0 * k0 + k1 * k1), dd = wave_sum(q0 * k0 * kg0 + q1 * k1 * kg1);
                const float kr = 1.0f / sqrtf(ss * (1.f / HD) + EPS);
                const float lgt = dd * kr * 0.08838834764831845f + rb[t5_bucket(t - s) * NH + h];
                if (lane == 0) { lgL[cnt] = lgt; ixL[cnt] = s; }
                mx = fmaxf(mx, lgt); ++cnt; }
        }
        LDS_WAIT(); asm volatile("" ::: "memory");
        float o0 = 0.f, o1 = 0.f, den = 0.f;
        for (int j = 0; j < cnt; ++j) { const float p = __expf(lgL[j] - mx); const int s = ixL[j];
            const unsigned vv = *(const unsigned*)(P + (size_t)(r0 + s) * PW + C_DV + c);
            o0 += p * bflo(vv); o1 += p * bfhi(vv); den += p; }
        *(unsigned*)(BR + (size_t)row * 3072 + 1024 + c) = pk2(o0 / den, o1 / den);
        LDS_WAIT(); asm volatile("" ::: "memory");
    }
}
__device__ __forceinline__ void nv_sb(const Frame& F) {
    const bf16* P = (const bf16*)(F.ws + WS_PROJ); bf16* BR = (bf16*)(F.ws + WS_BR);
    const int gw = GW_ID(F), NGW = GW_N(F), lane = fresh_lane();
    for (int it = gw; it < NTOK * NH; it += NGW) {
        const int row = it >> 3, h = it & 7, t = row & (SEQ - 1), r0 = row - t, c = h * HD + 2 * lane;
        const unsigned qq = *(const unsigned*)(P + (size_t)row * PW + C_SQ + c);
        const float q0 = bflo(qq) * 0.08838834764831845f, q1 = bfhi(qq) * 0.08838834764831845f;
        float o0 = 0.f, o1 = 0.f, lp = 0.f;
        for (int s = t - 1; s >= 0; --s) {
            const unsigned kk = *(const unsigned*)(P + (size_t)(r0 + s) * PW + C_SK + c);
            const float z = wave_sum(q0 * bflo(kk) + q1 * bfhi(kk));
            const float a = __expf(logsigmoidf_(z) + lp);
            const unsigned vv = *(const unsigned*)(P + (size_t)(r0 + s) * PW + C_SV + c);
            o0 += a * bflo(vv); o1 += a * bfhi(vv);
            lp += logsigmoidf_(-z);
            if (lp < -80.f) break;
        }
        *(unsigned*)(BR + (size_t)row * 3072 + 2048 + c) = pk2(o0, o1);
    }
}
__device__ __forceinline__ void nv_moe(const Frame& F) {
    const bf16* XN = (const bf16*)(F.ws + WS_XN); bf16* YB = (bf16*)(F.ws + WS_YB); const int* tinfo = tokinfo_ptr(F);
    LAS float* xL = (LAS float*)F.lds; LAS float* hL = xL + 2048;
    const int tid = (F.wave * 64 + fresh_lane());
    for (int slot = F.vcu; slot < 2 * NTOK; slot += F.G) {
        const int m = slot >> 1, k = slot & 1; const int e = tinfo[m * 8 + 4 * k]; const float w = __int_as_float(tinfo[m * 8 + 4 * k + 2]);
        __syncthreads();
        for (int i = tid; i < 2048; i += NTHR) xL[i] = bf2f(XN[(size_t)m * DM + i]);
        __syncthreads();
        { const int f = tid; const bf16* wg = (const bf16*)(F.ws + WS_WGU) + ((size_t)e * 1024 + (f >> 7) * 256 + (f & 127)) * DM; const bf16* wu = wg + (size_t)128 * DM;
          float g = 0.f, u = 0.f;
          for (int k8 = 0; k8 < 256; ++k8) { const v4u a = ((const v4u*)wg)[k8], b = ((const v4u*)wu)[k8]; const LAS float* x = xL + 8 * k8;
              g += x[0] * bflo(a.x) + x[1] * bfhi(a.x) + x[2] * bflo(a.y) + x[3] * bfhi(a.y) + x[4] * bflo(a.z) + x[5] * bfhi(a.z) + x[6] * bflo(a.w) + x[7] * bfhi(a.w);
              u += x[0] * bflo(b.x) + x[1] * bfhi(b.x) + x[2] * bflo(b.y) + x[3] * bfhi(b.y) + x[4] * bflo(b.z) + x[5] * bfhi(b.z) + x[6] * bflo(b.w) + x[7] * bfhi(b.w); }
          hL[f] = bf2f((unsigned short)f2bf(siluf_(g) * u)); }
        __syncthreads();
        { float y[4];
#pragma unroll
          for (int c = 0; c < 4; ++c) { const int d = 4 * tid + c; const bf16* wd = (const bf16*)(F.ws + WS_WDN) + ((size_t)e * DM + d) * DEXP; float a = 0.f;
              for (int k8 = 0; k8 < 64; ++k8) { const v4u x = ((const v4u*)wd)[k8]; const LAS float* hh = hL + 8 * k8;
                  a += hh[0] * bflo(x.x) + hh[1] * bfhi(x.x) + hh[2] * bflo(x.y) + hh[3] * bfhi(x.y) + hh[4] * bflo(x.z) + hh[5] * bfhi(x.z) + hh[6] * bflo(x.w) + hh[7] * bfhi(x.w); }
              y[c] = a * w; }
          v2u o; o.x = pk2(y[0], y[1]); o.y = pk2(y[2], y[3]); *(v2u*)(YB + (size_t)slot * DM + 4 * tid) = o; }
    }
}
constexpr int MOE_TAB_OFF = LDSCTL_OFF + 1024;
__device__ __forceinline__ void moe_tables(const Frame& F, int l) {
    LAS int* tp = (LAS int*)(F.lds + MOE_TAB_OFF); LAS int* cn = tp + 40; LAS int* sb = cn + 40;
    __syncthreads();
    if ((F.wave * 64 + fresh_lane()) == 0) { int p = 0, s = 0;
        for (int e = 0; e < NEXP; ++e) { const int c = (int)__hip_atomic_load(F.ctl + CW_ECNT + (l * NEXP + e) * 64, RLX_AGENT); tp[e] = p; cn[e] = c; sb[e] = s; p += (c + 255) >> 8; s += c; }
        tp[NEXP] = p; sb[NEXP] = s; }
    __syncthreads();
}
template <int NT> struct SchedMoeBase {
    const LAS int* tp; const LAS int* cn; const LAS int* sb; int G, c;
    __device__ __forceinline__ bool next(int i, pg8::Unit& u) const {
        const int L = i * G + c, total = tp[NEXP] * NT; if (L >= total) return false;
        const int mt = L / NT; u.pn = L % NT; int e = 0;
#pragma unroll 1
        for (int q = 1; q < NEXP; ++q) e = (tp[q] <= mt) ? q : e;
        u.e = e; u.pm = mt - tp[e]; const int r = cn[e] - 256 * u.pm; u.rows = r < 256 ? r : 256; return true;
    }
};
struct SchedMoeUp : SchedMoeBase<4> {
    static constexpr bool GATHER = true;
    const char* A; const char* B; const int* list;
    __device__ __forceinline__ const char* a_base(const pg8::Unit&) const { return A; }
    __device__ __forceinline__ const char* b_base(const pg8::Unit& u) const { return B + ((size_t)u.e * 1024 + (size_t)u.pn * 256) * DM * 2; }
    __device__ __forceinline__ void a_off(const pg8::Unit& u, int tid, unsigned (&v0)[2], unsigned (&v1)[2]) const {
        int R[2], C[2];
#pragma unroll
        for (int i = 0; i < 2; ++i) pg8::stage_rc(tid * 16 + i * 8192, R[i], C[i]);
        const int* le = list + (size_t)u.e * NTOK + 256 * u.pm;
#pragma unroll
        for (int i = 0; i < 2; ++i) { int r0 = R[i], r1 = R[i] + 128; r0 = r0 < u.rows ? r0 : u.rows - 1; r1 = r1 < u.rows ? r1 : u.rows - 1;
            const int t0 = le[r0] >> 1, t1 = le[r1] >> 1;
            v0[i] = (unsigned)(t0 * DM + C[i]) * 2u; v1[i] = (unsigned)(t1 * DM + C[i]) * 2u; }
    }
};
struct EpiMoeUp {
    static constexpr bool PERM = true;
    static constexpr bool PROBE2 = false;
    __device__ __forceinline__ bool zero_after(const pg8::Unit&) const { return true; }
    bf16* HB; const LAS int* sb;
    __device__ __forceinline__ void operator()(const f32x4 (&acc)[2][2][4][2], const pg8::Unit& u, int wr, int wc, int fr, int fq) const {
        const int col0 = u.pn * 128 + wc * 32 + 8 * fq; const size_t slot0 = (size_t)sb[u.e] + 256 * u.pm;
#pragma unroll
        for (int ai = 0; ai < 2; ++ai)
#pragma unroll
            for (int m = 0; m < 4; ++m) { const int r = ai * 128 + wr * 64 + m * 16 + fr;
                if (r < u.rows) { const f32x4 g0 = acc[ai][0][m][0], g1 = acc[ai][0][m][1], u0 = acc[ai][1][m][0], u1 = acc[ai][1][m][1];
                    v4u w; w.x = cvt_pk_bf16(siluf_(g0[0]) * u0[0], siluf_(g0[1]) * u0[1]); w.y = cvt_pk_bf16(siluf_(g0[2]) * u0[2], siluf_(g0[3]) * u0[3]);
                    w.z = cvt_pk_bf16(siluf_(g1[0]) * u1[0], siluf_(g1[1]) * u1[1]); w.w = cvt_pk_bf16(siluf_(g1[2]) * u1[2], siluf_(g1[3]) * u1[3]);
                    *(v4u*)(HB + (slot0 + r) * DEXP + col0) = w; } }
    }
};
struct SchedMoeDown : SchedMoeBase<8> {
    static constexpr bool GATHER = false;
    const char* A; const char* B;
    __device__ __forceinline__ const char* a_base(const pg8::Unit& u) const { return A + ((size_t)sb[u.e] + 256 * u.pm) * DEXP * 2; }
    __device__ __forceinline__ const char* b_base(const pg8::Unit& u) const { return B + ((size_t)u.e * DM + (size_t)u.pn * 256) * DEXP * 2; }
    __device__ __forceinline__ void a_off(const pg8::Unit&, int tid, unsigned (&v0)[2], unsigned (&v1)[2]) const {
        int R[2], C[2];
#pragma unroll
        for (int i = 0; i < 2; ++i) pg8::stage_rc(tid * 16 + i * 8192, R[i], C[i]);
#pragma unroll
        for (int i = 0; i < 2; ++i) { v0[i] = (unsigned)(R[i] * DEXP + C[i]) * 2u; v1[i] = v0[i] + 128u * DEXP * 2u; } }
};
struct EpiMoeDown {
    static constexpr bool PERM = true;
    static constexpr bool PROBE2 = false;
    __device__ __forceinline__ bool zero_after(const pg8::Unit&) const { return true; }
    bf16* YB; const int* list; const int* tinfo;
    __device__ __forceinline__ void operator()(const f32x4 (&acc)[2][2][4][2], const pg8::Unit& u, int wr, int wc, int fr, int fq) const {
        const int col0 = u.pn * 256 + wc * 32 + 8 * fq; const int* le = list + (size_t)u.e * NTOK + 256 * u.pm;
#pragma unroll
        for (int ai = 0; ai < 2; ++ai)
#pragma unroll
            for (int m = 0; m < 4; ++m) { const int r = ai * 128 + wr * 64 + m * 16 + fr;
                if (r < u.rows) { const int ent = le[r]; const float w = __int_as_float(tinfo[(ent >> 1) * 8 + 4 * (ent & 1) + 2]);
#pragma unroll
                    for (int bj = 0; bj < 2; ++bj) { const f32x4 v0 = acc[ai][bj][m][0] * w, v1 = acc[ai][bj][m][1] * w;
                        v4u o; o.x = cvt_pk_bf16(v0[0], v0[1]); o.y = cvt_pk_bf16(v0[2], v0[3]); o.z = cvt_pk_bf16(v1[0], v1[1]); o.w = cvt_pk_bf16(v1[2], v1[3]);
                        *(v4u*)(YB + (size_t)ent * DM + col0 + bj * 128) = o; } } }
    }
};
#define KSWZ(row, colB) ((row) * 256 + ((colB) ^ (((row) & 7) << 4)))
#define SBAR() __builtin_amdgcn_sched_barrier(0)
__device__ __forceinline__ int crow(int r, int hi) { return (r & 3) + 8 * (r >> 2) + 4 * hi; }
__device__ __forceinline__ void qkt64(f32x16& p0, f32x16& p1, const LAS char* Ks, const bf16x8* qr, int r32, int hi) {
    p0 = f32x16{}; p1 = f32x16{};
#pragma unroll
    for (int d0 = 0; d0 < 8; ++d0) { const int cb = (d0 * 16 + hi * 8) * 2;
        const bf16x8 b0 = *(const LAS bf16x8*)(Ks + KSWZ(r32, cb));
        const bf16x8 b1 = *(const LAS bf16x8*)(Ks + KSWZ(32 + r32, cb));
        p0 = __builtin_amdgcn_mfma_f32_32x32x16_bf16(b0, qr[d0], p0, 0, 0, 0);
        p1 = __builtin_amdgcn_mfma_f32_32x32x16_bf16(b1, qr[d0], p1, 0, 0, 0); }
}
__device__ __forceinline__ void qkt32(f32x16& p0, const LAS char* Ks, const bf16x8* qr, int r32, int hi) {
    p0 = f32x16{};
#pragma unroll
    for (int d0 = 0; d0 < 8; ++d0) { const int cb = (d0 * 16 + hi * 8) * 2;
        const bf16x8 b0 = *(const LAS bf16x8*)(Ks + KSWZ(r32, cb));
        p0 = __builtin_amdgcn_mfma_f32_32x32x16_bf16(b0, qr[d0], p0, 0, 0, 0); }
}
__device__ __forceinline__ int v_st(int k, int c) { const int kk = (k & ~0xC) | ((k & 4) << 1) | ((k & 8) >> 1); return ((kk >> 3) * 4 + (c >> 5)) * 512 + ((kk & 7) * 32 + (c & 31)) * 2; }
__device__ __forceinline__ int v_rd_base(int lane) { return ((lane & 3) << 3) | (((lane >> 2) & 3) << 6) | (((lane >> 4) & 1) << 5) | (((lane >> 5) & 1) << 8); }
constexpr int v_rd_off(int d0, int ks, int half) { return d0 * 512 + ks * 4096 + half * 2048; }
template <int OFF> __device__ __forceinline__ s16x4 tr_read(int vb) {
    s16x4 r; asm volatile("ds_read_b64_tr_b16 %0, %1 offset:%2" : "=&v"(r) : "v"(vb), "i"(OFF) : "memory"); return r;
}
__device__ __forceinline__ s16x4 tr_read_dyn(unsigned addr) { s16x4 r; asm volatile("ds_read_b64_tr_b16 %0, %1" : "=&v"(r) : "v"(addr) : "memory"); return r; }
template <int D0> __device__ __forceinline__ void pv_one(f32x16& od, int vb, bf16x8 pa0, bf16x8 pa1, bf16x8 pa2, bf16x8 pa3) {
    const s16x4 l0 = tr_read<v_rd_off(D0, 0, 0)>(vb), h0 = tr_read<v_rd_off(D0, 0, 1)>(vb), l1 = tr_read<v_rd_off(D0, 1, 0)>(vb), h1 = tr_read<v_rd_off(D0, 1, 1)>(vb);
    const s16x4 l2 = tr_read<v_rd_off(D0, 2, 0)>(vb), h2 = tr_read<v_rd_off(D0, 2, 1)>(vb), l3 = tr_read<v_rd_off(D0, 3, 0)>(vb), h3 = tr_read<v_rd_off(D0, 3, 1)>(vb);
    asm volatile("s_waitcnt lgkmcnt(0)" ::: "memory"); SBAR();
#define PKV(L, H) (bf16x8){L[0], L[1], L[2], L[3], H[0], H[1], H[2], H[3]}
    od = __builtin_amdgcn_mfma_f32_32x32x16_bf16(pa0, PKV(l0, h0), od, 0, 0, 0);
    od = __builtin_amdgcn_mfma_f32_32x32x16_bf16(pa1, PKV(l1, h1), od, 0, 0, 0);
    od = __builtin_amdgcn_mfma_f32_32x32x16_bf16(pa2, PKV(l2, h2), od, 0, 0, 0);
    od = __builtin_amdgcn_mfma_f32_32x32x16_bf16(pa3, PKV(l3, h3), od, 0, 0, 0);
}
template <int D0> __device__ __forceinline__ void pv_one_lo(f32x16& od, int vb, bf16x8 pa0, bf16x8 pa1) {
    const s16x4 l0 = tr_read<v_rd_off(D0, 0, 0)>(vb), h0 = tr_read<v_rd_off(D0, 0, 1)>(vb), l1 = tr_read<v_rd_off(D0, 1, 0)>(vb), h1 = tr_read<v_rd_off(D0, 1, 1)>(vb);
    asm volatile("s_waitcnt lgkmcnt(0)" ::: "memory"); SBAR();
    od = __builtin_amdgcn_mfma_f32_32x32x16_bf16(pa0, PKV(l0, h0), od, 0, 0, 0);
    od = __builtin_amdgcn_mfma_f32_32x32x16_bf16(pa1, PKV(l1, h1), od, 0, 0, 0);
}
__device__ __forceinline__ void pv_all(f32x16* o, int vb, bf16x8 pa0, bf16x8 pa1, bf16x8 pa2, bf16x8 pa3) {
    pv_one<0>(o[0], vb, pa0, pa1, pa2, pa3); pv_one<1>(o[1], vb, pa0, pa1, pa2, pa3); pv_one<2>(o[2], vb, pa0, pa1, pa2, pa3); pv_one<3>(o[3], vb, pa0, pa1, pa2, pa3);
}
#define PK4(P, BASE, OUT) do { unsigned a0_ = cvt_pk_bf16(P[BASE + 0], P[BASE + 1]), a1_ = cvt_pk_bf16(P[BASE + 2], P[BASE + 3]);   \
    unsigned b0_ = cvt_pk_bf16(P[BASE + 4], P[BASE + 5]), b1_ = cvt_pk_bf16(P[BASE + 6], P[BASE + 7]);                              \
    auto r0_ = __builtin_amdgcn_permlane32_swap(a0_, b0_, false, false); auto r1_ = __builtin_amdgcn_permlane32_swap(a1_, b1_, false, false); \
    v4u w_ = {r0_[0], r1_[0], r0_[1], r1_[1]}; OUT = *reinterpret_cast<bf16x8*>(&w_); } while (0)
__device__ __forceinline__ float pair_sum(float v) { auto rr = __builtin_amdgcn_permlane32_swap(__float_as_uint(v), __float_as_uint(v), false, false); return __uint_as_float(rr[0]) + __uint_as_float(rr[1]); }
__device__ __forceinline__ float pair_max(float v) { auto rr = __builtin_amdgcn_permlane32_swap(__float_as_uint(v), __float_as_uint(v), false, false); return fmaxf(__uint_as_float(rr[0]), __uint_as_float(rr[1])); }
__device__ __forceinline__ unsigned off_b(unsigned row, unsigned ch) { return 256u * row + 16u * (ch ^ (((row & 3) << 2) | ((row >> 2) & 3))); }
__device__ __forceinline__ unsigned trb_addr(unsigned lane, unsigned c, unsigned ks, unsigned t) {
    const unsigned h = lane >> 5, blk = (lane >> 4) & 1, q = (lane & 15) >> 2, p = lane & 3;
    return off_b(16 * ks + 8 * h + 4 * t + q, 4 * c + 2 * blk + (p >> 1)) + 8 * (p & 1);
}

constexpr int ML_TAB_OFF = LDSCTL_OFF + 2048;
struct MTabs { LAS float* g; LAS float* b; LAS float* pm; LAS float* G; LAS float* mprev; LAS float* dec; LAS float* fsc; };
__device__ __forceinline__ MTabs mtabs(const Frame& F) { MTabs T; T.g = (LAS float*)(F.lds + ML_TAB_OFF); T.b = T.g + 256; T.pm = T.b + 256; T.G = T.pm + 256; T.mprev = T.G + 4; T.dec = T.mprev + 4; T.fsc = T.dec + 32; return T; }
__device__ __forceinline__ float* gif_ptr(const Frame& F) { return (float*)(F.ws + WS_MSN + 512 * 1024); }
constexpr size_t WS_KC = WS_TMP, WS_QC = WS_TMP + 16 * MiB, WS_GTOK = WS_TMP + 32 * MiB, WS_MSUM = WS_TMP + 33 * MiB, WS_MPREV = WS_MSUM + 65536;
__device__ __forceinline__ void conv8(const bf16* P, const float* cw, size_t row, int t, int col0, int ch0, float sc, float (&o)[8]) {
#pragma unroll
    for (int e = 0; e < 8; ++e) o[e] = 0.f;
#pragma unroll
    for (int j = 0; j < 4; ++j) { const int tt = t - 3 + j;
        if (tt >= 0) { const v4u x = *(const v4u*)(P + (row - 3 + j) * PW + col0); const f32x4 w0 = *(const f32x4*)(cw + j * 2048 + ch0), w1 = *(const f32x4*)(cw + j * 2048 + ch0 + 4);
            o[0] += w0.x * bflo(x.x); o[1] += w0.y * bfhi(x.x); o[2] += w0.z * bflo(x.y); o[3] += w0.w * bfhi(x.y);
            o[4] += w1.x * bflo(x.z); o[5] += w1.y * bfhi(x.z); o[6] += w1.z * bflo(x.w); o[7] += w1.w * bfhi(x.w); } }
#pragma unroll
    for (int e = 0; e < 8; ++e) o[e] = siluf_(o[e]) * sc;
}
__device__ __forceinline__ void ml_delta(const Frame& F, int l) {
    const bf16* P = (const bf16*)(F.ws + WS_PROJ); const float* cw = arg_in(3) + (size_t)l * 4 * 2048;
    float* DEL = (float*)(F.ws + WS_MDEL); float* DN = (float*)(F.ws + WS_MDN);
    bf16* KC = (bf16*)(F.ws + WS_KC); bf16* QC = (bf16*)(F.ws + WS_QC); float* GTOK = (float*)(F.ws + WS_GTOK); float* MSUM = (float*)(F.ws + WS_MSUM);
    const float* gif = gif_ptr(F);
    const int wave = F.wave;
    const MTabs T = mtabs(F);
    for (int blk = F.vcu; blk < 256; blk += F.G) {
        const int tid = F.wave * 64 + fresh_lane();
        const int lane = tid & 63;
        const int bh = blk >> 3, cr = blk & 7, b = bh >> 3, h = bh & 7;
        __syncthreads();
        if (wave < 4) { const int ci = wave, c = 4 * cr + ci; const size_t row = (size_t)b * SEQ + 64 * c + lane;
            const float it = gif[row * 16 + h] + arg_in(4)[l * NH + h], lf = logsigmoidf_(gif[row * 16 + 8 + h] + arg_in(5)[l * NH + h]);
            float bc = lf;
#pragma unroll
            for (int o = 1; o < 64; o <<= 1) { const float t = __shfl_up(bc, o); bc += (lane >= o) ? t : 0.f; }
            const float g = it - bc; float pm = g;
#pragma unroll
            for (int o = 1; o < 64; o <<= 1) { const float t = __shfl_up(pm, o); pm = (lane >= o) ? fmaxf(pm, t) : pm; }
            T.g[ci * 64 + lane] = g; *(f32x4*)(GTOK + (row * 8 + h) * 4) = (f32x4){g, bc, pm, 0.f};
            if (lane == 63) { T.G[ci] = pm; MSUM[(bh * 32 + c) * 2] = bc; MSUM[(bh * 32 + c) * 2 + 1] = pm; } }
        __syncthreads();
#pragma unroll 1
        for (int it = tid; it < 4 * 64 * 16; it += NTHR) { const int ci = it >> 10, s = (it >> 4) & 63, ch = it & 15, t = 64 * (4 * cr + ci) + s; const size_t row = (size_t)b * SEQ + t;
            float kv[8]; conv8(P, cw, row, t, C_MK + h * HD + 8 * ch, 1024 + h * HD + 8 * ch, 1.f, kv);
            v4u o; o.x = pk2(kv[0], kv[1]); o.y = pk2(kv[2], kv[3]); o.z = pk2(kv[4], kv[5]); o.w = pk2(kv[6], kv[7]);
            *(LAS v4u*)(F.lds + ci * 32768 + off_b(s, ch)) = o; *(v4u*)(KC + row * 1024 + h * HD + 8 * ch) = o;
            conv8(P, cw, row, t, C_MQ + h * HD + 8 * ch, h * HD + 8 * ch, 0.08838834764831845f, kv);
            o.x = pk2(kv[0], kv[1]); o.y = pk2(kv[2], kv[3]); o.z = pk2(kv[4], kv[5]); o.w = pk2(kv[6], kv[7]);
            *(v4u*)(QC + row * 1024 + h * HD + 8 * ch) = o;
            const float ws = __expf(T.g[ci * 64 + s] - T.G[ci]);
            const v4u x = *(const v4u*)(P + row * PW + C_MV + h * HD + 8 * ch);
            o.x = pk2(ws * bflo(x.x), ws * bfhi(x.x)); o.y = pk2(ws * bflo(x.y), ws * bfhi(x.y)); o.z = pk2(ws * bflo(x.z), ws * bfhi(x.z)); o.w = pk2(ws * bflo(x.w), ws * bfhi(x.w));
            *(LAS v4u*)(F.lds + ci * 32768 + 16384 + off_b(s, ch)) = o; }
        __syncthreads();
        const int vb = wave >> 1, kh = wave & 1, r32 = lane & 31, hi = lane >> 5;
        const unsigned ldsb = (unsigned)(size_t)F.lds;
#pragma unroll 1
        for (int ci = 0; ci < 4; ++ci) { const int c = 4 * cr + ci; if (c == NCH - 1) break;
            f32x16 a0 = {}, a1 = {};
#pragma unroll
            for (int ks = 0; ks < 4; ++ks) {
                const s16x4 al = tr_read_dyn(ldsb + ci * 32768 + 16384 + trb_addr(lane, vb, ks, 0)), ah = tr_read_dyn(ldsb + ci * 32768 + 16384 + trb_addr(lane, vb, ks, 1));
                const s16x4 bl0 = tr_read_dyn(ldsb + ci * 32768 + trb_addr(lane, 2 * kh, ks, 0)), bh0 = tr_read_dyn(ldsb + ci * 32768 + trb_addr(lane, 2 * kh, ks, 1));
                const s16x4 bl1 = tr_read_dyn(ldsb + ci * 32768 + trb_addr(lane, 2 * kh + 1, ks, 0)), bh1 = tr_read_dyn(ldsb + ci * 32768 + trb_addr(lane, 2 * kh + 1, ks, 1));
                asm volatile("s_waitcnt lgkmcnt(0)" ::: "memory"); SBAR();
                a0 = __builtin_amdgcn_mfma_f32_32x32x16_bf16(PKV(al, ah), PKV(bl0, bh0), a0, 0, 0, 0);
                a1 = __builtin_amdgcn_mfma_f32_32x32x16_bf16(PKV(al, ah), PKV(bl1, bh1), a1, 0, 0, 0); }
            float* dp = DEL + ((size_t)(bh * 32 + c) * 128) * 128;
#pragma unroll
            for (int r = 0; r < 16; ++r) { const int v = 32 * vb + crow(r, hi); dp[(size_t)v * 128 + 64 * kh + r32] = a0[r]; dp[(size_t)v * 128 + 64 * kh + 32 + r32] = a1[r]; }
        }
        { const int ci = tid >> 7, k = tid & 127, c = 4 * cr + ci;
          if (c < NCH - 1) { float a = 0.f; const float G = T.G[ci];
              for (int s = 0; s < 64; ++s) a += __expf(T.g[ci * 64 + s] - G) * bf2f(*(const LAS unsigned short*)(F.lds + ci * 32768 + off_b(s, k >> 3) + 2 * (k & 7)));
              DN[(size_t)(bh * 32 + c) * 128 + k] = a; } }
    }
}
__device__ __forceinline__ void ml_scan(const Frame& F) {
    const float* DEL = (const float*)(F.ws + WS_MDEL); const float* DN = (const float*)(F.ws + WS_MDN); const float* MSUM = (const float*)(F.ws + WS_MSUM);
    bf16* ST = (bf16*)(F.ws + WS_MST); float* SN = (float*)(F.ws + WS_MSN); float* MPREV = (float*)(F.ws + WS_MPREV);
    const MTabs T = mtabs(F);
    for (int blk = F.vcu; blk < 256; blk += F.G) {
        const int tid = F.wave * 64 + fresh_lane(); const int bh = blk >> 3, part = blk & 7;
        __syncthreads();
        if (tid == 0) { float m = 0.f;
            for (int c = 0; c < NCH; ++c) { const float be = MSUM[(bh * 32 + c) * 2], G = MSUM[(bh * 32 + c) * 2 + 1], me = fmaxf(m, G);
                T.dec[c] = __expf(m - me); T.fsc[c] = __expf(G - me); if (part == 0) MPREV[bh * 32 + c] = m; m = be + me; } }
        __syncthreads();
        const int q = part * 512 + tid; f32x4 acc = {0.f, 0.f, 0.f, 0.f};
#pragma unroll 4
        for (int c = 0; c < NCH - 1; ++c) { const f32x4 x = *(const f32x4*)(DEL + ((size_t)(bh * 32 + c) * 4096 + q) * 4);
            acc = acc * T.dec[c] + x * T.fsc[c]; v2u o; o.x = pk2(acc.x, acc.y); o.y = pk2(acc.z, acc.w); *(v2u*)(ST + ((size_t)(bh * 32 + c + 1) * 4096 + q) * 4) = o; }
        if (part == 0 && tid < 128) { float a = 0.f;
            for (int c = 0; c < NCH - 1; ++c) { a = a * T.dec[c] + T.fsc[c] * DN[(size_t)(bh * 32 + c) * 128 + tid]; SN[(size_t)(bh * 32 + c + 1) * 128 + tid] = a; } }
    }
}
__device__ __forceinline__ void ml_out_unit(const Frame& F, int l, int blk) {
    const bf16* P = (const bf16*)(F.ws + WS_PROJ); bf16* BR = (bf16*)(F.ws + WS_BR);
    const bf16* KC = (const bf16*)(F.ws + WS_KC); const bf16* QC = (const bf16*)(F.ws + WS_QC); const float* GTOK = (const float*)(F.ws + WS_GTOK); const float* MPREV = (const float*)(F.ws + WS_MPREV);
    const bf16* ST = (const bf16*)(F.ws + WS_MST); const float* SN = (const float*)(F.ws + WS_MSN); const float* gain = arg_in(6) + (size_t)l * BW;
    const int wave = F.wave;
    const MTabs T = mtabs(F);
    LAS float* rowL = (LAS float*)(F.lds + ML_TAB_OFF + 4096) + wave * 32;
    {
        const int tid = F.wave * 64 + fresh_lane();
        const int lane = tid & 63, r32 = lane & 31, hi = lane >> 5;
        const int bh = blk >> 3, cr = blk & 7, b = bh >> 3, h = bh & 7;
        __syncthreads();
#pragma unroll 2
        for (int it = tid; it < 4 * 64 * 16; it += NTHR) { const int ci = it >> 10, s = (it >> 4) & 63, ch = it & 15; const size_t row = (size_t)b * SEQ + 64 * (4 * cr + ci) + s;
            *(LAS v4u*)(F.lds + ci * 32768 + KSWZ(s, ch * 16)) = *(const v4u*)(KC + row * 1024 + h * HD + 8 * ch);
            *(LAS v4u*)(F.lds + ci * 32768 + 16384 + v_st(s, ch * 8)) = *(const v4u*)(P + row * PW + C_MV + h * HD + 8 * ch); }
        if (tid < 256) { const size_t row = (size_t)b * SEQ + 256 * cr + tid; const f32x4 gv = *(const f32x4*)(GTOK + (row * 8 + h) * 4); T.g[tid] = gv.x; T.b[tid] = gv.y; T.pm[tid] = gv.z; }
        if (tid < 4) T.mprev[tid] = MPREV[bh * 32 + 4 * cr + tid];
        __syncthreads();
        const int ci = wave >> 1, rh = wave & 1, c = 4 * cr + ci, tau = 32 * rh + r32; const size_t row = (size_t)b * SEQ + 64 * c + tau;
        bf16x8 qr[8];
#pragma unroll
        for (int d0 = 0; d0 < 8; ++d0) qr[d0] = *(const bf16x8*)(QC + row * 1024 + h * HD + 16 * d0 + 8 * hi);
        const float mprev = T.mprev[ci], Mt = fmaxf(mprev, T.pm[ci * 64 + tau]), winter = __expf(mprev - Mt), flo = __expf(-T.b[ci * 64 + tau] - Mt);
        const LAS char* Kc = (const LAS char*)(F.lds + ci * 32768);
        const int vbase = (int)(size_t)(F.lds + ci * 32768 + 16384) + v_rd_base(lane);
        f32x16 o[4] = {}; f32x16 p0, p1; float ps = 0.f; bf16x8 pa0, pa1, pa2, pa3;
        const LAS f32x4* g4 = (const LAS f32x4*)(T.g + ci * 64);
        if (rh == 0) { qkt32(p0, Kc, qr, r32, hi);
#pragma unroll
            for (int q = 0; q < 4; ++q) { const f32x4 gg = g4[2 * q + hi];
#pragma unroll
                for (int e = 0; e < 4; ++e) { const int r = 4 * q + e, s = crow(r, hi); const float wgt = (s <= tau) ? __expf(gg[e] - Mt) : 0.f; p0[r] *= wgt; ps += p0[r]; } }
            PK4(p0, 0, pa0); PK4(p0, 8, pa1);
            pv_one_lo<0>(o[0], vbase, pa0, pa1); pv_one_lo<1>(o[1], vbase, pa0, pa1); pv_one_lo<2>(o[2], vbase, pa0, pa1); pv_one_lo<3>(o[3], vbase, pa0, pa1);
        } else { qkt64(p0, p1, Kc, qr, r32, hi);
#pragma unroll
            for (int q = 0; q < 4; ++q) { const f32x4 gg = g4[2 * q + hi], gh = g4[8 + 2 * q + hi];
#pragma unroll
                for (int e = 0; e < 4; ++e) { const int r = 4 * q + e, s = crow(r, hi); p0[r] *= __expf(gg[e] - Mt); ps += p0[r];
                    const float wgt = (32 + s <= tau) ? __expf(gh[e] - Mt) : 0.f; p1[r] *= wgt; ps += p1[r]; } }
            PK4(p0, 0, pa0); PK4(p0, 8, pa1); PK4(p1, 0, pa2); PK4(p1, 8, pa3);
            pv_all(o, vbase, pa0, pa1, pa2, pa3);
        }
        ps = pair_sum(ps);
        float nq = 0.f;
        if (c > 0) {
            const bf16* Sc = ST + (size_t)(bh * 32 + c) * 16384; const float* nc = SN + (size_t)(bh * 32 + c) * 128;
#pragma unroll
            for (int ks = 0; ks < 8; ++ks) { const v4u qq = *reinterpret_cast<const v4u*>(&qr[ks]);
                const f32x4 n0 = *(const f32x4*)(nc + 16 * ks + 8 * hi), n1 = *(const f32x4*)(nc + 16 * ks + 8 * hi + 4);
                nq += bflo(qq.x) * n0.x + bfhi(qq.x) * n0.y + bflo(qq.y) * n0.z + bfhi(qq.y) * n0.w + bflo(qq.z) * n1.x + bfhi(qq.z) * n1.y + bflo(qq.w) * n1.z + bfhi(qq.w) * n1.w;
                v4u sq; sq.x = pk2(bflo(qq.x) * winter, bfhi(qq.x) * winter); sq.y = pk2(bflo(qq.y) * winter, bfhi(qq.y) * winter); sq.z = pk2(bflo(qq.z) * winter, bfhi(qq.z) * winter); sq.w = pk2(bflo(qq.w) * winter, bfhi(qq.w) * winter);
                const bf16x8 qs = *reinterpret_cast<const bf16x8*>(&sq);
#pragma unroll
                for (int d0 = 0; d0 < 4; ++d0) { const bf16x8 cf = *(const bf16x8*)(Sc + (size_t)(32 * d0 + r32) * 128 + 16 * ks + 8 * hi);
                    o[d0] = __builtin_amdgcn_mfma_f32_32x32x16_bf16(qs, cf, o[d0], 0, 0, 0); }
                asm volatile("" ::: "memory"); }
            nq = pair_sum(nq);
        }
        const float den = winter * nq + ps, rinv = 1.0f / fmaxf(fabsf(den), flo);
        if (hi == 0) rowL[r32] = rinv;
        LDS_WAIT(); asm volatile("" ::: "memory");
        float ss[16];
#pragma unroll
        for (int r = 0; r < 16; ++r) { const float ri = rowL[crow(r, hi)]; float a = 0.f;
#pragma unroll
            for (int d0 = 0; d0 < 4; ++d0) { o[d0][r] *= ri; a += o[d0][r] * o[d0][r]; }
            ss[r] = a; }
#pragma unroll
        for (int r = 0; r < 16; ++r) {
#pragma unroll
            for (int of = 1; of < 32; of <<= 1) ss[r] += __shfl_xor(ss[r], of);
            ss[r] = 1.0f / sqrtf(ss[r] * (1.f / HD) + EPS); }
        const size_t row0 = (size_t)b * SEQ + 64 * c + 32 * rh;
#pragma unroll
        for (int d0 = 0; d0 < 4; ++d0) { const int col = h * HD + 32 * d0 + r32; const float gn = gain[col];
#pragma unroll
            for (int r = 0; r < 16; ++r) { const size_t rr = row0 + crow(r, hi);
                const float og = sigmoidf_(bf2f(P[rr * PW + C_MO + col]));
                BR[rr * 3072 + col] = (bf16)f2bf(o[d0][r] * ss[r] * gn * og); }
            asm volatile("" ::: "memory"); }
    }
}
__device__ __forceinline__ void ml_out(const Frame& F, int l) { for (int blk = F.vcu; blk < 256; blk += F.G) ml_out_unit(F, l, blk); __syncthreads(); }
__device__ __forceinline__ void ph_norm2_mfma(const Frame& F, int l) {
    const float* g = arg_in(11) + (size_t)l * DM;
    const float* wrg = arg_in(12) + (size_t)l * DM * NGRP; const float* brg = arg_in(13) + l * NGRP;
    const float* wre = arg_in(14) + (size_t)l * DM * NEXP; const float* bre = arg_in(15) + l * NEXP;
    const float* X1 = (const float*)(F.ws + WS_X1); bf16* XN = (bf16*)(F.ws + WS_XN);
    int* list = (int*)(F.ws + WS_LIST); int* tinfo = tokinfo_ptr(F);
    unsigned* ecnt = F.ctl + CW_ECNT + l * NEXP * 64;
    LAS float* PL = (LAS float*)F.lds;
    LAS float* LG = PL + 8 * 2048;
    LAS float* RS = LG + 32 * 36;
    for (int blk = F.vcu; blk < NTOK / 32; blk += F.G) {
        const int lane = fresh_lane(), wave = F.wave, tid = wave * 64 + lane; const int m0 = blk * 32;
        __syncthreads();
#pragma unroll 1
        for (int q = 0; q < 4; ++q) { const int m = m0 + 4 * wave + q;
            f32x4 v[8]; float s = 0.f;
            const f32x4* xr = (const f32x4*)(X1 + (size_t)m * DM) + lane;
#pragma unroll
            for (int j = 0; j < 8; ++j) { v[j] = xr[64 * j]; s += (v[j].x * v[j].x + v[j].y * v[j].y) + (v[j].z * v[j].z + v[j].w * v[j].w); }
            const float rstd = 1.0f / sqrtf(wave_sum(s) * (1.f / DM) + EPS);
            v2u* o8 = (v2u*)(XN + (size_t)m * DM) + lane; const f32x4* gr = (const f32x4*)g + lane;
#pragma unroll
            for (int j = 0; j < 8; ++j) { const f32x4 gg = gr[64 * j]; v2u o; o.x = pk2(v[j].x * rstd * gg.x, v[j].y * rstd * gg.y); o.y = pk2(v[j].z * rstd * gg.z, v[j].w * rstd * gg.w); o8[64 * j] = o; }
            if (lane == 0) RS[4 * wave + q] = rstd; }
        { const int i = lane & 31, h = lane >> 5, kb = 256 * wave + 128 * h;
          f32x16 aE = {}, aG = {};
          const float* xp = X1 + (size_t)(m0 + i) * DM + kb; const float* gp = g + kb;
          const float* we = wre + (size_t)kb * NEXP + i; const float* wg = wrg + (size_t)kb * NGRP + (i & 3);
#pragma unroll 2
          for (int s4 = 0; s4 < 32; ++s4) { const f32x4 xv = *(const f32x4*)(xp + 4 * s4), gv = *(const f32x4*)(gp + 4 * s4);
#pragma unroll
              for (int c = 0; c < 4; ++c) { const int s = 4 * s4 + c; const float gk = gv[c];
                  const float be = we[(size_t)s * NEXP] * gk; const float bg = (i < 4) ? wg[(size_t)s * NGRP] * gk : 0.f;
                  aE = __builtin_amdgcn_mfma_f32_32x32x2f32(xv[c], be, aE, 0, 0, 0);
                  aG = __builtin_amdgcn_mfma_f32_32x32x2f32(xv[c], bg, aG, 0, 0, 0); } }
#pragma unroll
          for (int r = 0; r < 16; ++r) { const int t = crow(r, h); PL[(wave * 2 + 0) * 1024 + t * 32 + i] = aE[r]; PL[(wave * 2 + 1) * 1024 + t * 32 + i] = aG[r]; } }
        __syncthreads();
        for (int idx = tid; idx < 32 * 36; idx += NTHR) { const int t = idx / 36, j = idx % 36; float a = 0.f;
#pragma unroll
            for (int w = 0; w < 8; ++w) a += (j < 4) ? PL[(w * 2 + 1) * 1024 + t * 32 + j] : PL[(w * 2) * 1024 + t * 32 + (j - 4)];
            LG[idx] = a * RS[t]; }
        __syncthreads();
        if (tid < 32) { const int m = m0 + tid; const LAS float* lg = LG + tid * 36;
            int gs = 0; float best = lg[0] + brg[0];
#pragma unroll
            for (int q = 1; q < 4; ++q) { const float t = lg[q] + brg[q]; if (t > best) { best = t; gs = q; } }
            const float gm = fmaxf(fmaxf(lg[0], lg[1]), fmaxf(lg[2], lg[3])); float gsum = 0.f, gsel = 0.f;
#pragma unroll
            for (int q = 0; q < 4; ++q) { const float e = __expf(lg[q] - gm); gsum += e; gsel = (q == gs) ? e : gsel; }
            const float pg = gsel / gsum;
            float ein[8];
#pragma unroll
            for (int q = 0; q < 8; ++q) ein[q] = lg[4 + gs * 8 + q];
            int e0 = 0, e1 = -1; float b0 = -3.0e38f, b1 = -3.0e38f;
#pragma unroll
            for (int q = 0; q < 8; ++q) { const float t = ein[q] + bre[gs * 8 + q];
                if (t > b0) { b1 = b0; e1 = e0; b0 = t; e0 = q; } else if (t > b1) { b1 = t; e1 = q; } }
            float em = ein[0];
#pragma unroll
            for (int q = 1; q < 8; ++q) em = fmaxf(em, ein[q]);
            float p0 = 0.f, p1 = 0.f;
#pragma unroll
            for (int q = 0; q < 8; ++q) { const float e = __expf(ein[q] - em); p0 = (q == e0) ? e : p0; p1 = (q == e1) ? e : p1; }
            const float w0 = pg * p0 / (p0 + p1), w1 = pg * p1 / (p0 + p1);
            const int x0 = gs * 8 + e0, x1 = gs * 8 + e1;
            const int pos0 = (int)atomicAdd(ecnt + x0 * 64, 1u), pos1 = (int)atomicAdd(ecnt + x1 * 64, 1u);
            list[x0 * NTOK + pos0] = 2 * m; list[x1 * NTOK + pos1] = 2 * m + 1;
            tinfo[m * 8 + 0] = x0; tinfo[m * 8 + 1] = pos0; tinfo[m * 8 + 2] = __float_as_int(w0); tinfo[m * 8 + 3] = 0;
            tinfo[m * 8 + 4] = x1; tinfo[m * 8 + 5] = pos1; tinfo[m * 8 + 6] = __float_as_int(w1); tinfo[m * 8 + 7] = 0; }
    }
}
constexpr int AT_TAB_OFF = LDSCTL_OFF + 8192;
__device__ __forceinline__ void dsa_index(const Frame& F) {
    const bf16* P = (const bf16*)(F.ws + WS_PROJ); unsigned long long* MK = (unsigned long long*)(F.ws + WS_MASK);
    LAS float* SL = (LAS float*)(F.lds + F.wave * 16384);
    const int gw = GW_ID(F), NGW = GW_N(F);
    for (int wu = gw; wu < 2048; wu += NGW) {
        const int lane = fresh_lane();
        const int m = lane & 31, hi = lane >> 5, qa = (m >> 2) & 1, head = (m & 3) + 4 * (m >> 3);
        const int b = wu >> 9, jj = wu & 511;
#pragma unroll 1
        for (int half = 0; half < 2; ++half) {
            const int tp = half ? 1023 - jj : jj, t0 = 2 * tp; const size_t rb = (size_t)b * SEQ;
            bf16x8 afr[4];
#pragma unroll
            for (int ks = 0; ks < 4; ++ks) afr[ks] = *(const bf16x8*)(P + (rb + t0 + qa) * PW + C_IQ + head * 64 + 16 * ks + 8 * hi);
            float wr[16];
            { const v4u w0 = *(const v4u*)(P + (rb + t0 + hi) * PW + C_IW), w1 = *(const v4u*)(P + (rb + t0 + hi) * PW + C_IW + 8);
              wr[0] = bflo(w0.x); wr[1] = bfhi(w0.x); wr[2] = bflo(w0.y); wr[3] = bfhi(w0.y); wr[4] = bflo(w0.z); wr[5] = bfhi(w0.z); wr[6] = bflo(w0.w); wr[7] = bfhi(w0.w);
              wr[8] = bflo(w1.x); wr[9] = bfhi(w1.x); wr[10] = bflo(w1.y); wr[11] = bfhi(w1.y); wr[12] = bflo(w1.z); wr[13] = bfhi(w1.z); wr[14] = bflo(w1.w); wr[15] = bfhi(w1.w);
#pragma unroll
              for (int r = 0; r < 16; ++r) wr[r] *= 0.03125f; }
            const int nkb = (t0 + 1) / 32 + 1;
#define IDX_LOAD(B_, kb0_) do { _Pragma("unroll") for (int i = 0; i < 4; ++i) { const int kb = ((kb0_) + i < nkb) ? (kb0_) + i : nkb - 1; const bf16* kp = P + (rb + 32 * kb + m) * PW + C_IK + 8 * hi; \
                _Pragma("unroll") for (int ks = 0; ks < 4; ++ks) B_[i][ks] = *(const bf16x8*)(kp + 16 * ks); } } while (0)
#define IDX_SCORE(B_, kb0_) do { _Pragma("unroll") for (int i = 0; i < 4; ++i) { f32x16 acc = {}; \
                _Pragma("unroll") for (int ks = 0; ks < 4; ++ks) acc = __builtin_amdgcn_mfma_f32_32x32x16_bf16(afr[ks], B_[i][ks], acc, 0, 0, 0); \
                float sc = 0.f; _Pragma("unroll") for (int r = 0; r < 16; ++r) sc += wr[r] * fmaxf(acc[r], 0.f); \
                if ((kb0_) + i < nkb) SL[hi * 2048 + 32 * ((kb0_) + i) + m] = sc; } } while (0)
            { bf16x8 bA[4][4], bB[4][4];
              IDX_LOAD(bA, 0);
#pragma unroll 1
              for (int kb0 = 0; kb0 < nkb; kb0 += 8) {
                  if (kb0 + 4 < nkb) IDX_LOAD(bB, kb0 + 4);
                  asm volatile("" ::: "memory");
                  IDX_SCORE(bA, kb0);
                  if (kb0 + 8 < nkb) IDX_LOAD(bA, kb0 + 8);
                  asm volatile("" ::: "memory");
                  if (kb0 + 4 < nkb) IDX_SCORE(bB, kb0 + 4);
              } }
#undef IDX_LOAD
#undef IDX_SCORE
            LDS_WAIT(); asm volatile("" ::: "memory");
#pragma unroll 1
            for (int q = 0; q < 2; ++q) { const int t = t0 + q; unsigned key[32];
#pragma unroll
                for (int j = 0; j < 32; ++j) { const int s = lane + 64 * j; key[j] = (s <= t) ? fkey(SL[q * 2048 + s]) : 0u; }
#ifndef IDX_SEL_REP
#define IDX_SEL_REP 1
#endif
#pragma unroll 1
                for (int rp = 0; rp < IDX_SEL_REP; ++rp) select_row(key, t + 1, MK + (rb + t) * 32, lane, (LAS unsigned*)(F.lds + AT_TAB_OFF + F.wave * 256)); }
            LDS_WAIT(); asm volatile("" ::: "memory");
        }
    }
}

struct KVRegs { v4u k0, k1, v0, v1; };
__device__ __forceinline__ void kv_load(KVRegs& R, const bf16* Kp, const bf16* Vp, size_t row0, int sr, int sc) {
    R.k0 = *(const v4u*)(Kp + (row0 + sr) * PW + sc); R.k1 = *(const v4u*)(Kp + (row0 + 32 + sr) * PW + sc);
    R.v0 = *(const v4u*)(Vp + (row0 + sr) * PW + sc); R.v1 = *(const v4u*)(Vp + (row0 + 32 + sr) * PW + sc);
}
__device__ __forceinline__ v4u knorm8(v4u x, const float (&kg)[8]) {
    float f[8] = {bflo(x.x), bfhi(x.x), bflo(x.y), bfhi(x.y), bflo(x.z), bfhi(x.z), bflo(x.w), bfhi(x.w)};
    float s = 0.f;
#pragma unroll
    for (int e = 0; e < 8; ++e) s += f[e] * f[e];
    s += __shfl_xor(s, 1); s += __shfl_xor(s, 2); s += __shfl_xor(s, 4); s += __shfl_xor(s, 8);
    const float r = 1.0f / sqrtf(s * (1.f / HD) + EPS);
    v4u o; o.x = pk2(f[0] * r * kg[0], f[1] * r * kg[1]); o.y = pk2(f[2] * r * kg[2], f[3] * r * kg[3]); o.z = pk2(f[4] * r * kg[4], f[5] * r * kg[5]); o.w = pk2(f[6] * r * kg[6], f[7] * r * kg[7]);
    return o;
}
template <bool NORM> __device__ __forceinline__ void kv_write(const KVRegs& R, LAS unsigned char* buf, int sr, int sc, const float (&kg)[8]) {
    *(LAS v4u*)(buf + KSWZ(sr, sc * 2)) = NORM ? knorm8(R.k0, kg) : R.k0; *(LAS v4u*)(buf + KSWZ(32 + sr, sc * 2)) = NORM ? knorm8(R.k1, kg) : R.k1;
    *(LAS v4u*)(buf + 16384 + v_st(sr, sc)) = R.v0; *(LAS v4u*)(buf + 16384 + v_st(32 + sr, sc)) = R.v1;
}

__device__ __forceinline__ void dsa_attn(const Frame& F, int l) {
    const bf16* P = (const bf16*)(F.ws + WS_PROJ); const unsigned long long* MK = (const unsigned long long*)(F.ws + WS_MASK); bf16* BR = (bf16*)(F.ws + WS_BR);
    const float* qg = arg_in(7) + l * HD; const float* kgp = arg_in(8) + l * HD; const float* rbias = arg_in(19);
    LAS float* biasL = (LAS float*)(F.lds + AT_TAB_OFF); LAS float* rowL = biasL + 128 + F.wave * 32;
    constexpr float C = 0.08838834764831845f * 1.4426950408889634f;
    for (int u = F.vcu; u < 256; u += F.G) {
        const int tid = F.wave * 64 + fresh_lane();
        const int lane = tid & 63, wave = F.wave, r32 = lane & 31, hi = lane >> 5, sr = tid >> 4, sc = (tid & 15) * 8;
        const int b = u >> 6, h = (u >> 3) & 7, qb = 7 - (u & 7), q0 = qb * 256, NT = 4 * (qb + 1); const size_t rb = (size_t)b * SEQ;
        __syncthreads();
        if (tid < 128) biasL[tid] = rbias[t5_bucket(tid) * NH + h] * 1.4426950408889634f;
        float kg[8];
#pragma unroll
        for (int e = 0; e < 8; ++e) kg[e] = kgp[sc + e];
        const int tq = q0 + 32 * wave + r32; bf16x8 qr[8];
        { v4u xs[8]; float s = 0.f;
#pragma unroll
          for (int d0 = 0; d0 < 8; ++d0) { const v4u x = *(const v4u*)(P + (rb + tq) * PW + C_DQ + h * HD + 16 * d0 + 8 * hi); xs[d0] = x;
              s += bflo(x.x) * bflo(x.x) + bfhi(x.x) * bfhi(x.x) + bflo(x.y) * bflo(x.y) + bfhi(x.y) * bfhi(x.y) + bflo(x.z) * bflo(x.z) + bfhi(x.z) * bfhi(x.z) + bflo(x.w) * bflo(x.w) + bfhi(x.w) * bfhi(x.w); }
          const float r = 1.0f / sqrtf(pair_sum(s) * (1.f / HD) + EPS);
#pragma unroll
          for (int d0 = 0; d0 < 8; ++d0) { const f32x4 g0 = *(const f32x4*)(qg + 16 * d0 + 8 * hi), g1 = *(const f32x4*)(qg + 16 * d0 + 8 * hi + 4); const v4u x = xs[d0];
              v4u o; o.x = pk2(bflo(x.x) * r * g0.x, bfhi(x.x) * r * g0.y); o.y = pk2(bflo(x.y) * r * g0.z, bfhi(x.y) * r * g0.w);
              o.z = pk2(bflo(x.z) * r * g1.x, bfhi(x.z) * r * g1.y); o.w = pk2(bflo(x.w) * r * g1.z, bfhi(x.w) * r * g1.w); qr[d0] = *reinterpret_cast<bf16x8*>(&o); } }
        const bf16* Kp = P + C_DK + h * HD; const bf16* Vp = P + C_DV + h * HD;
        KVRegs R; kv_load(R, Kp, Vp, rb, sr, sc); kv_write<true>(R, F.lds, sr, sc, kg);
        __syncthreads();
        float m_reg = -1e30f, l_reg = 0.f; f32x16 o[4] = {};
        const float b31 = biasL[127];
        for (int j = 0; j < NT; ++j) {
            LAS unsigned char* buf = F.lds + (j & 1) * 32768;
            if (j + 1 < NT) kv_load(R, Kp, Vp, rb + 64 * (j + 1), sr, sc);
            if (64 * j <= q0 + 32 * wave + 31) {
                const unsigned long long mw = MK[(rb + tq) * 32 + j]; const unsigned mlo = (unsigned)mw, mhi = (unsigned)(mw >> 32);
                f32x16 p0, p1; qkt64(p0, p1, (const LAS char*)buf, qr, r32, hi);
                const int rel0 = tq - 64 * j;
                const bool nearb = (q0 + 32 * wave - (64 * j + 63)) < 113;
                float pmax = -1e30f;
#pragma unroll
                for (int r = 0; r < 16; ++r) { const int kk = crow(r, hi);
                    float b0 = b31, b1 = b31;
                    if (nearb) { int i0 = rel0 - kk, i1 = rel0 - kk - 32; i0 = i0 < 0 ? 0 : (i0 > 127 ? 127 : i0); i1 = i1 < 0 ? 0 : (i1 > 127 ? 127 : i1); b0 = biasL[i0]; b1 = biasL[i1]; }
                    p0[r] = ((mlo >> kk) & 1u) ? fmaf(p0[r], C, b0) : -1e30f; p1[r] = ((mhi >> kk) & 1u) ? fmaf(p1[r], C, b1) : -1e30f;
                    pmax = fmaxf(pmax, fmaxf(p0[r], p1[r])); }
                pmax = pair_max(pmax);
                const float mn = fmaxf(m_reg, pmax), alpha = __builtin_amdgcn_exp2f(m_reg - mn); m_reg = mn;
                float ps = 0.f;
#pragma unroll
                for (int r = 0; r < 16; ++r) { const int kk = crow(r, hi);
                    p0[r] = ((mlo >> kk) & 1u) ? __builtin_amdgcn_exp2f(p0[r] - mn) : 0.f; p1[r] = ((mhi >> kk) & 1u) ? __builtin_amdgcn_exp2f(p1[r] - mn) : 0.f; ps += p0[r] + p1[r]; }
                l_reg = l_reg * alpha + pair_sum(ps);
                if (__any(alpha < 1.f)) { if (hi == 0) rowL[r32] = alpha; LDS_WAIT(); asm volatile("" ::: "memory");
#pragma unroll
                    for (int r = 0; r < 16; ++r) { const float a = rowL[crow(r, hi)];
#pragma unroll
                        for (int d = 0; d < 4; ++d) o[d][r] *= a; }
                    LDS_WAIT(); asm volatile("" ::: "memory"); }
                bf16x8 pa0, pa1, pa2, pa3; PK4(p0, 0, pa0); PK4(p0, 8, pa1); PK4(p1, 0, pa2); PK4(p1, 8, pa3);
                pv_all(o, (int)(size_t)(buf + 16384) + v_rd_base(lane), pa0, pa1, pa2, pa3);
            }
            if (j + 1 < NT) kv_write<true>(R, F.lds + ((j + 1) & 1) * 32768, sr, sc, kg);
            __syncthreads();
        }
        if (hi == 0) rowL[r32] = 1.0f / l_reg;
        LDS_WAIT(); asm volatile("" ::: "memory");
        const size_t row0 = rb + q0 + 32 * wave;
#pragma unroll
        for (int r = 0; r < 16; ++r) { const float a = rowL[crow(r, hi)]; bf16* op = BR + (row0 + crow(r, hi)) * 3072 + 1024 + h * HD + r32;
#pragma unroll
            for (int d = 0; d < 4; ++d) op[32 * d] = (bf16)f2bf(o[d][r] * a); }
    }
}

__device__ __forceinline__ void sb_attn(const Frame& F) {
    const bf16* P = (const bf16*)(F.ws + WS_PROJ); bf16* BR = (bf16*)(F.ws + WS_BR);
    LAS unsigned* flagL = (LAS unsigned*)(F.lds + AT_TAB_OFF + 2048);
    for (int u = F.vcu; u < 256; u += F.G) {
        const int tid = F.wave * 64 + fresh_lane();
        const int lane = tid & 63, wave = F.wave, r32 = lane & 31, hi = lane >> 5, sr = tid >> 4, sc = (tid & 15) * 8;
        const int b = u >> 6, h = (u >> 3) & 7, qb = u & 7, q0 = qb * 256, NT = 4 * (qb + 1); const size_t rb = (size_t)b * SEQ;
        const float kgd[8] = {1.f, 1.f, 1.f, 1.f, 1.f, 1.f, 1.f, 1.f};
        const int tq = q0 + 32 * wave + r32; bf16x8 qr[8];
#pragma unroll
        for (int d0 = 0; d0 < 8; ++d0) { const v4u x = *(const v4u*)(P + (rb + tq) * PW + C_SQ + h * HD + 16 * d0 + 8 * hi); const float s = 0.08838834764831845f;
            v4u o; o.x = pk2(bflo(x.x) * s, bfhi(x.x) * s); o.y = pk2(bflo(x.y) * s, bfhi(x.y) * s); o.z = pk2(bflo(x.z) * s, bfhi(x.z) * s); o.w = pk2(bflo(x.w) * s, bfhi(x.w) * s); qr[d0] = *reinterpret_cast<bf16x8*>(&o); }
        const bf16* Kp = P + C_SK + h * HD; const bf16* Vp = P + C_SV + h * HD;
        __syncthreads();
        KVRegs R; kv_load(R, Kp, Vp, rb + 64 * (NT - 1), sr, sc); kv_write<false>(R, F.lds, sr, sc, kgd);
        __syncthreads();
        float carry = 1.f; f32x16 o[4] = {};
        int it = 0;
        for (int j = NT - 1; j >= 0; --j, ++it) {
            LAS unsigned char* buf = F.lds + (it & 1) * 32768;
            if (j > 0) kv_load(R, Kp, Vp, rb + 64 * (j - 1), sr, sc);
            if (64 * j < q0 + 32 * wave + 31) {
                f32x16 p0, p1; qkt64(p0, p1, (const LAS char*)buf, qr, r32, hi);
                const int rel0 = tq - 64 * j;
                float To[8];
#pragma unroll
                for (int a = 0; a < 8; ++a) {
                    float n[4], sg[4];
#pragma unroll
                    for (int e = 0; e < 4; ++e) { const int r = 4 * (a & 3) + e, kk = crow(r, hi) + (a >= 4 ? 32 : 0);
                        float z = (a >= 4) ? p1[r] : p0[r]; z = fminf(fmaxf(z, -60.f), 60.f);
                        const float ex = __builtin_amdgcn_exp2f(-z * 1.4426950408889634f), s1 = __builtin_amdgcn_rcpf(1.f + ex);
                        const bool ok = kk < rel0; sg[e] = ok ? s1 : 0.f; n[e] = ok ? ex * s1 : 1.f; }
                    const float e2 = n[3], e1 = e2 * n[2], e0 = e1 * n[1]; To[a] = e0 * n[0];
                    if (a >= 4) { p1[4 * (a & 3) + 3] = sg[3]; p1[4 * (a & 3) + 2] = sg[2] * e2; p1[4 * (a & 3) + 1] = sg[1] * e1; p1[4 * (a & 3)] = sg[0] * e0; }
                    else { p0[4 * a + 3] = sg[3]; p0[4 * a + 2] = sg[2] * e2; p0[4 * a + 1] = sg[1] * e1; p0[4 * a] = sg[0] * e0; }
                }
                float run = carry;
#pragma unroll
                for (int a = 7; a >= 0; --a) { const float Tp = __shfl_xor(To[a], 32);
                    const float E = hi ? run : run * Tp; run = run * To[a] * Tp;
#pragma unroll
                    for (int e = 0; e < 4; ++e) { if (a >= 4) p1[4 * (a & 3) + e] *= E; else p0[4 * a + e] *= E; } }
                carry = run;
                bf16x8 pa0, pa1, pa2, pa3; PK4(p0, 0, pa0); PK4(p0, 8, pa1); PK4(p1, 0, pa2); PK4(p1, 8, pa3);
                pv_all(o, (int)(size_t)(buf + 16384) + v_rd_base(lane), pa0, pa1, pa2, pa3);
            }
            if (lane == 0) flagL[(it & 1) * 8 + wave] = __all(carry < 1e-30f) ? 1u : 0u;
            if (j > 0) kv_write<false>(R, F.lds + ((it + 1) & 1) * 32768, sr, sc, kgd);
            __syncthreads();
            unsigned done = 1u;
#pragma unroll
            for (int w = 0; w < 8; ++w) done &= flagL[(it & 1) * 8 + w];
            if (done) break;
        }
        const size_t row0 = rb + q0 + 32 * wave;
#pragma unroll
        for (int r = 0; r < 16; ++r) { bf16* op = BR + (row0 + crow(r, hi)) * 3072 + 2048 + h * HD + r32;
#pragma unroll
            for (int d = 0; d < 4; ++d) op[32 * d] = (bf16)f2bf(o[d][r]); }
    }
}
template <int LDA, int LDB> struct SchedDense {
    static constexpr bool GATHER = false;
    pg8::TileOrder T; const char* A; const char* B;
    __device__ __forceinline__ bool next(int i, pg8::Unit& u) const { u.e = 0; u.rows = 256; return T.tile(i, u.pm, u.pn); }
    __device__ __forceinline__ const char* a_base(const pg8::Unit& u) const { return A + (size_t)u.pm * 256 * LDA * 2; }
    __device__ __forceinline__ const char* b_base(const pg8::Unit& u) const { return B + (size_t)u.pn * 256 * LDB * 2; }
    __device__ __forceinline__ void a_off(const pg8::Unit&, int tid, unsigned (&v0)[2], unsigned (&v1)[2]) const {
        int R[2], C[2];
#pragma unroll
        for (int i = 0; i < 2; ++i) pg8::stage_rc(tid * 16 + i * 8192, R[i], C[i]);
#pragma unroll
        for (int i = 0; i < 2; ++i) { v0[i] = (unsigned)(R[i] * LDA + C[i]) * 2u; v1[i] = v0[i] + 128u * LDA * 2u; } }
};
struct EpiProj {
    static constexpr bool PERM = true;
    static constexpr bool PROBE2 = true;
    __device__ __forceinline__ bool zero_after(const pg8::Unit&) const { return true; }
    bf16* O; float* GIF;
    __device__ __forceinline__ void operator()(const f32x4 (&acc)[2][2][4][2], const pg8::Unit& u, int wr, int wc, int fr, int fq) const {
        const int row0 = u.pm * 256 + wr * 64 + fr, col0 = u.pn * 256 + wc * 32 + 8 * fq;
#pragma unroll
        for (int ai = 0; ai < 2; ++ai)
#pragma unroll
            for (int m = 0; m < 4; ++m) { bf16* rowp = O + (size_t)(row0 + ai * 128 + m * 16) * PW + col0;
#pragma unroll
                for (int bj = 0; bj < 2; ++bj) { const f32x4 v0 = acc[ai][bj][m][0], v1 = acc[ai][bj][m][1];
                    v4u w; w.x = cvt_pk_bf16(v0[0], v0[1]); w.y = cvt_pk_bf16(v0[2], v0[3]); w.z = cvt_pk_bf16(v1[0], v1[1]); w.w = cvt_pk_bf16(v1[2], v1[3]);
                    *(v4u*)(rowp + bj * 128) = w;
                    if (u.pn == PW / 256 - 1 && bj == 0 && wc == 0 && fq < 2) { float* gp = GIF + (size_t)(row0 + ai * 128 + m * 16) * 16 + 8 * fq; *(f32x4*)gp = v0; *(f32x4*)(gp + 4) = v1; } } }
    }
};
#ifdef PROBE_GEMM
template <int MODE> struct SchedProbe {
    static constexpr bool GATHER = false;
    pg8::TileOrder T; const char* A; const char* B;
    __device__ __forceinline__ bool next(int i, pg8::Unit& u) const { u.e = 0; u.rows = 256; return T.tile(i, u.pm, u.pn); }
    __device__ __forceinline__ const char* a_base(const pg8::Unit& u) const { return A + (size_t)((MODE & 2) ? 0 : u.pm) * 256 * DM * 2; }
    __device__ __forceinline__ const char* b_base(const pg8::Unit& u) const { return B + (size_t)((MODE & 1) ? 0 : u.pn) * 256 * DM * 2; }
    __device__ __forceinline__ void a_off(const pg8::Unit&, int tid, unsigned (&v0)[2], unsigned (&v1)[2]) const {
        int R[2], C[2];
#pragma unroll
        for (int i = 0; i < 2; ++i) pg8::stage_rc(tid * 16 + i * 8192, R[i], C[i]);
#pragma unroll
        for (int i = 0; i < 2; ++i) { v0[i] = (unsigned)(R[i] * DM + C[i]) * 2u; v1[i] = v0[i] + 128u * DM * 2u; } }
};
struct EpiProbe {
    static constexpr bool PERM = true;
    static constexpr bool PROBE2 = false;
    __device__ __forceinline__ bool zero_after(const pg8::Unit&) const { return true; }
    bf16* O;
    __device__ __forceinline__ void operator()(const f32x4 (&acc)[2][2][4][2], const pg8::Unit& u, int wr, int wc, int fr, int fq) const {
        const int row0 = ((u.pm * 256) & 1023) + wr * 64 + fr, col0 = u.pn * 256 + wc * 32 + 8 * fq;
#pragma unroll
        for (int ai = 0; ai < 2; ++ai)
#pragma unroll
            for (int m = 0; m < 4; ++m) { bf16* rowp = O + (size_t)(row0 + ai * 128 + m * 16) * PW + col0;
#pragma unroll
                for (int bj = 0; bj < 2; ++bj) { const f32x4 v0 = acc[ai][bj][m][0], v1 = acc[ai][bj][m][1];
                    v4u w; w.x = cvt_pk_bf16(v0[0], v0[1]); w.y = cvt_pk_bf16(v0[2], v0[3]); w.z = cvt_pk_bf16(v1[0], v1[1]); w.w = cvt_pk_bf16(v1[2], v1[3]);
                    *(v4u*)(rowp + bj * 128) = w; } }
    }
};
#endif
struct SchedBranch {
    static constexpr bool GATHER = false;
    pg8::TileOrder T; const char* A; const char* B;
    __device__ __forceinline__ bool next(int i, pg8::Unit& u) const { u.e = i % 3; u.rows = 256; return T.tile(i / 3, u.pm, u.pn); }
    __device__ __forceinline__ const char* a_base(const pg8::Unit& u) const { return A + ((size_t)u.pm * 256 * 3072 + (size_t)u.e * 1024) * 2; }
    __device__ __forceinline__ const char* b_base(const pg8::Unit& u) const { return B + ((size_t)u.e * 2048 + (size_t)u.pn * 256) * 1024 * 2; }
    __device__ __forceinline__ void a_off(const pg8::Unit&, int tid, unsigned (&v0)[2], unsigned (&v1)[2]) const {
        int R[2], C[2];
#pragma unroll
        for (int i = 0; i < 2; ++i) pg8::stage_rc(tid * 16 + i * 8192, R[i], C[i]);
#pragma unroll
        for (int i = 0; i < 2; ++i) { v0[i] = (unsigned)(R[i] * 3072 + C[i]) * 2u; v1[i] = v0[i] + 128u * 3072u * 2u; } }
};
struct EpiBranch {
    static constexpr bool PERM = true;
    static constexpr bool PROBE2 = false;
    __device__ __forceinline__ bool zero_after(const pg8::Unit& u) const { return u.e == 2; }
    const bf16* P; bf16* O;
    __device__ __forceinline__ void operator()(f32x4 (&acc)[2][2][4][2], const pg8::Unit& u, int wr, int wc, int fr, int fq) const {
        const int row0 = u.pm * 256 + wr * 64 + fr, col0 = u.pn * 256 + wc * 32 + 8 * fq;
#pragma unroll
        for (int ai = 0; ai < 2; ++ai)
#pragma unroll
            for (int m = 0; m < 4; ++m) { const size_t row = (size_t)(row0 + ai * 128 + m * 16);
#pragma unroll
                for (int bj = 0; bj < 2; ++bj) { const int col = col0 + bj * 128;
                    const v4u ga = *(const v4u*)(P + row * PW + C_G + u.e * 2048 + col);
                    float f[8];
                    { const float a[8] = {bflo(ga.x), bfhi(ga.x), bflo(ga.y), bfhi(ga.y), bflo(ga.z), bfhi(ga.z), bflo(ga.w), bfhi(ga.w)};
#pragma unroll
                      for (int e = 0; e < 8; ++e) f[e] = 1.0f / (1.0f + __expf(-fminf(fmaxf(a[e], -30.f), 30.f))); }
                    if (u.e < 2) { const v4u gb = *(const v4u*)(P + row * PW + C_G + (u.e + 1) * 2048 + col);
                        const float b[8] = {bflo(gb.x), bfhi(gb.x), bflo(gb.y), bfhi(gb.y), bflo(gb.z), bfhi(gb.z), bflo(gb.w), bfhi(gb.w)};
#pragma unroll
                        for (int e = 0; e < 8; ++e) f[e] *= 1.0f + __expf(-fminf(fmaxf(b[e], -30.f), 30.f)); }
                    f32x4 v0 = acc[ai][bj][m][0], v1 = acc[ai][bj][m][1];
                    v0[0] *= f[0]; v0[1] *= f[1]; v0[2] *= f[2]; v0[3] *= f[3]; v1[0] *= f[4]; v1[1] *= f[5]; v1[2] *= f[6]; v1[3] *= f[7];
                    if (u.e < 2) { acc[ai][bj][m][0] = v0; acc[ai][bj][m][1] = v1; }
                    else { v4u w; w.x = cvt_pk_bf16(v0[0], v0[1]); w.y = cvt_pk_bf16(v0[2], v0[3]); w.z = cvt_pk_bf16(v1[0], v1[1]); w.w = cvt_pk_bf16(v1[2], v1[3]);
                        *(v4u*)(O + row * DM + col) = w; } } }
    }
};
struct EpiOut {
    static constexpr bool PERM = false;
    static constexpr bool PROBE2 = false;
    __device__ __forceinline__ bool zero_after(const pg8::Unit&) const { return true; }
    const float* base; float* out;
    __device__ __forceinline__ void operator()(const f32x4 (&acc)[2][2][4][2], const pg8::Unit& u, int wr, int wc, int fr, int fq) const {
        const int row0 = u.pm * 256 + wr * 64 + fr, col0 = u.pn * 256 + wc * 32 + 4 * fq;
#pragma unroll
        for (int ai = 0; ai < 2; ++ai)
#pragma unroll
            for (int m = 0; m < 4; ++m) { const size_t off = (size_t)(row0 + ai * 128 + m * 16) * DM + col0;
#pragma unroll
                for (int bj = 0; bj < 2; ++bj)
#pragma unroll
                    for (int n = 0; n < 2; ++n) { const f32x4 bs = *(const f32x4*)(base + off + bj * 128 + n * 16); *(f32x4*)(out + off + bj * 128 + n * 16) = bs + acc[ai][bj][m][n]; } }
    }
};

#ifndef MK_NAIVE_MOE
#define MK_NAIVE_MOE 0
#endif
#ifndef PROBE_MASK
#define PROBE_MASK 0
#endif
#ifndef OFFMASK
#define OFFMASK 0
#endif
#ifndef CVT_FIRST
#define CVT_FIRST 4
#endif
constexpr int PH_PRE = 0, PH_INPROJ = 1, PH_MIXA = 2, PH_MIXB = 3, PH_MIXC = 4, PH_BRANCH = 5, PH_OUT = 6, PH_NORM2 = 7, PH_MOE = 8, PH_MOED = 9, NPH_L = 10,
              PH_FINAL = DEPTH * NPH_L, NPH = PH_FINAL + 1;

__global__ void __launch_bounds__(NTHR, 2) fwd_kernel(Args args) {
    extern __shared__ __attribute__((aligned(16))) unsigned char lds_raw[];
    Frame F;
    F.lds = (LAS unsigned char*)lds_raw;
    F.wave = __builtin_amdgcn_readfirstlane((int)threadIdx.x >> 6);
    const int wave0 = F.wave;
    F.G = gridDim.x; { const int bx = blockIdx.x; F.vcu = (F.G % 8 == 0) ? (bx % 8) * (F.G / 8) + bx / 8 : bx; }
    F.ws = args.ws; F.ctl = (unsigned*)(args.ws + WS_CTL);
    volatile LAS unsigned* MISC = (volatile LAS unsigned*)(F.lds + LDSCTL_OFF);
    for (int u = threadIdx.x; u < (LDS_BYTES - LDSCTL_OFF) / 4; u += NTHR) ((LAS unsigned*)(F.lds + LDSCTL_OFF))[u] = 0u;
    __syncthreads();
    XcdBarrier bar; bar.bar = F.ctl + CW_BAR; bar.x = 0; bar.st = nullptr;
    if (args.use_bar) bar = xcd_barrier_post(F.ctl + CW_BAR, MISC + 8);
    const int lo = args.ph_lo, hi = args.ph_hi;
#define IN(k) (lo <= (k) && (k) < hi)
#define FRESH() do { F.wave = wave0; F.ws = arg_ws(); F.ctl = (unsigned*)(F.ws + WS_CTL); } while (0)
#define SEAM(k) do { if (args.use_bar && IN((k) + 1)) { FRESH(); xcd_barrier(bar, (F.wave * 64 + fresh_lane())); } } while (0)
#define REPS(k) for (int rep_ = 0; rep_ < (int)((args.reps >> (2 * (k))) & 3u); ++rep_)
#define RSYNC() do { if (rep_) __syncthreads(); } while (0)
    { constexpr int l = 0; constexpr int p0 = 0;
        if (IN(p0 + PH_PRE)) { FRESH();
            _Pragma("unroll 1") REPS(0) { RSYNC(); ph_convw(F, l); }
            _Pragma("unroll 1") REPS(1) { RSYNC(); ph_norm1(F, l); }
            SEAM(p0 + PH_PRE); }
        if (IN(p0 + PH_INPROJ)) { FRESH();
            { SchedDense<DM, DM> S; S.T.init(NTOK / 256, PW / 256, F.G, (int)blockIdx.x); S.A = (const char*)(F.ws + WS_XN); S.B = (const char*)(F.ws + WS_WIN);
              EpiProj E{(bf16*)(F.ws + WS_PROJ), gif_ptr(F)};
              _Pragma("unroll 1") REPS(10) { RSYNC(); pg8::gemm_phase<SchedDense<DM, DM>, EpiProj, DM, DM, DM, true>(F.lds, S, E, (F.wave * 64 + fresh_lane())); } }
#ifdef PROBE_GEMM
            { __syncthreads(); SchedProbe<PROBE_GEMM> S; S.T.init(NTOK / 256, PW / 256, F.G, (int)blockIdx.x); S.A = (const char*)(F.ws + WS_XN); S.B = (const char*)(F.ws + WS_WIN);
              EpiProbe E{(bf16*)(F.ws + WS_TMP)};
              pg8::gemm_phase<SchedProbe<PROBE_GEMM>, EpiProbe, DM, DM, DM, true>(F.lds, S, E, (F.wave * 64 + fresh_lane())); }
#endif
            SEAM(p0 + PH_INPROJ); }
        if (IN(p0 + PH_MIXA)) { FRESH();
            _Pragma("unroll 1") REPS(2) { RSYNC(); ml_delta(F, l); }
            __syncthreads();
            _Pragma("unroll 1") REPS(5) { RSYNC(); dsa_index(F); }
            SEAM(p0 + PH_MIXA); }
        if (IN(p0 + PH_MIXB)) { FRESH();
            _Pragma("unroll 1") REPS(3) { RSYNC(); ml_scan(F); }
            __syncthreads();
            _Pragma("unroll 1") REPS(7) { RSYNC(); sb_attn(F); }
            SEAM(p0 + PH_MIXB); }
        if (IN(p0 + PH_MIXC)) { FRESH();
            _Pragma("unroll 1") REPS(6) { RSYNC(); dsa_attn(F, l); }
            __syncthreads();
            _Pragma("unroll 1") REPS(4) { RSYNC(); ml_out(F, l); }
            SEAM(p0 + PH_MIXC); }
        if (IN(p0 + PH_BRANCH)) { FRESH();
            SchedBranch S; S.T.init(NTOK / 256, DM / 256, F.G, (int)blockIdx.x); S.A = (const char*)(F.ws + WS_BR); S.B = (const char*)(F.ws + WS_WBR);
            EpiBranch E{(const bf16*)(F.ws + WS_PROJ), (bf16*)(F.ws + WS_MRG)};
            _Pragma("unroll 1") REPS(11) { RSYNC(); pg8::gemm_phase<SchedBranch, EpiBranch, BW, 3072, BW, true>(F.lds, S, E, (F.wave * 64 + fresh_lane())); }
            SEAM(p0 + PH_BRANCH); }
        if (IN(p0 + PH_OUT)) { FRESH();
            SchedDense<DM, DM> S; S.T.init(NTOK / 256, DM / 256, F.G, (int)blockIdx.x); S.A = (const char*)(F.ws + WS_MRG); S.B = (const char*)(F.ws + WS_WOUT);
            EpiOut E{l == 0 ? arg_in(0) : (const float*)(F.ws + WS_XA), (float*)(F.ws + WS_X1)};
            _Pragma("unroll 1") REPS(12) { RSYNC(); pg8::gemm_phase<SchedDense<DM, DM>, EpiOut, DM, DM, DM, true>(F.lds, S, E, (F.wave * 64 + fresh_lane())); }
            SEAM(p0 + PH_OUT); }
        if (IN(p0 + PH_NORM2)) { FRESH(); _Pragma("unroll 1") REPS(8) { RSYNC(); ph_norm2_mfma(F, l); } SEAM(p0 + PH_NORM2); }
        if (IN(p0 + PH_MOE)) { FRESH();
            moe_tables(F, l);
            SchedMoeUp S; S.tp = (const LAS int*)(F.lds + MOE_TAB_OFF); S.cn = S.tp + 40; S.sb = S.cn + 40; S.G = F.G; S.c = (int)blockIdx.x;
            S.A = (const char*)(F.ws + WS_XN); S.B = (const char*)(F.ws + WS_WGU); S.list = (const int*)(F.ws + WS_LIST);
            EpiMoeUp E{(bf16*)(F.ws + WS_HB), S.sb};
            _Pragma("unroll 1") REPS(13) { RSYNC(); pg8::gemm_phase<SchedMoeUp, EpiMoeUp, DM, DM, DM, true>(F.lds, S, E, (F.wave * 64 + fresh_lane())); }
            SEAM(p0 + PH_MOE); }
        if (IN(p0 + PH_MOED)) { FRESH();
            moe_tables(F, l);
            SchedMoeDown S; S.tp = (const LAS int*)(F.lds + MOE_TAB_OFF); S.cn = S.tp + 40; S.sb = S.cn + 40; S.G = F.G; S.c = (int)blockIdx.x;
            S.A = (const char*)(F.ws + WS_HB); S.B = (const char*)(F.ws + WS_WDN);
            EpiMoeDown E{(bf16*)(F.ws + WS_YB), (const int*)(F.ws + WS_LIST), (const int*)tokinfo_ptr(F)};
            _Pragma("unroll 1") REPS(14) { RSYNC(); pg8::gemm_phase<SchedMoeDown, EpiMoeDown, DEXP, DEXP, DEXP, true>(F.lds, S, E, (F.wave * 64 + fresh_lane())); }
            SEAM(p0 + PH_MOED); }
    }
    { constexpr int l = 1; constexpr int p0 = NPH_L;
        if (IN(p0 + PH_PRE)) { FRESH();
            _Pragma("unroll 1") REPS(0) { RSYNC(); ph_convw(F, l); }
            _Pragma("unroll 1") REPS(1) { RSYNC(); ph_norm1(F, l); }
            SEAM(p0 + PH_PRE); }
        if (IN(p0 + PH_INPROJ)) { FRESH();
            { SchedDense<DM, DM> S; S.T.init(NTOK / 256, PW / 256, F.G, (int)blockIdx.x); S.A = (const char*)(F.ws + WS_XN); S.B = (const char*)(F.ws + WS_WIN);
              EpiProj E{(bf16*)(F.ws + WS_PROJ), gif_ptr(F)};
              _Pragma("unroll 1") REPS(10) { RSYNC(); pg8::gemm_phase<SchedDense<DM, DM>, EpiProj, DM, DM, DM, true>(F.lds, S, E, (F.wave * 64 + fresh_lane())); } }
#ifdef PROBE_GEMM
            { __syncthreads(); SchedProbe<PROBE_GEMM> S; S.T.init(NTOK / 256, PW / 256, F.G, (int)blockIdx.x); S.A = (const char*)(F.ws + WS_XN); S.B = (const char*)(F.ws + WS_WIN);
              EpiProbe E{(bf16*)(F.ws + WS_TMP)};
              pg8::gemm_phase<SchedProbe<PROBE_GEMM>, EpiProbe, DM, DM, DM, true>(F.lds, S, E, (F.wave * 64 + fresh_lane())); }
#endif
            SEAM(p0 + PH_INPROJ); }
        if (IN(p0 + PH_MIXA)) { FRESH();
            _Pragma("unroll 1") REPS(2) { RSYNC(); ml_delta(F, l); }
            __syncthreads();
            _Pragma("unroll 1") REPS(5) { RSYNC(); dsa_index(F); }
            SEAM(p0 + PH_MIXA); }
        if (IN(p0 + PH_MIXB)) { FRESH();
            _Pragma("unroll 1") REPS(3) { RSYNC(); ml_scan(F); }
            __syncthreads();
            _Pragma("unroll 1") REPS(7) { RSYNC(); sb_attn(F); }
            SEAM(p0 + PH_MIXB); }
        if (IN(p0 + PH_MIXC)) { FRESH();
            _Pragma("unroll 1") REPS(6) { RSYNC(); dsa_attn(F, l); }
            __syncthreads();
            _Pragma("unroll 1") REPS(4) { RSYNC(); ml_out(F, l); }
            SEAM(p0 + PH_MIXC); }
        if (IN(p0 + PH_BRANCH)) { FRESH();
            SchedBranch S; S.T.init(NTOK / 256, DM / 256, F.G, (int)blockIdx.x); S.A = (const char*)(F.ws + WS_BR); S.B = (const char*)(F.ws + WS_WBR);
            EpiBranch E{(const bf16*)(F.ws + WS_PROJ), (bf16*)(F.ws + WS_MRG)};
            _Pragma("unroll 1") REPS(11) { RSYNC(); pg8::gemm_phase<SchedBranch, EpiBranch, BW, 3072, BW, true>(F.lds, S, E, (F.wave * 64 + fresh_lane())); }
            SEAM(p0 + PH_BRANCH); }
        if (IN(p0 + PH_OUT)) { FRESH();
            SchedDense<DM, DM> S; S.T.init(NTOK / 256, DM / 256, F.G, (int)blockIdx.x); S.A = (const char*)(F.ws + WS_MRG); S.B = (const char*)(F.ws + WS_WOUT);
            EpiOut E{l == 0 ? arg_in(0) : (const float*)(F.ws + WS_XA), (float*)(F.ws + WS_X1)};
            _Pragma("unroll 1") REPS(12) { RSYNC(); pg8::gemm_phase<SchedDense<DM, DM>, EpiOut, DM, DM, DM, true>(F.lds, S, E, (F.wave * 64 + fresh_lane())); }
            SEAM(p0 + PH_OUT); }
        if (IN(p0 + PH_NORM2)) { FRESH(); _Pragma("unroll 1") REPS(8) { RSYNC(); ph_norm2_mfma(F, l); } SEAM(p0 + PH_NORM2); }
        if (IN(p0 + PH_MOE)) { FRESH();
            moe_tables(F, l);
            SchedMoeUp S; S.tp = (const LAS int*)(F.lds + MOE_TAB_OFF); S.cn = S.tp + 40; S.sb = S.cn + 40; S.G = F.G; S.c = (int)blockIdx.x;
            S.A = (const char*)(F.ws + WS_XN); S.B = (const char*)(F.ws + WS_WGU); S.list = (const int*)(F.ws + WS_LIST);
            EpiMoeUp E{(bf16*)(F.ws + WS_HB), S.sb};
            _Pragma("unroll 1") REPS(13) { RSYNC(); pg8::gemm_phase<SchedMoeUp, EpiMoeUp, DM, DM, DM, true>(F.lds, S, E, (F.wave * 64 + fresh_lane())); }
            SEAM(p0 + PH_MOE); }
        if (IN(p0 + PH_MOED)) { FRESH();
            moe_tables(F, l);
            SchedMoeDown S; S.tp = (const LAS int*)(F.lds + MOE_TAB_OFF); S.cn = S.tp + 40; S.sb = S.cn + 40; S.G = F.G; S.c = (int)blockIdx.x;
            S.A = (const char*)(F.ws + WS_HB); S.B = (const char*)(F.ws + WS_WDN);
            EpiMoeDown E{(bf16*)(F.ws + WS_YB), (const int*)(F.ws + WS_LIST), (const int*)tokinfo_ptr(F)};
            _Pragma("unroll 1") REPS(14) { RSYNC(); pg8::gemm_phase<SchedMoeDown, EpiMoeDown, DEXP, DEXP, DEXP, true>(F.lds, S, E, (F.wave * 64 + fresh_lane())); }
            SEAM(p0 + PH_MOED); }
    }
    if (IN(PH_FINAL)) { FRESH(); } if (IN(PH_FINAL)) ph_final(F, args.out);
#undef IN
#undef SEAM
}

#ifndef MK_ONE_LAUNCH
#define MK_ONE_LAUNCH 1
#endif
extern "C" void kernel_launch(void* const* d_in, const int* in_sizes, int n_in, void* d_out, int out_size, void* d_ws, size_t ws_size, hipStream_t stream) {
    static int grid = 0;
    if (grid == 0) {
        if (n_in != 20 || in_sizes[0] != NTOK * DM || out_size != NTOK * DM || ws_size < WS_END) { fprintf(stderr, "kernel_launch: shape mismatch (n_in %d, ws %zu < %zu?)\n", n_in, ws_size, (size_t)WS_END); grid = -1; return; }
        int dev = 0, cus = 0, per_cu = 0;
        if (hipGetDevice(&dev) != hipSuccess || hipDeviceGetAttribute(&cus, hipDeviceAttributeMultiprocessorCount, dev) != hipSuccess) { grid = -1; return; }
        if (hipFuncSetAttribute((const void*)fwd_kernel, hipFuncAttributeMaxDynamicSharedMemorySize, LDS_BYTES) != hipSuccess) { fprintf(stderr, "kernel_launch: hipFuncSetAttribute failed\n"); grid = -1; return; }
        if (hipOccupancyMaxActiveBlocksPerMultiprocessor(&per_cu, (const void*)fwd_kernel, NTHR, LDS_BYTES) != hipSuccess || per_cu < 1) fprintf(stderr, "kernel_launch: occupancy query says %d\n", per_cu);
        (void)hipGetLastError();
        grid = cus;
    }
    if (grid < 0) return;
    if (hipMemsetAsync((char*)d_ws + WS_CTL, 0, CTL_ZERO_BYTES, stream) != hipSuccess) return;
    Args a{};
    for (int i = 0; i < 20; ++i) a.in[i] = (const float*)d_in[i];
    a.out = (float*)d_out; a.ws = (unsigned char*)d_ws;
    { unsigned r = 0; for (int k = 0; k < 15; ++k) r |= (1u + ((PROBE_MASK >> k) & 1u)) << (2 * k); a.reps = r; }
#if MK_ONE_LAUNCH
    a.ph_lo = 0; a.ph_hi = NPH; a.use_bar = 1;
    hipLaunchKernelGGL(fwd_kernel, dim3(grid), dim3(NTHR), LDS_BYTES, stream, a);
#else
    for (int ph = 0; ph < NPH; ++ph) { a.ph_lo = ph; a.ph_hi = ph + 1; a.use_bar = 0;
        hipLaunchKernelGGL(fwd_kernel, dim3(grid), dim3(NTHR), LDS_BYTES, stream, a); }
#endif
    const hipError_t le = hipPeekAtLastError();
    if (le != hipSuccess) fprintf(stderr, "kernel_launch: launch failed: %s\n", hipGetErrorName(le));
}
```

```cpp
#define PROBE_MASK 0x0
#include <hip/hip_runtime.h>
#include <cstdio>
#include <cstdint>

constexpr int BATCH = 4, SEQ = 2048, DM = 2048, NTOK = BATCH * SEQ, NH = 8, HD = 128, BW = 1024, DEPTH = 2;
constexpr int NIN = 17504, PW = 17664;
constexpr int IDXH = 16, IDXD = 64, TOPK = 256, NEXP = 32, NGRP = 4, EPG = 8, DEXP = 512, MCH = 64, NCH = SEQ / MCH;
constexpr float EPS = 1e-6f;
constexpr int C_MQ = 0, C_MK = 1024, C_MV = 2048, C_MO = 3072, C_DQ = 4096, C_DK = 5120, C_DV = 6144, C_IQ = 7168, C_SQ = 8192, C_SK = 9216, C_SV = 10240,
              C_G = 11264, C_MI = 17408, C_MF = 17416, C_IK = 17424, C_IW = 17488;
__host__ __device__ __forceinline__ int src_col(int c) {
    if (c < 4096) return c;
    if (c < 8192) return c + 16;
    if (c < 17408) return c + 96;
    if (c < 17424) return 4096 + (c - 17408);
    if (c < 17488) return 8208 + (c - 17424);
    if (c < 17504) return 8272 + (c - 17488);
    return -1;
}

constexpr size_t MiB = 1u << 20;
constexpr size_t WS_CTL = 0, CTL_ZERO_BYTES = 1 * MiB;
constexpr size_t WS_WIN = 1 * MiB;
constexpr size_t WS_WBR = WS_WIN + 69 * MiB;
constexpr size_t WS_WOUT = WS_WBR + 12 * MiB;
constexpr size_t WS_WGU = WS_WOUT + 8 * MiB;
constexpr size_t WS_WDN = WS_WGU + 128 * MiB;
constexpr size_t WS_XN = WS_WDN + 64 * MiB;
constexpr size_t WS_XA = WS_XN + 32 * MiB;
constexpr size_t WS_X1 = WS_XA + 64 * MiB;
constexpr size_t WS_PROJ = WS_X1 + 64 * MiB;
constexpr size_t WS_BR = WS_PROJ + 276 * MiB;
constexpr size_t WS_MRG = WS_BR + 48 * MiB;
constexpr size_t WS_MASK = WS_MRG + 32 * MiB;
constexpr size_t WS_MDEL = WS_MASK + 2 * MiB;
constexpr size_t WS_MDN = WS_MDEL + 64 * MiB;
constexpr size_t WS_MST = WS_MDN + 1 * MiB;
constexpr size_t WS_MSN = WS_MST + 32 * MiB;
constexpr size_t WS_HB = WS_MSN + 1 * MiB;
constexpr size_t WS_YB = WS_HB + 16 * MiB;
constexpr size_t WS_LIST = WS_YB + 64 * MiB;
constexpr size_t WS_TMP = WS_LIST + 2 * MiB;
constexpr size_t WS_WIN2 = WS_TMP;
constexpr size_t WS_END = WS_WIN2 + 69 * MiB;
static_assert(WS_END <= 1100 * MiB, "workspace map");

constexpr int CW_BAR = 4096;
constexpr int CW_CVT = 12288;
constexpr int CW_ECNT = 16384;

#define GAS __attribute__((address_space(1)))
#define LAS __attribute__((address_space(3)))
typedef unsigned short bf16;
typedef unsigned v4u __attribute__((ext_vector_type(4)));
typedef unsigned v2u __attribute__((ext_vector_type(2)));
typedef float f32x4 __attribute__((ext_vector_type(4)));
typedef float f32x2 __attribute__((ext_vector_type(2)));
typedef float f32x16 __attribute__((ext_vector_type(16)));
typedef short bf16x8 __attribute__((ext_vector_type(8)));
typedef short s16x4 __attribute__((ext_vector_type(4)));
#define RLX_AGENT __ATOMIC_RELAXED, __HIP_MEMORY_SCOPE_AGENT
#define LDS_WAIT() asm volatile("s_waitcnt lgkmcnt(0)" ::: "memory")
#define VM_WAIT() asm volatile("s_waitcnt vmcnt(0)" ::: "memory")
constexpr int NWAVES = 8, NTHR = 512;
constexpr int RING_BYTES = 131072, LDSCTL_OFF = RING_BYTES, LDS_BYTES = 147456;

__device__ __forceinline__ unsigned f2bf(float f) { unsigned u = __builtin_bit_cast(unsigned, f); return (u + 0x7fffu + ((u >> 16) & 1u)) >> 16; }
__device__ __forceinline__ unsigned pk2(float lo, float hi) { return f2bf(lo) | (f2bf(hi) << 16); }
__device__ __forceinline__ float bf2f(unsigned short b) { return __builtin_bit_cast(float, ((unsigned)b) << 16); }
__device__ __forceinline__ float bflo(unsigned w) { return __builtin_bit_cast(float, w << 16); }
__device__ __forceinline__ float bfhi(unsigned w) { return __builtin_bit_cast(float, w & 0xffff0000u); }
__device__ __forceinline__ unsigned cvt_pk_bf16(float lo, float hi) { unsigned r; asm volatile("v_cvt_pk_bf16_f32 %0, %1, %2" : "=v"(r) : "v"(lo), "v"(hi)); return r; }
__device__ __forceinline__ float wave_sum(float v) {
#pragma unroll
    for (int o = 1; o < 64; o <<= 1) v += __shfl_xor(v, o);
    return v;
}
__device__ __forceinline__ float wave_max(float v) {
#pragma unroll
    for (int o = 1; o < 64; o <<= 1) v = fmaxf(v, __shfl_xor(v, o));
    return v;
}
__device__ __forceinline__ float sigmoidf_(float x) { return 1.0f / (1.0f + __expf(-x)); }
__device__ __forceinline__ float siluf_(float x) { return x / (1.0f + __expf(-x)); }
__device__ __forceinline__ float logsigmoidf_(float x) { return fminf(x, 0.f) - log1pf(__expf(-fabsf(x))); }
__device__ __forceinline__ int t5_bucket(int n) {
    if (n < 16) return n;
    return 16 + (n >= 19) + (n >= 21) + (n >= 24) + (n >= 27) + (n >= 31) + (n >= 35) + (n >= 40) + (n >= 46) + (n >= 52) + (n >= 59) + (n >= 67) + (n >= 77) + (n >= 87) + (n >= 99) + (n >= 113);
}
namespace pg8 {
constexpr int BM = 256, BK = 64, HALF = 128, HTB = HALF * BK * 2, STAGE_BYTES = 8 * HTB, NXCD = 8, WGM = 8;
__host__ __device__ __forceinline__ int lds_byte(int r, int c) { const int st = (r >> 4) * 2 + (c >> 5), rr = r & 15, cc = c & 31, ob = rr * 64 + cc * 2; return st * 1024 + (ob ^ (((ob >> 9) & 1) << 5)); }
__host__ __device__ __forceinline__ void stage_rc(int b, int& R, int& C) { const int st = b / 1024, sb = b % 1024, swz = sb ^ (((sb >> 9) & 1) << 5); R = (st >> 1) * 16 + swz / 64; C = (st & 1) * 32 + (swz % 64) / 2; }
__host__ __device__ __forceinline__ int perm32(int rho) { const int n = rho >> 4, i = rho & 15; return 8 * (i >> 2) + 4 * n + (i & 3); }

struct Unit { int pm, pn, e, rows; };

struct TileOrder {
    int nM, nN, nwg, G, c;
    __device__ void init(int nM_, int nN_, int G_, int c_) { nM = nM_; nN = nN_; nwg = nM * nN; G = G_; c = c_; }
    __device__ bool tile(int i, int& pm, int& pn) const {
        const long L = (long)i * G + c; if (L >= nwg) return false;
        int wgid = (int)L; { const int q = nwg / NXCD, r = nwg % NXCD, xcd = wgid % NXCD, off = wgid / NXCD; wgid = (xcd < r ? xcd * (q + 1) : r * (q + 1) + (xcd - r) * q) + off; }
        const int nig = WGM * nN, gid = wgid / nig, fm = gid * WGM, gsz = (nM - fm) < WGM ? (nM - fm) : WGM;
        pm = fm + ((wgid % nig) % gsz); pn = (wgid % nig) / gsz; return true;
    }
};

template <class Sched, class Epi, int K, int LDA, int LDB, bool ALIGN_EPI>
__device__ __forceinline__ void gemm_phase(LAS unsigned char* lds, const Sched& S, const Epi& E, int tid_in) {
    int tid_ = tid_in; asm volatile("" : "+v"(tid_));
    const int tid = tid_, wid = __builtin_amdgcn_readfirstlane(tid >> 6), lane = tid & 63, wr = wid >> 2, wc = wid & 3, fr = lane & 15, fq = lane >> 4;
    constexpr int nt = K / BK;
    static_assert(K % 128 == 0 && K >= 256, "K");
    unsigned voffB[2];
#pragma unroll
    for (int i = 0; i < 2; ++i) { int R, C; stage_rc(tid * 16 + i * 8192, R, C); const int Rb = Epi::PERM ? ((R & ~31) + perm32(R & 31)) : R;
        voffB[i] = (unsigned)(Rb * LDB + C) * 2u; }
    constexpr size_t kstep = (size_t)(BK * 2);
    constexpr size_t hstepB = (size_t)HALF * LDB * 2;
    constexpr size_t hstepA = Sched::GATHER ? 0 : (size_t)HALF * LDA * 2;
    const unsigned ldsw = (unsigned)wid * 1024u;
    const int aoff = lds_byte(wr * 64 + fr, fq * 8), boff = lds_byte(wc * 32 + fr, fq * 8);
#define PG8_SA(b, h) (((b) * 2 + (h)) * HTB)
#define PG8_SB(b, h) ((4 + (b) * 2 + (h)) * HTB)
#define PG8_STAGE(bufoff, gbase, voff) do { _Pragma("unroll") for (int _i = 0; _i < 2; ++_i) \
        __builtin_amdgcn_global_load_lds((const unsigned*)((const char*)(gbase) + (voff)[_i]), (LAS unsigned*)(lds + (bufoff) + ldsw + _i * 8192), 16, 0, 0); } while (0)
#define PG8_LDA(dst, b, h) do { _Pragma("unroll") for (int m = 0; m < 4; ++m) _Pragma("unroll") for (int k = 0; k < 2; ++k) dst[m][k] = *(const LAS bf16x8*)(lds + PG8_SA(b, h) + aoff + m * 2048 + k * 1024); } while (0)
#define PG8_LDB(dst, b, h) do { _Pragma("unroll") for (int n = 0; n < 2; ++n) _Pragma("unroll") for (int k = 0; k < 2; ++k) dst[n][k] = *(const LAS bf16x8*)(lds + PG8_SB(b, h) + boff + n * 2048 + k * 1024); } while (0)
#define PG8_MMA(ai, bj, At, Bt) do { __builtin_amdgcn_s_setprio(1); _Pragma("unroll") for (int m = 0; m < 4; ++m) _Pragma("unroll") for (int n = 0; n < 2; ++n) _Pragma("unroll") for (int k = 0; k < 2; ++k) \
        acc[ai][bj][m][n] = __builtin_amdgcn_mfma_f32_16x16x32_bf16(Bt[n][k], At[m][k], acc[ai][bj][m][n], 0, 0, 0); __builtin_amdgcn_s_setprio(0); } while (0)
#define VA1 (Sched::GATHER ? vA1 : vA0)
#define W0 vA0
#define W1 VA1
#define PG8_WAIT_V(n) asm volatile("s_waitcnt vmcnt(" #n ")" ::: "memory")
#define PG8_WAIT_L(n) asm volatile("s_waitcnt lgkmcnt(" #n ")" ::: "memory")
#define PG8_BAR __builtin_amdgcn_s_barrier()
#define PG8_SCHED __builtin_amdgcn_sched_barrier(0)
    Unit cur, nxt; int ui = 0;
    if (!S.next(0, cur)) return;
    f32x4 acc[2][2][4][2];
#pragma unroll
    for (int a = 0; a < 2; ++a)
#pragma unroll
        for (int b = 0; b < 2; ++b)
#pragma unroll
            for (int m = 0; m < 4; ++m)
#pragma unroll
                for (int n = 0; n < 2; ++n) acc[a][b][m][n] = (f32x4){0.f, 0.f, 0.f, 0.f};
    bf16x8 At[4][2], B0[2][2], B1[2][2];
    unsigned vA0[2], vA1[2];
    S.a_off(cur, tid, vA0, vA1);
    const char* cA = S.a_base(cur); const char* cB = S.b_base(cur);
    PG8_STAGE(PG8_SB(0, 0), cB, voffB); PG8_STAGE(PG8_SB(0, 1), cB + hstepB, voffB); PG8_STAGE(PG8_SA(0, 0), cA, vA0); PG8_STAGE(PG8_SA(0, 1), cA + hstepA, VA1);
    if (wr == 1) PG8_BAR;
    PG8_WAIT_V(2); PG8_BAR;
    PG8_STAGE(PG8_SB(1, 0), cB + kstep, voffB); PG8_STAGE(PG8_SA(1, 0), cA + kstep, vA0); PG8_STAGE(PG8_SB(1, 1), cB + hstepB + kstep, voffB);
    PG8_WAIT_V(6); PG8_BAR;
    for (;;) {
        const bool has_next = S.next(ui + 1, nxt);
        const char* nA = has_next ? S.a_base(nxt) : cA; const char* nB = has_next ? S.b_base(nxt) : cB;
        for (int t = 0; t < nt; t += 2) {
            const bool last = (t == nt - 2);
            const char* a1 = cA + (size_t)(t + 1) * kstep;
            const char* a2 = last ? nA : cA + (size_t)(t + 2) * kstep; const char* b2 = last ? nB : cB + (size_t)(t + 2) * kstep;
            const char* a3 = a2 + kstep; const char* b3 = b2 + kstep;
            PG8_LDB(B0, 0, 0); PG8_LDB(B1, 0, 1); PG8_SCHED; PG8_LDA(At, 0, 0); PG8_STAGE(PG8_SA(1, 1), a1 + hstepA, VA1);
            if constexpr (Sched::GATHER) { if (last && has_next) S.a_off(nxt, tid, vA0, vA1); }
            PG8_WAIT_V(8); PG8_WAIT_L(0); PG8_BAR; PG8_MMA(0, 0, At, B0); PG8_MMA(0, 1, At, B1); PG8_BAR; PG8_SCHED;
            PG8_LDA(At, 0, 1); PG8_STAGE(PG8_SB(0, 0), b2, voffB); PG8_STAGE(PG8_SB(0, 1), b2 + hstepB, voffB); PG8_STAGE(PG8_SA(0, 0), a2, W0);
            PG8_WAIT_V(8); PG8_WAIT_L(0); PG8_BAR; PG8_MMA(1, 0, At, B0); PG8_MMA(1, 1, At, B1); PG8_BAR; PG8_SCHED;
            PG8_LDB(B0, 1, 0); PG8_LDB(B1, 1, 1); PG8_SCHED; PG8_LDA(At, 1, 0); PG8_STAGE(PG8_SA(0, 1), a2 + hstepA, W1);
            PG8_WAIT_V(8); PG8_WAIT_L(0); PG8_BAR; PG8_MMA(0, 0, At, B0); PG8_MMA(0, 1, At, B1); PG8_BAR; PG8_SCHED;
            PG8_LDA(At, 1, 1); PG8_STAGE(PG8_SB(1, 0), b3, voffB); PG8_STAGE(PG8_SB(1, 1), b3 + hstepB, voffB); PG8_STAGE(PG8_SA(1, 0), a3, W0);
            PG8_WAIT_V(8); PG8_WAIT_L(0); PG8_BAR; PG8_MMA(1, 0, At, B0); PG8_MMA(1, 1, At, B1); PG8_BAR; PG8_SCHED;
        }
        if constexpr (ALIGN_EPI) { if (wr == 0) PG8_BAR; }
        { int fr_e = fr, fq_e = fq; asm volatile("" : "+v"(fr_e), "+v"(fq_e));
          E(acc, cur, wr, wc, fr_e, fq_e);
#ifdef PROBE_EPI2
          if constexpr (Epi::PROBE2) E(acc, cur, wr, wc, fr_e, fq_e);
#endif
        }
        if (!has_next) break;
        if (E.zero_after(cur)) {
#pragma unroll
        for (int a = 0; a < 2; ++a)
#pragma unroll
            for (int b = 0; b < 2; ++b)
#pragma unroll
                for (int m = 0; m < 4; ++m)
#pragma unroll
                    for (int n = 0; n < 2; ++n) acc[a][b][m][n] = (f32x4){0.f, 0.f, 0.f, 0.f}; }
        cur = nxt; cA = nA; cB = nB; ++ui;
        if constexpr (ALIGN_EPI) { if (wr == 1) PG8_BAR; }
    }
    PG8_WAIT_V(0);
    if constexpr (!ALIGN_EPI) { if (wr == 0) PG8_BAR; }
    PG8_BAR;
#undef PG8_SA
#undef VA1
#undef W0
#undef W1
#undef PG8_SB
#undef PG8_STAGE
#undef PG8_LDA
#undef PG8_LDB
#undef PG8_MMA
#undef PG8_WAIT_V
#undef PG8_WAIT_L
#undef PG8_BAR
#undef PG8_SCHED
}
}
#define XB_TMO      128
#define XB_XCNT(j)  (256  + 64 * (j))
#define XB_XSUB(j)  (1280 + 64 * (j))
#define XB_XGEN(j)  (2304 + 64 * (j))
#define XB_TOP      3328
#define XB_TOPGEN   3392
#define XCD_BAR_WORDS 3456
#define XB_SPIN_CAP (1u << 18)
__device__ __forceinline__ unsigned xb_ld(unsigned* p)              { return __hip_atomic_load(p, __ATOMIC_RELAXED, __HIP_MEMORY_SCOPE_AGENT); }
__device__ __forceinline__ unsigned xb_add(unsigned* p, unsigned v) { return __hip_atomic_fetch_add(p, v, __ATOMIC_RELAXED, __HIP_MEMORY_SCOPE_AGENT); }
__device__ __forceinline__ unsigned xb_xcc_id() { return (unsigned)__builtin_amdgcn_s_getreg((3 << 11) | 20) & 0xFu; }
#define XB_SPIN(cond, bar) do { unsigned _sp = 0; while (cond) { __builtin_amdgcn_s_sleep(1); \
    if ((++_sp & 255u) == 0u) { if (xb_ld(&(bar)[XB_TMO])) break; if (_sp > XB_SPIN_CAP) { atomicAdd(&(bar)[XB_TMO], 1u); break; } } } } while (0)
struct XcdBarrier { unsigned* bar; unsigned x; volatile LAS unsigned* st; };
__device__ __forceinline__ XcdBarrier xcd_barrier_post(unsigned* bar, volatile LAS unsigned* st) {
    XcdBarrier b; b.bar = bar; b.x = xb_xcc_id(); b.st = st;
    if (threadIdx.x == 0) (void)xb_add(&bar[XB_XCNT(b.x)], 1u);
    return b;
}
__device__ __forceinline__ void xcd_barrier_complete(unsigned* bar, unsigned x, unsigned& nloc, unsigned& nx) {
    const unsigned G = gridDim.x * gridDim.y * gridDim.z;
    unsigned sum, cnt, mine, sp = 0u;
    for (;;) {
        sum = 0u; cnt = 0u; mine = 0u;
#pragma unroll
        for (unsigned j = 0; j < 16; ++j) { const unsigned c = xb_ld(&bar[XB_XCNT(j)]); sum += c; cnt += (c > 0u) ? 1u : 0u; mine = (j == x) ? c : mine; }
        if (sum == G) break;
        __builtin_amdgcn_s_sleep(1);
        if ((++sp & 255u) == 0u) { if (xb_ld(&bar[XB_TMO])) break; if (sp > XB_SPIN_CAP) { atomicAdd(&bar[XB_TMO], 1u); break; } }
    }
    nloc = mine > 0u ? mine : 1u; nx = cnt > 0u ? cnt : 1u;
}
__device__ __forceinline__ void xcd_barrier(const XcdBarrier& b, int tid) {
    asm volatile("s_waitcnt vmcnt(0)" ::: "memory");
    __syncthreads();
    if (tid == 0) {
        unsigned* bar = b.bar; asm volatile("" : "+s"(bar));
        __builtin_amdgcn_s_waitcnt(0);
        unsigned nloc = b.st[0], nx = b.st[1];
        if (nloc == 0u) { xcd_barrier_complete(bar, b.x, nloc, nx); b.st[0] = nloc; b.st[1] = nx; }
        const unsigned old = xb_add(&bar[XB_XSUB(b.x)], 1u);
        const unsigned gen = old / nloc;
        if (old + 1u == (gen + 1u) * nloc) {
            __builtin_amdgcn_fence(__ATOMIC_RELEASE, "agent");
            asm volatile("s_waitcnt vmcnt(0)" ::: "memory");
            const unsigned og = xb_add(&bar[XB_TOP], 1u);
            const unsigned tg = og / nx;
            if (og + 1u == (tg + 1u) * nx) xb_add(&bar[XB_TOPGEN], 1u);
            else XB_SPIN(xb_ld(&bar[XB_TOPGEN]) == tg, bar);
            __builtin_amdgcn_fence(__ATOMIC_ACQUIRE, "agent");
            xb_add(&bar[XB_XGEN(b.x)], 1u);
            asm volatile("s_waitcnt vmcnt(0)" ::: "memory");
        } else {
            XB_SPIN(xb_ld(&bar[XB_XGEN(b.x)]) == gen, bar);
            __builtin_amdgcn_fence(__ATOMIC_ACQUIRE, "agent");
            asm volatile("s_waitcnt vmcnt(0)" ::: "memory");
        }
    }
    __syncthreads();
}

struct Args { const float* in[20]; float* out; unsigned char* ws; int ph_lo, ph_hi, use_bar; unsigned reps; };
struct Frame {
    LAS unsigned char* lds;
    unsigned* ctl;
    int wave, vcu, G;
    unsigned char* ws;
};
__device__ __forceinline__ int fresh_lane() { int l_; asm volatile("v_mbcnt_lo_u32_b32 %0, -1, 0\n\tv_mbcnt_hi_u32_b32 %0, -1, %0" : "=v"(l_)); return l_; }
__device__ __forceinline__ const float* arg_in(int i) { asm volatile("" : "+s"(i)); return ((const float* const __attribute__((address_space(4)))*)__builtin_amdgcn_kernarg_segment_ptr())[i]; }
__device__ __forceinline__ unsigned char* arg_ws() { int i = 21; asm volatile("" : "+s"(i)); return ((unsigned char* const __attribute__((address_space(4)))*)__builtin_amdgcn_kernarg_segment_ptr())[i]; }
#define GW_ID(F) ((F).vcu * NWAVES + (F).wave)
#define GW_N(F) ((F).G * NWAVES)

__device__ __forceinline__ void cvt_item(const float* W, int ldw, int k0, int srcc, bf16* WT, size_t out_row0, int ldo, LAS float* scr, int lane) {
    float t[32];
#pragma unroll
    for (int i = 0; i < 32; ++i) { const int kk = 2 * i + (lane >> 5); t[i] = srcc >= 0 ? W[(size_t)(k0 + kk) * ldw + srcc] : 0.f; }
#pragma unroll
    for (int i = 0; i < 32; ++i) { const int kk = 2 * i + (lane >> 5); scr[kk * 33 + (lane & 31)] = t[i]; }
    LDS_WAIT(); asm volatile("" ::: "memory");
    const int c = lane & 7;
#pragma unroll
    for (int j = 0; j < 4; ++j) { const int n = (lane >> 3) + 8 * j; const LAS float* s = scr + (8 * c) * 33 + n;
        v4u o; o.x = pk2(s[0 * 33], s[1 * 33]); o.y = pk2(s[2 * 33], s[3 * 33]); o.z = pk2(s[4 * 33], s[5 * 33]); o.w = pk2(s[6 * 33], s[7 * 33]);
        *(v4u*)(WT + (out_row0 + n) * (size_t)ldo + k0 + 8 * c) = o; }
    LDS_WAIT(); asm volatile("" ::: "memory");
}
__device__ __forceinline__ void ph_convw(const Frame& F, int l) {
    LAS float* scr = (LAS float*)(F.lds + F.wave * 16384);
    const int gw = GW_ID(F), NGW = GW_N(F), lane = fresh_lane(), ln = lane & 31;
    constexpr int I_IN = (PW / 32) * 32, I_BR = 3 * 64 * 16, I_OUT = 64 * 32, I_G = 32 * 16 * 32, I_D = 32 * 64 * 8;
    constexpr int NITEMS = I_IN + I_BR + I_OUT + 2 * I_G + I_D;
    for (int it = gw; it < NITEMS; it += NGW) {
        int r = it;
        if (r < I_IN) { const int kb = r / (PW / 32), nb = r % (PW / 32);
            cvt_item(arg_in(2) + (size_t)l * DM * NIN, NIN, 64 * kb, src_col(32 * nb + ln), (bf16*)(F.ws + WS_WIN), (size_t)32 * nb, DM, scr, lane); continue; }
        r -= I_IN;
        if (r < I_BR) { const int n = r / (64 * 16), q = r % (64 * 16), kb = q / 64, nb = q % 64;
            cvt_item(arg_in(9) + ((size_t)l * 3 + n) * BW * DM, DM, 64 * kb, 32 * nb + ln, (bf16*)(F.ws + WS_WBR) + (size_t)n * DM * BW, (size_t)32 * nb, BW, scr, lane); continue; }
        r -= I_BR;
        if (r < I_OUT) { const int kb = r / 64, nb = r % 64;
            cvt_item(arg_in(10) + (size_t)l * DM * DM, DM, 64 * kb, 32 * nb + ln, (bf16*)(F.ws + WS_WOUT), (size_t)32 * nb, DM, scr, lane); continue; }
        r -= I_OUT;
        if (r < 2 * I_G) { const int up = r >= I_G; if (up) r -= I_G; const int e = r / (16 * 32), q = r % (16 * 32), kb = q / 16, nb = q % 16, f0 = 32 * nb;
            cvt_item(arg_in(up ? 17 : 16) + ((size_t)l * NEXP + e) * DM * DEXP, DEXP, 64 * kb, f0 + ln, (bf16*)(F.ws + WS_WGU) + (size_t)e * 1024 * DM,
                     (size_t)((f0 >> 7) * 256 + (up ? 128 : 0) + (f0 & 127)), DM, scr, lane); continue; }
        r -= 2 * I_G;
        { const int e = r / (64 * 8), q = r % (64 * 8), kb = q / 64, nb = q % 64;
            cvt_item(arg_in(18) + ((size_t)l * NEXP + e) * DEXP * DM, DM, 64 * kb, 32 * nb + ln, (bf16*)(F.ws + WS_WDN) + (size_t)e * DM * DEXP, (size_t)32 * nb, DEXP, scr, lane); }
    }
}

__device__ __forceinline__ int* tokinfo_ptr(const Frame& F) { return (int*)(F.ws + WS_LIST + MiB); }

__device__ __forceinline__ void ph_norm1(const Frame& F, int l) {
    const int gw = GW_ID(F), NGW = GW_N(F), lane = fresh_lane();
    const float* g = arg_in(1) + (size_t)l * DM;
    bf16* XN = (bf16*)(F.ws + WS_XN);
    for (int m = gw; m < NTOK; m += NGW) {
        f32x4 v[8]; float s = 0.f;
        if (l == 0) {
            const f32x4* xr = (const f32x4*)(arg_in(0) + (size_t)m * DM) + lane;
#pragma unroll
            for (int j = 0; j < 8; ++j) v[j] = xr[64 * j];
        } else {
            const f32x4* xr = (const f32x4*)((const float*)(F.ws + WS_X1) + (size_t)m * DM) + lane;
            const v2u* y0 = (const v2u*)((const bf16*)(F.ws + WS_YB) + (size_t)(2 * m) * DM) + lane;
            const v2u* y1 = (const v2u*)((const bf16*)(F.ws + WS_YB) + (size_t)(2 * m + 1) * DM) + lane;
            f32x4* xo = (f32x4*)((float*)(F.ws + WS_XA) + (size_t)m * DM) + lane;
#pragma unroll
            for (int j = 0; j < 8; ++j) { f32x4 x = xr[64 * j]; const v2u a = y0[64 * j], b = y1[64 * j];
                x.x = (x.x + bflo(a.x)) + bflo(b.x); x.y = (x.y + bfhi(a.x)) + bfhi(b.x); x.z = (x.z + bflo(a.y)) + bflo(b.y); x.w = (x.w + bfhi(a.y)) + bfhi(b.y);
                v[j] = x; xo[64 * j] = x; }
        }
#pragma unroll
        for (int j = 0; j < 8; ++j) s += (v[j].x * v[j].x + v[j].y * v[j].y) + (v[j].z * v[j].z + v[j].w * v[j].w);
        const float rstd = 1.0f / sqrtf(wave_sum(s) * (1.f / DM) + EPS);
        v2u* o8 = (v2u*)(XN + (size_t)m * DM) + lane;
        const f32x4* gr = (const f32x4*)g + lane;
#pragma unroll
        for (int j = 0; j < 8; ++j) { const f32x4 gg = gr[64 * j]; v2u o; o.x = pk2(v[j].x * rstd * gg.x, v[j].y * rstd * gg.y); o.y = pk2(v[j].z * rstd * gg.z, v[j].w * rstd * gg.w); o8[64 * j] = o; }
    }
}

__device__ __forceinline__ void ph_final(const Frame& F, float* out) {
    const int gw = GW_ID(F), NGW = GW_N(F), lane = fresh_lane();
    for (int m = gw; m < NTOK; m += NGW) {
        const f32x4* xr = (const f32x4*)((const float*)(F.ws + WS_X1) + (size_t)m * DM) + lane;
        const v2u* y0 = (const v2u*)((const bf16*)(F.ws + WS_YB) + (size_t)(2 * m) * DM) + lane;
        const v2u* y1 = (const v2u*)((const bf16*)(F.ws + WS_YB) + (size_t)(2 * m + 1) * DM) + lane;
        f32x4* xo = (f32x4*)(out + (size_t)m * DM) + lane;
#pragma unroll
        for (int j = 0; j < 8; ++j) { f32x4 x = xr[64 * j]; const v2u a = y0[64 * j], b = y1[64 * j];
            x.x = (x.x + bflo(a.x)) + bflo(b.x); x.y = (x.y + bfhi(a.x)) + bfhi(b.x); x.z = (x.z + bflo(a.y)) + bflo(b.y); x.w = (x.w + bfhi(a.y)) + bfhi(b.y);
            xo[64 * j] = x; }
    }
}

__device__ __forceinline__ void ph_norm2(const Frame& F, int l) {
    const int gw = GW_ID(F), NGW = GW_N(F), lane = fresh_lane();
    const float* g = arg_in(11) + (size_t)l * DM;
    const float* wrg = arg_in(12) + (size_t)l * DM * NGRP; const float* brg = arg_in(13) + l * NGRP;
    const float* wre = arg_in(14) + (size_t)l * DM * NEXP; const float* bre = arg_in(15) + l * NEXP;
    bf16* XN = (bf16*)(F.ws + WS_XN);
    int* list = (int*)(F.ws + WS_LIST); int* tinfo = tokinfo_ptr(F);
    unsigned* ecnt = F.ctl + CW_ECNT + l * NEXP * 64;
    for (int m = gw; m < NTOK; m += NGW) {
        f32x4 v[8]; float s = 0.f;
        const f32x4* xr = (const f32x4*)((const float*)(F.ws + WS_X1) + (size_t)m * DM) + lane;
#pragma unroll
        for (int j = 0; j < 8; ++j) { v[j] = xr[64 * j]; s += (v[j].x * v[j].x + v[j].y * v[j].y) + (v[j].z * v[j].z + v[j].w * v[j].w); }
        const float rstd = 1.0f / sqrtf(wave_sum(s) * (1.f / DM) + EPS);
        v2u* o8 = (v2u*)(XN + (size_t)m * DM) + lane;
        const f32x4* gr = (const f32x4*)g + lane;
#pragma unroll
        for (int j = 0; j < 8; ++j) { const f32x4 gg = gr[64 * j]; v2u o; o.x = pk2(v[j].x * rstd * gg.x, v[j].y * rstd * gg.y); o.y = pk2(v[j].z * rstd * gg.z, v[j].w * rstd * gg.w); o8[64 * j] = o; }
        float lg[36];
#pragma unroll
        for (int q = 0; q < 36; ++q) lg[q] = 0.f;
#pragma unroll 1
        for (int j = 0; j < 8; ++j) { const f32x4 gg = gr[64 * j], xx = xr[64 * j]; f32x4 x; x.x = xx.x * rstd * gg.x; x.y = xx.y * rstd * gg.y; x.z = xx.z * rstd * gg.z; x.w = xx.w * rstd * gg.w;
            const int k0 = 4 * lane + 256 * j;
#pragma unroll
            for (int c = 0; c < 4; ++c) { const float xv = x[c];
                const f32x4 wg = *(const f32x4*)(wrg + (size_t)(k0 + c) * NGRP);
                lg[0] += xv * wg.x; lg[1] += xv * wg.y; lg[2] += xv * wg.z; lg[3] += xv * wg.w;
                const f32x4* we = (const f32x4*)(wre + (size_t)(k0 + c) * NEXP);
#pragma unroll
                for (int q = 0; q < 8; ++q) { const f32x4 w = we[q]; lg[4 + 4 * q] += xv * w.x; lg[5 + 4 * q] += xv * w.y; lg[6 + 4 * q] += xv * w.z; lg[7 + 4 * q] += xv * w.w; } } }
#pragma unroll
        for (int q = 0; q < 36; ++q) lg[q] = wave_sum(lg[q]);
        LAS float* lgL = (LAS float*)(F.lds + F.wave * 256);
        if (lane == 0) {
#pragma unroll
            for (int q = 0; q < 36; ++q) lgL[q] = lg[q];
            int gs = 0; float best = lg[0] + brg[0];
#pragma unroll
            for (int q = 1; q < 4; ++q) { const float t = lg[q] + brg[q]; if (t > best) { best = t; gs = q; } }
            float gm = fmaxf(fmaxf(lg[0], lg[1]), fmaxf(lg[2], lg[3])), gsum = 0.f, gsel = 0.f;
#pragma unroll
            for (int q = 0; q < 4; ++q) { const float e = __expf(lg[q] - gm); gsum += e; gsel = (q == gs) ? e : gsel; }
            const float pg = gsel / gsum;
            LDS_WAIT(); asm volatile("" ::: "memory");
            float ein[8];
#pragma unroll
            for (int q = 0; q < 8; ++q) ein[q] = lgL[4 + gs * 8 + q];
            int e0 = 0, e1 = -1; float b0 = -3.0e38f, b1 = -3.0e38f;
#pragma unroll
            for (int q = 0; q < 8; ++q) { const float t = ein[q] + bre[gs * 8 + q];
                if (t > b0) { b1 = b0; e1 = e0; b0 = t; e0 = q; } else if (t > b1) { b1 = t; e1 = q; } }
            float em = ein[0];
#pragma unroll
            for (int q = 1; q < 8; ++q) em = fmaxf(em, ein[q]);
            float p0 = 0.f, p1 = 0.f;
#pragma unroll
            for (int q = 0; q < 8; ++q) { const float e = __expf(ein[q] - em); p0 = (q == e0) ? e : p0; p1 = (q == e1) ? e : p1; }
            const float w0 = pg * p0 / (p0 + p1), w1 = pg * p1 / (p0 + p1);
            const int x0 = gs * 8 + e0, x1 = gs * 8 + e1;
            const int pos0 = (int)atomicAdd(ecnt + x0 * 64, 1u), pos1 = (int)atomicAdd(ecnt + x1 * 64, 1u);
            list[x0 * NTOK + pos0] = 2 * m; list[x1 * NTOK + pos1] = 2 * m + 1;
            tinfo[m * 8 + 0] = x0; tinfo[m * 8 + 1] = pos0; tinfo[m * 8 + 2] = __float_as_int(w0); tinfo[m * 8 + 3] = 0;
            tinfo[m * 8 + 4] = x1; tinfo[m * 8 + 5] = pos1; tinfo[m * 8 + 6] = __float_as_int(w1); tinfo[m * 8 + 7] = 0;
        }
    }
}

__device__ __forceinline__ void nv_conv(const Frame& F, int l) {
    const bf16* P = (const bf16*)(F.ws + WS_PROJ); float* QK = (float*)(F.ws + WS_TMP);
    const float* cw = arg_in(3) + (size_t)l * 4 * 2048;
    const size_t total = (size_t)NTOK * 2048, stride = (size_t)F.G * NTHR;
    for (size_t i = (size_t)F.vcu * NTHR + (F.wave * 64 + fresh_lane()); i < total; i += stride) {
        const int row = (int)(i >> 11), c = (int)(i & 2047), t = row & (SEQ - 1);
        float a = 0.f;
#pragma unroll
        for (int j = 0; j < 4; ++j) { const int tt = t - 3 + j; if (tt >= 0) a += cw[j * 2048 + c] * bf2f(P[(size_t)(row - 3 + j) * PW + c]); }
        QK[i] = siluf_(a);
    }
}
__device__ __forceinline__ void nv_mlstm(const Frame& F, int l) {
    const bf16* P = (const bf16*)(F.ws + WS_PROJ); const float* QK = (const float*)(F.ws + WS_TMP); float* HR = (float*)(F.ws + WS_TMP + 64 * MiB);
    const int tid = (F.wave * 64 + fresh_lane()), v = tid >> 2, kq = tid & 3;
    for (int bh = F.vcu; bh < BATCH * NH; bh += F.G) {
        const int b = bh >> 3, h = bh & 7;
        const float bi = arg_in(4)[l * NH + h], bfv = arg_in(5)[l * NH + h];
        float C[32], nn[32], m = 0.f;
#pragma unroll
        for (int j = 0; j < 32; ++j) { C[j] = 0.f; nn[j] = 0.f; }
        for (int t = 0; t < SEQ; ++t) {
            const size_t row = (size_t)b * SEQ + t;
            const float it = bf2f(P[row * PW + C_MI + h]) + bi, ft = bf2f(P[row * PW + C_MF + h]) + bfv;
            const float lf = logsigmoidf_(ft);
            const float mn = fmaxf(lf + m, it), ip = __expf(it - mn), fp = __expf(lf + m - mn); m = mn;
            const float vv = bf2f(P[row * PW + C_MV + h * HD + v]);
            const f32x4* qp = (const f32x4*)(QK + row * 2048 + h * HD + kq * 32);
            const f32x4* kp = (const f32x4*)(QK + row * 2048 + 1024 + h * HD + kq * 32);
            float num = 0.f, den = 0.f;
#pragma unroll
            for (int j4 = 0; j4 < 8; ++j4) { const f32x4 q = qp[j4], k = kp[j4];
#pragma unroll
                for (int c = 0; c < 4; ++c) { const int j = 4 * j4 + c; const float qq = q[c] * 0.08838834764831845f;
                    C[j] = fp * C[j] + ip * vv * k[c]; nn[j] = fp * nn[j] + ip * k[c]; num += C[j] * qq; den += nn[j] * qq; } }
            num += __shfl_xor(num, 1); num += __shfl_xor(num, 2); den += __shfl_xor(den, 1); den += __shfl_xor(den, 2);
            if (kq == 0) HR[row * 1024 + h * HD + v] = num / fmaxf(fabsf(den), __expf(-m));
        }
    }
}
__device__ __forceinline__ void nv_mnorm(const Frame& F, int l) {
    const bf16* P = (const bf16*)(F.ws + WS_PROJ); const float* HR = (const float*)(F.ws + WS_TMP + 64 * MiB); bf16* BR = (bf16*)(F.ws + WS_BR);
    const float* g = arg_in(6) + (size_t)l * BW;
    const int gw = GW_ID(F), NGW = GW_N(F), lane = fresh_lane();
    for (int it = gw; it < NTOK * NH; it += NGW) {
        const size_t row = it >> 3; const int h = it & 7, c = h * HD + 2 * lane;
        const float a = HR[row * 1024 + c], b = HR[row * 1024 + c + 1];
        const float r = 1.0f / sqrtf(wave_sum(a * a + b * b) * (1.f / HD) + EPS);
        const float o0 = a * r * g[c] * sigmoidf_(bf2f(P[row * PW + C_MO + c])), o1 = b * r * g[c + 1] * sigmoidf_(bf2f(P[row * PW + C_MO + c + 1]));
        *(unsigned*)(BR + row * 3072 + c) = pk2(o0, o1);
    }
}
__device__ __forceinline__ unsigned fkey(float f) { const unsigned u = __float_as_uint(f); return (u & 0x80000000u) ? ~u : (u | 0x80000000u); }
__device__ __forceinline__ void select_row(const unsigned (&key)[32], int nvalid, unsigned long long* mrow, int lane, LAS unsigned* cand) {
    if (nvalid <= TOPK) {
#pragma unroll
        for (int j = 0; j < 32; ++j) { const unsigned long long b = __ballot(lane + 64 * j < nvalid); if (lane == 0) mrow[j] = b; }
        return;
    }
    unsigned T = 0u; int cT = 2048, cU = 0, bit = 31;
    for (; bit >= 0; --bit) {
        const unsigned cnd = T | (1u << bit); int c = 0;
#pragma unroll
        for (int j = 0; j < 32; ++j) c += __popcll(__ballot(key[j] >= cnd));
        if (c >= TOPK) { T = cnd; cT = c; } else cU = c;
        if (cT - cU <= 64) break;
    }
    if (bit > 0) {
        const unsigned span = 1u << bit; int base = 0;
#pragma unroll
        for (int j = 0; j < 32; ++j) { const bool pr = (key[j] - T) < span; const unsigned long long m = __ballot(pr);
            if (m) { const int pos = base + (int)__builtin_amdgcn_mbcnt_hi((unsigned)(m >> 32), __builtin_amdgcn_mbcnt_lo((unsigned)m, 0u)); if (pr) cand[pos] = key[j]; base += __popcll(m); } }
        LDS_WAIT(); asm volatile("" ::: "memory");
        const int u = cT - cU, kq = TOPK - cU;
        const unsigned my = (lane < u) ? cand[lane] : 0u; int cnt = 0;
        for (int m = 0; m < u; ++m) cnt += (cand[m] > my) ? 1 : 0;
        unsigned best = (lane < u && cnt < kq) ? my : 0xFFFFFFFFu;
#pragma unroll
        for (int o = 1; o < 64; o <<= 1) { const unsigned t = (unsigned)__shfl_xor((int)best, o); best = t < best ? t : best; }
        T = best;
        LDS_WAIT(); asm volatile("" ::: "memory");
    }
    int cgt = 0;
#pragma unroll
    for (int j = 0; j < 32; ++j) cgt += __popcll(__ballot(key[j] > T));
    const int need = TOPK - cgt; int run = 0;
    const unsigned long long below = (lane == 0) ? 0ull : (~0ull >> (64 - lane));
#pragma unroll
    for (int j = 0; j < 32; ++j) {
        const bool eq = key[j] == T; const unsigned long long be = __ballot(eq);
        const int rank = run + __popcll(be & below);
        const bool sel = (key[j] > T) || (eq && rank < need);
        run += __popcll(be);
        const unsigned long long b = __ballot(sel); if (lane == 0) mrow[j] = b;
    }
}
__device__ __forceinline__ void nv_index(const Frame& F) {
    const bf16* P = (const bf16*)(F.ws + WS_PROJ); unsigned long long* MK = (unsigned long long*)(F.ws + WS_MASK);
    LAS float* iqL = (LAS float*)(F.lds + F.wave * 12288); LAS float* scL = iqL + 1024;
    const int gw = GW_ID(F), NGW = GW_N(F), lane = fresh_lane();
    for (int row = gw; row < NTOK; row += NGW) {
        const int t = row & (SEQ - 1), r0 = row - t;
        for (int i = lane; i < 1024; i += 64) iqL[i] = bf2f(P[(size_t)row * PW + C_IQ + i]);
        float w[16];
#pragma unroll
        for (int hh = 0; hh < 16; ++hh) w[hh] = bf2f(P[(size_t)row * PW + C_IW + hh]) * 0.25f;
        LDS_WAIT(); asm volatile("" ::: "memory");
        for (int s = lane; s <= t; s += 64) {
            float d[16];
#pragma unroll
            for (int hh = 0; hh < 16; ++hh) d[hh] = 0.f;
            const v4u* kp = (const v4u*)(P + (size_t)(r0 + s) * PW + C_IK);
#pragma unroll 1
            for (int hf = 0; hf < 2; ++hf) {
                float kr[32];
#pragma unroll
                for (int q = 0; q < 4; ++q) { const v4u x = kp[4 * hf + q]; kr[8 * q] = bflo(x.x); kr[8 * q + 1] = bfhi(x.x); kr[8 * q + 2] = bflo(x.y); kr[8 * q + 3] = bfhi(x.y); kr[8 * q + 4] = bflo(x.z); kr[8 * q + 5] = bfhi(x.z); kr[8 * q + 6] = bflo(x.w); kr[8 * q + 7] = bfhi(x.w); }
#pragma unroll
                for (int hh = 0; hh < 16; ++hh) {
#pragma unroll
                    for (int e = 0; e < 32; ++e) d[hh] += iqL[hh * 64 + hf * 32 + e] * kr[e]; }
            }
            float sc = 0.f;
#pragma unroll
            for (int hh = 0; hh < 16; ++hh) sc += w[hh] * fmaxf(d[hh] * 0.125f, 0.f);
            scL[s] = sc;
        }
        LDS_WAIT(); asm volatile("" ::: "memory");
        unsigned key[32];
#pragma unroll
        for (int j = 0; j < 32; ++j) { const int s = lane + 64 * j; key[j] = (s <= t) ? fkey(scL[s]) : 0u; }
        select_row(key, t + 1, MK + (size_t)row * 32, lane, (LAS unsigned*)scL);
        LDS_WAIT(); asm volatile("" ::: "memory");
    }
}
__device__ __forceinline__ void nv_dsa(const Frame& F, int l) {
    const bf16* P = (const bf16*)(F.ws + WS_PROJ); const unsigned long long* MK = (const unsigned long long*)(F.ws + WS_MASK); bf16* BR = (bf16*)(F.ws + WS_BR);
    const float* qg = arg_in(7) + l * HD; const float* kg = arg_in(8) + l * HD; const float* rb = arg_in(19);
    LAS float* lgL = (LAS float*)(F.lds + F.wave * 2048); LAS int* ixL = (LAS int*)(lgL + 256);
    const int gw = GW_ID(F), NGW = GW_N(F), lane = fresh_lane();
    for (int it = gw; it < NTOK * NH; it += NGW) {
        const int row = it >> 3, h = it & 7, t = row & (SEQ - 1), r0 = row - t, c = h * HD + 2 * lane;
        float q0 = bf2f(P[(size_t)row * PW + C_DQ + c]), q1 = bf2f(P[(size_t)row * PW + C_DQ + c + 1]);
        const float qr = 1.0f / sqrtf(wave_sum(q0 * q0 + q1 * q1) * (1.f / HD) + EPS);
        q0 *= qr * qg[2 * lane]; q1 *= qr * qg[2 * lane + 1];
        const float kg0 = kg[2 * lane], kg1 = kg[2 * lane + 1];
        int cnt = 0; float mx = -3.0e38f;
        for (int wi = 0; wi <= (t >> 6); ++wi) {
            unsigned long long w = MK[(size_t)row * 32 + wi];
            while (w) { const int s = wi * 64 + __builtin_ctzll(w); w &= w - 1;
                const unsigned kk = *(const unsigned*)(P + (size_t)(r0 + s) * PW + C_DK + c);
                const float k0 = bflo(kk), k1 = bfhi(kk);
                const float ss = wave_sum(k0 * k0 + k1 * k1), dd = wave_sum(q0 * k0 * kg0 + q1 * k1 * kg1);
                const float kr = 1.0f / sqrtf(ss * (1.f / HD) + EPS);
                const float lgt = dd * kr * 0.08838834764831845f + rb[t5_bucket(t - s) * NH + h];
                if (lane == 0) { lgL[cnt] = lgt; ixL[cnt] = s; }
                mx = fmaxf(mx, lgt); ++cnt; }
        }
        LDS_WAIT(); asm volatile("" ::: "memory");
        float o0 = 0.f, o1 = 0.f, den = 0.f;
        for (int j = 0; j < cnt; ++j) { const float p = __expf(lgL[j] - mx); const int s = ixL[j];
            const unsigned vv = *(const unsigned*)(P + (size_t)(r0 + s) * PW + C_DV + c);
            o0 += p * bflo(vv); o1 += p * bfhi(vv); den += p; }
        *(unsigned*)(BR + (size_t)row * 3072 + 1024 + c) = pk2(o0 / den, o1 / den);
        LDS_WAIT(); asm volatile("" ::: "memory");
    }
}
__device__ __forceinline__ void nv_sb(const Frame& F) {
    const bf16* P = (const bf16*)(F.ws + WS_PROJ); bf16* BR = (bf16*)(F.ws + WS_BR);
    const int gw = GW_ID(F), NGW = GW_N(F), lane = fresh_lane();
    for (int it = gw; it < NTOK * NH; it += NGW) {
        const int row = it >> 3, h = it & 7, t = row & (SEQ - 1), r0 = row - t, c = h * HD + 2 * lane;
        const unsigned qq = *(const unsigned*)(P + (size_t)row * PW + C_SQ + c);
        const float q0 = bflo(qq) * 0.08838834764831845f, q1 = bfhi(qq) * 0.08838834764831845f;
        float o0 = 0.f, o1 = 0.f, lp = 0.f;
        for (int s = t - 1; s >= 0; --s) {
            const unsigned kk = *(const unsigned*)(P + (size_t)(r0 + s) * PW + C_SK + c);
            const float z = wave_sum(q0 * bflo(kk) + q1 * bfhi(kk));
            const float a = __expf(logsigmoidf_(z) + lp);
            const unsigned vv = *(const unsigned*)(P + (size_t)(r0 + s) * PW + C_SV + c);
            o0 += a * bflo(vv); o1 += a * bfhi(vv);
            lp += logsigmoidf_(-z);
            if (lp < -80.f) break;
        }
        *(unsigned*)(BR + (size_t)row * 3072 + 2048 + c) = pk2(o0, o1);
    }
}
__device__ __forceinline__ void nv_moe(const Frame& F) {
    const bf16* XN = (const bf16*)(F.ws + WS_XN); bf16* YB = (bf16*)(F.ws + WS_YB); const int* tinfo = tokinfo_ptr(F);
    LAS float* xL = (LAS float*)F.lds; LAS float* hL = xL + 2048;
    const int tid = (F.wave * 64 + fresh_lane());
    for (int slot = F.vcu; slot < 2 * NTOK; slot += F.G) {
        const int m = slot >> 1, k = slot & 1; const int e = tinfo[m * 8 + 4 * k]; const float w = __int_as_float(tinfo[m * 8 + 4 * k + 2]);
        __syncthreads();
        for (int i = tid; i < 2048; i += NTHR) xL[i] = bf2f(XN[(size_t)m * DM + i]);
        __syncthreads();
        { const int f = tid; const bf16* wg = (const bf16*)(F.ws + WS_WGU) + ((size_t)e * 1024 + (f >> 7) * 256 + (f & 127)) * DM; const bf16* wu = wg + (size_t)128 * DM;
          float g = 0.f, u = 0.f;
          for (int k8 = 0; k8 < 256; ++k8) { const v4u a = ((const v4u*)wg)[k8], b = ((const v4u*)wu)[k8]; const LAS float* x = xL + 8 * k8;
              g += x[0] * bflo(a.x) + x[1] * bfhi(a.x) + x[2] * bflo(a.y) + x[3] * bfhi(a.y) + x[4] * bflo(a.z) + x[5] * bfhi(a.z) + x[6] * bflo(a.w) + x[7] * bfhi(a.w);
              u += x[0] * bflo(b.x) + x[1] * bfhi(b.x) + x[2] * bflo(b.y) + x[3] * bfhi(b.y) + x[4] * bflo(b.z) + x[5] * bfhi(b.z) + x[6] * bflo(b.w) + x[7] * bfhi(b.w); }
          hL[f] = bf2f((unsigned short)f2bf(siluf_(g) * u)); }
        __syncthreads();
        { float y[4];
#pragma unroll
          for (int c = 0; c < 4; ++c) { const int d = 4 * tid + c; const bf16* wd = (const bf16*)(F.ws + WS_WDN) + ((size_t)e * DM + d) * DEXP; float a = 0.f;
              for (int k8 = 0; k8 < 64; ++k8) { const v4u x = ((const v4u*)wd)[k8]; const LAS float* hh = hL + 8 * k8;
                  a += hh[0] * bflo(x.x) + hh[1] * bfhi(x.x) + hh[2] * bflo(x.y) + hh[3] * bfhi(x.y) + hh[4] * bflo(x.z) + hh[5] * bfhi(x.z) + hh[6] * bflo(x.w) + hh[7] * bfhi(x.w); }
              y[c] = a * w; }
          v2u o; o.x = pk2(y[0], y[1]); o.y = pk2(y[2], y[3]); *(v2u*)(YB + (size_t)slot * DM + 4 * tid) = o; }
    }
}
constexpr int MOE_TAB_OFF = LDSCTL_OFF + 1024;
__device__ __forceinline__ void moe_tables(const Frame& F, int l) {
    LAS int* tp = (LAS int*)(F.lds + MOE_TAB_OFF); LAS int* cn = tp + 40; LAS int* sb = cn + 40;
    __syncthreads();
    if ((F.wave * 64 + fresh_lane()) == 0) { int p = 0, s = 0;
        for (int e = 0; e < NEXP; ++e) { const int c = (int)__hip_atomic_load(F.ctl + CW_ECNT + (l * NEXP + e) * 64, RLX_AGENT); tp[e] = p; cn[e] = c; sb[e] = s; p += (c + 255) >> 8; s += c; }
        tp[NEXP] = p; sb[NEXP] = s; }
    __syncthreads();
}
template <int NT> struct SchedMoeBase {
    const LAS int* tp; const LAS int* cn; const LAS int* sb; int G, c;
    __device__ __forceinline__ bool next(int i, pg8::Unit& u) const {
        const int L = i * G + c, total = tp[NEXP] * NT; if (L >= total) return false;
        const int mt = L / NT; u.pn = L % NT; int e = 0;
#pragma unroll 1
        for (int q = 1; q < NEXP; ++q) e = (tp[q] <= mt) ? q : e;
        u.e = e; u.pm = mt - tp[e]; const int r = cn[e] - 256 * u.pm; u.rows = r < 256 ? r : 256; return true;
    }
};
struct SchedMoeUp : SchedMoeBase<4> {
    static constexpr bool GATHER = true;
    const char* A; const char* B; const int* list;
    __device__ __forceinline__ const char* a_base(const pg8::Unit&) const { return A; }
    __device__ __forceinline__ const char* b_base(const pg8::Unit& u) const { return B + ((size_t)u.e * 1024 + (size_t)u.pn * 256) * DM * 2; }
    __device__ __forceinline__ void a_off(const pg8::Unit& u, int tid, unsigned (&v0)[2], unsigned (&v1)[2]) const {
        int R[2], C[2];
#pragma unroll
        for (int i = 0; i < 2; ++i) pg8::stage_rc(tid * 16 + i * 8192, R[i], C[i]);
        const int* le = list + (size_t)u.e * NTOK + 256 * u.pm;
#pragma unroll
        for (int i = 0; i < 2; ++i) { int r0 = R[i], r1 = R[i] + 128; r0 = r0 < u.rows ? r0 : u.rows - 1; r1 = r1 < u.rows ? r1 : u.rows - 1;
            const int t0 = le[r0] >> 1, t1 = le[r1] >> 1;
            v0[i] = (unsigned)(t0 * DM + C[i]) * 2u; v1[i] = (unsigned)(t1 * DM + C[i]) * 2u; }
    }
};
struct EpiMoeUp {
    static constexpr bool PERM = true;
    static constexpr bool PROBE2 = false;
    __device__ __forceinline__ bool zero_after(const pg8::Unit&) const { return true; }
    bf16* HB; const LAS int* sb;
    __device__ __forceinline__ void operator()(const f32x4 (&acc)[2][2][4][2], const pg8::Unit& u, int wr, int wc, int fr, int fq) const {
        const int col0 = u.pn * 128 + wc * 32 + 8 * fq; const size_t slot0 = (size_t)sb[u.e] + 256 * u.pm;
#pragma unroll
        for (int ai = 0; ai < 2; ++ai)
#pragma unroll
            for (int m = 0; m < 4; ++m) { const int r = ai * 128 + wr * 64 + m * 16 + fr;
                if (r < u.rows) { const f32x4 g0 = acc[ai][0][m][0], g1 = acc[ai][0][m][1], u0 = acc[ai][1][m][0], u1 = acc[ai][1][m][1];
                    v4u w; w.x = cvt_pk_bf16(siluf_(g0[0]) * u0[0], siluf_(g0[1]) * u0[1]); w.y = cvt_pk_bf16(siluf_(g0[2]) * u0[2], siluf_(g0[3]) * u0[3]);
                    w.z = cvt_pk_bf16(siluf_(g1[0]) * u1[0], siluf_(g1[1]) * u1[1]); w.w = cvt_pk_bf16(siluf_(g1[2]) * u1[2], siluf_(g1[3]) * u1[3]);
                    *(v4u*)(HB + (slot0 + r) * DEXP + col0) = w; } }
    }
};
struct SchedMoeDown : SchedMoeBase<8> {
    static constexpr bool GATHER = false;
    const char* A; const char* B;
    __device__ __forceinline__ const char* a_base(const pg8::Unit& u) const { return A + ((size_t)sb[u.e] + 256 * u.pm) * DEXP * 2; }
    __device__ __forceinline__ const char* b_base(const pg8::Unit& u) const { return B + ((size_t)u.e * DM + (size_t)u.pn * 256) * DEXP * 2; }
    __device__ __forceinline__ void a_off(const pg8::Unit&, int tid, unsigned (&v0)[2], unsigned (&v1)[2]) const {
        int R[2], C[2];
#pragma unroll
        for (int i = 0; i < 2; ++i) pg8::stage_rc(tid * 16 + i * 8192, R[i], C[i]);
#pragma unroll
        for (int i = 0; i < 2; ++i) { v0[i] = (unsigned)(R[i] * DEXP + C[i]) * 2u; v1[i] = v0[i] + 128u * DEXP * 2u; } }
};
struct EpiMoeDown {
    static constexpr bool PERM = true;
    static constexpr bool PROBE2 = false;
    __device__ __forceinline__ bool zero_after(const pg8::Unit&) const { return true; }
    bf16* YB; const int* list; const int* tinfo;
    __device__ __forceinline__ void operator()(const f32x4 (&acc)[2][2][4][2], const pg8::Unit& u, int wr, int wc, int fr, int fq) const {
        const int col0 = u.pn * 256 + wc * 32 + 8 * fq; const int* le = list + (size_t)u.e * NTOK + 256 * u.pm;
#pragma unroll
        for (int ai = 0; ai < 2; ++ai)
#pragma unroll
            for (int m = 0; m < 4; ++m) { const int r = ai * 128 + wr * 64 + m * 16 + fr;
                if (r < u.rows) { const int ent = le[r]; const float w = __int_as_float(tinfo[(ent >> 1) * 8 + 4 * (ent & 1) + 2]);
#pragma unroll
                    for (int bj = 0; bj < 2; ++bj) { const f32x4 v0 = acc[ai][bj][m][0] * w, v1 = acc[ai][bj][m][1] * w;
                        v4u o; o.x = cvt_pk_bf16(v0[0], v0[1]); o.y = cvt_pk_bf16(v0[2], v0[3]); o.z = cvt_pk_bf16(v1[0], v1[1]); o.w = cvt_pk_bf16(v1[2], v1[3]);
                        *(v4u*)(YB + (size_t)ent * DM + col0 + bj * 128) = o; } } }
    }
};
#define KSWZ(row, colB) ((row) * 256 + ((colB) ^ (((row) & 7) << 4)))
#define SBAR() __builtin_amdgcn_sched_barrier(0)
__device__ __forceinline__ int crow(int r, int hi) { return (r & 3) + 8 * (r >> 2) + 4 * hi; }
__device__ __forceinline__ void qkt64(f32x16& p0, f32x16& p1, const LAS char* Ks, const bf16x8* qr, int r32, int hi) {
    p0 = f32x16{}; p1 = f32x16{};
#pragma unroll
    for (int d0 = 0; d0 < 8; ++d0) { const int cb = (d0 * 16 + hi * 8) * 2;
        const bf16x8 b0 = *(const LAS bf16x8*)(Ks + KSWZ(r32, cb));
        const bf16x8 b1 = *(const LAS bf16x8*)(Ks + KSWZ(32 + r32, cb));
        p0 = __builtin_amdgcn_mfma_f32_32x32x16_bf16(b0, qr[d0], p0, 0, 0, 0);
        p1 = __builtin_amdgcn_mfma_f32_32x32x16_bf16(b1, qr[d0], p1, 0, 0, 0); }
}
__device__ __forceinline__ void qkt32(f32x16& p0, const LAS char* Ks, const bf16x8* qr, int r32, int hi) {
    p0 = f32x16{};
#pragma unroll
    for (int d0 = 0; d0 < 8; ++d0) { const int cb = (d0 * 16 + hi * 8) * 2;
        const bf16x8 b0 = *(const LAS bf16x8*)(Ks + KSWZ(r32, cb));
        p0 = __builtin_amdgcn_mfma_f32_32x32x16_bf16(b0, qr[d0], p0, 0, 0, 0); }
}
__device__ __forceinline__ int v_st(int k, int c) { const int kk = (k & ~0xC) | ((k & 4) << 1) | ((k & 8) >> 1); return ((kk >> 3) * 4 + (c >> 5)) * 512 + ((kk & 7) * 32 + (c & 31)) * 2; }
__device__ __forceinline__ int v_rd_base(int lane) { return ((lane & 3) << 3) | (((lane >> 2) & 3) << 6) | (((lane >> 4) & 1) << 5) | (((lane >> 5) & 1) << 8); }
constexpr int v_rd_off(int d0, int ks, int half) { return d0 * 512 + ks * 4096 + half * 2048; }
template <int OFF> __device__ __forceinline__ s16x4 tr_read(int vb) {
    s16x4 r; asm volatile("ds_read_b64_tr_b16 %0, %1 offset:%2" : "=&v"(r) : "v"(vb), "i"(OFF) : "memory"); return r;
}
__device__ __forceinline__ s16x4 tr_read_dyn(unsigned addr) { s16x4 r; asm volatile("ds_read_b64_tr_b16 %0, %1" : "=&v"(r) : "v"(addr) : "memory"); return r; }
template <int D0> __device__ __forceinline__ void pv_one(f32x16& od, int vb, bf16x8 pa0, bf16x8 pa1, bf16x8 pa2, bf16x8 pa3) {
    const s16x4 l0 = tr_read<v_rd_off(D0, 0, 0)>(vb), h0 = tr_read<v_rd_off(D0, 0, 1)>(vb), l1 = tr_read<v_rd_off(D0, 1, 0)>(vb), h1 = tr_read<v_rd_off(D0, 1, 1)>(vb);
    const s16x4 l2 = tr_read<v_rd_off(D0, 2, 0)>(vb), h2 = tr_read<v_rd_off(D0, 2, 1)>(vb), l3 = tr_read<v_rd_off(D0, 3, 0)>(vb), h3 = tr_read<v_rd_off(D0, 3, 1)>(vb);
    asm volatile("s_waitcnt lgkmcnt(0)" ::: "memory"); SBAR();
#define PKV(L, H) (bf16x8){L[0], L[1], L[2], L[3], H[0], H[1], H[2], H[3]}
    od = __builtin_amdgcn_mfma_f32_32x32x16_bf16(pa0, PKV(l0, h0), od, 0, 0, 0);
    od = __builtin_amdgcn_mfma_f32_32x32x16_bf16(pa1, PKV(l1, h1), od, 0, 0, 0);
    od = __builtin_amdgcn_mfma_f32_32x32x16_bf16(pa2, PKV(l2, h2), od, 0, 0, 0);
    od = __builtin_amdgcn_mfma_f32_32x32x16_bf16(pa3, PKV(l3, h3), od, 0, 0, 0);
}
template <int D0> __device__ __forceinline__ void pv_one_lo(f32x16& od, int vb, bf16x8 pa0, bf16x8 pa1) {
    const s16x4 l0 = tr_read<v_rd_off(D0, 0, 0)>(vb), h0 = tr_read<v_rd_off(D0, 0, 1)>(vb), l1 = tr_read<v_rd_off(D0, 1, 0)>(vb), h1 = tr_read<v_rd_off(D0, 1, 1)>(vb);
    asm volatile("s_waitcnt lgkmcnt(0)" ::: "memory"); SBAR();
    od = __builtin_amdgcn_mfma_f32_32x32x16_bf16(pa0, PKV(l0, h0), od, 0, 0, 0);
    od = __builtin_amdgcn_mfma_f32_32x32x16_bf16(pa1, PKV(l1, h1), od, 0, 0, 0);
}
__device__ __forceinline__ void pv_all(f32x16* o, int vb, bf16x8 pa0, bf16x8 pa1, bf16x8 pa2, bf16x8 pa3) {
    pv_one<0>(o[0], vb, pa0, pa1, pa2, pa3); pv_one<1>(o[1], vb, pa0, pa1, pa2, pa3); pv_one<2>(o[2], vb, pa0, pa1, pa2, pa3); pv_one<3>(o[3], vb, pa0, pa1, pa2, pa3);
}
#define PK4(P, BASE, OUT) do { unsigned a0_ = cvt_pk_bf16(P[BASE + 0], P[BASE + 1]), a1_ = cvt_pk_bf16(P[BASE + 2], P[BASE + 3]);   \
    unsigned b0_ = cvt_pk_bf16(P[BASE + 4], P[BASE + 5]), b1_ = cvt_pk_bf16(P[BASE + 6], P[BASE + 7]);                              \
    auto r0_ = __builtin_amdgcn_permlane32_swap(a0_, b0_, false, false); auto r1_ = __builtin_amdgcn_permlane32_swap(a1_, b1_, false, false); \
    v4u w_ = {r0_[0], r1_[0], r0_[1], r1_[1]}; OUT = *reinterpret_cast<bf16x8*>(&w_); } while (0)
__device__ __forceinline__ float pair_sum(float v) { auto rr = __builtin_amdgcn_permlane32_swap(__float_as_uint(v), __float_as_uint(v), false, false); return __uint_as_float(rr[0]) + __uint_as_float(rr[1]); }
__device__ __forceinline__ float pair_max(float v) { auto rr = __builtin_amdgcn_permlane32_swap(__float_as_uint(v), __float_as_uint(v), false, false); return fmaxf(__uint_as_float(rr[0]), __uint_as_float(rr[1])); }
__device__ __forceinline__ unsigned off_b(unsigned row, unsigned ch) { return 256u * row + 16u * (ch ^ (((row & 3) << 2) | ((row >> 2) & 3))); }
__device__ __forceinline__ unsigned trb_addr(unsigned lane, unsigned c, unsigned ks, unsigned t) {
    const unsigned h = lane >> 5, blk = (lane >> 4) & 1, q = (lane & 15) >> 2, p = lane & 3;
    return off_b(16 * ks + 8 * h + 4 * t + q, 4 * c + 2 * blk + (p >> 1)) + 8 * (p & 1);
}

constexpr int ML_TAB_OFF = LDSCTL_OFF + 2048;
struct MTabs { LAS float* g; LAS float* b; LAS float* pm; LAS float* G; LAS float* mprev; LAS float* dec; LAS float* fsc; };
__device__ __forceinline__ MTabs mtabs(const Frame& F) { MTabs T; T.g = (LAS float*)(F.lds + ML_TAB_OFF); T.b = T.g + 256; T.pm = T.b + 256; T.G = T.pm + 256; T.mprev = T.G + 4; T.dec = T.mprev + 4; T.fsc = T.dec + 32; return T; }
__device__ __forceinline__ float* gif_ptr(const Frame& F) { return (float*)(F.ws + WS_MSN + 512 * 1024); }
constexpr size_t WS_KC = WS_TMP, WS_QC = WS_TMP + 16 * MiB, WS_GTOK = WS_TMP + 32 * MiB, WS_MSUM = WS_TMP + 33 * MiB, WS_MPREV = WS_MSUM + 65536;
__device__ __forceinline__ void conv8(const bf16* P, const float* cw, size_t row, int t, int col0, int ch0, float sc, float (&o)[8]) {
#pragma unroll
    for (int e = 0; e < 8; ++e) o[e] = 0.f;
#pragma unroll
    for (int j = 0; j < 4; ++j) { const int tt = t - 3 + j;
        if (tt >= 0) { const v4u x = *(const v4u*)(P + (row - 3 + j) * PW + col0); const f32x4 w0 = *(const f32x4*)(cw + j * 2048 + ch0), w1 = *(const f32x4*)(cw + j * 2048 + ch0 + 4);
            o[0] += w0.x * bflo(x.x); o[1] += w0.y * bfhi(x.x); o[2] += w0.z * bflo(x.y); o[3] += w0.w * bfhi(x.y);
            o[4] += w1.x * bflo(x.z); o[5] += w1.y * bfhi(x.z); o[6] += w1.z * bflo(x.w); o[7] += w1.w * bfhi(x.w); } }
#pragma unroll
    for (int e = 0; e < 8; ++e) o[e] = siluf_(o[e]) * sc;
}
__device__ __forceinline__ void ml_delta(const Frame& F, int l) {
    const bf16* P = (const bf16*)(F.ws + WS_PROJ); const float* cw = arg_in(3) + (size_t)l * 4 * 2048;
    float* DEL = (float*)(F.ws + WS_MDEL); float* DN = (float*)(F.ws + WS_MDN);
    bf16* KC = (bf16*)(F.ws + WS_KC); bf16* QC = (bf16*)(F.ws + WS_QC); float* GTOK = (float*)(F.ws + WS_GTOK); float* MSUM = (float*)(F.ws + WS_MSUM);
    const float* gif = gif_ptr(F);
    const int wave = F.wave;
    const MTabs T = mtabs(F);
    for (int blk = F.vcu; blk < 256; blk += F.G) {
        const int tid = F.wave * 64 + fresh_lane();
        const int lane = tid & 63;
        const int bh = blk >> 3, cr = blk & 7, b = bh >> 3, h = bh & 7;
        __syncthreads();
        if (wave < 4) { const int ci = wave, c = 4 * cr + ci; const size_t row = (size_t)b * SEQ + 64 * c + lane;
            const float it = gif[row * 16 + h] + arg_in(4)[l * NH + h], lf = logsigmoidf_(gif[row * 16 + 8 + h] + arg_in(5)[l * NH + h]);
            float bc = lf;
#pragma unroll
            for (int o = 1; o < 64; o <<= 1) { const float t = __shfl_up(bc, o); bc += (lane >= o) ? t : 0.f; }
            const float g = it - bc; float pm = g;
#pragma unroll
            for (int o = 1; o < 64; o <<= 1) { const float t = __shfl_up(pm, o); pm = (lane >= o) ? fmaxf(pm, t) : pm; }
            T.g[ci * 64 + lane] = g; *(f32x4*)(GTOK + (row * 8 + h) * 4) = (f32x4){g, bc, pm, 0.f};
            if (lane == 63) { T.G[ci] = pm; MSUM[(bh * 32 + c) * 2] = bc; MSUM[(bh * 32 + c) * 2 + 1] = pm; } }
        __syncthreads();
        { const int ch = tid & 15;
          f32x4 wk[4][2], wq[4][2];
#pragma unroll
          for (int j = 0; j < 4; ++j) { wk[j][0] = *(const f32x4*)(cw + j * 2048 + 1024 + h * HD + 8 * ch); wk[j][1] = *(const f32x4*)(cw + j * 2048 + 1024 + h * HD + 8 * ch + 4);
              wq[j][0] = *(const f32x4*)(cw + j * 2048 + h * HD + 8 * ch); wq[j][1] = *(const f32x4*)(cw + j * 2048 + h * HD + 8 * ch + 4); }
#pragma unroll 2
          for (int q = 0; q < 8; ++q) { const int it = tid + q * NTHR, ci = it >> 10, s = (it >> 4) & 63, t = 64 * (4 * cr + ci) + s; const size_t row = (size_t)b * SEQ + t;
              v4u xk[4], xq[4];
#pragma unroll
              for (int j = 0; j < 4; ++j) { const bool ok = t - 3 + j >= 0; xk[j] = ok ? *(const v4u*)(P + (row - 3 + j) * PW + C_MK + h * HD + 8 * ch) : (v4u){0u, 0u, 0u, 0u};
                  xq[j] = ok ? *(const v4u*)(P + (row - 3 + j) * PW + C_MQ + h * HD + 8 * ch) : (v4u){0u, 0u, 0u, 0u}; }
              const v4u x = *(const v4u*)(P + row * PW + C_MV + h * HD + 8 * ch);
              float ak[8], aq[8];
#pragma unroll
              for (int e = 0; e < 8; ++e) { ak[e] = 0.f; aq[e] = 0.f; }
#pragma unroll
              for (int j = 0; j < 4; ++j) {
                  ak[0] += wk[j][0].x * bflo(xk[j].x); ak[1] += wk[j][0].y * bfhi(xk[j].x); ak[2] += wk[j][0].z * bflo(xk[j].y); ak[3] += wk[j][0].w * bfhi(xk[j].y);
                  ak[4] += wk[j][1].x * bflo(xk[j].z); ak[5] += wk[j][1].y * bfhi(xk[j].z); ak[6] += wk[j][1].z * bflo(xk[j].w); ak[7] += wk[j][1].w * bfhi(xk[j].w);
                  aq[0] += wq[j][0].x * bflo(xq[j].x); aq[1] += wq[j][0].y * bfhi(xq[j].x); aq[2] += wq[j][0].z * bflo(xq[j].y); aq[3] += wq[j][0].w * bfhi(xq[j].y);
                  aq[4] += wq[j][1].x * bflo(xq[j].z); aq[5] += wq[j][1].y * bfhi(xq[j].z); aq[6] += wq[j][1].z * bflo(xq[j].w); aq[7] += wq[j][1].w * bfhi(xq[j].w); }
#pragma unroll
              for (int e = 0; e < 8; ++e) { ak[e] = siluf_(ak[e]); aq[e] = siluf_(aq[e]) * 0.08838834764831845f; }
              v4u o; o.x = pk2(ak[0], ak[1]); o.y = pk2(ak[2], ak[3]); o.z = pk2(ak[4], ak[5]); o.w = pk2(ak[6], ak[7]);
              *(LAS v4u*)(F.lds + ci * 32768 + off_b(s, ch)) = o; *(v4u*)(KC + row * 1024 + h * HD + 8 * ch) = o;
              o.x = pk2(aq[0], aq[1]); o.y = pk2(aq[2], aq[3]); o.z = pk2(aq[4], aq[5]); o.w = pk2(aq[6], aq[7]);
              *(v4u*)(QC + row * 1024 + h * HD + 8 * ch) = o;
              const float ws = __expf(T.g[ci * 64 + s] - T.G[ci]);
              o.x = pk2(ws * bflo(x.x), ws * bfhi(x.x)); o.y = pk2(ws * bflo(x.y), ws * bfhi(x.y)); o.z = pk2(ws * bflo(x.z), ws * bfhi(x.z)); o.w = pk2(ws * bflo(x.w), ws * bfhi(x.w));
              *(LAS v4u*)(F.lds + ci * 32768 + 16384 + off_b(s, ch)) = o; } }
        __syncthreads();
        const int vb = wave >> 1, kh = wave & 1, r32 = lane & 31, hi = lane >> 5;
        const unsigned ldsb = (unsigned)(size_t)F.lds;
#pragma unroll 1
        for (int ci = 0; ci < 4; ++ci) { const int c = 4 * cr + ci; if (c == NCH - 1) break;
            f32x16 a0 = {}, a1 = {};
#pragma unroll
            for (int ks = 0; ks < 4; ++ks) {
                const s16x4 al = tr_read_dyn(ldsb + ci * 32768 + 16384 + trb_addr(lane, vb, ks, 0)), ah = tr_read_dyn(ldsb + ci * 32768 + 16384 + trb_addr(lane, vb, ks, 1));
                const s16x4 bl0 = tr_read_dyn(ldsb + ci * 32768 + trb_addr(lane, 2 * kh, ks, 0)), bh0 = tr_read_dyn(ldsb + ci * 32768 + trb_addr(lane, 2 * kh, ks, 1));
                const s16x4 bl1 = tr_read_dyn(ldsb + ci * 32768 + trb_addr(lane, 2 * kh + 1, ks, 0)), bh1 = tr_read_dyn(ldsb + ci * 32768 + trb_addr(lane, 2 * kh + 1, ks, 1));
                asm volatile("s_waitcnt lgkmcnt(0)" ::: "memory"); SBAR();
                a0 = __builtin_amdgcn_mfma_f32_32x32x16_bf16(PKV(al, ah), PKV(bl0, bh0), a0, 0, 0, 0);
                a1 = __builtin_amdgcn_mfma_f32_32x32x16_bf16(PKV(al, ah), PKV(bl1, bh1), a1, 0, 0, 0); }
            float* dp = DEL + ((size_t)(bh * 32 + c) * 128) * 128;
#pragma unroll
            for (int r = 0; r < 16; ++r) { const int v = 32 * vb + crow(r, hi); dp[(size_t)v * 128 + 64 * kh + r32] = a0[r]; dp[(size_t)v * 128 + 64 * kh + 32 + r32] = a1[r]; }
        }
        { const int ci = tid >> 7, k = tid & 127, c = 4 * cr + ci;
          if (c < NCH - 1) { float a = 0.f; const float G = T.G[ci];
              for (int s = 0; s < 64; ++s) a += __expf(T.g[ci * 64 + s] - G) * bf2f(*(const LAS unsigned short*)(F.lds + ci * 32768 + off_b(s, k >> 3) + 2 * (k & 7)));
              DN[(size_t)(bh * 32 + c) * 128 + k] = a; } }
    }
}
__device__ __forceinline__ void ml_scan(const Frame& F) {
    const float* DEL = (const float*)(F.ws + WS_MDEL); const float* DN = (const float*)(F.ws + WS_MDN); const float* MSUM = (const float*)(F.ws + WS_MSUM);
    bf16* ST = (bf16*)(F.ws + WS_MST); float* SN = (float*)(F.ws + WS_MSN); float* MPREV = (float*)(F.ws + WS_MPREV);
    const MTabs T = mtabs(F);
    for (int blk = F.vcu; blk < 256; blk += F.G) {
        const int tid = F.wave * 64 + fresh_lane(); const int bh = blk >> 3, part = blk & 7;
        __syncthreads();
        if (tid == 0) { float m = 0.f;
            for (int c = 0; c < NCH; ++c) { const float be = MSUM[(bh * 32 + c) * 2], G = MSUM[(bh * 32 + c) * 2 + 1], me = fmaxf(m, G);
                T.dec[c] = __expf(m - me); T.fsc[c] = __expf(G - me); if (part == 0) MPREV[bh * 32 + c] = m; m = be + me; } }
        __syncthreads();
        const int q = part * 512 + tid; f32x4 acc = {0.f, 0.f, 0.f, 0.f};
#pragma unroll 4
        for (int c = 0; c < NCH - 1; ++c) { const f32x4 x = *(const f32x4*)(DEL + ((size_t)(bh * 32 + c) * 4096 + q) * 4);
            acc = acc * T.dec[c] + x * T.fsc[c]; v2u o; o.x = pk2(acc.x, acc.y); o.y = pk2(acc.z, acc.w); *(v2u*)(ST + ((size_t)(bh * 32 + c + 1) * 4096 + q) * 4) = o; }
        if (part == 0 && tid < 128) { float a = 0.f;
            for (int c = 0; c < NCH - 1; ++c) { a = a * T.dec[c] + T.fsc[c] * DN[(size_t)(bh * 32 + c) * 128 + tid]; SN[(size_t)(bh * 32 + c + 1) * 128 + tid] = a; } }
    }
}
__device__ __forceinline__ void ml_out_unit(const Frame& F, int l, int blk) {
    const bf16* P = (const bf16*)(F.ws + WS_PROJ); bf16* BR = (bf16*)(F.ws + WS_BR);
    const bf16* KC = (const bf16*)(F.ws + WS_KC); const bf16* QC = (const bf16*)(F.ws + WS_QC); const float* GTOK = (const float*)(F.ws + WS_GTOK); const float* MPREV = (const float*)(F.ws + WS_MPREV);
    const bf16* ST = (const bf16*)(F.ws + WS_MST); const float* SN = (const float*)(F.ws + WS_MSN); const float* gain = arg_in(6) + (size_t)l * BW;
    const int wave = F.wave;
    const MTabs T = mtabs(F);
    LAS float* rowL = (LAS float*)(F.lds + ML_TAB_OFF + 4096) + wave * 32;
    {
        const int tid = F.wave * 64 + fresh_lane();
        const int lane = tid & 63, r32 = lane & 31, hi = lane >> 5;
        const int bh = blk >> 3, cr = blk & 7, b = bh >> 3, h = bh & 7;
        __syncthreads();
        { v4u kx[8], vx[8];
#pragma unroll
          for (int q = 0; q < 8; ++q) { const int it = tid + q * NTHR, ci = it >> 10, s = (it >> 4) & 63, ch = it & 15; const size_t row = (size_t)b * SEQ + 64 * (4 * cr + ci) + s;
              kx[q] = *(const v4u*)(KC + row * 1024 + h * HD + 8 * ch); vx[q] = *(const v4u*)(P + row * PW + C_MV + h * HD + 8 * ch); }
#pragma unroll
          for (int q = 0; q < 8; ++q) { const int it = tid + q * NTHR, ci = it >> 10, s = (it >> 4) & 63, ch = it & 15;
              *(LAS v4u*)(F.lds + ci * 32768 + KSWZ(s, ch * 16)) = kx[q]; *(LAS v4u*)(F.lds + ci * 32768 + 16384 + v_st(s, ch * 8)) = vx[q]; } }
        if (tid < 256) { const size_t row = (size_t)b * SEQ + 256 * cr + tid; const f32x4 gv = *(const f32x4*)(GTOK + (row * 8 + h) * 4); T.g[tid] = gv.x; T.b[tid] = gv.y; T.pm[tid] = gv.z; }
        if (tid < 4) T.mprev[tid] = MPREV[bh * 32 + 4 * cr + tid];
        __syncthreads();
        const int ci = wave >> 1, rh = wave & 1, c = 4 * cr + ci, tau = 32 * rh + r32; const size_t row = (size_t)b * SEQ + 64 * c + tau;
        bf16x8 qr[8];
#pragma unroll
        for (int d0 = 0; d0 < 8; ++d0) qr[d0] = *(const bf16x8*)(QC + row * 1024 + h * HD + 16 * d0 + 8 * hi);
        const float mprev = T.mprev[ci], Mt = fmaxf(mprev, T.pm[ci * 64 + tau]), winter = __expf(mprev - Mt), flo = __expf(-T.b[ci * 64 + tau] - Mt);
        const LAS char* Kc = (const LAS char*)(F.lds + ci * 32768);
        const int vbase = (int)(size_t)(F.lds + ci * 32768 + 16384) + v_rd_base(lane);
        f32x16 o[4] = {}; f32x16 p0, p1; float ps = 0.f; bf16x8 pa0, pa1, pa2, pa3;
        const LAS f32x4* g4 = (const LAS f32x4*)(T.g + ci * 64);
        if (rh == 0) { qkt32(p0, Kc, qr, r32, hi);
#pragma unroll
            for (int q = 0; q < 4; ++q) { const f32x4 gg = g4[2 * q + hi];
#pragma unroll
                for (int e = 0; e < 4; ++e) { const int r = 4 * q + e, s = crow(r, hi); const float wgt = (s <= tau) ? __expf(gg[e] - Mt) : 0.f; p0[r] *= wgt; ps += p0[r]; } }
            PK4(p0, 0, pa0); PK4(p0, 8, pa1);
            pv_one_lo<0>(o[0], vbase, pa0, pa1); pv_one_lo<1>(o[1], vbase, pa0, pa1); pv_one_lo<2>(o[2], vbase, pa0, pa1); pv_one_lo<3>(o[3], vbase, pa0, pa1);
        } else { qkt64(p0, p1, Kc, qr, r32, hi);
#pragma unroll
            for (int q = 0; q < 4; ++q) { const f32x4 gg = g4[2 * q + hi], gh = g4[8 + 2 * q + hi];
#pragma unroll
                for (int e = 0; e < 4; ++e) { const int r = 4 * q + e, s = crow(r, hi); p0[r] *= __expf(gg[e] - Mt); ps += p0[r];
                    const float wgt = (32 + s <= tau) ? __expf(gh[e] - Mt) : 0.f; p1[r] *= wgt; ps += p1[r]; } }
            PK4(p0, 0, pa0); PK4(p0, 8, pa1); PK4(p1, 0, pa2); PK4(p1, 8, pa3);
            pv_all(o, vbase, pa0, pa1, pa2, pa3);
        }
        ps = pair_sum(ps);
        float nq = 0.f;
        if (c > 0) {
            const bf16* Sc = ST + (size_t)(bh * 32 + c) * 16384; const float* nc = SN + (size_t)(bh * 32 + c) * 128;
#pragma unroll
            for (int kh2 = 0; kh2 < 2; ++kh2) {
                bf16x8 cf[4][4]; f32x4 nn[4][2];
#pragma unroll
                for (int k4 = 0; k4 < 4; ++k4) { const int ks = 4 * kh2 + k4; nn[k4][0] = *(const f32x4*)(nc + 16 * ks + 8 * hi); nn[k4][1] = *(const f32x4*)(nc + 16 * ks + 8 * hi + 4);
#pragma unroll
                    for (int d0 = 0; d0 < 4; ++d0) cf[k4][d0] = *(const bf16x8*)(Sc + (size_t)(32 * d0 + r32) * 128 + 16 * ks + 8 * hi); }
#pragma unroll
                for (int k4 = 0; k4 < 4; ++k4) { const int ks = 4 * kh2 + k4; const v4u qq = *reinterpret_cast<const v4u*>(&qr[ks]); const f32x4 n0 = nn[k4][0], n1 = nn[k4][1];
                    nq += bflo(qq.x) * n0.x + bfhi(qq.x) * n0.y + bflo(qq.y) * n0.z + bfhi(qq.y) * n0.w + bflo(qq.z) * n1.x + bfhi(qq.z) * n1.y + bflo(qq.w) * n1.z + bfhi(qq.w) * n1.w;
                    v4u sq; sq.x = pk2(bflo(qq.x) * winter, bfhi(qq.x) * winter); sq.y = pk2(bflo(qq.y) * winter, bfhi(qq.y) * winter); sq.z = pk2(bflo(qq.z) * winter, bfhi(qq.z) * winter); sq.w = pk2(bflo(qq.w) * winter, bfhi(qq.w) * winter);
                    const bf16x8 qs = *reinterpret_cast<const bf16x8*>(&sq);
#pragma unroll
                    for (int d0 = 0; d0 < 4; ++d0) o[d0] = __builtin_amdgcn_mfma_f32_32x32x16_bf16(qs, cf[k4][d0], o[d0], 0, 0, 0); }
                asm volatile("" ::: "memory"); }
            nq = pair_sum(nq);
        }
        const float den = winter * nq + ps, rinv = 1.0f / fmaxf(fabsf(den), flo);
        if (hi == 0) rowL[r32] = rinv;
        LDS_WAIT(); asm volatile("" ::: "memory");
        float ss[16];
#pragma unroll
        for (int r = 0; r < 16; ++r) { const float ri = rowL[crow(r, hi)]; float a = 0.f;
#pragma unroll
            for (int d0 = 0; d0 < 4; ++d0) { o[d0][r] *= ri; a += o[d0][r] * o[d0][r]; }
            ss[r] = a; }
#pragma unroll
        for (int r = 0; r < 16; ++r) {
#pragma unroll
            for (int of = 1; of < 32; of <<= 1) ss[r] += __shfl_xor(ss[r], of);
            ss[r] = 1.0f / sqrtf(ss[r] * (1.f / HD) + EPS); }
        const size_t row0 = (size_t)b * SEQ + 64 * c + 32 * rh;
#pragma unroll
        for (int dh = 0; dh < 2; ++dh) {
            unsigned short gt[2][16];
#pragma unroll
            for (int d2 = 0; d2 < 2; ++d2)
#pragma unroll
                for (int r = 0; r < 16; ++r) gt[d2][r] = P[(row0 + crow(r, hi)) * PW + C_MO + h * HD + 32 * (2 * dh + d2) + r32];
#pragma unroll
            for (int d2 = 0; d2 < 2; ++d2) { const int d0 = 2 * dh + d2, col = h * HD + 32 * d0 + r32; const float gn = gain[col];
#pragma unroll
                for (int r = 0; r < 16; ++r) BR[(row0 + crow(r, hi)) * 3072 + col] = (bf16)f2bf(o[d0][r] * ss[r] * gn * sigmoidf_(bf2f(gt[d2][r]))); }
            asm volatile("" ::: "memory"); }
    }
}
__device__ __forceinline__ void ml_out(const Frame& F, int l) { for (int blk = F.vcu; blk < 256; blk += F.G) ml_out_unit(F, l, blk); __syncthreads(); }
__device__ __forceinline__ void ph_norm2_mfma(const Frame& F, int l) {
    const float* g = arg_in(11) + (size_t)l * DM;
    const float* wrg = arg_in(12) + (size_t)l * DM * NGRP; const float* brg = arg_in(13) + l * NGRP;
    const float* wre = arg_in(14) + (size_t)l * DM * NEXP; const float* bre = arg_in(15) + l * NEXP;
    const float* X1 = (const float*)(F.ws + WS_X1); bf16* XN = (bf16*)(F.ws + WS_XN);
    int* list = (int*)(F.ws + WS_LIST); int* tinfo = tokinfo_ptr(F);
    unsigned* ecnt = F.ctl + CW_ECNT + l * NEXP * 64;
    LAS float* PL = (LAS float*)F.lds;
    LAS float* LG = PL + 8 * 2048;
    LAS float* RS = LG + 32 * 36;
    for (int blk = F.vcu; blk < NTOK / 32; blk += F.G) {
        const int lane = fresh_lane(), wave = F.wave, tid = wave * 64 + lane; const int m0 = blk * 32;
        __syncthreads();
#pragma unroll 1
        for (int q = 0; q < 4; ++q) { const int m = m0 + 4 * wave + q;
            f32x4 v[8]; float s = 0.f;
            const f32x4* xr = (const f32x4*)(X1 + (size_t)m * DM) + lane;
#pragma unroll
            for (int j = 0; j < 8; ++j) { v[j] = xr[64 * j]; s += (v[j].x * v[j].x + v[j].y * v[j].y) + (v[j].z * v[j].z + v[j].w * v[j].w); }
            const float rstd = 1.0f / sqrtf(wave_sum(s) * (1.f / DM) + EPS);
            v2u* o8 = (v2u*)(XN + (size_t)m * DM) + lane; const f32x4* gr = (const f32x4*)g + lane;
#pragma unroll
            for (int j = 0; j < 8; ++j) { const f32x4 gg = gr[64 * j]; v2u o; o.x = pk2(v[j].x * rstd * gg.x, v[j].y * rstd * gg.y); o.y = pk2(v[j].z * rstd * gg.z, v[j].w * rstd * gg.w); o8[64 * j] = o; }
            if (lane == 0) RS[4 * wave + q] = rstd; }
        { const int i = lane & 31, h = lane >> 5, kb = 256 * wave + 128 * h;
          f32x16 aE = {}, aG = {};
          const float* xp = X1 + (size_t)(m0 + i) * DM + kb; const float* gp = g + kb;
          const float* we = wre + (size_t)kb * NEXP + i; const float* wg = wrg + (size_t)kb * NGRP + (i & 3);
#pragma unroll 2
          for (int s4 = 0; s4 < 32; ++s4) { const f32x4 xv = *(const f32x4*)(xp + 4 * s4), gv = *(const f32x4*)(gp + 4 * s4);
#pragma unroll
              for (int c = 0; c < 4; ++c) { const int s = 4 * s4 + c; const float gk = gv[c];
                  const float be = we[(size_t)s * NEXP] * gk; const float bg = (i < 4) ? wg[(size_t)s * NGRP] * gk : 0.f;
                  aE = __builtin_amdgcn_mfma_f32_32x32x2f32(xv[c], be, aE, 0, 0, 0);
                  aG = __builtin_amdgcn_mfma_f32_32x32x2f32(xv[c], bg, aG, 0, 0, 0); } }
#pragma unroll
          for (int r = 0; r < 16; ++r) { const int t = crow(r, h); PL[(wave * 2 + 0) * 1024 + t * 32 + i] = aE[r]; PL[(wave * 2 + 1) * 1024 + t * 32 + i] = aG[r]; } }
        __syncthreads();
        for (int idx = tid; idx < 32 * 36; idx += NTHR) { const int t = idx / 36, j = idx % 36; float a = 0.f;
#pragma unroll
            for (int w = 0; w < 8; ++w) a += (j < 4) ? PL[(w * 2 + 1) * 1024 + t * 32 + j] : PL[(w * 2) * 1024 + t * 32 + (j - 4)];
            LG[idx] = a * RS[t]; }
        __syncthreads();
        if (tid < 32) { const int m = m0 + tid; const LAS float* lg = LG + tid * 36;
            int gs = 0; float best = lg[0] + brg[0];
#pragma unroll
            for (int q = 1; q < 4; ++q) { const float t = lg[q] + brg[q]; if (t > best) { best = t; gs = q; } }
            const float gm = fmaxf(fmaxf(lg[0], lg[1]), fmaxf(lg[2], lg[3])); float gsum = 0.f, gsel = 0.f;
#pragma unroll
            for (int q = 0; q < 4; ++q) { const float e = __expf(lg[q] - gm); gsum += e; gsel = (q == gs) ? e : gsel; }
            const float pg = gsel / gsum;
            float ein[8];
#pragma unroll
            for (int q = 0; q < 8; ++q) ein[q] = lg[4 + gs * 8 + q];
            int e0 = 0, e1 = -1; float b0 = -3.0e38f, b1 = -3.0e38f;
#pragma unroll
            for (int q = 0; q < 8; ++q) { const float t = ein[q] + bre[gs * 8 + q];
                if (t > b0) { b1 = b0; e1 = e0; b0 = t; e0 = q; } else if (t > b1) { b1 = t; e1 = q; } }
            float em = ein[0];
#pragma unroll
            for (int q = 1; q < 8; ++q) em = fmaxf(em, ein[q]);
            float p0 = 0.f, p1 = 0.f;
#pragma unroll
            for (int q = 0; q < 8; ++q) { const float e = __expf(ein[q] - em); p0 = (q == e0) ? e : p0; p1 = (q == e1) ? e : p1; }
            const float w0 = pg * p0 / (p0 + p1), w1 = pg * p1 / (p0 + p1);
            const int x0 = gs * 8 + e0, x1 = gs * 8 + e1;
            const int pos0 = (int)atomicAdd(ecnt + x0 * 64, 1u), pos1 = (int)atomicAdd(ecnt + x1 * 64, 1u);
            list[x0 * NTOK + pos0] = 2 * m; list[x1 * NTOK + pos1] = 2 * m + 1;
            tinfo[m * 8 + 0] = x0; tinfo[m * 8 + 1] = pos0; tinfo[m * 8 + 2] = __float_as_int(w0); tinfo[m * 8 + 3] = 0;
            tinfo[m * 8 + 4] = x1; tinfo[m * 8 + 5] = pos1; tinfo[m * 8 + 6] = __float_as_int(w1); tinfo[m * 8 + 7] = 0; }
    }
}
constexpr int AT_TAB_OFF = LDSCTL_OFF + 8192;
__device__ __forceinline__ void dsa_index(const Frame& F) {
    const bf16* P = (const bf16*)(F.ws + WS_PROJ); unsigned long long* MK = (unsigned long long*)(F.ws + WS_MASK);
    LAS float* SL = (LAS float*)(F.lds + F.wave * 16384);
    const int gw = GW_ID(F), NGW = GW_N(F);
    for (int wu = gw; wu < 2048; wu += NGW) {
        const int lane = fresh_lane();
        const int m = lane & 31, hi = lane >> 5, qa = (m >> 2) & 1, head = (m & 3) + 4 * (m >> 3);
        const int b = wu >> 9, jj = wu & 511;
#pragma unroll 1
        for (int half = 0; half < 2; ++half) {
            const int tp = half ? 1023 - jj : jj, t0 = 2 * tp; const size_t rb = (size_t)b * SEQ;
            bf16x8 afr[4];
#pragma unroll
            for (int ks = 0; ks < 4; ++ks) afr[ks] = *(const bf16x8*)(P + (rb + t0 + qa) * PW + C_IQ + head * 64 + 16 * ks + 8 * hi);
            float wr[16];
            { const v4u w0 = *(const v4u*)(P + (rb + t0 + hi) * PW + C_IW), w1 = *(const v4u*)(P + (rb + t0 + hi) * PW + C_IW + 8);
              wr[0] = bflo(w0.x); wr[1] = bfhi(w0.x); wr[2] = bflo(w0.y); wr[3] = bfhi(w0.y); wr[4] = bflo(w0.z); wr[5] = bfhi(w0.z); wr[6] = bflo(w0.w); wr[7] = bfhi(w0.w);
              wr[8] = bflo(w1.x); wr[9] = bfhi(w1.x); wr[10] = bflo(w1.y); wr[11] = bfhi(w1.y); wr[12] = bflo(w1.z); wr[13] = bfhi(w1.z); wr[14] = bflo(w1.w); wr[15] = bfhi(w1.w);
#pragma unroll
              for (int r = 0; r < 16; ++r) wr[r] *= 0.03125f; }
            const int nkb = (t0 + 1) / 32 + 1;
#define IDX_LOAD(B_, kb0_) do { _Pragma("unroll") for (int i = 0; i < 4; ++i) { const int kb = ((kb0_) + i < nkb) ? (kb0_) + i : nkb - 1; const bf16* kp = P + (rb + 32 * kb + m) * PW + C_IK + 8 * hi; \
                _Pragma("unroll") for (int ks = 0; ks < 4; ++ks) B_[i][ks] = *(const bf16x8*)(kp + 16 * ks); } } while (0)
#define IDX_SCORE(B_, kb0_) do { _Pragma("unroll") for (int i = 0; i < 4; ++i) { f32x16 acc = {}; \
                _Pragma("unroll") for (int ks = 0; ks < 4; ++ks) acc = __builtin_amdgcn_mfma_f32_32x32x16_bf16(afr[ks], B_[i][ks], acc, 0, 0, 0); \
                float sc = 0.f; _Pragma("unroll") for (int r = 0; r < 16; ++r) sc += wr[r] * fmaxf(acc[r], 0.f); \
                if ((kb0_) + i < nkb) SL[hi * 2048 + 32 * ((kb0_) + i) + m] = sc; } } while (0)
            { bf16x8 bA[4][4], bB[4][4];
              IDX_LOAD(bA, 0);
#pragma unroll 1
              for (int kb0 = 0; kb0 < nkb; kb0 += 8) {
                  if (kb0 + 4 < nkb) IDX_LOAD(bB, kb0 + 4);
                  asm volatile("" ::: "memory");
                  IDX_SCORE(bA, kb0);
                  if (kb0 + 8 < nkb) IDX_LOAD(bA, kb0 + 8);
                  asm volatile("" ::: "memory");
                  if (kb0 + 4 < nkb) IDX_SCORE(bB, kb0 + 4);
              } }
#undef IDX_LOAD
#undef IDX_SCORE
            LDS_WAIT(); asm volatile("" ::: "memory");
#pragma unroll 1
            for (int q = 0; q < 2; ++q) { const int t = t0 + q; unsigned key[32];
#pragma unroll
                for (int j = 0; j < 32; ++j) { const int s = lane + 64 * j; key[j] = (s <= t) ? fkey(SL[q * 2048 + s]) : 0u; }
#ifndef IDX_SEL_REP
#define IDX_SEL_REP 1
#endif
#pragma unroll 1
                for (int rp = 0; rp < IDX_SEL_REP; ++rp) select_row(key, t + 1, MK + (rb + t) * 32, lane, (LAS unsigned*)(F.lds + AT_TAB_OFF + F.wave * 256)); }
            LDS_WAIT(); asm volatile("" ::: "memory");
        }
    }
}

struct KVRegs { v4u k0, k1, v0, v1; };
template <int KP> __device__ __forceinline__ void kv_load(KVRegs& R, const bf16* Kp, const bf16* Vp, size_t row0, int sr, int sc) {
    R.k0 = *(const v4u*)(Kp + (row0 + sr) * KP + sc); R.k1 = *(const v4u*)(Kp + (row0 + 32 + sr) * KP + sc);
    R.v0 = *(const v4u*)(Vp + (row0 + sr) * PW + sc); R.v1 = *(const v4u*)(Vp + (row0 + 32 + sr) * PW + sc);
}
__device__ __forceinline__ v4u knorm8(v4u x, const float (&kg)[8]) {
    float f[8] = {bflo(x.x), bfhi(x.x), bflo(x.y), bfhi(x.y), bflo(x.z), bfhi(x.z), bflo(x.w), bfhi(x.w)};
    float s = 0.f;
#pragma unroll
    for (int e = 0; e < 8; ++e) s += f[e] * f[e];
    s += __shfl_xor(s, 1); s += __shfl_xor(s, 2); s += __shfl_xor(s, 4); s += __shfl_xor(s, 8);
    const float r = 1.0f / sqrtf(s * (1.f / HD) + EPS);
    v4u o; o.x = pk2(f[0] * r * kg[0], f[1] * r * kg[1]); o.y = pk2(f[2] * r * kg[2], f[3] * r * kg[3]); o.z = pk2(f[4] * r * kg[4], f[5] * r * kg[5]); o.w = pk2(f[6] * r * kg[6], f[7] * r * kg[7]);
    return o;
}
template <bool NORM> __device__ __forceinline__ void kv_write(const KVRegs& R, LAS unsigned char* buf, int sr, int sc, const float (&kg)[8]) {
    *(LAS v4u*)(buf + KSWZ(sr, sc * 2)) = NORM ? knorm8(R.k0, kg) : R.k0; *(LAS v4u*)(buf + KSWZ(32 + sr, sc * 2)) = NORM ? knorm8(R.k1, kg) : R.k1;
    *(LAS v4u*)(buf + 16384 + v_st(sr, sc)) = R.v0; *(LAS v4u*)(buf + 16384 + v_st(32 + sr, sc)) = R.v1;
}

constexpr size_t WS_KN = WS_TMP + 34 * MiB;
__device__ __forceinline__ void dsa_knorm(const Frame& F, int l) {
    const bf16* P = (const bf16*)(F.ws + WS_PROJ); bf16* KN = (bf16*)(F.ws + WS_KN); const float* kgp = arg_in(8) + l * HD;
    const int gw = GW_ID(F), NGW = GW_N(F), lane = fresh_lane(), sc = (lane & 15) * 8;
    float kg[8];
#pragma unroll
    for (int e = 0; e < 8; ++e) kg[e] = kgp[sc + e];
    for (int row = gw; row < NTOK; row += NGW) {
#pragma unroll
        for (int q = 0; q < 2; ++q) { const int col = q * 512 + lane * 8;
            *(v4u*)(KN + (size_t)row * 1024 + col) = knorm8(*(const v4u*)(P + (size_t)row * PW + C_DK + col), kg); } }
}
__device__ __forceinline__ void dsa_attn_unit(const Frame& F, int l, int u) {
    const bf16* P = (const bf16*)(F.ws + WS_PROJ); const unsigned long long* MK = (const unsigned long long*)(F.ws + WS_MASK); bf16* BR = (bf16*)(F.ws + WS_BR);
    const float* qg = arg_in(7) + l * HD; const float* rbias = arg_in(19); const bf16* KN = (const bf16*)(F.ws + WS_KN);
    LAS float* biasL = (LAS float*)(F.lds + AT_TAB_OFF); LAS float* rowL = biasL + 128 + F.wave * 32;
    constexpr float C = 0.08838834764831845f * 1.4426950408889634f;
    {
        const int tid = F.wave * 64 + fresh_lane();
        const int lane = tid & 63, wave = F.wave, r32 = lane & 31, hi = lane >> 5, sr = tid >> 4, sc = (tid & 15) * 8;
        const int b = u >> 6, h = (u >> 3) & 7, qb = 7 - (u & 7), q0 = qb * 256, NT = 4 * (qb + 1); const size_t rb = (size_t)b * SEQ;
        __syncthreads();
        if (tid < 128) biasL[tid] = rbias[t5_bucket(tid) * NH + h] * 1.4426950408889634f;
        const float kg[8] = {1.f, 1.f, 1.f, 1.f, 1.f, 1.f, 1.f, 1.f};
        const int tq = q0 + 32 * wave + r32; bf16x8 qr[8];
        { v4u xs[8]; float s = 0.f;
#pragma unroll
          for (int d0 = 0; d0 < 8; ++d0) { const v4u x = *(const v4u*)(P + (rb + tq) * PW + C_DQ + h * HD + 16 * d0 + 8 * hi); xs[d0] = x;
              s += bflo(x.x) * bflo(x.x) + bfhi(x.x) * bfhi(x.x) + bflo(x.y) * bflo(x.y) + bfhi(x.y) * bfhi(x.y) + bflo(x.z) * bflo(x.z) + bfhi(x.z) * bfhi(x.z) + bflo(x.w) * bflo(x.w) + bfhi(x.w) * bfhi(x.w); }
          const float r = 1.0f / sqrtf(pair_sum(s) * (1.f / HD) + EPS);
#pragma unroll
          for (int d0 = 0; d0 < 8; ++d0) { const f32x4 g0 = *(const f32x4*)(qg + 16 * d0 + 8 * hi), g1 = *(const f32x4*)(qg + 16 * d0 + 8 * hi + 4); const v4u x = xs[d0];
              v4u o; o.x = pk2(bflo(x.x) * r * g0.x, bfhi(x.x) * r * g0.y); o.y = pk2(bflo(x.y) * r * g0.z, bfhi(x.y) * r * g0.w);
              o.z = pk2(bflo(x.z) * r * g1.x, bfhi(x.z) * r * g1.y); o.w = pk2(bflo(x.w) * r * g1.z, bfhi(x.w) * r * g1.w); qr[d0] = *reinterpret_cast<bf16x8*>(&o); } }
        const bf16* Kp = KN + h * HD; const bf16* Vp = P + C_DV + h * HD;
        KVRegs R; kv_load<1024>(R, Kp, Vp, rb, sr, sc); kv_write<false>(R, F.lds, sr, sc, kg);
        __syncthreads();
        float m_reg = -1e20f, l_reg = 0.f; f32x16 o[4] = {};
        const float b31 = biasL[127];
        unsigned long long mnext = MK[(rb + tq) * 32];
        for (int j = 0; j < NT; ++j) {
            LAS unsigned char* buf = F.lds + (j & 1) * 32768;
            const unsigned long long mw = mnext;
            if (j + 1 < NT) { kv_load<1024>(R, Kp, Vp, rb + 64 * (j + 1), sr, sc); mnext = MK[(rb + tq) * 32 + j + 1]; }
            if (64 * j <= q0 + 32 * wave + 31) {
                const unsigned mlo = (unsigned)mw, mhi = (unsigned)(mw >> 32);
                f32x16 p0, p1; qkt64(p0, p1, (const LAS char*)buf, qr, r32, hi);
                const int rel0 = tq - 64 * j;
                const bool nearb = (q0 + 32 * wave - (64 * j + 63)) < 113;
                float pmax = -1e30f;
#pragma unroll
                for (int r = 0; r < 16; ++r) { const int kk = crow(r, hi);
                    float b0 = b31, b1 = b31;
                    if (nearb) { int i0 = rel0 - kk, i1 = rel0 - kk - 32; i0 = i0 < 0 ? 0 : (i0 > 127 ? 127 : i0); i1 = i1 < 0 ? 0 : (i1 > 127 ? 127 : i1); b0 = biasL[i0]; b1 = biasL[i1]; }
                    const int t0 = __builtin_amdgcn_sbfe((int)mlo, kk, 1), t1 = __builtin_amdgcn_sbfe((int)mhi, kk, 1);
                    const unsigned x0 = __float_as_uint(fmaf(p0[r], C, b0)), x1 = __float_as_uint(fmaf(p1[r], C, b1));
                    p0[r] = __uint_as_float((x0 & (unsigned)t0) | (0xF149F2CAu & ~(unsigned)t0)); p1[r] = __uint_as_float((x1 & (unsigned)t1) | (0xF149F2CAu & ~(unsigned)t1));
                    pmax = fmaxf(pmax, fmaxf(p0[r], p1[r])); }
                pmax = pair_max(pmax);
                const float mn = fmaxf(m_reg, pmax), alpha = __builtin_amdgcn_exp2f(m_reg - mn); m_reg = mn;
                float ps = 0.f;
#pragma unroll
                for (int r = 0; r < 16; ++r) { p0[r] = __builtin_amdgcn_exp2f(p0[r] - mn); p1[r] = __builtin_amdgcn_exp2f(p1[r] - mn); ps += p0[r] + p1[r]; }
                l_reg = l_reg * alpha + pair_sum(ps);
                if (__any(alpha < 1.f)) { if (hi == 0) rowL[r32] = alpha; LDS_WAIT(); asm volatile("" ::: "memory");
#pragma unroll
                    for (int r = 0; r < 16; ++r) { const float a = rowL[crow(r, hi)];
#pragma unroll
                        for (int d = 0; d < 4; ++d) o[d][r] *= a; }
                    LDS_WAIT(); asm volatile("" ::: "memory"); }
                bf16x8 pa0, pa1, pa2, pa3; PK4(p0, 0, pa0); PK4(p0, 8, pa1); PK4(p1, 0, pa2); PK4(p1, 8, pa3);
                pv_all(o, (int)(size_t)(buf + 16384) + v_rd_base(lane), pa0, pa1, pa2, pa3);
            }
            if (j + 1 < NT) kv_write<false>(R, F.lds + ((j + 1) & 1) * 32768, sr, sc, kg);
            __syncthreads();
        }
        if (hi == 0) rowL[r32] = 1.0f / l_reg;
        LDS_WAIT(); asm volatile("" ::: "memory");
        const size_t row0 = rb + q0 + 32 * wave;
#pragma unroll
        for (int r = 0; r < 16; ++r) { const float a = rowL[crow(r, hi)]; bf16* op = BR + (row0 + crow(r, hi)) * 3072 + 1024 + h * HD + r32;
#pragma unroll
            for (int d = 0; d < 4; ++d) op[32 * d] = (bf16)f2bf(o[d][r] * a); }
    }
}

__device__ __forceinline__ void sb_attn_unit(const Frame& F, int u) {
    const bf16* P = (const bf16*)(F.ws + WS_PROJ); bf16* BR = (bf16*)(F.ws + WS_BR);
    LAS unsigned* flagL = (LAS unsigned*)(F.lds + AT_TAB_OFF + 2048);
    {
        const int tid = F.wave * 64 + fresh_lane();
        const int lane = tid & 63, wave = F.wave, r32 = lane & 31, hi = lane >> 5, sr = tid >> 4, sc = (tid & 15) * 8;
        const int b = u >> 6, h = (u >> 3) & 7, qb = u & 7, q0 = qb * 256, NT = 4 * (qb + 1); const size_t rb = (size_t)b * SEQ;
        const float kgd[8] = {1.f, 1.f, 1.f, 1.f, 1.f, 1.f, 1.f, 1.f};
        const int tq = q0 + 32 * wave + r32; bf16x8 qr[8];
#pragma unroll
        for (int d0 = 0; d0 < 8; ++d0) { const v4u x = *(const v4u*)(P + (rb + tq) * PW + C_SQ + h * HD + 16 * d0 + 8 * hi); const float s = 0.08838834764831845f;
            v4u o; o.x = pk2(bflo(x.x) * s, bfhi(x.x) * s); o.y = pk2(bflo(x.y) * s, bfhi(x.y) * s); o.z = pk2(bflo(x.z) * s, bfhi(x.z) * s); o.w = pk2(bflo(x.w) * s, bfhi(x.w) * s); qr[d0] = *reinterpret_cast<bf16x8*>(&o); }
        const bf16* Kp = P + C_SK + h * HD; const bf16* Vp = P + C_SV + h * HD;
        __syncthreads();
        KVRegs R; kv_load<PW>(R, Kp, Vp, rb + 64 * (NT - 1), sr, sc); kv_write<false>(R, F.lds, sr, sc, kgd);
        __syncthreads();
        float carry = 1.f; f32x16 o[4] = {};
        int it = 0;
        for (int j = NT - 1; j >= 0; --j, ++it) {
            LAS unsigned char* buf = F.lds + (it & 1) * 32768;
            if (j > 0) kv_load<PW>(R, Kp, Vp, rb + 64 * (j - 1), sr, sc);
            if (64 * j < q0 + 32 * wave + 31) {
                f32x16 p0, p1; qkt64(p0, p1, (const LAS char*)buf, qr, r32, hi);
                const int rel0 = tq - 64 * j;
                float To[8];
#pragma unroll
                for (int a = 0; a < 8; ++a) {
                    float n[4], sg[4];
#pragma unroll
                    for (int e = 0; e < 4; ++e) { const int r = 4 * (a & 3) + e, kk = crow(r, hi) + (a >= 4 ? 32 : 0);
                        float z = (a >= 4) ? p1[r] : p0[r]; z = fminf(fmaxf(z, -60.f), 60.f);
                        const float ex = __builtin_amdgcn_exp2f(-z * 1.4426950408889634f), s1 = __builtin_amdgcn_rcpf(1.f + ex);
                        const bool ok = kk < rel0; sg[e] = ok ? s1 : 0.f; n[e] = ok ? ex * s1 : 1.f; }
                    const float e2 = n[3], e1 = e2 * n[2], e0 = e1 * n[1]; To[a] = e0 * n[0];
                    if (a >= 4) { p1[4 * (a & 3) + 3] = sg[3]; p1[4 * (a & 3) + 2] = sg[2] * e2; p1[4 * (a & 3) + 1] = sg[1] * e1; p1[4 * (a & 3)] = sg[0] * e0; }
                    else { p0[4 * a + 3] = sg[3]; p0[4 * a + 2] = sg[2] * e2; p0[4 * a + 1] = sg[1] * e1; p0[4 * a] = sg[0] * e0; }
                }
                float run = carry;
#pragma unroll
                for (int a = 7; a >= 0; --a) { const float Tp = __shfl_xor(To[a], 32);
                    const float E = hi ? run : run * Tp; run = run * To[a] * Tp;
#pragma unroll
                    for (int e = 0; e < 4; ++e) { if (a >= 4) p1[4 * (a & 3) + e] *= E; else p0[4 * a + e] *= E; } }
                carry = run;
                bf16x8 pa0, pa1, pa2, pa3; PK4(p0, 0, pa0); PK4(p0, 8, pa1); PK4(p1, 0, pa2); PK4(p1, 8, pa3);
                pv_all(o, (int)(size_t)(buf + 16384) + v_rd_base(lane), pa0, pa1, pa2, pa3);
            }
            if (lane == 0) flagL[(it & 1) * 8 + wave] = __all(carry < 1e-30f) ? 1u : 0u;
            if (j > 0) kv_write<false>(R, F.lds + ((it + 1) & 1) * 32768, sr, sc, kgd);
            __syncthreads();
            unsigned done = 1u;
#pragma unroll
            for (int w = 0; w < 8; ++w) done &= flagL[(it & 1) * 8 + w];
            if (done) break;
        }
        const size_t row0 = rb + q0 + 32 * wave;
#pragma unroll
        for (int r = 0; r < 16; ++r) { bf16* op = BR + (row0 + crow(r, hi)) * 3072 + 2048 + h * HD + r32;
#pragma unroll
            for (int d = 0; d < 4; ++d) op[32 * d] = (bf16)f2bf(o[d][r]); }
    }
}

__device__ __forceinline__ void mixc_program(const Frame& F, int l) {
    if (F.G == 256) {
        const int g = F.vcu >> 3, j = F.vcu & 7;
#ifndef MIXC_REP_DSA
#define MIXC_REP_DSA 1
#define MIXC_REP_ML 1
#define MIXC_REP_SB 1
#endif
        for (int rp = 0; rp < MIXC_REP_DSA; ++rp) { dsa_attn_unit(F, l, F.vcu); __syncthreads(); }
        const int nml = (j < 2) ? 0 : (j < 6 ? 1 : 2), ml0 = (j < 2) ? 0 : (j < 6 ? j - 2 : 4 + 2 * (j - 6));
        for (int rp = 0; rp < MIXC_REP_ML; ++rp) for (int k = 0; k < nml; ++k) ml_out_unit(F, l, g * 8 + ml0 + k);
        __syncthreads();
        const int nsb = (j < 4) ? 0 : (j == 4 ? 1 : (j == 7 ? 3 : 2)), sb0 = (j == 4) ? 0 : (j == 5 ? 1 : (j == 6 ? 3 : 5));
        for (int rp = 0; rp < MIXC_REP_SB; ++rp) for (int k = 0; k < nsb; ++k) sb_attn_unit(F, g * 8 + sb0 + k);
    } else {
        for (int u = F.vcu; u < 256; u += F.G) dsa_attn_unit(F, l, u);
        __syncthreads();
        for (int u = F.vcu; u < 256; u += F.G) ml_out_unit(F, l, u);
        __syncthreads();
        for (int u = F.vcu; u < 256; u += F.G) sb_attn_unit(F, u);
    }
    __syncthreads();
}
template <int LDA, int LDB> struct SchedDense {
    static constexpr bool GATHER = false;
    pg8::TileOrder T; const char* A; const char* B;
    __device__ __forceinline__ bool next(int i, pg8::Unit& u) const { u.e = 0; u.rows = 256; return T.tile(i, u.pm, u.pn); }
    __device__ __forceinline__ const char* a_base(const pg8::Unit& u) const { return A + (size_t)u.pm * 256 * LDA * 2; }
    __device__ __forceinline__ const char* b_base(const pg8::Unit& u) const { return B + (size_t)u.pn * 256 * LDB * 2; }
    __device__ __forceinline__ void a_off(const pg8::Unit&, int tid, unsigned (&v0)[2], unsigned (&v1)[2]) const {
        int R[2], C[2];
#pragma unroll
        for (int i = 0; i < 2; ++i) pg8::stage_rc(tid * 16 + i * 8192, R[i], C[i]);
#pragma unroll
        for (int i = 0; i < 2; ++i) { v0[i] = (unsigned)(R[i] * LDA + C[i]) * 2u; v1[i] = v0[i] + 128u * LDA * 2u; } }
};
struct EpiProj {
    static constexpr bool PERM = true;
    static constexpr bool PROBE2 = true;
    __device__ __forceinline__ bool zero_after(const pg8::Unit&) const { return true; }
    bf16* O; float* GIF;
    __device__ __forceinline__ void operator()(const f32x4 (&acc)[2][2][4][2], const pg8::Unit& u, int wr, int wc, int fr, int fq) const {
        const int row0 = u.pm * 256 + wr * 64 + fr, col0 = u.pn * 256 + wc * 32 + 8 * fq;
#pragma unroll
        for (int ai = 0; ai < 2; ++ai)
#pragma unroll
            for (int m = 0; m < 4; ++m) { bf16* rowp = O + (size_t)(row0 + ai * 128 + m * 16) * PW + col0;
#pragma unroll
                for (int bj = 0; bj < 2; ++bj) { const f32x4 v0 = acc[ai][bj][m][0], v1 = acc[ai][bj][m][1];
                    v4u w; w.x = cvt_pk_bf16(v0[0], v0[1]); w.y = cvt_pk_bf16(v0[2], v0[3]); w.z = cvt_pk_bf16(v1[0], v1[1]); w.w = cvt_pk_bf16(v1[2], v1[3]);
                    *(v4u*)(rowp + bj * 128) = w;
                    if (u.pn == PW / 256 - 1 && bj == 0 && wc == 0 && fq < 2) { float* gp = GIF + (size_t)(row0 + ai * 128 + m * 16) * 16 + 8 * fq; *(f32x4*)gp = v0; *(f32x4*)(gp + 4) = v1; } } }
    }
};
#ifdef PROBE_GEMM
template <int MODE> struct SchedProbe {
    static constexpr bool GATHER = false;
    pg8::TileOrder T; const char* A; const char* B;
    __device__ __forceinline__ bool next(int i, pg8::Unit& u) const { u.e = 0; u.rows = 256; return T.tile(i, u.pm, u.pn); }
    __device__ __forceinline__ const char* a_base(const pg8::Unit& u) const { return A + (size_t)((MODE & 2) ? 0 : u.pm) * 256 * DM * 2; }
    __device__ __forceinline__ const char* b_base(const pg8::Unit& u) const { return B + (size_t)((MODE & 1) ? 0 : u.pn) * 256 * DM * 2; }
    __device__ __forceinline__ void a_off(const pg8::Unit&, int tid, unsigned (&v0)[2], unsigned (&v1)[2]) const {
        int R[2], C[2];
#pragma unroll
        for (int i = 0; i < 2; ++i) pg8::stage_rc(tid * 16 + i * 8192, R[i], C[i]);
#pragma unroll
        for (int i = 0; i < 2; ++i) { v0[i] = (unsigned)(R[i] * DM + C[i]) * 2u; v1[i] = v0[i] + 128u * DM * 2u; } }
};
struct EpiProbe {
    static constexpr bool PERM = true;
    static constexpr bool PROBE2 = false;
    __device__ __forceinline__ bool zero_after(const pg8::Unit&) const { return true; }
    bf16* O;
    __device__ __forceinline__ void operator()(const f32x4 (&acc)[2][2][4][2], const pg8::Unit& u, int wr, int wc, int fr, int fq) const {
        const int row0 = ((u.pm * 256) & 1023) + wr * 64 + fr, col0 = u.pn * 256 + wc * 32 + 8 * fq;
#pragma unroll
        for (int ai = 0; ai < 2; ++ai)
#pragma unroll
            for (int m = 0; m < 4; ++m) { bf16* rowp = O + (size_t)(row0 + ai * 128 + m * 16) * PW + col0;
#pragma unroll
                for (int bj = 0; bj < 2; ++bj) { const f32x4 v0 = acc[ai][bj][m][0], v1 = acc[ai][bj][m][1];
                    v4u w; w.x = cvt_pk_bf16(v0[0], v0[1]); w.y = cvt_pk_bf16(v0[2], v0[3]); w.z = cvt_pk_bf16(v1[0], v1[1]); w.w = cvt_pk_bf16(v1[2], v1[3]);
                    *(v4u*)(rowp + bj * 128) = w; } }
    }
};
#endif
struct SchedBranch {
    static constexpr bool GATHER = false;
    pg8::TileOrder T; const char* A; const char* B;
    __device__ __forceinline__ bool next(int i, pg8::Unit& u) const { u.e = i % 3; u.rows = 256; return T.tile(i / 3, u.pm, u.pn); }
    __device__ __forceinline__ const char* a_base(const pg8::Unit& u) const { return A + ((size_t)u.pm * 256 * 3072 + (size_t)u.e * 1024) * 2; }
    __device__ __forceinline__ const char* b_base(const pg8::Unit& u) const { return B + ((size_t)u.e * 2048 + (size_t)u.pn * 256) * 1024 * 2; }
    __device__ __forceinline__ void a_off(const pg8::Unit&, int tid, unsigned (&v0)[2], unsigned (&v1)[2]) const {
        int R[2], C[2];
#pragma unroll
        for (int i = 0; i < 2; ++i) pg8::stage_rc(tid * 16 + i * 8192, R[i], C[i]);
#pragma unroll
        for (int i = 0; i < 2; ++i) { v0[i] = (unsigned)(R[i] * 3072 + C[i]) * 2u; v1[i] = v0[i] + 128u * 3072u * 2u; } }
};
struct EpiBranch {
    static constexpr bool PERM = true;
    static constexpr bool PROBE2 = false;
    __device__ __forceinline__ bool zero_after(const pg8::Unit& u) const { return u.e == 2; }
    const bf16* P; bf16* O;
    __device__ __forceinline__ void operator()(f32x4 (&acc)[2][2][4][2], const pg8::Unit& u, int wr, int wc, int fr, int fq) const {
        const int row0 = u.pm * 256 + wr * 64 + fr, col0 = u.pn * 256 + wc * 32 + 8 * fq;
#pragma unroll
        for (int ai = 0; ai < 2; ++ai)
#pragma unroll
            for (int m = 0; m < 4; ++m) { const size_t row = (size_t)(row0 + ai * 128 + m * 16);
#pragma unroll
                for (int bj = 0; bj < 2; ++bj) { const int col = col0 + bj * 128;
                    const v4u ga = *(const v4u*)(P + row * PW + C_G + u.e * 2048 + col);
                    float f[8];
                    { const float a[8] = {bflo(ga.x), bfhi(ga.x), bflo(ga.y), bfhi(ga.y), bflo(ga.z), bfhi(ga.z), bflo(ga.w), bfhi(ga.w)};
#pragma unroll
                      for (int e = 0; e < 8; ++e) f[e] = 1.0f / (1.0f + __expf(-fminf(fmaxf(a[e], -30.f), 30.f))); }
                    if (u.e < 2) { const v4u gb = *(const v4u*)(P + row * PW + C_G + (u.e + 1) * 2048 + col);
                        const float b[8] = {bflo(gb.x), bfhi(gb.x), bflo(gb.y), bfhi(gb.y), bflo(gb.z), bfhi(gb.z), bflo(gb.w), bfhi(gb.w)};
#pragma unroll
                        for (int e = 0; e < 8; ++e) f[e] *= 1.0f + __expf(-fminf(fmaxf(b[e], -30.f), 30.f)); }
                    f32x4 v0 = acc[ai][bj][m][0], v1 = acc[ai][bj][m][1];
                    v0[0] *= f[0]; v0[1] *= f[1]; v0[2] *= f[2]; v0[3] *= f[3]; v1[0] *= f[4]; v1[1] *= f[5]; v1[2] *= f[6]; v1[3] *= f[7];
                    if (u.e < 2) { acc[ai][bj][m][0] = v0; acc[ai][bj][m][1] = v1; }
                    else { v4u w; w.x = cvt_pk_bf16(v0[0], v0[1]); w.y = cvt_pk_bf16(v0[2], v0[3]); w.z = cvt_pk_bf16(v1[0], v1[1]); w.w = cvt_pk_bf16(v1[2], v1[3]);
                        *(v4u*)(O + row * DM + col) = w; } } }
    }
};
struct EpiOut {
    static constexpr bool PERM = false;
    static constexpr bool PROBE2 = false;
    __device__ __forceinline__ bool zero_after(const pg8::Unit&) const { return true; }
    const float* base; float* out;
    __device__ __forceinline__ void operator()(const f32x4 (&acc)[2][2][4][2], const pg8::Unit& u, int wr, int wc, int fr, int fq) const {
        const int row0 = u.pm * 256 + wr * 64 + fr, col0 = u.pn * 256 + wc * 32 + 4 * fq;
#pragma unroll
        for (int ai = 0; ai < 2; ++ai)
#pragma unroll
            for (int m = 0; m < 4; ++m) { const size_t off = (size_t)(row0 + ai * 128 + m * 16) * DM + col0;
#pragma unroll
                for (int bj = 0; bj < 2; ++bj)
#pragma unroll
                    for (int n = 0; n < 2; ++n) { const f32x4 bs = *(const f32x4*)(base + off + bj * 128 + n * 16); *(f32x4*)(out + off + bj * 128 + n * 16) = bs + acc[ai][bj][m][n]; } }
    }
};

#ifndef MK_NAIVE_MOE
#define MK_NAIVE_MOE 0
#endif
#ifndef PROBE_MASK
#define PROBE_MASK 0
#endif
#ifndef OFFMASK
#define OFFMASK 0
#endif
#ifndef CVT_FIRST
#define CVT_FIRST 4
#endif
constexpr int PH_PRE = 0, PH_INPROJ = 1, PH_MIXA = 2, PH_MIXB = 3, PH_MIXC = 4, PH_BRANCH = 5, PH_OUT = 6, PH_NORM2 = 7, PH_MOE = 8, PH_MOED = 9, NPH_L = 10,
              PH_FINAL = DEPTH * NPH_L, NPH = PH_FINAL + 1;

__global__ void __launch_bounds__(NTHR, 2) fwd_kernel(Args args) {
    extern __shared__ __attribute__((aligned(16))) unsigned char lds_raw[];
    Frame F;
    F.lds = (LAS unsigned char*)lds_raw;
    F.wave = __builtin_amdgcn_readfirstlane((int)threadIdx.x >> 6);
    const int wave0 = F.wave;
    F.G = gridDim.x; { const int bx = blockIdx.x; F.vcu = (F.G % 8 == 0) ? (bx % 8) * (F.G / 8) + bx / 8 : bx; }
    F.ws = args.ws; F.ctl = (unsigned*)(args.ws + WS_CTL);
    volatile LAS unsigned* MISC = (volatile LAS unsigned*)(F.lds + LDSCTL_OFF);
    for (int u = threadIdx.x; u < (LDS_BYTES - LDSCTL_OFF) / 4; u += NTHR) ((LAS unsigned*)(F.lds + LDSCTL_OFF))[u] = 0u;
    __syncthreads();
    XcdBarrier bar; bar.bar = F.ctl + CW_BAR; bar.x = 0; bar.st = nullptr;
    if (args.use_bar) bar = xcd_barrier_post(F.ctl + CW_BAR, MISC + 8);
    const int lo = args.ph_lo, hi = args.ph_hi;
#define IN(k) (lo <= (k) && (k) < hi)
#define FRESH() do { F.wave = wave0; F.ws = arg_ws(); F.ctl = (unsigned*)(F.ws + WS_CTL); } while (0)
#define SEAM(k) do { if (args.use_bar && IN((k) + 1)) { FRESH(); xcd_barrier(bar, (F.wave * 64 + fresh_lane())); } } while (0)
#define REPS(k) for (int rep_ = 0; rep_ < (int)((args.reps >> (2 * (k))) & 3u); ++rep_)
#define RSYNC() do { if (rep_) __syncthreads(); } while (0)
    { constexpr int l = 0; constexpr int p0 = 0;
        if (IN(p0 + PH_PRE)) { FRESH();
            _Pragma("unroll 1") REPS(0) { RSYNC(); ph_convw(F, l); }
            _Pragma("unroll 1") REPS(1) { RSYNC(); ph_norm1(F, l); }
            SEAM(p0 + PH_PRE); }
        if (IN(p0 + PH_INPROJ)) { FRESH();
            { SchedDense<DM, DM> S; S.T.init(NTOK / 256, PW / 256, F.G, (int)blockIdx.x); S.A = (const char*)(F.ws + WS_XN); S.B = (const char*)(F.ws + WS_WIN);
              EpiProj E{(bf16*)(F.ws + WS_PROJ), gif_ptr(F)};
              _Pragma("unroll 1") REPS(10) { RSYNC(); pg8::gemm_phase<SchedDense<DM, DM>, EpiProj, DM, DM, DM, true>(F.lds, S, E, (F.wave * 64 + fresh_lane())); } }
#ifdef PROBE_GEMM
            { __syncthreads(); SchedProbe<PROBE_GEMM> S; S.T.init(NTOK / 256, PW / 256, F.G, (int)blockIdx.x); S.A = (const char*)(F.ws + WS_XN); S.B = (const char*)(F.ws + WS_WIN);
              EpiProbe E{(bf16*)(F.ws + WS_TMP)};
              pg8::gemm_phase<SchedProbe<PROBE_GEMM>, EpiProbe, DM, DM, DM, true>(F.lds, S, E, (F.wave * 64 + fresh_lane())); }
#endif
            SEAM(p0 + PH_INPROJ); }
        if (IN(p0 + PH_MIXA)) { FRESH();
            _Pragma("unroll 1") REPS(2) { RSYNC(); ml_delta(F, l); }
            __syncthreads();
            _Pragma("unroll 1") REPS(5) { RSYNC(); dsa_index(F); }
            dsa_knorm(F, l);
            SEAM(p0 + PH_MIXA); }
        if (IN(p0 + PH_MIXB)) { FRESH();
            _Pragma("unroll 1") REPS(3) { RSYNC(); ml_scan(F); }
            SEAM(p0 + PH_MIXB); }
        if (IN(p0 + PH_MIXC)) { FRESH();
            _Pragma("unroll 1") REPS(6) { RSYNC(); mixc_program(F, l); }
            SEAM(p0 + PH_MIXC); }
        if (IN(p0 + PH_BRANCH)) { FRESH();
            SchedBranch S; S.T.init(NTOK / 256, DM / 256, F.G, (int)blockIdx.x); S.A = (const char*)(F.ws + WS_BR); S.B = (const char*)(F.ws + WS_WBR);
            EpiBranch E{(const bf16*)(F.ws + WS_PROJ), (bf16*)(F.ws + WS_MRG)};
            _Pragma("unroll 1") REPS(11) { RSYNC(); pg8::gemm_phase<SchedBranch, EpiBranch, BW, 3072, BW, true>(F.lds, S, E, (F.wave * 64 + fresh_lane())); }
            SEAM(p0 + PH_BRANCH); }
        if (IN(p0 + PH_OUT)) { FRESH();
            SchedDense<DM, DM> S; S.T.init(NTOK / 256, DM / 256, F.G, (int)blockIdx.x); S.A = (const char*)(F.ws + WS_MRG); S.B = (const char*)(F.ws + WS_WOUT);
            EpiOut E{l == 0 ? arg_in(0) : (const float*)(F.ws + WS_XA), (float*)(F.ws + WS_X1)};
            _Pragma("unroll 1") REPS(12) { RSYNC(); pg8::gemm_phase<SchedDense<DM, DM>, EpiOut, DM, DM, DM, true>(F.lds, S, E, (F.wave * 64 + fresh_lane())); }
            SEAM(p0 + PH_OUT); }
        if (IN(p0 + PH_NORM2)) { FRESH(); _Pragma("unroll 1") REPS(8) { RSYNC(); ph_norm2_mfma(F, l); } SEAM(p0 + PH_NORM2); }
        if (IN(p0 + PH_MOE)) { FRESH();
            moe_tables(F, l);
            SchedMoeUp S; S.tp = (const LAS int*)(F.lds + MOE_TAB_OFF); S.cn = S.tp + 40; S.sb = S.cn + 40; S.G = F.G; S.c = (int)blockIdx.x;
            S.A = (const char*)(F.ws + WS_XN); S.B = (const char*)(F.ws + WS_WGU); S.list = (const int*)(F.ws + WS_LIST);
            EpiMoeUp E{(bf16*)(F.ws + WS_HB), S.sb};
            _Pragma("unroll 1") REPS(13) { RSYNC(); pg8::gemm_phase<SchedMoeUp, EpiMoeUp, DM, DM, DM, true>(F.lds, S, E, (F.wave * 64 + fresh_lane())); }
            SEAM(p0 + PH_MOE); }
        if (IN(p0 + PH_MOED)) { FRESH();
            moe_tables(F, l);
            SchedMoeDown S; S.tp = (const LAS int*)(F.lds + MOE_TAB_OFF); S.cn = S.tp + 40; S.sb = S.cn + 40; S.G = F.G; S.c = (int)blockIdx.x;
            S.A = (const char*)(F.ws + WS_HB); S.B = (const char*)(F.ws + WS_WDN);
            EpiMoeDown E{(bf16*)(F.ws + WS_YB), (const int*)(F.ws + WS_LIST), (const int*)tokinfo_ptr(F)};
            _Pragma("unroll 1") REPS(14) { RSYNC(); pg8::gemm_phase<SchedMoeDown, EpiMoeDown, DEXP, DEXP, DEXP, true>(F.lds, S, E, (F.wave * 64 + fresh_lane())); }
            SEAM(p0 + PH_MOED); }
    }
    { constexpr int l = 1; constexpr int p0 = NPH_L;
        if (IN(p0 + PH_PRE)) { FRESH();
            _Pragma("unroll 1") REPS(0) { RSYNC(); ph_convw(F, l); }
            _Pragma("unroll 1") REPS(1) { RSYNC(); ph_norm1(F, l); }
            SEAM(p0 + PH_PRE); }
        if (IN(p0 + PH_INPROJ)) { FRESH();
            { SchedDense<DM, DM> S; S.T.init(NTOK / 256, PW / 256, F.G, (int)blockIdx.x); S.A = (const char*)(F.ws + WS_XN); S.B = (const char*)(F.ws + WS_WIN);
              EpiProj E{(bf16*)(F.ws + WS_PROJ), gif_ptr(F)};
              _Pragma("unroll 1") REPS(10) { RSYNC(); pg8::gemm_phase<SchedDense<DM, DM>, EpiProj, DM, DM, DM, true>(F.lds, S, E, (F.wave * 64 + fresh_lane())); } }
#ifdef PROBE_GEMM
            { __syncthreads(); SchedProbe<PROBE_GEMM> S; S.T.init(NTOK / 256, PW / 256, F.G, (int)blockIdx.x); S.A = (const char*)(F.ws + WS_XN); S.B = (const char*)(F.ws + WS_WIN);
              EpiProbe E{(bf16*)(F.ws + WS_TMP)};
              pg8::gemm_phase<SchedProbe<PROBE_GEMM>, EpiProbe, DM, DM, DM, true>(F.lds, S, E, (F.wave * 64 + fresh_lane())); }
#endif
            SEAM(p0 + PH_INPROJ); }
        if (IN(p0 + PH_MIXA)) { FRESH();
            _Pragma("unroll 1") REPS(2) { RSYNC(); ml_delta(F, l); }
            __syncthreads();
            _Pragma("unroll 1") REPS(5) { RSYNC(); dsa_index(F); }
            dsa_knorm(F, l);
            SEAM(p0 + PH_MIXA); }
        if (IN(p0 + PH_MIXB)) { FRESH();
            _Pragma("unroll 1") REPS(3) { RSYNC(); ml_scan(F); }
            SEAM(p0 + PH_MIXB); }
        if (IN(p0 + PH_MIXC)) { FRESH();
            _Pragma("unroll 1") REPS(6) { RSYNC(); mixc_program(F, l); }
            SEAM(p0 + PH_MIXC); }
        if (IN(p0 + PH_BRANCH)) { FRESH();
            SchedBranch S; S.T.init(NTOK / 256, DM / 256, F.G, (int)blockIdx.x); S.A = (const char*)(F.ws + WS_BR); S.B = (const char*)(F.ws + WS_WBR);
            EpiBranch E{(const bf16*)(F.ws + WS_PROJ), (bf16*)(F.ws + WS_MRG)};
            _Pragma("unroll 1") REPS(11) { RSYNC(); pg8::gemm_phase<SchedBranch, EpiBranch, BW, 3072, BW, true>(F.lds, S, E, (F.wave * 64 + fresh_lane())); }
            SEAM(p0 + PH_BRANCH); }
        if (IN(p0 + PH_OUT)) { FRESH();
            SchedDense<DM, DM> S; S.T.init(NTOK / 256, DM / 256, F.G, (int)blockIdx.x); S.A = (const char*)(F.ws + WS_MRG); S.B = (const char*)(F.ws + WS_WOUT);
            EpiOut E{l == 0 ? arg_in(0) : (const float*)(F.ws + WS_XA), (float*)(F.ws + WS_X1)};
            _Pragma("unroll 1") REPS(12) { RSYNC(); pg8::gemm_phase<SchedDense<DM, DM>, EpiOut, DM, DM, DM, true>(F.lds, S, E, (F.wave * 64 + fresh_lane())); }
            SEAM(p0 + PH_OUT); }
        if (IN(p0 + PH_NORM2)) { FRESH(); _Pragma("unroll 1") REPS(8) { RSYNC(); ph_norm2_mfma(F, l); } SEAM(p0 + PH_NORM2); }
        if (IN(p0 + PH_MOE)) { FRESH();
            moe_tables(F, l);
            SchedMoeUp S; S.tp = (const LAS int*)(F.lds + MOE_TAB_OFF); S.cn = S.tp + 40; S.sb = S.cn + 40; S.G = F.G; S.c = (int)blockIdx.x;
            S.A = (const char*)(F.ws + WS_XN); S.B = (const char*)(F.ws + WS_WGU); S.list = (const int*)(F.ws + WS_LIST);
            EpiMoeUp E{(bf16*)(F.ws + WS_HB), S.sb};
            _Pragma("unroll 1") REPS(13) { RSYNC(); pg8::gemm_phase<SchedMoeUp, EpiMoeUp, DM, DM, DM, true>(F.lds, S, E, (F.wave * 64 + fresh_lane())); }
            SEAM(p0 + PH_MOE); }
        if (IN(p0 + PH_MOED)) { FRESH();
            moe_tables(F, l);
            SchedMoeDown S; S.tp = (const LAS int*)(F.lds + MOE_TAB_OFF); S.cn = S.tp + 40; S.sb = S.cn + 40; S.G = F.G; S.c = (int)blockIdx.x;
            S.A = (const char*)(F.ws + WS_HB); S.B = (const char*)(F.ws + WS_WDN);
            EpiMoeDown E{(bf16*)(F.ws + WS_YB), (const int*)(F.ws + WS_LIST), (const int*)tokinfo_ptr(F)};
            _Pragma("unroll 1") REPS(14) { RSYNC(); pg8::gemm_phase<SchedMoeDown, EpiMoeDown, DEXP, DEXP, DEXP, true>(F.lds, S, E, (F.wave * 64 + fresh_lane())); }
            SEAM(p0 + PH_MOED); }
    }
    if (IN(PH_FINAL)) { FRESH(); } if (IN(PH_FINAL)) ph_final(F, args.out);
#undef IN
#undef SEAM
}

#ifndef MK_ONE_LAUNCH
#define MK_ONE_LAUNCH 1
#endif
extern "C" void kernel_launch(void* const* d_in, const int* in_sizes, int n_in, void* d_out, int out_size, void* d_ws, size_t ws_size, hipStream_t stream) {
    static int grid = 0;
    if (grid == 0) {
        if (n_in != 20 || in_sizes[0] != NTOK * DM || out_size != NTOK * DM || ws_size < WS_END) { fprintf(stderr, "kernel_launch: shape mismatch (n_in %d, ws %zu < %zu?)\n", n_in, ws_size, (size_t)WS_END); grid = -1; return; }
        int dev = 0, cus = 0, per_cu = 0;
        if (hipGetDevice(&dev) != hipSuccess || hipDeviceGetAttribute(&cus, hipDeviceAttributeMultiprocessorCount, dev) != hipSuccess) { grid = -1; return; }
        if (hipFuncSetAttribute((const void*)fwd_kernel, hipFuncAttributeMaxDynamicSharedMemorySize, LDS_BYTES) != hipSuccess) { fprintf(stderr, "kernel_launch: hipFuncSetAttribute failed\n"); grid = -1; return; }
        if (hipOccupancyMaxActiveBlocksPerMultiprocessor(&per_cu, (const void*)fwd_kernel, NTHR, LDS_BYTES) != hipSuccess || per_cu < 1) fprintf(stderr, "kernel_launch: occupancy query says %d\n", per_cu);
        (void)hipGetLastError();
        grid = cus;
    }
    if (grid < 0) return;
    if (hipMemsetAsync((char*)d_ws + WS_CTL, 0, CTL_ZERO_BYTES, stream) != hipSuccess) return;
    Args a{};
    for (int i = 0; i < 20; ++i) a.in[i] = (const float*)d_in[i];
    a.out = (float*)d_out; a.ws = (unsigned char*)d_ws;
    { unsigned r = 0; for (int k = 0; k < 15; ++k) r |= (1u + ((PROBE_MASK >> k) & 1u)) << (2 * k); a.reps = r; }
#if MK_ONE_LAUNCH
    a.ph_lo = 0; a.ph_hi = NPH; a.use_bar = 1;
    hipLaunchKernelGGL(fwd_kernel, dim3(grid), dim3(NTHR), LDS_BYTES, stream, a);
#else
    for (int ph = 0; ph < NPH; ++ph) { a.ph_lo = ph; a.ph_hi = ph + 1; a.use_bar = 0;
        hipLaunchKernelGGL(fwd_kernel, dim3(grid), dim3(NTHR), LDS_BYTES, stream, a); }
#endif
    const hipError_t le = hipPeekAtLastError();
    if (le != hipSuccess) fprintf(stderr, "kernel_launch: launch failed: %s\n", hipGetErrorName(le));
}
```
